# Optimizing an MI355X kernel written in HIP

```python
import math
import jax, jax.numpy as jnp
from jax import lax
import numpy as np

D_MODEL = 2048
BATCH = 2
SEQ = 4096
DEPTH = 1

GRID_W = 64
CTX_LEN = 256
N_ADA = 9
D_FF = 5632
SSM_WIDTH = 1024
SSM_GROUP = 16
SSM_GROUPS = SSM_WIDTH // SSM_GROUP
SSM_STATE = 64
RET_HEADS = 8
RET_DK = 128
RET_DV = 256
RET_QK_WIDTH = RET_HEADS * RET_DK
RET_V_WIDTH = RET_HEADS * RET_DV
RET_CHUNK = 128
ROPE_BASE = 10000.0
NORM_EPS = 1e-6
MIX_SPLITS = (SSM_WIDTH, RET_QK_WIDTH, RET_QK_WIDTH, RET_V_WIDTH, RET_V_WIDTH, D_MODEL, D_MODEL)
MIX_IN_WIDTH = sum(MIX_SPLITS)

kernel_name = "hybrid_s5_retention_macaron_dit_layer"


def rmsnorm(h, g):
    hf = h.astype(jnp.float32)
    hf = hf * lax.rsqrt(jnp.mean(hf * hf, axis=-1, keepdims=True) + NORM_EPS)
    return (hf * g.astype(jnp.float32)).astype(h.dtype)


def head_rmsnorm(o):
    of = o.astype(jnp.float32)
    return of * lax.rsqrt(jnp.mean(of * of, axis=-1, keepdims=True) + NORM_EPS)


def ada_pre(h, ada, i, g):
    return rmsnorm(h, g) * (1.0 + ada[:, :, 3 * i + 1]) + ada[:, :, 3 * i]


def ada_post(h, out, ada, i, g, res_w):
    return (h + res_w * ada[:, :, 3 * i + 2] * rmsnorm(out, g)).astype(h.dtype)


def swiglu(h, w_in, w_out):
    gt, up = jnp.split(h @ w_in, 2, axis=-1)
    return (jax.nn.silu(gt) * up) @ w_out


def _flip(t, axis, rev):
    return jnp.flip(t, axis=axis) if rev else t


def rope_1d(t, pos):
    half = t.shape[-1] // 2
    inv = ROPE_BASE ** (-jnp.arange(half, dtype=jnp.float32) / half)
    ang = pos.astype(jnp.float32)[:, None] * inv
    cos = jnp.cos(ang).astype(t.dtype)
    sin = jnp.sin(ang).astype(t.dtype)
    t1, t2 = t[..., :half], t[..., half:]
    return jnp.concatenate([t1 * cos - t2 * sin, t1 * sin + t2 * cos], axis=-1)


def rope_2d(t, row, col):
    half = t.shape[-1] // 2
    return jnp.concatenate([rope_1d(t[..., :half], row), rope_1d(t[..., half:], col)], axis=-1)


def split_heads(t, dh):
    b, l, _ = t.shape
    return t.reshape(b, l, -1, dh).transpose(0, 2, 1, 3)


def merge_heads(o):
    b, h, l, dh = o.shape
    return o.transpose(0, 2, 1, 3).reshape(b, l, h * dh)


def complex_affine_combine(e1, e2):
    a1r, a1i, b1r, b1i = e1
    a2r, a2i, b2r, b2i = e2
    ar = a2r * a1r - a2i * a1i
    ai = a2r * a1i + a2i * a1r
    br = a2r * b1r - a2i * b1i + b2r
    bi = a2r * b1i + a2i * b1r + b2i
    return ar, ai, br, bi


def s5_scan(u, lam_re, lam_im, log_step, b_re, b_im, c_re, c_im, h0_re, h0_im, with_output):
    f32 = jnp.float32
    lam_re, lam_im = lam_re.astype(f32), lam_im.astype(f32)
    b_re, b_im = b_re.astype(f32), b_im.astype(f32)
    step = jnp.exp(log_step.astype(f32))[:, None]
    mag = jnp.exp(lam_re * step)
    a_re, a_im = mag * jnp.cos(lam_im * step), mag * jnp.sin(lam_im * step)
    den = lam_re * lam_re + lam_im * lam_im
    num_re, num_im = a_re - 1.0, a_im
    k_re = (num_re * lam_re + num_im * lam_im) / den
    k_im = (num_im * lam_re - num_re * lam_im) / den
    bb_re = k_re[..., None] * b_re - k_im[..., None] * b_im
    bb_im = k_re[..., None] * b_im + k_im[..., None] * b_re
    x_re = jnp.einsum('blgc,gpc->lbgp', u, bb_re)
    x_im = jnp.einsum('blgc,gpc->lbgp', u, bb_im)
    x_re = x_re.at[0].add(a_re * h0_re - a_im * h0_im)
    x_im = x_im.at[0].add(a_re * h0_im + a_im * h0_re)
    seq_len = u.shape[1]
    ar = jnp.broadcast_to(a_re, (seq_len, 1) + a_re.shape)
    ai = jnp.broadcast_to(a_im, (seq_len, 1) + a_im.shape)
    _, _, h_re, h_im = lax.associative_scan(complex_affine_combine, (ar, ai, x_re, x_im), axis=0)
    final = (h_re[-1], h_im[-1])
    if not with_output:
        return None, final
    y = (jnp.einsum('lbgp,gcp->blgc', h_re, c_re.astype(f32))
         - jnp.einsum('lbgp,gcp->blgc', h_im, c_im.astype(f32)))
    return y, final


def retention_chunked(q, k, v, log_gamma, s0, strict, with_output):
    b, h, seq_len, dk = k.shape
    dv = v.shape[-1]
    n = seq_len // RET_CHUNK
    kc = k.reshape(b, h, n, RET_CHUNK, dk)
    vc = v.reshape(b, h, n, RET_CHUNK, dv)
    pos = jnp.arange(RET_CHUNK, dtype=jnp.float32)
    lg = log_gamma[:, None]
    w_end = jnp.exp(lg * (RET_CHUNK - 1.0 - pos))
    kv = jnp.einsum('bhncd,bhnce->nbhde', kc * w_end[None, :, None, :, None], vc)
    g_chunk = jnp.exp(log_gamma * RET_CHUNK)[None, :, None, None]

    def step(s, inc):
        return g_chunk * s + inc, s

    s_final, s_in = lax.scan(step, s0, kv)
    if not with_output:
        return None, s_final
    qc = q.reshape(b, h, n, RET_CHUNK, dk)
    diff = pos[:, None] - pos[None, :]
    mask = diff > 0 if strict else diff >= 0
    decay = jnp.where(mask, jnp.exp(lg[:, :, None] * jnp.where(mask, diff, 0.0)), 0.0)
    scores = jnp.einsum('bhnid,bhnjd->bhnij', qc, kc) * decay[None, :, None]
    o = jnp.einsum('bhnij,bhnje->bhnie', scores, vc)
    w_in = jnp.exp(lg * (pos + 1.0))
    o = o + jnp.einsum('bhnid,nbhde->bhnie', qc * w_in[None, :, None, :, None], s_in)
    return o.reshape(b, h, seq_len, dv), s_final


def merge_branches(y_ssm, o_ret, g, gs, gr, ssm_glu_w, ret_w_proj, mix_w_out):
    a = jax.nn.gelu(y_ssm)
    ga, gb = jnp.split(a @ ssm_glu_w, 2, axis=-1)
    ssm_branch = ga * jax.nn.sigmoid(gb)
    ret_branch = (jax.nn.silu(g) * o_ret) @ ret_w_proj
    merged = jax.nn.sigmoid(gs) * ssm_branch + jax.nn.sigmoid(gr) * ret_branch
    return merged @ mix_w_out


def token_mixer(u_x, u_c, w_in, lam_re, lam_im, log_step, b_re, b_im, c_re, c_im, d_skip,
                glu_w, decay_logit, ret_w_proj, w_out, with_ctx_out):
    f32 = jnp.float32
    b, seq_len, _ = u_x.shape
    ctx_len = u_c.shape[1]
    dt = u_x.dtype
    rows = seq_len // GRID_W
    row = jnp.repeat(jnp.arange(rows, dtype=jnp.int32), GRID_W)
    col = jnp.tile(jnp.arange(GRID_W, dtype=jnp.int32), rows)
    cuts = [int(v) for v in np.cumsum(MIX_SPLITS)[:-1]]
    s_x, q_x, k_x, v_x, g_x, gs_x, gr_x = jnp.split(u_x @ w_in, cuts, axis=-1)
    s_c, q_c, k_c, v_c, g_c, gs_c, gr_c = jnp.split(u_c @ w_in, cuts, axis=-1)

    us_x = s_x.astype(f32).reshape(b, seq_len, SSM_GROUPS, SSM_GROUP)
    us_c = s_c.astype(f32).reshape(b, ctx_len, SSM_GROUPS, SSM_GROUP)
    dg = d_skip.astype(f32).reshape(SSM_GROUPS, SSM_GROUP)
    y_x = dg * us_x
    y_c = dg * us_c
    h_zero = jnp.zeros((b, SSM_GROUPS, SSM_STATE), f32)
    for d in range(2):
        rev = d == 1
        prm = (lam_re[d], lam_im[d], log_step[d], b_re[d], b_im[d], c_re[d], c_im[d])
        yc_d, (hc_re, hc_im) = s5_scan(_flip(us_c, 1, rev), *prm, h_zero, h_zero, with_ctx_out)
        yx_d, _ = s5_scan(_flip(us_x, 1, rev), *prm, hc_re, hc_im, True)
        y_x = y_x + _flip(yx_d, 1, rev)
        if with_ctx_out:
            y_c = y_c + _flip(yc_d, 1, rev)

    q_scale = RET_DK ** -0.5
    qx = rope_2d(split_heads(q_x, RET_DK), row, col) * q_scale
    kx = rope_2d(split_heads(k_x, RET_DK), row, col)
    vx = split_heads(v_x, RET_DV)
    qc = split_heads(q_c, RET_DK) * q_scale
    kc = split_heads(k_c, RET_DK)
    vc = split_heads(v_c, RET_DV)
    log_gamma = jax.nn.log_sigmoid(decay_logit.astype(f32))
    s_zero = jnp.zeros((b, RET_HEADS, RET_DK, RET_DV), f32)
    ox_dirs = []
    oc_dirs = []
    for d in range(2):
        rev = d == 1
        oc_d, s_ctx = retention_chunked(_flip(qc, 2, rev), _flip(kc, 2, rev), _flip(vc, 2, rev),
                                        log_gamma[d], s_zero, rev, with_ctx_out)
        ox_d, _ = retention_chunked(_flip(qx, 2, rev), _flip(kx, 2, rev), _flip(vx, 2, rev),
                                    log_gamma[d], s_ctx, rev, True)
        ox_dirs.append(_flip(ox_d, 2, rev))
        if with_ctx_out:
            oc_dirs.append(_flip(oc_d, 2, rev))
    o_x = merge_heads(head_rmsnorm(ox_dirs[0] + ox_dirs[1])).astype(dt)

    out_x = merge_branches(y_x.reshape(b, seq_len, SSM_WIDTH).astype(dt), o_x, g_x, gs_x, gr_x,
                           glu_w, ret_w_proj, w_out)
    if not with_ctx_out:
        return out_x, None
    o_c = merge_heads(head_rmsnorm(oc_dirs[0] + oc_dirs[1])).astype(dt)
    out_c = merge_branches(y_c.reshape(b, ctx_len, SSM_WIDTH).astype(dt), o_c, g_c, gs_c, gr_c,
                           glu_w, ret_w_proj, w_out)
    return out_x, out_c


def setup_inputs(seed: int = 0) -> dict:
    key = jax.random.key(seed)
    ks = jax.random.split(key, 24)
    f32 = jnp.float32
    G, P, H = SSM_GROUPS, SSM_STATE, RET_HEADS

    def normal(k, shape, scale):
        return jax.random.normal(k, shape, f32) * scale

    n_idx = jnp.arange(P, dtype=f32)
    heads = jnp.arange(H, dtype=f32)
    decay_base = jnp.log(2.0 ** (5.0 + heads) - 1.0)
    return {
        "x": normal(ks[0], (BATCH, SEQ, D_MODEL), 1.0),
        "c": normal(ks[1], (BATCH, D_MODEL), 1.0),
        "ctx": normal(ks[2], (BATCH, CTX_LEN, D_MODEL), 1.0),
        "c_ctx": normal(ks[3], (D_MODEL,), 1.0),
        "ada_w": normal(ks[4], (DEPTH, D_MODEL, N_ADA * D_MODEL), 0.5 * D_MODEL ** -0.5),
        "ada_b": normal(ks[5], (DEPTH, N_ADA * D_MODEL), 0.02),
        "norm_g": 1.0 + normal(ks[6], (DEPTH, 6, D_MODEL), 0.02),
        "ffn_w_in": normal(ks[7], (DEPTH, 2, D_MODEL, 2 * D_FF), D_MODEL ** -0.5),
        "ffn_w_out": normal(ks[8], (DEPTH, 2, D_FF, D_MODEL), D_FF ** -0.5),
        "mix_w_in": normal(ks[9], (DEPTH, D_MODEL, MIX_IN_WIDTH), D_MODEL ** -0.5),
        "ssm_lam_re": -0.5 + normal(ks[10], (DEPTH, 2, G, P), 0.01),
        "ssm_lam_im": math.pi * n_idx + normal(ks[11], (DEPTH, 2, G, P), 0.01),
        "ssm_log_step": jax.random.uniform(ks[12], (DEPTH, 2, G), f32, math.log(1e-3), math.log(1e-1)),
        "ssm_b_re": normal(ks[13], (DEPTH, 2, G, P, SSM_GROUP), (2 * SSM_GROUP) ** -0.5),
        "ssm_b_im": normal(ks[14], (DEPTH, 2, G, P, SSM_GROUP), (2 * SSM_GROUP) ** -0.5),
        "ssm_c_re": normal(ks[15], (DEPTH, 2, G, SSM_GROUP, P), P ** -0.5),
        "ssm_c_im": normal(ks[16], (DEPTH, 2, G, SSM_GROUP, P), P ** -0.5),
        "ssm_d": normal(ks[17], (DEPTH, SSM_WIDTH), 1.0),
        "ssm_glu_w": normal(ks[18], (DEPTH, SSM_WIDTH, 2 * D_MODEL), SSM_WIDTH ** -0.5),
        "ret_decay_logit": decay_base + normal(ks[19], (DEPTH, 2, H), 0.05),
        "ret_w_proj": normal(ks[20], (DEPTH, RET_V_WIDTH, D_MODEL), RET_V_WIDTH ** -0.5),
        "mix_w_out": normal(ks[21], (DEPTH, D_MODEL, D_MODEL), D_MODEL ** -0.5),
    }


def reference(x, c, ctx, c_ctx, ada_w, ada_b, norm_g, ffn_w_in, ffn_w_out, mix_w_in,
              ssm_lam_re, ssm_lam_im, ssm_log_step, ssm_b_re, ssm_b_im, ssm_c_re, ssm_c_im,
              ssm_d, ssm_glu_w, ret_decay_logit, ret_w_proj, mix_w_out):
    b = x.shape[0]
    for l in range(DEPTH):
        last = l == DEPTH - 1
        g = norm_g[l]
        ada_x = (jax.nn.silu(c) @ ada_w[l] + ada_b[l]).reshape(b, 1, N_ADA, D_MODEL)
        ada_c = (jax.nn.silu(c_ctx) @ ada_w[l] + ada_b[l]).reshape(1, 1, N_ADA, D_MODEL)

        x = ada_post(x, swiglu(ada_pre(x, ada_x, 0, g[0]), ffn_w_in[l, 0], ffn_w_out[l, 0]), ada_x, 0, g[1], 0.5)
        ctx = ada_post(ctx, swiglu(ada_pre(ctx, ada_c, 0, g[0]), ffn_w_in[l, 0], ffn_w_out[l, 0]), ada_c, 0, g[1], 0.5)

        u_x = ada_pre(x, ada_x, 1, g[2])
        u_c = ada_pre(ctx, ada_c, 1, g[2])
        mix_x, mix_c = token_mixer(u_x, u_c, mix_w_in[l], ssm_lam_re[l], ssm_lam_im[l], ssm_log_step[l],
                                   ssm_b_re[l], ssm_b_im[l], ssm_c_re[l], ssm_c_im[l], ssm_d[l],
                                   ssm_glu_w[l], ret_decay_logit[l], ret_w_proj[l], mix_w_out[l],
                                   not last)
        x = ada_post(x, mix_x, ada_x, 1, g[3], 1.0)

        x = ada_post(x, swiglu(ada_pre(x, ada_x, 2, g[4]), ffn_w_in[l, 1], ffn_w_out[l, 1]), ada_x, 2, g[5], 0.5)
        if not last:
            ctx = ada_post(ctx, mix_c, ada_c, 1, g[3], 1.0)
            ctx = ada_post(ctx, swiglu(ada_pre(ctx, ada_c, 2, g[4]), ffn_w_in[l, 1], ffn_w_out[l, 1]), ada_c, 2, g[5], 0.5)
    return x
```

```cpp
#include <hip/hip_runtime.h>
#include <cstdio>
#include <cstdint>

#define GAS __attribute__((address_space(1)))
#define LAS __attribute__((address_space(3)))
typedef unsigned short bf16;
typedef unsigned v4u __attribute__((ext_vector_type(4)));
typedef unsigned v2u __attribute__((ext_vector_type(2)));
typedef float f32x4 __attribute__((ext_vector_type(4)));
typedef float f32x2 __attribute__((ext_vector_type(2)));
typedef short bf16x8 __attribute__((ext_vector_type(8)));
typedef short bf16x4 __attribute__((ext_vector_type(4)));

constexpr int D = 2048, NB = 2, SEQ = 4096, MX = NB * SEQ, LC = 256, MC = NB * LC, MT = MX + MC;
constexpr int DFF = 5632, NFF = 2 * DFF, SW = 1024, NMIX = 11264, NH = 8, DK = 128, DV = 256, CH = 128, NCH = SEQ / CH;
constexpr int NADA = 9 * D;
constexpr float EPS = 1e-6f;
constexpr int NWAVES = 8;

constexpr size_t MiB = 1u << 20;
constexpr size_t WS_CTL = 0, CTL_ZERO_BYTES = 1 * MiB;
constexpr size_t WS_W1T = 1 * MiB, WS_W2T = 45 * MiB, WS_WMT = 67 * MiB, WS_WGT = 115 * MiB, WS_WPT = 123 * MiB, WS_WOT = 131 * MiB, WS_W3T = 139 * MiB, WS_W4T = 183 * MiB;
constexpr size_t WS_ABUF = 205 * MiB;
constexpr size_t WS_HBUF = 239 * MiB;
constexpr size_t WS_OBUF = 335 * MiB;
constexpr size_t WS_US = 403 * MiB;
constexpr size_t WS_Q = 420 * MiB, WS_QF = 436 * MiB, WS_QB = 452 * MiB;
constexpr size_t WS_K = 468 * MiB;
constexpr size_t WS_KFT = 484 * MiB, WS_KBT = 500 * MiB, WS_KFTC = 516 * MiB, WS_KBTC = 517 * MiB;
constexpr size_t WS_VT = 518 * MiB, WS_VTC = 550 * MiB;
constexpr size_t WS_YF = 552 * MiB;
constexpr size_t WS_AGLU = 584 * MiB;
constexpr size_t WS_TAB = 600 * MiB;
constexpr size_t WS_END = 602 * MiB;
constexpr size_t TAB_ROPE = 0, TAB_LG2 = 16384, TAB_AR = 32768, TAB_AI = 65536, TAB_BBT = 131072, TAB_CMT = 131072 + 524288;
constexpr int CW_BAR = 4096;
constexpr size_t CTL_ADA = 65536;

#define RLX_AGENT __ATOMIC_RELAXED, __HIP_MEMORY_SCOPE_AGENT
#define LDS_WAIT() asm volatile("s_waitcnt lgkmcnt(0)" ::: "memory")
#define VM_WAIT() asm volatile("s_waitcnt vmcnt(0)" ::: "memory")

__device__ __forceinline__ unsigned f2bf(float f) { unsigned u = __builtin_bit_cast(unsigned, f); return (u + 0x7fffu + ((u >> 16) & 1u)) >> 16; }
__device__ __forceinline__ unsigned pk2(float lo, float hi) { return f2bf(lo) | (f2bf(hi) << 16); }
__device__ __forceinline__ unsigned cvt_pk_bf16(float lo, float hi) { unsigned r; asm volatile("v_cvt_pk_bf16_f32 %0, %1, %2" : "=v"(r) : "v"(lo), "v"(hi)); return r; }
__device__ __forceinline__ float bflo(unsigned w) { return __builtin_bit_cast(float, w << 16); }
__device__ __forceinline__ float bfhi(unsigned w) { return __builtin_bit_cast(float, w & 0xffff0000u); }
__device__ __forceinline__ float fast_sigmoid(float x) { return __builtin_amdgcn_rcpf(1.0f + __builtin_amdgcn_exp2f(-1.4426950408889634f * x)); }
__device__ __forceinline__ float fast_silu(float x) { return x * fast_sigmoid(x); }
__device__ __forceinline__ float gelu_tanh(float x) { const float u = 0.7978845608028654f * (x + 0.044715f * x * x * x); return x * fast_sigmoid(2.0f * u); }
__device__ __forceinline__ float wave_sum(float v) {
#pragma unroll
    for (int o = 1; o < 64; o <<= 1) v += __shfl_xor(v, o);
    return v;
}

#define XB_TMO      128
#define XB_XCNT(j)  (256  + 64 * (j))
#define XB_XSUB(j)  (1280 + 64 * (j))
#define XB_XGEN(j)  (2304 + 64 * (j))
#define XB_TOP      3328
#define XB_TOPGEN   3392
#define XCD_BAR_WORDS 3456
#define XB_SPIN_CAP (1u << 18)
__device__ __forceinline__ unsigned xb_ld(unsigned* p)              { return __hip_atomic_load(p, __ATOMIC_RELAXED, __HIP_MEMORY_SCOPE_AGENT); }
__device__ __forceinline__ unsigned xb_add(unsigned* p, unsigned v) { return __hip_atomic_fetch_add(p, v, __ATOMIC_RELAXED, __HIP_MEMORY_SCOPE_AGENT); }
__device__ __forceinline__ unsigned xb_xcc_id() { return (unsigned)__builtin_amdgcn_s_getreg((3 << 11) | 20) & 0xFu; }
#define XB_SPIN(cond, bar) do { unsigned _sp = 0; while (cond) { __builtin_amdgcn_s_sleep(1); \
    if ((++_sp & 255u) == 0u) { if (xb_ld(&(bar)[XB_TMO])) break; if (_sp > XB_SPIN_CAP) { atomicAdd(&(bar)[XB_TMO], 1u); break; } } } } while (0)
struct XcdBarrier { unsigned* bar; unsigned x; volatile LAS unsigned* st; };
__device__ __forceinline__ XcdBarrier xcd_barrier_post(unsigned* bar, volatile LAS unsigned* st) {
    XcdBarrier b; b.bar = bar; b.x = xb_xcc_id(); b.st = st;
    if (threadIdx.x == 0) (void)xb_add(&bar[XB_XCNT(b.x)], 1u);
    return b;
}
__device__ __forceinline__ void xcd_barrier_complete(unsigned* bar, unsigned x, unsigned& nloc, unsigned& nx) {
    const unsigned G = gridDim.x * gridDim.y * gridDim.z;
    unsigned sum, cnt, mine, sp = 0u;
    for (;;) {
        sum = 0u; cnt = 0u; mine = 0u;
#pragma unroll
        for (unsigned j = 0; j < 16; ++j) { const unsigned c = xb_ld(&bar[XB_XCNT(j)]); sum += c; cnt += (c > 0u) ? 1u : 0u; mine = (j == x) ? c : mine; }
        if (sum == G) break;
        __builtin_amdgcn_s_sleep(1);
        if ((++sp & 255u) == 0u) { if (xb_ld(&bar[XB_TMO])) break; if (sp > XB_SPIN_CAP) { atomicAdd(&bar[XB_TMO], 1u); break; } }
    }
    nloc = mine > 0u ? mine : 1u; nx = cnt > 0u ? cnt : 1u;
}
__device__ __forceinline__ void xcd_barrier(const XcdBarrier& b) {
    asm volatile("s_waitcnt vmcnt(0)" ::: "memory");
    __syncthreads();
    if (threadIdx.x == 0) {
        unsigned* bar = b.bar;
        __builtin_amdgcn_s_waitcnt(0);
        unsigned nloc = b.st[0], nx = b.st[1];
        if (nloc == 0u) { xcd_barrier_complete(bar, b.x, nloc, nx); b.st[0] = nloc; b.st[1] = nx; }
        const unsigned old = xb_add(&bar[XB_XSUB(b.x)], 1u);
        const unsigned gen = old / nloc;
        if (old + 1u == (gen + 1u) * nloc) {
            __builtin_amdgcn_fence(__ATOMIC_RELEASE, "agent");
            asm volatile("s_waitcnt vmcnt(0)" ::: "memory");
            const unsigned og = xb_add(&bar[XB_TOP], 1u);
            const unsigned tg = og / nx;
            if (og + 1u == (tg + 1u) * nx) xb_add(&bar[XB_TOPGEN], 1u);
            else XB_SPIN(xb_ld(&bar[XB_TOPGEN]) == tg, bar);
            __builtin_amdgcn_fence(__ATOMIC_ACQUIRE, "agent");
            xb_add(&bar[XB_XGEN(b.x)], 1u);
            asm volatile("s_waitcnt vmcnt(0)" ::: "memory");
        } else {
            XB_SPIN(xb_ld(&bar[XB_XGEN(b.x)]) == gen, bar);
            __builtin_amdgcn_fence(__ATOMIC_ACQUIRE, "agent");
            asm volatile("s_waitcnt vmcnt(0)" ::: "memory");
        }
    }
    __syncthreads();
}

namespace pg8 {
constexpr int BM = 256, BK = 64, HALF = 128, HTB = HALF * BK * 2, STAGE_BYTES = 8 * HTB, NXCD = 8;
__device__ __forceinline__ int lds_byte(int r, int c) { const int st = (r >> 4) * 2 + (c >> 5), rr = r & 15, cc = c & 31, ob = rr * 64 + cc * 2; return st * 1024 + (ob ^ (((ob >> 9) & 1) << 5)); }
__device__ __forceinline__ void stage_rc(int b, int& R, int& C) { const int st = b / 1024, sb = b % 1024, swz = sb ^ (((sb >> 9) & 1) << 5); R = (st >> 1) * 16 + swz / 64; C = (st & 1) * 32 + (swz % 64) / 2; }
__device__ __forceinline__ int perm32(int rho) { const int n = rho >> 4, i = rho & 15; return 8 * (i >> 2) + 4 * n + (i & 3); }

struct Unit { const char* A; const char* B; int pm, pn, kind; };
__device__ __forceinline__ int xcd_remap(int L, int nwg) { const int q = nwg / NXCD, r = nwg % NXCD, xcd = L % NXCD, off = L / NXCD; return (xcd < r ? xcd * (q + 1) : r * (q + 1) + (xcd - r) * q) + off; }

template <class Epi, class Sched>
__device__ __forceinline__ void gemm_phase(LAS unsigned char* lds, const int K, const Sched& S, const Epi& E) {
    int tid = threadIdx.x; asm volatile("" : "+v"(tid));
    const int wid = __builtin_amdgcn_readfirstlane(tid >> 6), lane = tid & 63, wr = wid >> 2, wc = wid & 3, fr = lane & 15, fq = lane >> 4;
    const int nt = K / BK;
    unsigned voffA[2], voffB[2];
#pragma unroll
    for (int i = 0; i < 2; ++i) { int R, C; stage_rc(tid * 16 + i * 8192, R, C); const int Rb = (R & ~31) + perm32(R & 31);
        voffA[i] = (unsigned)(R * K + C) * 2u; voffB[i] = (unsigned)(Rb * K + C) * 2u; }
    const size_t kstep = (size_t)(BK * 2);
    const size_t hstep = (size_t)HALF * K * 2;
    const unsigned ldsw = (unsigned)wid * 1024u;
    const int aoff = lds_byte(wr * 64 + fr, fq * 8), boff = lds_byte(wc * 32 + fr, fq * 8);
#define PG8_SA(b, h) (((b) * 2 + (h)) * HTB)
#define PG8_SB(b, h) ((4 + (b) * 2 + (h)) * HTB)
#define PG8_STAGE(bufoff, gbase, voff) do { _Pragma("unroll") for (int _i = 0; _i < 2; ++_i) \
        __builtin_amdgcn_global_load_lds((const unsigned*)((const char*)(gbase) + (voff)[_i]), (LAS unsigned*)(lds + (bufoff) + ldsw + _i * 8192), 16, 0, 0); } while (0)
#define PG8_LDA(dst, b, h) do { _Pragma("unroll") for (int m = 0; m < 4; ++m) _Pragma("unroll") for (int k = 0; k < 2; ++k) dst[m][k] = *(const LAS bf16x8*)(lds + PG8_SA(b, h) + aoff + m * 2048 + k * 1024); } while (0)
#define PG8_LDB(dst, b, h) do { _Pragma("unroll") for (int n = 0; n < 2; ++n) _Pragma("unroll") for (int k = 0; k < 2; ++k) dst[n][k] = *(const LAS bf16x8*)(lds + PG8_SB(b, h) + boff + n * 2048 + k * 1024); } while (0)
#define PG8_MMA(ai, bj, At, Bt) do { __builtin_amdgcn_s_setprio(1); _Pragma("unroll") for (int m = 0; m < 4; ++m) _Pragma("unroll") for (int n = 0; n < 2; ++n) _Pragma("unroll") for (int k = 0; k < 2; ++k) \
        acc[ai][bj][m][n] = __builtin_amdgcn_mfma_f32_16x16x32_bf16(Bt[n][k], At[m][k], acc[ai][bj][m][n], 0, 0, 0); __builtin_amdgcn_s_setprio(0); } while (0)
#define PG8_WAIT_V(n) asm volatile("s_waitcnt vmcnt(" #n ")" ::: "memory")
#define PG8_WAIT_L(n) asm volatile("s_waitcnt lgkmcnt(" #n ")" ::: "memory")
#define PG8_BAR __builtin_amdgcn_s_barrier()
#define PG8_SCHED __builtin_amdgcn_sched_barrier(0)
    Unit cur, nxt; int ui = 0;
    if (!S.next(0, cur)) return;
    f32x4 acc[2][2][4][2];
#pragma unroll
    for (int a = 0; a < 2; ++a)
#pragma unroll
        for (int b = 0; b < 2; ++b)
#pragma unroll
            for (int m = 0; m < 4; ++m)
#pragma unroll
                for (int n = 0; n < 2; ++n) acc[a][b][m][n] = (f32x4){0.f, 0.f, 0.f, 0.f};
    bf16x8 At[4][2], B0[2][2], B1[2][2];
    const char* cA = cur.A; const char* cB = cur.B;
    PG8_STAGE(PG8_SB(0, 0), cB, voffB); PG8_STAGE(PG8_SB(0, 1), cB + hstep, voffB); PG8_STAGE(PG8_SA(0, 0), cA, voffA); PG8_STAGE(PG8_SA(0, 1), cA + hstep, voffA);
    if (wr == 1) PG8_BAR;
    PG8_WAIT_V(2); PG8_BAR;
    PG8_STAGE(PG8_SB(1, 0), cB + kstep, voffB); PG8_STAGE(PG8_SA(1, 0), cA + kstep, voffA); PG8_STAGE(PG8_SB(1, 1), cB + hstep + kstep, voffB);
    PG8_WAIT_V(6); PG8_BAR;
    for (;;) {
        const bool has_next = S.next(ui + 1, nxt);
        const char* nA = has_next ? nxt.A : cA; const char* nB = has_next ? nxt.B : cB;
        for (int t = 0; t < nt; t += 2) {
            const bool last = (t == nt - 2);
            const char* a1 = cA + (size_t)(t + 1) * kstep;
            const char* a2 = last ? nA : cA + (size_t)(t + 2) * kstep; const char* b2 = last ? nB : cB + (size_t)(t + 2) * kstep;
            const char* a3 = a2 + kstep; const char* b3 = b2 + kstep;
            PG8_LDB(B0, 0, 0); PG8_LDB(B1, 0, 1); PG8_SCHED; PG8_LDA(At, 0, 0); PG8_STAGE(PG8_SA(1, 1), a1 + hstep, voffA);
            PG8_WAIT_V(8); PG8_WAIT_L(0); PG8_BAR; PG8_MMA(0, 0, At, B0); PG8_MMA(0, 1, At, B1); PG8_BAR; PG8_SCHED;
            PG8_LDA(At, 0, 1); PG8_STAGE(PG8_SB(0, 0), b2, voffB); PG8_STAGE(PG8_SB(0, 1), b2 + hstep, voffB); PG8_STAGE(PG8_SA(0, 0), a2, voffA);
            PG8_WAIT_V(8); PG8_WAIT_L(0); PG8_BAR; PG8_MMA(1, 0, At, B0); PG8_MMA(1, 1, At, B1); PG8_BAR; PG8_SCHED;
            PG8_LDB(B0, 1, 0); PG8_LDB(B1, 1, 1); PG8_SCHED; PG8_LDA(At, 1, 0); PG8_STAGE(PG8_SA(0, 1), a2 + hstep, voffA);
            PG8_WAIT_V(8); PG8_WAIT_L(0); PG8_BAR; PG8_MMA(0, 0, At, B0); PG8_MMA(0, 1, At, B1); PG8_BAR; PG8_SCHED;
            PG8_LDA(At, 1, 1); PG8_STAGE(PG8_SB(1, 0), b3, voffB); PG8_STAGE(PG8_SB(1, 1), b3 + hstep, voffB); PG8_STAGE(PG8_SA(1, 0), a3, voffA);
            PG8_WAIT_V(8); PG8_WAIT_L(0); PG8_BAR; PG8_MMA(1, 0, At, B0); PG8_MMA(1, 1, At, B1); PG8_BAR; PG8_SCHED;
        }
        if (wr == 0) PG8_BAR;
        E(acc, cur, wr, wc, fr, fq);
        if (!has_next) break;
#pragma unroll
        for (int a = 0; a < 2; ++a)
#pragma unroll
            for (int b = 0; b < 2; ++b)
#pragma unroll
                for (int m = 0; m < 4; ++m)
#pragma unroll
                    for (int n = 0; n < 2; ++n) acc[a][b][m][n] = (f32x4){0.f, 0.f, 0.f, 0.f};
        cur = nxt; cA = nA; cB = nB; ++ui;
        if (wr == 1) PG8_BAR;
    }
    PG8_WAIT_V(0);
    PG8_BAR;
#undef PG8_SA
#undef PG8_SB
#undef PG8_STAGE
#undef PG8_LDA
#undef PG8_LDB
#undef PG8_MMA
#undef PG8_WAIT_V
#undef PG8_WAIT_L
#undef PG8_BAR
#undef PG8_SCHED
}

struct GridOrder {
    const char* A; const char* B; size_t tstep; int nM, nN, nwg, G, c;
    __device__ __forceinline__ void init(const void* A_, const void* B_, int K, int nM_, int nN_, int G_, int c_) { A = (const char*)A_; B = (const char*)B_; tstep = (size_t)BM * K * 2; nM = nM_; nN = nN_; nwg = nM * nN; G = G_; c = c_; }
    __device__ __forceinline__ bool next(int i, Unit& u) const {
        const long L = (long)i * G + c; if (L >= nwg) return false;
        const int wgid = xcd_remap((int)L, nwg);
        const int nig = 8 * nN, gid = wgid / nig, fm = gid * 8, gsz = (nM - fm) < 8 ? (nM - fm) : 8;
        u.pm = fm + ((wgid % nig) % gsz); u.pn = (wgid % nig) / gsz; u.kind = 0;
        u.A = A + (size_t)u.pm * tstep; u.B = B + (size_t)u.pn * tstep; return true;
    }
};
}

typedef f32x4 Acc[2][2][4][2];
struct EpiSwiGLU {
    bf16* Hid;
    __device__ __forceinline__ void operator()(const Acc& acc, const pg8::Unit& u, int wr, int wc, int fr0, int fq0) const {
        int fr = fr0, fq = fq0; asm volatile("" : "+v"(fr), "+v"(fq));
        const int row0 = u.pm * 256 + wr * 64 + fr, col0 = u.pn * 128 + wc * 32 + 8 * fq;
#pragma unroll
        for (int ai = 0; ai < 2; ++ai)
#pragma unroll
            for (int m = 0; m < 4; ++m) {
                float v[8];
#pragma unroll
                for (int n = 0; n < 2; ++n)
#pragma unroll
                    for (int j = 0; j < 4; ++j) v[4 * n + j] = fast_silu(acc[ai][0][m][n][j]) * acc[ai][1][m][n][j];
                v4u w; w.x = cvt_pk_bf16(v[0], v[1]); w.y = cvt_pk_bf16(v[2], v[3]); w.z = cvt_pk_bf16(v[4], v[5]); w.w = cvt_pk_bf16(v[6], v[7]);
                *(v4u*)(Hid + (size_t)(row0 + ai * 128 + m * 16) * DFF + col0) = w;
            }
    }
};
struct EpiF32 {
    float* C; int ldc;
    __device__ __forceinline__ void operator()(const Acc& acc, const pg8::Unit& u, int wr, int wc, int fr0, int fq0) const {
        int fr = fr0, fq = fq0; asm volatile("" : "+v"(fr), "+v"(fq));
        const int row0 = u.pm * 256 + wr * 64 + fr, col0 = u.pn * 256 + wc * 32 + 8 * fq;
#pragma unroll
        for (int ai = 0; ai < 2; ++ai)
#pragma unroll
            for (int m = 0; m < 4; ++m) { float* rowp = C + (size_t)(row0 + ai * 128 + m * 16) * ldc + col0;
#pragma unroll
                for (int bj = 0; bj < 2; ++bj) { *(f32x4*)(rowp + bj * 128) = acc[ai][bj][m][0]; *(f32x4*)(rowp + bj * 128 + 4) = acc[ai][bj][m][1]; } }
    }
};
struct EpiGLU {
    const bf16* SGS; bf16* out;
    __device__ __forceinline__ void operator()(const Acc& acc, const pg8::Unit& u, int wr, int wc, int fr0, int fq0) const {
        int fr = fr0, fq = fq0; asm volatile("" : "+v"(fr), "+v"(fq));
        const int row0 = u.pm * 256 + wr * 64 + fr, col0 = u.pn * 128 + wc * 32 + 8 * fq;
#pragma unroll
        for (int ai = 0; ai < 2; ++ai)
#pragma unroll
            for (int m = 0; m < 4; ++m) {
                const size_t off = (size_t)(row0 + ai * 128 + m * 16) * D + col0;
                const v4u s = *(const v4u*)(SGS + off);
                const float sg[8] = {bflo(s.x), bfhi(s.x), bflo(s.y), bfhi(s.y), bflo(s.z), bfhi(s.z), bflo(s.w), bfhi(s.w)};
                float v[8];
#pragma unroll
                for (int n = 0; n < 2; ++n)
#pragma unroll
                    for (int j = 0; j < 4; ++j) v[4 * n + j] = acc[ai][0][m][n][j] * fast_sigmoid(acc[ai][1][m][n][j]) * sg[4 * n + j];
                v4u w; w.x = cvt_pk_bf16(v[0], v[1]); w.y = cvt_pk_bf16(v[2], v[3]); w.z = cvt_pk_bf16(v[4], v[5]); w.w = cvt_pk_bf16(v[6], v[7]);
                *(v4u*)(out + off) = w;
            }
    }
};
struct EpiMerge {
    const bf16* SGR; bf16* mg;
    __device__ __forceinline__ void operator()(const Acc& acc, const pg8::Unit& u, int wr, int wc, int fr0, int fq0) const {
        int fr = fr0, fq = fq0; asm volatile("" : "+v"(fr), "+v"(fq));
        const int row0 = u.pm * 256 + wr * 64 + fr, col0 = u.pn * 256 + wc * 32 + 8 * fq;
#pragma unroll
        for (int ai = 0; ai < 2; ++ai)
#pragma unroll
            for (int m = 0; m < 4; ++m)
#pragma unroll
                for (int bj = 0; bj < 2; ++bj) {
                    const size_t off = (size_t)(row0 + ai * 128 + m * 16) * D + col0 + bj * 128;
                    const v4u s = *(const v4u*)(SGR + off), p = *(const v4u*)(mg + off);
                    const float sg[8] = {bflo(s.x), bfhi(s.x), bflo(s.y), bfhi(s.y), bflo(s.z), bfhi(s.z), bflo(s.w), bfhi(s.w)};
                    const float pp[8] = {bflo(p.x), bfhi(p.x), bflo(p.y), bfhi(p.y), bflo(p.z), bfhi(p.z), bflo(p.w), bfhi(p.w)};
                    float v[8];
#pragma unroll
                    for (int n = 0; n < 2; ++n)
#pragma unroll
                        for (int j = 0; j < 4; ++j) v[4 * n + j] = pp[4 * n + j] + sg[4 * n + j] * acc[ai][bj][m][n][j];
                    v4u w; w.x = cvt_pk_bf16(v[0], v[1]); w.y = cvt_pk_bf16(v[2], v[3]); w.z = cvt_pk_bf16(v[4], v[5]); w.w = cvt_pk_bf16(v[6], v[7]);
                    *(v4u*)(mg + off) = w;
                }
    }
};

enum { MK_S = 0, MK_Q = 1, MK_K = 2, MK_G = 3, MK_GS = 4, MK_GR = 5, MK_KT = 6, MK_VT = 7 };
struct EpiMix {
    unsigned char* ws;
    __device__ __forceinline__ void operator()(const Acc& acc, const pg8::Unit& u, int wr, int wc, int fr0, int fq0) const {
        int fr = fr0, fq = fq0; asm volatile("" : "+v"(fr), "+v"(fq));
        bf16* const US = (bf16*)(ws + WS_US); bf16* const Q = (bf16*)(ws + WS_Q); bf16* const QF = (bf16*)(ws + WS_QF); bf16* const QB = (bf16*)(ws + WS_QB); bf16* const KN = (bf16*)(ws + WS_K);
        bf16* const SG = (bf16*)(ws + WS_HBUF); bf16* const SGS = (bf16*)(ws + WS_HBUF + 32 * MiB); bf16* const SGR = (bf16*)(ws + WS_HBUF + 64 * MiB);
        bf16* const KFT = (bf16*)(ws + WS_KFT); bf16* const KBT = (bf16*)(ws + WS_KBT); bf16* const KFTC = (bf16*)(ws + WS_KFTC); bf16* const KBTC = (bf16*)(ws + WS_KBTC);
        bf16* const VT = (bf16*)(ws + WS_VT); bf16* const VTC = (bf16*)(ws + WS_VTC);
        const f32x2* const rope = (const f32x2*)(ws + WS_TAB + TAB_ROPE);
        const float* const lg2 = (const float*)(ws + WS_TAB + TAB_LG2);
        const int kind = u.kind;
        if (kind == MK_S) {
            const int row0 = u.pm * 256 + wr * 64 + fr, col0 = u.pn * 256 + wc * 32 + 8 * fq;
#pragma unroll
            for (int ai = 0; ai < 2; ++ai)
#pragma unroll
                for (int m = 0; m < 4; ++m)
#pragma unroll
                    for (int bj = 0; bj < 2; ++bj) {
                        const f32x4 a = acc[ai][bj][m][0], b = acc[ai][bj][m][1];
                        v4u w; w.x = cvt_pk_bf16(a[0], a[1]); w.y = cvt_pk_bf16(a[2], a[3]); w.z = cvt_pk_bf16(b[0], b[1]); w.w = cvt_pk_bf16(b[2], b[3]);
                        *(v4u*)(US + (size_t)(row0 + ai * 128 + m * 16) * SW + col0 + bj * 128) = w;
                    }
        } else if (kind == MK_G || kind == MK_GS || kind == MK_GR) {
            bf16* dst = kind == MK_G ? SG : (kind == MK_GS ? SGS : SGR);
            const int row0 = u.pm * 256 + wr * 64 + fr, col0 = u.pn * 256 + wc * 32 + 8 * fq;
#pragma unroll
            for (int ai = 0; ai < 2; ++ai)
#pragma unroll
                for (int m = 0; m < 4; ++m)
#pragma unroll
                    for (int bj = 0; bj < 2; ++bj) {
                        float v[8];
#pragma unroll
                        for (int n = 0; n < 2; ++n)
#pragma unroll
                            for (int j = 0; j < 4; ++j) { const float x = acc[ai][bj][m][n][j]; const float s = fast_sigmoid(x); v[4 * n + j] = kind == MK_G ? x * s : s; }
                        v4u w; w.x = cvt_pk_bf16(v[0], v[1]); w.y = cvt_pk_bf16(v[2], v[3]); w.z = cvt_pk_bf16(v[4], v[5]); w.w = cvt_pk_bf16(v[6], v[7]);
                        *(v4u*)(dst + (size_t)(row0 + ai * 128 + m * 16) * D + col0 + bj * 128) = w;
                    }
        } else if (kind == MK_Q || kind == MK_K) {
            const int p = wc >> 1, i0 = 16 * (wc & 1) + 4 * fq;
            const int d0 = 64 * p + i0;
#pragma unroll
            for (int ai = 0; ai < 2; ++ai)
#pragma unroll
                for (int m = 0; m < 4; ++m) {
                    const int row = u.pm * 256 + ai * 128 + wr * 64 + m * 16 + fr;
                    const int l = row & (SEQ - 1), pos = p ? (l & 63) : (l >> 6), ic = l & (CH - 1);
                    const f32x4 cs0 = *(const f32x4*)(rope + pos * 32 + i0), cs1 = *(const f32x4*)(rope + pos * 32 + i0 + 2);
                    const float cc[4] = {cs0[0], cs0[2], cs1[0], cs1[2]}, ss[4] = {cs0[1], cs0[3], cs1[1], cs1[3]};
#pragma unroll
                    for (int bj = 0; bj < 2; ++bj) {
                        const int head = 2 * u.pn + bj;
                        float y1[4], y2[4];
#pragma unroll
                        for (int j = 0; j < 4; ++j) { const float x1 = acc[ai][bj][m][0][j], x2 = acc[ai][bj][m][1][j]; y1[j] = x1 * cc[j] - x2 * ss[j]; y2[j] = x1 * ss[j] + x2 * cc[j]; }
                        const size_t off = (size_t)row * 1024 + head * 128 + d0;
                        if (kind == MK_K) {
                            v2u a, b; a.x = cvt_pk_bf16(y1[0], y1[1]); a.y = cvt_pk_bf16(y1[2], y1[3]); b.x = cvt_pk_bf16(y2[0], y2[1]); b.y = cvt_pk_bf16(y2[2], y2[3]);
                            *(v2u*)(KN + off) = a; *(v2u*)(KN + off + 32) = b;
                        } else {
                            const float qs = 0.08838834764831845f;
                            const float wf = qs * __builtin_amdgcn_exp2f((float)(ic + 1) * lg2[head]), wb = qs * __builtin_amdgcn_exp2f((float)(CH - ic) * lg2[8 + head]);
                            v2u a, b;
                            a.x = cvt_pk_bf16(y1[0] * qs, y1[1] * qs); a.y = cvt_pk_bf16(y1[2] * qs, y1[3] * qs); b.x = cvt_pk_bf16(y2[0] * qs, y2[1] * qs); b.y = cvt_pk_bf16(y2[2] * qs, y2[3] * qs);
                            *(v2u*)(Q + off) = a; *(v2u*)(Q + off + 32) = b;
                            a.x = cvt_pk_bf16(y1[0] * wf, y1[1] * wf); a.y = cvt_pk_bf16(y1[2] * wf, y1[3] * wf); b.x = cvt_pk_bf16(y2[0] * wf, y2[1] * wf); b.y = cvt_pk_bf16(y2[2] * wf, y2[3] * wf);
                            *(v2u*)(QF + off) = a; *(v2u*)(QF + off + 32) = b;
                            a.x = cvt_pk_bf16(y1[0] * wb, y1[1] * wb); a.y = cvt_pk_bf16(y1[2] * wb, y1[3] * wb); b.x = cvt_pk_bf16(y2[0] * wb, y2[1] * wb); b.y = cvt_pk_bf16(y2[2] * wb, y2[3] * wb);
                            *(v2u*)(QB + off) = a; *(v2u*)(QB + off + 32) = b;
                        }
                    }
                    asm volatile("" ::: "memory");
                }
        } else if (kind == MK_VT) {
            const bool isctx = u.pn >= 32;
#pragma unroll
            for (int ai = 0; ai < 2; ++ai)
#pragma unroll
                for (int m = 0; m < 4; ++m) {
                    const int f = u.pm * 256 + ai * 128 + wr * 64 + m * 16 + fr;
#pragma unroll
                    for (int bj = 0; bj < 2; ++bj) {
                        const f32x4 a = acc[ai][bj][m][0], b = acc[ai][bj][m][1];
                        v4u w; w.x = cvt_pk_bf16(a[0], a[1]); w.y = cvt_pk_bf16(a[2], a[3]); w.z = cvt_pk_bf16(b[0], b[1]); w.w = cvt_pk_bf16(b[2], b[3]);
                        const int tc = bj * 128 + wc * 32 + 8 * fq;
                        if (!isctx) { const int tok = u.pn * 256 + tc, b_ = tok >> 12, l = tok & (SEQ - 1); *(v4u*)(VT + ((size_t)(b_ * 2048 + f) * SEQ + l)) = w; }
                        else { const int b_ = u.pn - 32; *(v4u*)(VTC + ((size_t)(b_ * 2048 + f) * LC + tc)) = w; }
                    }
                }
        } else {
            const bool isctx = u.pn >= 32;
            const int p = wr;
#pragma unroll
            for (int ai = 0; ai < 2; ++ai) {
                const int head = 2 * u.pm + ai;
                const float lgf = lg2[head], lgb = lg2[8 + head];
#pragma unroll
                for (int mm = 0; mm < 2; ++mm) {
                    const int i = 16 * mm + fr, d1 = 64 * p + i;
#pragma unroll
                    for (int bj = 0; bj < 2; ++bj)
#pragma unroll
                        for (int n = 0; n < 2; ++n) {
                            float o1f[4], o2f[4], o1b[4], o2b[4];
                            const int tc = bj * 128 + wc * 32 + 8 * fq + 4 * n;
#pragma unroll
                            for (int j = 0; j < 4; ++j) {
                                const int t = tc + j;
                                const float x1 = acc[ai][bj][mm][n][j], x2 = acc[ai][bj][mm + 2][n][j];
                                float y1, y2; int ic;
                                if (!isctx) { const int l = (u.pn * 256 + t) & (SEQ - 1), pos = p ? (l & 63) : (l >> 6); const f32x2 cs = rope[pos * 32 + i]; y1 = x1 * cs[0] - x2 * cs[1]; y2 = x1 * cs[1] + x2 * cs[0]; ic = l & (CH - 1); }
                                else { y1 = x1; y2 = x2; ic = t & (CH - 1); }
                                const float wf = __builtin_amdgcn_exp2f((float)(CH - 1 - ic) * lgf), wb = __builtin_amdgcn_exp2f((float)ic * lgb);
                                o1f[j] = y1 * wf; o2f[j] = y2 * wf; o1b[j] = y1 * wb; o2b[j] = y2 * wb;
                            }
                            v2u w1f, w2f, w1b, w2b;
                            w1f.x = cvt_pk_bf16(o1f[0], o1f[1]); w1f.y = cvt_pk_bf16(o1f[2], o1f[3]); w2f.x = cvt_pk_bf16(o2f[0], o2f[1]); w2f.y = cvt_pk_bf16(o2f[2], o2f[3]);
                            w1b.x = cvt_pk_bf16(o1b[0], o1b[1]); w1b.y = cvt_pk_bf16(o1b[2], o1b[3]); w2b.x = cvt_pk_bf16(o2b[0], o2b[1]); w2b.y = cvt_pk_bf16(o2b[2], o2b[3]);
                            if (!isctx) {
                                const int tok = u.pn * 256 + tc, b_ = tok >> 12, l = tok & (SEQ - 1);
                                const size_t o1 = ((size_t)((b_ * NH + head) * DK + d1)) * SEQ + l, o2 = o1 + (size_t)32 * SEQ;
                                *(v2u*)(KFT + o1) = w1f; *(v2u*)(KFT + o2) = w2f; *(v2u*)(KBT + o1) = w1b; *(v2u*)(KBT + o2) = w2b;
                            } else {
                                const int b_ = u.pn - 32;
                                const size_t o1 = ((size_t)((b_ * NH + head) * DK + d1)) * LC + tc, o2 = o1 + (size_t)32 * LC;
                                *(v2u*)(KFTC + o1) = w1f; *(v2u*)(KFTC + o2) = w2f; *(v2u*)(KBTC + o1) = w1b; *(v2u*)(KBTC + o2) = w2b;
                            }
                            asm volatile("" ::: "memory");
                        }
                }
            }
        }
    }
};
struct MixOrder {
    const char* U; const char* WM; int G, c;
    static constexpr int N_NORM = 32 * 36, N_CTXS = 8, N_SWAP = 12 * 34, NWG = N_NORM + N_CTXS + N_SWAP;
    __device__ __forceinline__ bool next(int i, pg8::Unit& u) const {
        const long L = (long)i * G + c; if (L >= NWG) return false;
        int w = pg8::xcd_remap((int)L, NWG);
        const size_t tstep = (size_t)256 * D * 2;
        if (w < N_NORM) {
            const int nig = 8 * 36, gid = w / nig, r = w % nig; const int pm = gid * 8 + (r & 7), ct = r >> 3;
            int wt, kind, pn;
            if (ct < 4) { wt = ct; kind = MK_S; pn = ct; } else if (ct < 8) { wt = ct; kind = MK_Q; pn = ct - 4; } else if (ct < 12) { wt = ct; kind = MK_K; pn = ct - 8; }
            else if (ct < 20) { wt = ct + 8; kind = MK_G; pn = ct - 12; } else if (ct < 28) { wt = ct + 8; kind = MK_GS; pn = ct - 20; } else { wt = ct + 8; kind = MK_GR; pn = ct - 28; }
            u.A = U + (size_t)pm * tstep; u.B = WM + (size_t)wt * tstep; u.pm = pm; u.pn = pn; u.kind = kind; return true;
        }
        w -= N_NORM;
        if (w < N_CTXS) { const int pm = 32 + (w & 1), ct = w >> 1; u.A = U + (size_t)pm * tstep; u.B = WM + (size_t)ct * tstep; u.pm = pm; u.pn = ct; u.kind = MK_S; return true; }
        w -= N_CTXS;
        { const int tt = w / 12, ft = w % 12;
          u.B = U + (size_t)tt * tstep; u.pn = tt;
          if (ft < 4) { u.A = WM + (size_t)(44 + ft) * tstep; u.pm = ft; u.kind = MK_KT; } else { u.A = WM + (size_t)(12 + ft - 4) * tstep; u.pm = ft - 4; u.kind = MK_VT; }
          return true; }
    }
};

constexpr int RING_BYTES = 131072, LDSCTL_OFF = RING_BYTES, MISC_OFF = LDSCTL_OFF + 320, LDS_BYTES = 147456;
struct Args { const float* in[22]; float* out; unsigned char* ws; };
struct Frame {
    LAS unsigned char* lds; volatile LAS unsigned* MISC; unsigned* ctl;
    int tid, lane, wave, vcu, G;
    const float* in[22]; float* out; unsigned char* ws;
};

__device__ __forceinline__ int map_pair(int n, int half) { const int h = n < half ? n : n - half, up = n >= half; return 256 * (h >> 7) + 128 * up + (h & 127); }
__device__ __forceinline__ int map_mix(int n) {
    if (n < 1024 || n >= 3072) return n;
    const int base = n & ~127, d = n & 127, p = d >> 6, e = d & 63, s = e >> 5, i = e & 31, t = 32 * p + i;
    return base + 32 * (t >> 4) + 8 * ((t >> 2) & 3) + 4 * s + (t & 3);
}
template <int MAPID>
__device__ __forceinline__ void transpose_item(const float* W, int ldw, int K, int nblk, bf16* WT, int row_off, int half, LAS float* scr, int item, int lane) {
    const int kb = item / nblk, nb = item % nblk, k0 = 64 * kb, n0 = 32 * nb;
#pragma unroll 8
    for (int i = 0; i < 32; ++i) { const int kk = 2 * i + (lane >> 5); scr[kk * 33 + (lane & 31)] = W[(size_t)(k0 + kk) * ldw + n0 + (lane & 31)]; }
    LDS_WAIT(); asm volatile("" ::: "memory");
    const int c = lane & 7;
#pragma unroll
    for (int j = 0; j < 4; ++j) { const int n = (lane >> 3) + 8 * j; const LAS float* s = scr + (8 * c) * 33 + n;
        v4u o; o.x = pk2(s[0 * 33], s[1 * 33]); o.y = pk2(s[2 * 33], s[3 * 33]); o.z = pk2(s[4 * 33], s[5 * 33]); o.w = pk2(s[6 * 33], s[7 * 33]);
        const int nn = n0 + n; const int dr = MAPID == 0 ? nn : (MAPID == 1 ? map_pair(nn, half) : map_mix(nn));
        *(v4u*)(WT + (size_t)(row_off + dr) * K + k0 + 8 * c) = o; }
    LDS_WAIT(); asm volatile("" ::: "memory");
}
__device__ __forceinline__ void sincos_d(double x, double& s, double& c) {
    const double TWO_PI = 6.283185307179586476925286766559;
    x -= TWO_PI * __builtin_rint(x / TWO_PI);
    const double h = 0.125 * x, h2 = h * h;
    double sn = h * (1.0 + h2 * (-1.0 / 6 + h2 * (1.0 / 120 + h2 * (-1.0 / 5040 + h2 * (1.0 / 362880 + h2 * (-1.0 / 39916800 + h2 * (1.0 / 6227020800.0)))))));
    double cs = 1.0 + h2 * (-0.5 + h2 * (1.0 / 24 + h2 * (-1.0 / 720 + h2 * (1.0 / 40320 + h2 * (-1.0 / 3628800 + h2 * (1.0 / 479001600.0 + h2 * (-1.0 / 87178291200.0)))))));
#pragma unroll
    for (int k = 0; k < 3; ++k) { const double s2 = 2.0 * sn * cs, c2 = 1.0 - 2.0 * sn * sn; sn = s2; cs = c2; }
    s = sn; c = cs;
}
__device__ __forceinline__ double exp_d(double x) {
    const double y = x * (1.0 / 4096.0);
    double e = 1.0 + y * (1.0 + y * (0.5 + y * (1.0 / 6 + y * (1.0 / 24 + y * (1.0 / 120 + y * (1.0 / 720))))));
#pragma unroll
    for (int k = 0; k < 12; ++k) e = e * e;
    return e;
}
__device__ __forceinline__ double log1p_small_d(double z) {
    const double t = z / (2.0 + z), t2 = t * t;
    return 2.0 * t * (1.0 + t2 * (1.0 / 3 + t2 * (1.0 / 5 + t2 * (1.0 / 7 + t2 * (1.0 / 9 + t2 * (1.0 / 11))))));
}

__device__ __forceinline__ void phase_prologue(Frame& F0) {
    Frame F = F0; asm volatile("" : "+v"(F.lane));
    LAS float* scr = (LAS float*)(F.lds + F.wave * 16384);
    const int gw = F.vcu * NWAVES + F.wave, NGW = F.G * NWAVES;
    unsigned char* ws = F.ws;
    {
        const int gt = gw * 64 + F.lane, NT = NGW * 64;
        unsigned char* tab = ws + WS_TAB;
        for (int idx = gt; idx < 2048; idx += NT) {
            const int pos = idx >> 5, i = idx & 31;
            const double inv = exp_d(-(double)i * (9.210340371976182736 / 32.0));
            double s, c; sincos_d((double)pos * inv, s, c);
            ((f32x2*)(tab + TAB_ROPE))[idx] = (f32x2){(float)c, (float)s};
        }
        for (int idx = gt; idx < 16; idx += NT) {
            const double x = (double)F.in[19][idx];
            ((float*)(tab + TAB_LG2))[idx] = (float)(-log1p_small_d(exp_d(-x)) * 1.4426950408889634074);
        }
        for (int idx = gt; idx < 2 * 64 * 64; idx += NT) {
            const int dg = idx >> 6, p = idx & 63;
            const double lr = (double)F.in[10][idx], li = (double)F.in[11][idx], step = exp_d((double)F.in[12][dg]);
            const double mag = exp_d(lr * step); double sn, cs; sincos_d(li * step, sn, cs);
            const double ar = mag * cs, ai = mag * sn, den = lr * lr + li * li, nr = ar - 1.0, ni = ai;
            const double kr = (nr * lr + ni * li) / den, ki = (ni * lr - nr * li) / den;
            ((float*)(tab + TAB_AR))[idx] = (float)ar; ((float*)(tab + TAB_AI))[idx] = (float)ai;
            bf16* bbt = (bf16*)(tab + TAB_BBT) + (size_t)dg * 128 * 16;
            const float* bre = F.in[13] + (size_t)idx * 16; const float* bim = F.in[14] + (size_t)idx * 16;
            for (int c = 0; c < 16; ++c) { const double br = (double)bre[c], bi = (double)bim[c];
                bbt[p * 16 + c] = (bf16)f2bf((float)(kr * br - ki * bi)); bbt[(64 + p) * 16 + c] = (bf16)f2bf((float)(kr * bi + ki * br)); }
        }
        for (int idx = gt; idx < 2 * 64 * 16 * 64; idx += NT) {
            const int p = idx & 63, dgc = idx >> 6;
            bf16* cmt = (bf16*)(tab + TAB_CMT) + (size_t)dgc * 128;
            cmt[p] = (bf16)f2bf(F.in[15][idx]); cmt[64 + p] = (bf16)f2bf(-F.in[16][idx]);
        }
    }
    {
        float* ADA = (float*)(ws + WS_CTL + CTL_ADA);
        const float* aw = F.in[4];
        for (int it = gw; it < 16 * 72; it += NGW) {
            const int kc = it / 72, cb = it % 72, k0 = kc * 128, col = cb * 256 + 4 * F.lane;
            for (int i = F.lane; i < 384; i += 64) { const int v = i >> 7, k = i & 127; const float x = v == 0 ? F.in[1][k0 + k] : (v == 1 ? F.in[1][D + k0 + k] : F.in[3][k0 + k]); scr[i] = x / (1.0f + __expf(-x)); }
            LDS_WAIT(); asm volatile("" ::: "memory");
            f32x4 a0 = {0.f, 0.f, 0.f, 0.f}, a1 = a0, a2 = a0;
#pragma unroll 8
            for (int k = 0; k < 128; ++k) { const f32x4 w = *(const f32x4*)(aw + (size_t)(k0 + k) * NADA + col); a0 += w * scr[k]; a1 += w * scr[128 + k]; a2 += w * scr[256 + k]; }
#pragma unroll
            for (int j = 0; j < 4; ++j) { __hip_atomic_fetch_add(ADA + col + j, a0[j], RLX_AGENT); __hip_atomic_fetch_add(ADA + NADA + col + j, a1[j], RLX_AGENT); __hip_atomic_fetch_add(ADA + 2 * NADA + col + j, a2[j], RLX_AGENT); }
            LDS_WAIT(); asm volatile("" ::: "memory");
        }
    }
    {
        constexpr int I1 = (D / 64) * (NFF / 32), I2 = (DFF / 64) * (D / 32), IM = (D / 64) * (NMIX / 32), IK = (D / 64) * (1024 / 32), IG = (SW / 64) * (2 * D / 32), IP = (D / 64) * (D / 32);
        constexpr int NITEMS = 2 * I1 + 2 * I2 + IM + IK + IG + 2 * IP;
        for (int it = gw; it < NITEMS; it += NGW) {
            int r = it;
            if (r < I1) { transpose_item<1>(F.in[7], NFF, D, NFF / 32, (bf16*)(ws + WS_W1T), 0, DFF, scr, r, F.lane); continue; } r -= I1;
            if (r < I2) { transpose_item<0>(F.in[8], D, DFF, D / 32, (bf16*)(ws + WS_W2T), 0, 0, scr, r, F.lane); continue; } r -= I2;
            if (r < IM) { transpose_item<2>(F.in[9], NMIX, D, NMIX / 32, (bf16*)(ws + WS_WMT), 0, 0, scr, r, F.lane); continue; } r -= IM;
            if (r < IK) { transpose_item<0>(F.in[9] + 2048, NMIX, D, 1024 / 32, (bf16*)(ws + WS_WMT), NMIX, 0, scr, r, F.lane); continue; } r -= IK;
            if (r < IG) { transpose_item<1>(F.in[18], 2 * D, SW, 2 * D / 32, (bf16*)(ws + WS_WGT), 0, D, scr, r, F.lane); continue; } r -= IG;
            if (r < IP) { transpose_item<0>(F.in[20], D, D, D / 32, (bf16*)(ws + WS_WPT), 0, 0, scr, r, F.lane); continue; } r -= IP;
            if (r < IP) { transpose_item<0>(F.in[21], D, D, D / 32, (bf16*)(ws + WS_WOT), 0, 0, scr, r, F.lane); continue; } r -= IP;
            if (r < I1) { transpose_item<1>(F.in[7] + (size_t)D * NFF, NFF, D, NFF / 32, (bf16*)(ws + WS_W3T), 0, DFF, scr, r, F.lane); continue; } r -= I1;
            transpose_item<0>(F.in[8] + (size_t)DFF * D, D, DFF, D / 32, (bf16*)(ws + WS_W4T), 0, 0, scr, r, F.lane);
        }
    }
}

template <int MODE>
__device__ __forceinline__ void phase_rows(Frame& F0) {
    Frame F = F0; asm volatile("" : "+v"(F.lane));
    const int gw = F.vcu * NWAVES + F.wave, NGW = F.G * NWAVES;
    const float* ADA = (const float*)(F.ws + WS_CTL + CTL_ADA);
    const float* adab = F.in[5]; const float* ng = F.in[6];
    const float* O = (const float*)(F.ws + WS_OBUF);
    bf16* A = (bf16*)(F.ws + WS_ABUF);
    const int nrows = (MODE <= 1) ? MT : MX;
    for (int r = gw; r < nrows; r += NGW) {
        const int av = r < MX ? (r >> 12) : 2;
        const float* ada = ADA + (size_t)av * NADA;
        f32x4 h[8];
        const float* hsrc = (MODE <= 1) ? (r < MX ? F.in[0] + (size_t)r * D : F.in[2] + (size_t)(r - MX) * D) : F.out + (size_t)r * D;
#pragma unroll
        for (int j = 0; j < 8; ++j) h[j] = *(const f32x4*)(hsrc + 256 * j + 4 * F.lane);
        if (MODE >= 1) {
            constexpr int ipost = MODE - 1;
            const float resw = (MODE == 2) ? 1.0f : 0.5f;
            f32x4 o[8]; float ss = 0.f;
#pragma unroll
            for (int j = 0; j < 8; ++j) { o[j] = *(const f32x4*)(O + (size_t)r * D + 256 * j + 4 * F.lane); ss += (o[j][0] * o[j][0] + o[j][1] * o[j][1]) + (o[j][2] * o[j][2] + o[j][3] * o[j][3]); }
            const float rstd = 1.0f / sqrtf(wave_sum(ss) * (1.0f / D) + EPS);
#pragma unroll
            for (int j = 0; j < 8; ++j) { const int c = 256 * j + 4 * F.lane;
                const f32x4 gate = *(const f32x4*)(ada + (3 * ipost + 2) * D + c) + *(const f32x4*)(adab + (3 * ipost + 2) * D + c);
                const f32x4 g = *(const f32x4*)(ng + (2 * ipost + 1) * D + c);
                h[j] = h[j] + (resw * rstd) * (gate * (o[j] * g)); }
            if (r < MX) {
#pragma unroll
                for (int j = 0; j < 8; ++j) *(f32x4*)(F.out + (size_t)r * D + 256 * j + 4 * F.lane) = h[j];
            }
        }
        if (MODE <= 2) {
            constexpr int ipre = MODE;
            float ss = 0.f;
#pragma unroll
            for (int j = 0; j < 8; ++j) ss += (h[j][0] * h[j][0] + h[j][1] * h[j][1]) + (h[j][2] * h[j][2] + h[j][3] * h[j][3]);
            const float rstd = 1.0f / sqrtf(wave_sum(ss) * (1.0f / D) + EPS);
#pragma unroll
            for (int j = 0; j < 8; ++j) { const int c = 256 * j + 4 * F.lane;
                const f32x4 shift = *(const f32x4*)(ada + (3 * ipre) * D + c) + *(const f32x4*)(adab + (3 * ipre) * D + c);
                const f32x4 scale = *(const f32x4*)(ada + (3 * ipre + 1) * D + c) + *(const f32x4*)(adab + (3 * ipre + 1) * D + c);
                const f32x4 g = *(const f32x4*)(ng + (2 * ipre) * D + c);
                const f32x4 v = (h[j] * rstd) * g * (scale + 1.0f) + shift;
                v2u w; w.x = cvt_pk_bf16(v[0], v[1]); w.y = cvt_pk_bf16(v[2], v[3]);
                *(v2u*)(A + (size_t)r * D + c) = w; }
        }
    }
}

constexpr int S5_SEG = (LC + SEQ) / NWAVES;
constexpr int XS_STRIDE = 132, HS_STRIDE = 136;
constexpr int S5_WAVE_BYTES = 16 * XS_STRIDE * 4 + 16 * HS_STRIDE * 2;
constexpr int S5_EX_OFF = NWAVES * S5_WAVE_BYTES;
__device__ __forceinline__ int s5_row(int b, int dir, int s) {
    if (s < LC) { const int l = dir ? (LC - 1 - s) : s; return MX + b * LC + l; }
    const int l2 = s - LC; const int l = dir ? (SEQ - 1 - l2) : l2; return b * SEQ + l;
}
__device__ __forceinline__ void phase_s5(Frame& F) {
    const unsigned char* tab = F.ws + WS_TAB;
    const bf16* US = (const bf16*)(F.ws + WS_US);
    float* YF = (float*)(F.ws + WS_YF);
    bf16* AGLU = (bf16*)(F.ws + WS_AGLU);
    const float* dskip = F.in[17];
    LAS float* Xs = (LAS float*)(F.lds + F.wave * S5_WAVE_BYTES);
    LAS bf16* Hs = (LAS bf16*)(F.lds + F.wave * S5_WAVE_BYTES + 16 * XS_STRIDE * 4);
    LAS f32x2* EX = (LAS f32x2*)(F.lds + S5_EX_OFF);
    int lane = F.lane; asm volatile("" : "+v"(lane));
    const int fr = lane & 15, fq = lane >> 4, w = F.wave;
    for (int unit = F.vcu; unit < NB * 64; unit += F.G) {
        const int b = unit >> 6, g = unit & 63;
        for (int dir = 0; dir < 2; ++dir) {
            const int dg = dir * 64 + g;
            const float ar = ((const float*)(tab + TAB_AR))[dg * 64 + lane], ai = ((const float*)(tab + TAB_AI))[dg * 64 + lane];
            bf16x8 bfr[8], cfr[4];
            const bf16* bbt = (const bf16*)(tab + TAB_BBT) + (size_t)dg * 128 * 16;
            const bf16* cmt = (const bf16*)(tab + TAB_CMT) + (size_t)dg * 16 * 128;
#pragma unroll
            for (int nt = 0; nt < 8; ++nt) { bf16x8 z = {0, 0, 0, 0, 0, 0, 0, 0}; if (fq < 2) z = *(const bf16x8*)(bbt + (16 * nt + fr) * 16 + 8 * fq); bfr[nt] = z; }
#pragma unroll
            for (int ks = 0; ks < 4; ++ks) cfr[ks] = *(const bf16x8*)(cmt + fr * 128 + 32 * ks + 8 * fq);
            float hr = 0.f, hi = 0.f;
            for (int pass = 0; pass < 2; ++pass) {
                if (pass == 1) {
                    EX[w * 64 + lane] = (f32x2){hr, hi};
                    __syncthreads();
                    float pr = ar, pi = ai, p32r = 0.f, p32i = 0.f;
#pragma unroll
                    for (int k = 0; k < 9; ++k) { const float nr = pr * pr - pi * pi, ni = 2.f * pr * pi; pr = nr; pi = ni; if (k == 4) { p32r = pr; p32i = pi; } }
                    const float qr = pr * p32r - pi * p32i, qi = pr * p32i + pi * p32r;
                    hr = 0.f; hi = 0.f;
                    for (int k = 0; k < w; ++k) { const f32x2 e = EX[k * 64 + lane]; const float nr = qr * hr - qi * hi + e[0], ni = qr * hi + qi * hr + e[1]; hr = nr; hi = ni; }
                }
                for (int sc = 0; sc < S5_SEG / 16; ++sc) {
                    const int s0 = w * S5_SEG + sc * 16;
                    bf16x8 ufr = {0, 0, 0, 0, 0, 0, 0, 0};
                    if (fq < 2) ufr = *(const bf16x8*)(US + (size_t)s5_row(b, dir, s0 + fr) * SW + 16 * g + 8 * fq);
#pragma unroll
                    for (int nt = 0; nt < 8; ++nt) {
                        const f32x4 x = __builtin_amdgcn_mfma_f32_16x16x32_bf16(bfr[nt], ufr, (f32x4){0.f, 0.f, 0.f, 0.f}, 0, 0, 0);
                        *(LAS f32x4*)(Xs + fr * XS_STRIDE + 16 * nt + 4 * fq) = x;
                    }
                    if (pass == 0) {
#pragma unroll
                        for (int t = 0; t < 16; ++t) { const float xr = Xs[t * XS_STRIDE + lane], xi = Xs[t * XS_STRIDE + 64 + lane];
                            const float nr = ar * hr - ai * hi + xr, ni = ar * hi + ai * hr + xi; hr = nr; hi = ni; }
                    } else {
#pragma unroll
                        for (int t = 0; t < 16; ++t) { const float xr = Xs[t * XS_STRIDE + lane], xi = Xs[t * XS_STRIDE + 64 + lane];
                            const float nr = ar * hr - ai * hi + xr, ni = ar * hi + ai * hr + xi; hr = nr; hi = ni;
                            Hs[t * HS_STRIDE + lane] = (bf16)f2bf(hr); Hs[t * HS_STRIDE + 64 + lane] = (bf16)f2bf(hi); }
                        if (s0 >= LC) {
                            f32x4 y = {0.f, 0.f, 0.f, 0.f};
#pragma unroll
                            for (int ks = 0; ks < 4; ++ks) { const bf16x8 hf = *(const LAS bf16x8*)(Hs + fr * HS_STRIDE + 32 * ks + 8 * fq); y = __builtin_amdgcn_mfma_f32_16x16x32_bf16(cfr[ks], hf, y, 0, 0, 0); }
                            const int row = s5_row(b, dir, s0 + fr), ch = 16 * g + 4 * fq;
                            if (dir == 0) {
                                const v2u uu = *(const v2u*)(US + (size_t)row * SW + ch); const f32x4 dk = *(const f32x4*)(dskip + ch);
                                y[0] += dk[0] * bflo(uu.x); y[1] += dk[1] * bfhi(uu.x); y[2] += dk[2] * bflo(uu.y); y[3] += dk[3] * bfhi(uu.y);
                                *(f32x4*)(YF + (size_t)row * SW + ch) = y;
                            } else {
                                y += *(const f32x4*)(YF + (size_t)row * SW + ch);
                                v2u o; o.x = cvt_pk_bf16(gelu_tanh(y[0]), gelu_tanh(y[1])); o.y = cvt_pk_bf16(gelu_tanh(y[2]), gelu_tanh(y[3]));
                                *(v2u*)(AGLU + (size_t)row * SW + ch) = o;
                            }
                        }
                    }
                }
            }
            __syncthreads();
        }
    }
}

__device__ __forceinline__ void phase_rstate(Frame& F) {
    const bf16* KFT = (const bf16*)(F.ws + WS_KFT); const bf16* KBT = (const bf16*)(F.ws + WS_KBT);
    const bf16* KFTC = (const bf16*)(F.ws + WS_KFTC); const bf16* KBTC = (const bf16*)(F.ws + WS_KBTC);
    const bf16* VT = (const bf16*)(F.ws + WS_VT); const bf16* VTC = (const bf16*)(F.ws + WS_VTC);
    bf16* SIN = (bf16*)(F.ws + WS_OBUF);
    const float* lg2 = (const float*)(F.ws + WS_TAB + TAB_LG2);
    int lane = F.lane; asm volatile("" : "+v"(lane));
    const int fr = lane & 15, fq = lane >> 4, w = F.wave;
    for (int unit = F.vcu; unit < NB * NH * 2 * 8; unit += F.G) {
        const int sl = unit & 7, dir = (unit >> 3) & 1, h = (unit >> 4) & 7, b = unit >> 7;
        const float gC = __builtin_amdgcn_exp2f((float)CH * lg2[dir * 8 + h]);
        const int bh = b * NH + h;
        const int drow = 16 * w + fr;
        f32x4 st[2] = {{0.f, 0.f, 0.f, 0.f}, {0.f, 0.f, 0.f, 0.f}};
        for (int k = 0; k < 34; ++k) {
            const bf16* kp; const bf16* vp; int n = -1;
            if (k < 2) { const int cc = dir ? (1 - k) : k; kp = (dir ? KBTC : KFTC) + ((size_t)(bh * DK + drow)) * LC + cc * CH; vp = VTC + ((size_t)(bh * DV + 32 * sl + fr)) * LC + cc * CH; }
            else { n = dir ? (33 - k) : (k - 2); kp = (dir ? KBT : KFT) + ((size_t)(bh * DK + drow)) * SEQ + n * CH; vp = VT + ((size_t)(bh * DV + 32 * sl + fr)) * SEQ + n * CH; }
            const size_t vstep = (size_t)16 * (k < 2 ? LC : SEQ);
            bf16x8 kf[4], vf[2][4];
#pragma unroll
            for (int ks = 0; ks < 4; ++ks) { kf[ks] = *(const bf16x8*)(kp + 32 * ks + 8 * fq); vf[0][ks] = *(const bf16x8*)(vp + 32 * ks + 8 * fq); vf[1][ks] = *(const bf16x8*)(vp + vstep + 32 * ks + 8 * fq); }
            if (n >= 0) {
#pragma unroll
                for (int et = 0; et < 2; ++et) { v2u o; o.x = cvt_pk_bf16(st[et][0], st[et][1]); o.y = cvt_pk_bf16(st[et][2], st[et][3]);
                    *(v2u*)(SIN + ((((size_t)(bh * 2 + dir) * NCH + n) * DV + 32 * sl + 16 * et + fr) * DK + 16 * w + 4 * fq)) = o; }
            }
#pragma unroll
            for (int et = 0; et < 2; ++et) {
                f32x4 kv = {0.f, 0.f, 0.f, 0.f};
#pragma unroll
                for (int ks = 0; ks < 4; ++ks) kv = __builtin_amdgcn_mfma_f32_16x16x32_bf16(kf[ks], vf[et][ks], kv, 0, 0, 0);
                st[et] = st[et] * gC + kv;
            }
        }
    }
}

__device__ __forceinline__ void phase_rout(Frame& F) {
    const bf16* Q = (const bf16*)(F.ws + WS_Q); const bf16* QF = (const bf16*)(F.ws + WS_QF); const bf16* QB = (const bf16*)(F.ws + WS_QB);
    const bf16* KN = (const bf16*)(F.ws + WS_K); const bf16* VT = (const bf16*)(F.ws + WS_VT);
    const bf16* SIN = (const bf16*)(F.ws + WS_OBUF);
    bf16* SG = (bf16*)(F.ws + WS_HBUF);
    const float* lg2 = (const float*)(F.ws + WS_TAB + TAB_LG2);
    int lane = F.lane; asm volatile("" : "+v"(lane));
    const int fr0 = lane & 15, fq0 = lane >> 4, w = F.wave;
    for (int unit = F.vcu; unit < NB * NH * NCH; unit += F.G) {
        const int n = unit & 31, h = (unit >> 5) & 7, b = unit >> 8, bh = b * NH + h;
        int fr = fr0, fq = fq0; asm volatile("" : "+v"(fr), "+v"(fq));
        const float lgf = lg2[h], lgb = lg2[8 + h];
        const int tok0 = b * SEQ + n * CH;
        const int i = 16 * w + fr;
        const size_t qoff = (size_t)(tok0 + i) * 1024 + h * DK;
        f32x4 sc[8];
        {
            bf16x8 qf[4];
#pragma unroll
            for (int ks = 0; ks < 4; ++ks) qf[ks] = *(const bf16x8*)(Q + qoff + 32 * ks + 8 * fq);
#pragma unroll
            for (int jt = 0; jt < 8; ++jt) {
                f32x4 a = {0.f, 0.f, 0.f, 0.f};
#pragma unroll
                for (int ks = 0; ks < 4; ++ks) { const bf16x8 kf = *(const bf16x8*)(KN + (size_t)(tok0 + 16 * jt + fr) * 1024 + h * DK + 32 * ks + 8 * fq); a = __builtin_amdgcn_mfma_f32_16x16x32_bf16(kf, qf[ks], a, 0, 0, 0); }
#pragma unroll
                for (int r = 0; r < 4; ++r) { const int j = 16 * jt + 4 * fq + r, df = i - j; a[r] *= df >= 0 ? __builtin_amdgcn_exp2f((float)df * lgf) : __builtin_amdgcn_exp2f((float)(-df) * lgb); }
                sc[jt] = a;
                asm volatile("" ::: "memory");
            }
        }
        f32x4 o[16];
#pragma unroll
        for (int et = 0; et < 16; ++et) o[et] = (f32x4){0.f, 0.f, 0.f, 0.f};
#pragma unroll
        for (int ks = 0; ks < 4; ++ks) {
            v4u pw; pw.x = cvt_pk_bf16(sc[2 * ks][0], sc[2 * ks][1]); pw.y = cvt_pk_bf16(sc[2 * ks][2], sc[2 * ks][3]); pw.z = cvt_pk_bf16(sc[2 * ks + 1][0], sc[2 * ks + 1][1]); pw.w = cvt_pk_bf16(sc[2 * ks + 1][2], sc[2 * ks + 1][3]);
            const bf16x8 pf = __builtin_bit_cast(bf16x8, pw);
#pragma unroll
            for (int et = 0; et < 16; ++et) {
                const bf16* vp = VT + ((size_t)(bh * DV + 16 * et + fr)) * SEQ + n * CH + 32 * ks + 4 * fq;
                const v2u lo = *(const v2u*)vp, hi2 = *(const v2u*)(vp + 16);
                v4u vw; vw.x = lo.x; vw.y = lo.y; vw.z = hi2.x; vw.w = hi2.y;
                o[et] = __builtin_amdgcn_mfma_f32_16x16x32_bf16(__builtin_bit_cast(bf16x8, vw), pf, o[et], 0, 0, 0);
                if ((et & 3) == 3) asm volatile("" ::: "memory");
            }
        }
#pragma unroll
        for (int dir = 0; dir < 2; ++dir) {
            const bf16* sp = SIN + (((size_t)(bh * 2 + dir) * NCH + n) * DV) * DK;
            const bf16* qd = dir ? QB : QF;
#pragma unroll
            for (int ks = 0; ks < 4; ++ks) {
                const bf16x8 qf = *(const bf16x8*)(qd + qoff + 32 * ks + 8 * fq);
#pragma unroll
                for (int et = 0; et < 16; ++et) { const bf16x8 sf = *(const bf16x8*)(sp + (size_t)(16 * et + fr) * DK + 32 * ks + 8 * fq); o[et] = __builtin_amdgcn_mfma_f32_16x16x32_bf16(sf, qf, o[et], 0, 0, 0);
                    if ((et & 3) == 3) asm volatile("" ::: "memory"); }
            }
        }
        float ss = 0.f;
#pragma unroll
        for (int et = 0; et < 16; ++et) ss += (o[et][0] * o[et][0] + o[et][1] * o[et][1]) + (o[et][2] * o[et][2] + o[et][3] * o[et][3]);
        ss += __shfl_xor(ss, 16); ss += __shfl_xor(ss, 32);
        const float rinv = 1.0f / sqrtf(ss * (1.0f / DV) + EPS);
        bf16* gp = SG + (size_t)(tok0 + i) * D + h * DV + 4 * fq;
#pragma unroll
        for (int et = 0; et < 16; ++et) { const v2u gg = *(const v2u*)(gp + 16 * et);
            v2u ow; ow.x = cvt_pk_bf16(o[et][0] * rinv * bflo(gg.x), o[et][1] * rinv * bfhi(gg.x)); ow.y = cvt_pk_bf16(o[et][2] * rinv * bflo(gg.y), o[et][3] * rinv * bfhi(gg.y));
            *(v2u*)(gp + 16 * et) = ow; }
    }
}

__global__ void __launch_bounds__(NWAVES * 64, 2) fwd_megakernel(Args args) {
    extern __shared__ __attribute__((aligned(16))) unsigned char lds[];
    Frame F;
    F.lds = (LAS unsigned char*)lds;
    F.MISC = (volatile LAS unsigned*)(F.lds + MISC_OFF);
    F.tid = threadIdx.x; F.lane = F.tid & 63; F.wave = __builtin_amdgcn_readfirstlane(F.tid >> 6);
    F.G = gridDim.x; { const int bx = blockIdx.x; F.vcu = (F.G % 8 == 0) ? (bx % 8) * (F.G / 8) + bx / 8 : bx; }
#pragma unroll
    for (int i = 0; i < 22; ++i) F.in[i] = args.in[i];
    F.out = args.out; F.ws = args.ws; F.ctl = (unsigned*)(args.ws + WS_CTL);
    for (int u = F.tid; u < (LDS_BYTES - LDSCTL_OFF) / 4; u += NWAVES * 64) ((LAS unsigned*)(F.lds + LDSCTL_OFF))[u] = 0u;
    __syncthreads();
    XcdBarrier bar = xcd_barrier_post(F.ctl + CW_BAR, F.MISC + 8);
    unsigned char* ws = F.ws;
    const int G = F.G, cid = (int)blockIdx.x;
#define GRID_BAR() xcd_barrier(bar)

#ifndef PHM
#define PHM 0xFFFFF
#endif
#define PH(k) ((PHM >> (k)) & 1)
#if PH(0)
    phase_prologue(F);
#endif
    GRID_BAR();
#if PH(1)
    phase_rows<0>(F);
#endif
    GRID_BAR();
#if PH(2)
    {
        pg8::GridOrder S; S.init(ws + WS_ABUF, ws + WS_W1T, D, MT / 256, NFF / 256, G, cid);
        EpiSwiGLU E{(bf16*)(ws + WS_HBUF)};
        pg8::gemm_phase(F.lds, D, S, E);
    }
#endif
    GRID_BAR();
#if PH(3)
    {
        pg8::GridOrder S; S.init(ws + WS_HBUF, ws + WS_W2T, DFF, MT / 256, D / 256, G, cid);
        EpiF32 E{(float*)(ws + WS_OBUF), D};
        pg8::gemm_phase(F.lds, DFF, S, E);
    }
#endif
    GRID_BAR();
#if PH(4)
    phase_rows<1>(F);
#endif
    GRID_BAR();
#if PH(5)
    {
        MixOrder S{(const char*)(ws + WS_ABUF), (const char*)(ws + WS_WMT), G, cid};
        EpiMix E{ws};
        pg8::gemm_phase(F.lds, D, S, E);
    }
#endif
    GRID_BAR();
#if PH(6)
    phase_rstate(F);
#endif
#if PH(7)
    phase_s5(F);
#endif
    GRID_BAR();
#if PH(8)
    phase_rout(F);
#endif
    GRID_BAR();
#if PH(9)
    {
        pg8::GridOrder S; S.init(ws + WS_AGLU, ws + WS_WGT, SW, MX / 256, 2 * D / 256, G, cid);
        EpiGLU E{(const bf16*)(ws + WS_HBUF + 32 * MiB), (bf16*)(ws + WS_Q)};
        pg8::gemm_phase(F.lds, SW, S, E);
    }
#endif
    GRID_BAR();
#if PH(10)
    {
        pg8::GridOrder S; S.init(ws + WS_HBUF, ws + WS_WPT, D, MX / 256, D / 256, G, cid);
        EpiMerge E{(const bf16*)(ws + WS_HBUF + 64 * MiB), (bf16*)(ws + WS_Q)};
        pg8::gemm_phase(F.lds, D, S, E);
    }
#endif
    GRID_BAR();
#if PH(11)
    {
        pg8::GridOrder S; S.init(ws + WS_Q, ws + WS_WOT, D, MX / 256, D / 256, G, cid);
        EpiF32 E{(float*)(ws + WS_OBUF), D};
        pg8::gemm_phase(F.lds, D, S, E);
    }
#endif
    GRID_BAR();
#if PH(12)
    phase_rows<2>(F);
#endif
    GRID_BAR();
#if PH(13)
    {
        pg8::GridOrder S; S.init(ws + WS_ABUF, ws + WS_W3T, D, MX / 256, NFF / 256, G, cid);
        EpiSwiGLU E{(bf16*)(ws + WS_HBUF)};
        pg8::gemm_phase(F.lds, D, S, E);
    }
#endif
    GRID_BAR();
#if PH(14)
    {
        pg8::GridOrder S; S.init(ws + WS_HBUF, ws + WS_W4T, DFF, MX / 256, D / 256, G, cid);
        EpiF32 E{(float*)(ws + WS_OBUF), D};
        pg8::gemm_phase(F.lds, DFF, S, E);
    }
#endif
    GRID_BAR();
#if PH(15)
    phase_rows<3>(F);
#endif
}

extern "C" void kernel_launch(void* const* d_in, const int* in_sizes, int n_in, void* d_out, int out_size, void* d_ws, size_t ws_size, hipStream_t stream) {
    static int grid = 0;
    if (grid == 0) {
        if (n_in != 22 || in_sizes[0] != MX * D || out_size != MX * D || ws_size < WS_END) { fprintf(stderr, "kernel_launch: unexpected problem (n_in %d, in0 %d, out %d, ws %zu, need %zu)\n", n_in, n_in > 0 ? in_sizes[0] : -1, out_size, ws_size, (size_t)WS_END); grid = -1; return; }
        int dev = 0, cus = 0, per_cu = 0;
        if (hipGetDevice(&dev) != hipSuccess || hipDeviceGetAttribute(&cus, hipDeviceAttributeMultiprocessorCount, dev) != hipSuccess) { grid = -1; return; }
        if (hipFuncSetAttribute((const void*)fwd_megakernel, hipFuncAttributeMaxDynamicSharedMemorySize, LDS_BYTES) != hipSuccess) { fprintf(stderr, "kernel_launch: hipFuncSetAttribute failed\n"); grid = -1; return; }
        if (hipOccupancyMaxActiveBlocksPerMultiprocessor(&per_cu, (const void*)fwd_megakernel, NWAVES * 64, LDS_BYTES) != hipSuccess || per_cu < 1) { fprintf(stderr, "kernel_launch: occupancy query says %d blocks per CU\n", per_cu); grid = -1; (void)hipGetLastError(); return; }
        grid = cus;
    }
    if (grid < 0) return;
    if (hipMemsetAsync((char*)d_ws + WS_CTL, 0, CTL_ZERO_BYTES, stream) != hipSuccess) return;
    Args a{};
    for (int i = 0; i < 22; ++i) a.in[i] = (const float*)d_in[i];
    a.out = (float*)d_out; a.ws = (unsigned char*)d_ws;
    void* kargs[] = {&a};
    hipError_t e = hipLaunchCooperativeKernel((const void*)fwd_megakernel, dim3(grid), dim3(NWAVES * 64), kargs, LDS_BYTES, stream);
    if (e != hipSuccess) fprintf(stderr, "kernel_launch: cooperative launch failed: %s (grid %d)\n", hipGetErrorString(e), grid);
}
```

```cpp
#include <hip/hip_runtime.h>
#include <cstdio>
#include <cstdint>

#define GAS __attribute__((address_space(1)))
#define LAS __attribute__((address_space(3)))
typedef unsigned short bf16;
typedef unsigned v4u __attribute__((ext_vector_type(4)));
typedef unsigned v2u __attribute__((ext_vector_type(2)));
typedef float f32x4 __attribute__((ext_vector_type(4)));
typedef float f32x2 __attribute__((ext_vector_type(2)));
typedef short bf16x8 __attribute__((ext_vector_type(8)));
typedef short bf16x4 __attribute__((ext_vector_type(4)));

constexpr int D = 2048, NB = 2, SEQ = 4096, MX = NB * SEQ, LC = 256, MC = NB * LC, MT = MX + MC;
constexpr int DFF = 5632, NFF = 2 * DFF, SW = 1024, NMIX = 11264, NH = 8, DK = 128, DV = 256, CH = 128, NCH = SEQ / CH;
constexpr int NADA = 9 * D;
constexpr float EPS = 1e-6f;
constexpr int NWAVES = 8;

constexpr size_t MiB = 1u << 20;
constexpr size_t WS_CTL = 0, CTL_ZERO_BYTES = 1 * MiB;
constexpr size_t WS_W1T = 1 * MiB, WS_W2T = 45 * MiB, WS_WMT = 67 * MiB, WS_WGT = 115 * MiB, WS_WPT = 123 * MiB, WS_WOT = 131 * MiB, WS_W3T = 139 * MiB, WS_W4T = 183 * MiB;
constexpr size_t WS_ABUF = 205 * MiB;
constexpr size_t WS_HBUF = 239 * MiB;
constexpr size_t WS_OBUF = 335 * MiB;
constexpr size_t WS_US = 403 * MiB;
constexpr size_t WS_Q = 420 * MiB, WS_QF = 436 * MiB, WS_QB = 452 * MiB;
constexpr size_t WS_K = 468 * MiB;
constexpr size_t WS_KFT = 484 * MiB, WS_KBT = 500 * MiB, WS_KFTC = 516 * MiB, WS_KBTC = 517 * MiB;
constexpr size_t WS_VT = 518 * MiB, WS_VTC = 550 * MiB;
constexpr size_t WS_YF = 552 * MiB;
constexpr size_t WS_S5WE = WS_YF, WS_S5WY1 = WS_YF + 8 * MiB, WS_S5WY2 = WS_YF + 16 * MiB, WS_S5KT = WS_YF + 24 * MiB, WS_S5BRF = WS_YF + 26 * MiB;
constexpr size_t WS_S5E = WS_ABUF, WS_S5ZH = WS_ABUF + 17 * MiB;
constexpr int S5_ROWS = 272;
constexpr size_t WS_AGLU = 584 * MiB;
constexpr size_t WS_TAB = 600 * MiB;
constexpr size_t WS_END = 602 * MiB;
constexpr size_t TAB_ROPE = 0, TAB_LG2 = 16384, TAB_AR = 32768, TAB_AI = 65536, TAB_END = 131072;
constexpr int CW_BAR = 4096;
constexpr size_t CTL_ADA = 65536;

#define RLX_AGENT __ATOMIC_RELAXED, __HIP_MEMORY_SCOPE_AGENT
#define LDS_WAIT() asm volatile("s_waitcnt lgkmcnt(0)" ::: "memory")
#define VM_WAIT() asm volatile("s_waitcnt vmcnt(0)" ::: "memory")

__device__ __forceinline__ unsigned f2bf(float f) { unsigned u = __builtin_bit_cast(unsigned, f); return (u + 0x7fffu + ((u >> 16) & 1u)) >> 16; }
__device__ __forceinline__ unsigned pk2(float lo, float hi) { return f2bf(lo) | (f2bf(hi) << 16); }
__device__ __forceinline__ unsigned cvt_pk_bf16(float lo, float hi) { unsigned r; asm volatile("v_cvt_pk_bf16_f32 %0, %1, %2" : "=v"(r) : "v"(lo), "v"(hi)); return r; }
__device__ __forceinline__ float bflo(unsigned w) { return __builtin_bit_cast(float, w << 16); }
__device__ __forceinline__ float bfhi(unsigned w) { return __builtin_bit_cast(float, w & 0xffff0000u); }
__device__ __forceinline__ float fast_sigmoid(float x) { return __builtin_amdgcn_rcpf(1.0f + __builtin_amdgcn_exp2f(-1.4426950408889634f * x)); }
__device__ __forceinline__ float fast_silu(float x) { return x * fast_sigmoid(x); }
__device__ __forceinline__ float gelu_tanh(float x) { const float u = 0.7978845608028654f * (x + 0.044715f * x * x * x); return x * fast_sigmoid(2.0f * u); }
__device__ __forceinline__ int lane_id() { return (int)__builtin_amdgcn_mbcnt_hi(~0u, __builtin_amdgcn_mbcnt_lo(~0u, 0u)); }
__device__ __forceinline__ float shfl_xor_l(float v, int mask, int lane) { return __builtin_bit_cast(float, __builtin_amdgcn_ds_bpermute((lane ^ mask) << 2, __builtin_bit_cast(int, v))); }
__device__ __forceinline__ float wave_sum(float v, int lane) {
#pragma unroll
    for (int o = 1; o < 64; o <<= 1) v += shfl_xor_l(v, o, lane);
    return v;
}

#define XB_TMO      128
#define XB_XCNT(j)  (256  + 64 * (j))
#define XB_XSUB(j)  (1280 + 64 * (j))
#define XB_XGEN(j)  (2304 + 64 * (j))
#define XB_TOP      3328
#define XB_TOPGEN   3392
#define XCD_BAR_WORDS 3456
#define XB_SPIN_CAP (1u << 18)
__device__ __forceinline__ unsigned xb_ld(unsigned* p)              { return __hip_atomic_load(p, __ATOMIC_RELAXED, __HIP_MEMORY_SCOPE_AGENT); }
__device__ __forceinline__ unsigned xb_add(unsigned* p, unsigned v) { return __hip_atomic_fetch_add(p, v, __ATOMIC_RELAXED, __HIP_MEMORY_SCOPE_AGENT); }
__device__ __forceinline__ unsigned xb_xcc_id() { return (unsigned)__builtin_amdgcn_s_getreg((3 << 11) | 20) & 0xFu; }
#define XB_SPIN(cond, bar) do { unsigned _sp = 0; while (cond) { __builtin_amdgcn_s_sleep(1); \
    if ((++_sp & 255u) == 0u) { if (xb_ld(&(bar)[XB_TMO])) break; if (_sp > XB_SPIN_CAP) { atomicAdd(&(bar)[XB_TMO], 1u); break; } } } } while (0)
struct XcdBarrier { unsigned* bar; unsigned x; volatile LAS unsigned* st; };
__device__ __forceinline__ XcdBarrier xcd_barrier_post(unsigned* bar, volatile LAS unsigned* st) {
    XcdBarrier b; b.bar = bar; b.x = xb_xcc_id(); b.st = st;
    if (threadIdx.x == 0) (void)xb_add(&bar[XB_XCNT(b.x)], 1u);
    return b;
}
__device__ __forceinline__ void xcd_barrier_complete(unsigned* bar, unsigned x, unsigned& nloc, unsigned& nx) {
    const unsigned G = gridDim.x * gridDim.y * gridDim.z;
    unsigned sum, cnt, mine, sp = 0u;
    for (;;) {
        sum = 0u; cnt = 0u; mine = 0u;
#pragma unroll
        for (unsigned j = 0; j < 16; ++j) { const unsigned c = xb_ld(&bar[XB_XCNT(j)]); sum += c; cnt += (c > 0u) ? 1u : 0u; mine = (j == x) ? c : mine; }
        if (sum == G) break;
        __builtin_amdgcn_s_sleep(1);
        if ((++sp & 255u) == 0u) { if (xb_ld(&bar[XB_TMO])) break; if (sp > XB_SPIN_CAP) { atomicAdd(&bar[XB_TMO], 1u); break; } }
    }
    nloc = mine > 0u ? mine : 1u; nx = cnt > 0u ? cnt : 1u;
}
__device__ __forceinline__ void xcd_barrier(const XcdBarrier& b) {
    asm volatile("s_waitcnt vmcnt(0)" ::: "memory");
    __syncthreads();
    if (threadIdx.x == 0) {
        unsigned* bar = b.bar;
        __builtin_amdgcn_s_waitcnt(0);
        unsigned nloc = b.st[0], nx = b.st[1];
        if (nloc == 0u) { xcd_barrier_complete(bar, b.x, nloc, nx); b.st[0] = nloc; b.st[1] = nx; }
        const unsigned old = xb_add(&bar[XB_XSUB(b.x)], 1u);
        const unsigned gen = old / nloc;
        if (old + 1u == (gen + 1u) * nloc) {
            __builtin_amdgcn_fence(__ATOMIC_RELEASE, "agent");
            asm volatile("s_waitcnt vmcnt(0)" ::: "memory");
            const unsigned og = xb_add(&bar[XB_TOP], 1u);
            const unsigned tg = og / nx;
            if (og + 1u == (tg + 1u) * nx) xb_add(&bar[XB_TOPGEN], 1u);
            else XB_SPIN(xb_ld(&bar[XB_TOPGEN]) == tg, bar);
            __builtin_amdgcn_fence(__ATOMIC_ACQUIRE, "agent");
            xb_add(&bar[XB_XGEN(b.x)], 1u);
            asm volatile("s_waitcnt vmcnt(0)" ::: "memory");
        } else {
            XB_SPIN(xb_ld(&bar[XB_XGEN(b.x)]) == gen, bar);
            __builtin_amdgcn_fence(__ATOMIC_ACQUIRE, "agent");
            asm volatile("s_waitcnt vmcnt(0)" ::: "memory");
        }
    }
    __syncthreads();
}

namespace pg8 {
constexpr int BM = 256, BK = 64, HALF = 128, HTB = HALF * BK * 2, STAGE_BYTES = 8 * HTB, NXCD = 8;
__device__ __forceinline__ int lds_byte(int r, int c) { const int st = (r >> 4) * 2 + (c >> 5), rr = r & 15, cc = c & 31, ob = rr * 64 + cc * 2; return st * 1024 + (ob ^ (((ob >> 9) & 1) << 5)); }
__device__ __forceinline__ void stage_rc(int b, int& R, int& C) { const int st = b / 1024, sb = b % 1024, swz = sb ^ (((sb >> 9) & 1) << 5); R = (st >> 1) * 16 + swz / 64; C = (st & 1) * 32 + (swz % 64) / 2; }
__device__ __forceinline__ int perm32(int rho) { const int n = rho >> 4, i = rho & 15; return 8 * (i >> 2) + 4 * n + (i & 3); }

struct Unit {
    const char* A; const char* B; unsigned info;
    __device__ __forceinline__ int pm() const { return (int)(info & 255u); }
    __device__ __forceinline__ int pn() const { return (int)((info >> 8) & 255u); }
    __device__ __forceinline__ int kind() const { return (int)((info >> 16) & 15u); }
    __device__ __forceinline__ int nt() const { return (int)((info >> 20) & 255u); }
    __device__ __forceinline__ int cont() const { return (int)((info >> 28) & 1u); }
};
__device__ __forceinline__ Unit make_unit(const char* A, const char* B, int pm, int pn, int kind, int nt, int cont) { return Unit{A, B, (unsigned)pm | ((unsigned)pn << 8) | ((unsigned)kind << 16) | ((unsigned)nt << 20) | ((unsigned)cont << 28)}; }
__device__ __forceinline__ int xcd_remap(int L, int nwg) { const int q = nwg / NXCD, r = nwg % NXCD, xcd = L % NXCD, off = L / NXCD; return (xcd < r ? xcd * (q + 1) : r * (q + 1) + (xcd - r) * q) + off; }

template <class Epi, class Sched>
__device__ __forceinline__ void gemm_phase(LAS unsigned char* lds, const int K, const Sched& S, const Epi& E, const int wave_) {
    int tid = wave_ * 64 + lane_id(); asm volatile("" : "+v"(tid));
    const int wid = wave_, lane = tid & 63, wr = wid >> 2, wc = wid & 3, fr = lane & 15, fq = lane >> 4;
    unsigned voffA[2], voffB[2];
#pragma unroll
    for (int i = 0; i < 2; ++i) { int R, C; stage_rc(tid * 16 + i * 8192, R, C); const int Rb = (R & ~31) + perm32(R & 31);
        voffA[i] = (unsigned)(R * K + C) * 2u; voffB[i] = (unsigned)(Rb * K + C) * 2u; }
    const size_t kstep = (size_t)(BK * 2);
    const size_t hstep = (size_t)HALF * K * 2;
    const unsigned ldsw = (unsigned)wid * 1024u;
    const int aoff = lds_byte(wr * 64 + fr, fq * 8), boff = lds_byte(wc * 32 + fr, fq * 8);
#define PG8_SA(b, h) (((b) * 2 + (h)) * HTB)
#define PG8_SB(b, h) ((4 + (b) * 2 + (h)) * HTB)
#define PG8_STAGE(bufoff, gbase, voff) do { _Pragma("unroll") for (int _i = 0; _i < 2; ++_i) \
        __builtin_amdgcn_global_load_lds((const unsigned*)((const char*)(gbase) + (voff)[_i]), (LAS unsigned*)(lds + (bufoff) + ldsw + _i * 8192), 16, 0, 0); } while (0)
#define PG8_LDA(dst, b, h) do { _Pragma("unroll") for (int m = 0; m < 4; ++m) _Pragma("unroll") for (int k = 0; k < 2; ++k) dst[m][k] = *(const LAS bf16x8*)(lds + PG8_SA(b, h) + aoff + m * 2048 + k * 1024); } while (0)
#define PG8_LDB(dst, b, h) do { _Pragma("unroll") for (int n = 0; n < 2; ++n) _Pragma("unroll") for (int k = 0; k < 2; ++k) dst[n][k] = *(const LAS bf16x8*)(lds + PG8_SB(b, h) + boff + n * 2048 + k * 1024); } while (0)
#define PG8_MMA(ai, bj, At, Bt) do { __builtin_amdgcn_s_setprio(1); _Pragma("unroll") for (int m = 0; m < 4; ++m) _Pragma("unroll") for (int n = 0; n < 2; ++n) _Pragma("unroll") for (int k = 0; k < 2; ++k) \
        acc[ai][bj][m][n] = __builtin_amdgcn_mfma_f32_16x16x32_bf16(Bt[n][k], At[m][k], acc[ai][bj][m][n], 0, 0, 0); __builtin_amdgcn_s_setprio(0); } while (0)
#define PG8_WAIT_V(n) asm volatile("s_waitcnt vmcnt(" #n ")" ::: "memory")
#define PG8_WAIT_L(n) asm volatile("s_waitcnt lgkmcnt(" #n ")" ::: "memory")
#define PG8_BAR __builtin_amdgcn_s_barrier()
#define PG8_SCHED __builtin_amdgcn_sched_barrier(0)
    Unit cur, nxt; int ui = 0;
    if (!S.next(0, cur)) return;
    f32x4 acc[2][2][4][2];
#pragma unroll
    for (int a = 0; a < 2; ++a)
#pragma unroll
        for (int b = 0; b < 2; ++b)
#pragma unroll
            for (int m = 0; m < 4; ++m)
#pragma unroll
                for (int n = 0; n < 2; ++n) acc[a][b][m][n] = (f32x4){0.f, 0.f, 0.f, 0.f};
    bf16x8 At[4][2], B0[2][2], B1[2][2];
    const char* cA = cur.A; const char* cB = cur.B;
    PG8_STAGE(PG8_SB(0, 0), cB, voffB); PG8_STAGE(PG8_SB(0, 1), cB + hstep, voffB); PG8_STAGE(PG8_SA(0, 0), cA, voffA); PG8_STAGE(PG8_SA(0, 1), cA + hstep, voffA);
    if (wr == 1) PG8_BAR;
    PG8_WAIT_V(2); PG8_BAR;
    PG8_STAGE(PG8_SB(1, 0), cB + kstep, voffB); PG8_STAGE(PG8_SA(1, 0), cA + kstep, voffA); PG8_STAGE(PG8_SB(1, 1), cB + hstep + kstep, voffB);
    PG8_WAIT_V(6); PG8_BAR;
    for (;;) {
        const bool has_next = S.next(ui + 1, nxt);
        const char* nA = has_next ? nxt.A : cA; const char* nB = has_next ? nxt.B : cB;
        const int nt = cur.nt();
        for (int t = 0; t < nt; t += 2) {
            const bool last = (t == nt - 2);
            const char* a1 = cA + (size_t)(t + 1) * kstep;
            const char* a2 = last ? nA : cA + (size_t)(t + 2) * kstep; const char* b2 = last ? nB : cB + (size_t)(t + 2) * kstep;
            const char* a3 = a2 + kstep; const char* b3 = b2 + kstep;
            PG8_LDB(B0, 0, 0); PG8_LDB(B1, 0, 1); PG8_SCHED; PG8_LDA(At, 0, 0); PG8_STAGE(PG8_SA(1, 1), a1 + hstep, voffA);
            PG8_WAIT_V(8); PG8_WAIT_L(0); PG8_BAR; PG8_MMA(0, 0, At, B0); PG8_MMA(0, 1, At, B1); PG8_BAR; PG8_SCHED;
            PG8_LDA(At, 0, 1); PG8_STAGE(PG8_SB(0, 0), b2, voffB); PG8_STAGE(PG8_SB(0, 1), b2 + hstep, voffB); PG8_STAGE(PG8_SA(0, 0), a2, voffA);
            PG8_WAIT_V(8); PG8_WAIT_L(0); PG8_BAR; PG8_MMA(1, 0, At, B0); PG8_MMA(1, 1, At, B1); PG8_BAR; PG8_SCHED;
            PG8_LDB(B0, 1, 0); PG8_LDB(B1, 1, 1); PG8_SCHED; PG8_LDA(At, 1, 0); PG8_STAGE(PG8_SA(0, 1), a2 + hstep, voffA);
            PG8_WAIT_V(8); PG8_WAIT_L(0); PG8_BAR; PG8_MMA(0, 0, At, B0); PG8_MMA(0, 1, At, B1); PG8_BAR; PG8_SCHED;
            PG8_LDA(At, 1, 1); PG8_STAGE(PG8_SB(1, 0), b3, voffB); PG8_STAGE(PG8_SB(1, 1), b3 + hstep, voffB); PG8_STAGE(PG8_SA(1, 0), a3, voffA);
            PG8_WAIT_V(8); PG8_WAIT_L(0); PG8_BAR; PG8_MMA(1, 0, At, B0); PG8_MMA(1, 1, At, B1); PG8_BAR; PG8_SCHED;
        }
        if (wr == 0) PG8_BAR;
        if (!cur.cont()) E(acc, cur, wr, wc, fr, fq);
        if (!has_next) break;
        if (!cur.cont()) {
#pragma unroll
        for (int a = 0; a < 2; ++a)
#pragma unroll
            for (int b = 0; b < 2; ++b)
#pragma unroll
                for (int m = 0; m < 4; ++m)
#pragma unroll
                    for (int n = 0; n < 2; ++n) acc[a][b][m][n] = (f32x4){0.f, 0.f, 0.f, 0.f};
        }
        cur = nxt; cA = nA; cB = nB; ++ui;
        if (wr == 1) PG8_BAR;
    }
    PG8_WAIT_V(0);
    PG8_BAR;
#undef PG8_SA
#undef PG8_SB
#undef PG8_STAGE
#undef PG8_LDA
#undef PG8_LDB
#undef PG8_MMA
#undef PG8_WAIT_V
#undef PG8_WAIT_L
#undef PG8_BAR
#undef PG8_SCHED
}

struct GridOrder {
    const char* A; const char* B; size_t tstep; int nM, nN, nwg, G, c, nt;
    __device__ __forceinline__ void init(const void* A_, const void* B_, int K, int nM_, int nN_, int G_, int c_) { A = (const char*)A_; B = (const char*)B_; tstep = (size_t)BM * K * 2; nM = nM_; nN = nN_; nwg = nM * nN; G = G_; c = c_; nt = K / BK; }
    __device__ __forceinline__ bool next(int i, Unit& u) const {
        const long L = (long)i * G + c; if (L >= nwg) return false;
        const int wgid = xcd_remap((int)L, nwg);
        const int nig = 8 * nN, gid = wgid / nig, fm = gid * 8, gsz = (nM - fm) < 8 ? (nM - fm) : 8;
        const int pm = fm + ((wgid % nig) % gsz), pn = (wgid % nig) / gsz;
        u = make_unit(A + (size_t)pm * tstep, B + (size_t)pn * tstep, pm, pn, 0, nt, 0); return true;
    }
};
}

typedef f32x4 Acc[2][2][4][2];
struct EpiSwiGLU {
    bf16* Hid;
    __device__ __forceinline__ void operator()(const Acc& acc, const pg8::Unit& u, int wr, int wc, int fr0, int fq0) const {
        int fr = fr0, fq = fq0; asm volatile("" : "+v"(fr), "+v"(fq));
        const int row0 = u.pm() * 256 + wr * 64 + fr, col0 = u.pn() * 128 + wc * 32 + 8 * fq;
#pragma unroll
        for (int ai = 0; ai < 2; ++ai)
#pragma unroll
            for (int m = 0; m < 4; ++m) {
                float v[8];
#pragma unroll
                for (int n = 0; n < 2; ++n)
#pragma unroll
                    for (int j = 0; j < 4; ++j) v[4 * n + j] = fast_silu(acc[ai][0][m][n][j]) * acc[ai][1][m][n][j];
                v4u w; w.x = cvt_pk_bf16(v[0], v[1]); w.y = cvt_pk_bf16(v[2], v[3]); w.z = cvt_pk_bf16(v[4], v[5]); w.w = cvt_pk_bf16(v[6], v[7]);
                *(v4u*)(Hid + (size_t)(row0 + ai * 128 + m * 16) * DFF + col0) = w;
            }
    }
};
struct EpiF32 {
    float* C; int ldc;
    __device__ __forceinline__ void operator()(const Acc& acc, const pg8::Unit& u, int wr, int wc, int fr0, int fq0) const {
        int fr = fr0, fq = fq0; asm volatile("" : "+v"(fr), "+v"(fq));
        const int row0 = u.pm() * 256 + wr * 64 + fr, col0 = u.pn() * 256 + wc * 32 + 8 * fq;
#pragma unroll
        for (int ai = 0; ai < 2; ++ai)
#pragma unroll
            for (int m = 0; m < 4; ++m) { float* rowp = C + (size_t)(row0 + ai * 128 + m * 16) * ldc + col0;
#pragma unroll
                for (int bj = 0; bj < 2; ++bj) { *(f32x4*)(rowp + bj * 128) = acc[ai][bj][m][0]; *(f32x4*)(rowp + bj * 128 + 4) = acc[ai][bj][m][1]; } }
    }
};
struct EpiGLU {
    const bf16* SGS; bf16* out;
    __device__ __forceinline__ void operator()(const Acc& acc, const pg8::Unit& u, int wr, int wc, int fr0, int fq0) const {
        int fr = fr0, fq = fq0; asm volatile("" : "+v"(fr), "+v"(fq));
        const int row0 = u.pm() * 256 + wr * 64 + fr, col0 = u.pn() * 128 + wc * 32 + 8 * fq;
#pragma unroll
        for (int ai = 0; ai < 2; ++ai)
#pragma unroll
            for (int m = 0; m < 4; ++m) {
                const size_t off = (size_t)(row0 + ai * 128 + m * 16) * D + col0;
                const v4u s = *(const v4u*)(SGS + off);
                const float sg[8] = {bflo(s.x), bfhi(s.x), bflo(s.y), bfhi(s.y), bflo(s.z), bfhi(s.z), bflo(s.w), bfhi(s.w)};
                float v[8];
#pragma unroll
                for (int n = 0; n < 2; ++n)
#pragma unroll
                    for (int j = 0; j < 4; ++j) v[4 * n + j] = acc[ai][0][m][n][j] * fast_sigmoid(acc[ai][1][m][n][j]) * sg[4 * n + j];
                v4u w; w.x = cvt_pk_bf16(v[0], v[1]); w.y = cvt_pk_bf16(v[2], v[3]); w.z = cvt_pk_bf16(v[4], v[5]); w.w = cvt_pk_bf16(v[6], v[7]);
                *(v4u*)(out + off) = w;
            }
    }
};
struct EpiMerge {
    const bf16* SGR; bf16* mg;
    __device__ __forceinline__ void operator()(const Acc& acc, const pg8::Unit& u, int wr, int wc, int fr0, int fq0) const {
        int fr = fr0, fq = fq0; asm volatile("" : "+v"(fr), "+v"(fq));
        const int row0 = u.pm() * 256 + wr * 64 + fr, col0 = u.pn() * 256 + wc * 32 + 8 * fq;
#pragma unroll
        for (int ai = 0; ai < 2; ++ai)
#pragma unroll
            for (int m = 0; m < 4; ++m)
#pragma unroll
                for (int bj = 0; bj < 2; ++bj) {
                    const size_t off = (size_t)(row0 + ai * 128 + m * 16) * D + col0 + bj * 128;
                    const v4u s = *(const v4u*)(SGR + off), p = *(const v4u*)(mg + off);
                    const float sg[8] = {bflo(s.x), bfhi(s.x), bflo(s.y), bfhi(s.y), bflo(s.z), bfhi(s.z), bflo(s.w), bfhi(s.w)};
                    const float pp[8] = {bflo(p.x), bfhi(p.x), bflo(p.y), bfhi(p.y), bflo(p.z), bfhi(p.z), bflo(p.w), bfhi(p.w)};
                    float v[8];
#pragma unroll
                    for (int n = 0; n < 2; ++n)
#pragma unroll
                        for (int j = 0; j < 4; ++j) v[4 * n + j] = pp[4 * n + j] + sg[4 * n + j] * acc[ai][bj][m][n][j];
                    v4u w; w.x = cvt_pk_bf16(v[0], v[1]); w.y = cvt_pk_bf16(v[2], v[3]); w.z = cvt_pk_bf16(v[4], v[5]); w.w = cvt_pk_bf16(v[6], v[7]);
                    *(v4u*)(mg + off) = w;
                }
    }
};

enum { MK_S = 0, MK_Q = 1, MK_K = 2, MK_G = 3, MK_GS = 4, MK_GR = 5, MK_KT = 6, MK_VT = 7 };
struct EpiMix {
    unsigned char* ws;
    __device__ __forceinline__ void operator()(const Acc& acc, const pg8::Unit& u, int wr, int wc, int fr0, int fq0) const {
        int fr = fr0, fq = fq0; asm volatile("" : "+v"(fr), "+v"(fq));
        bf16* const US = (bf16*)(ws + WS_US); bf16* const Q = (bf16*)(ws + WS_Q); bf16* const QF = (bf16*)(ws + WS_QF); bf16* const QB = (bf16*)(ws + WS_QB); bf16* const KN = (bf16*)(ws + WS_K);
        bf16* const SG = (bf16*)(ws + WS_HBUF); bf16* const SGS = (bf16*)(ws + WS_HBUF + 32 * MiB); bf16* const SGR = (bf16*)(ws + WS_HBUF + 64 * MiB);
        bf16* const KFT = (bf16*)(ws + WS_KFT); bf16* const KBT = (bf16*)(ws + WS_KBT); bf16* const KFTC = (bf16*)(ws + WS_KFTC); bf16* const KBTC = (bf16*)(ws + WS_KBTC);
        bf16* const VT = (bf16*)(ws + WS_VT); bf16* const VTC = (bf16*)(ws + WS_VTC);
        const f32x2* const rope = (const f32x2*)(ws + WS_TAB + TAB_ROPE);
        const float* const lg2 = (const float*)(ws + WS_TAB + TAB_LG2);
        const int kind = u.kind();
        if (kind == MK_S) {
#pragma unroll
            for (int ai = 0; ai < 2; ++ai)
#pragma unroll
                for (int m = 0; m < 4; ++m) {
                    const int row = u.pm() * 256 + ai * 128 + wr * 64 + m * 16 + fr;
                    int b_, crow;
                    if (row < MX) { b_ = row >> 12; crow = (row & (SEQ - 1)) >> 4; } else { b_ = (row - MX) >> 8; crow = 256 + (((row - MX) & (LC - 1)) >> 4); }
                    const int s = row & 15;
#pragma unroll
                    for (int bj = 0; bj < 2; ++bj) {
                        const int ch = u.pn() * 256 + bj * 128 + wc * 32 + 8 * fq, g = ch >> 4, c0 = ch & 15;
                        const f32x4 a = acc[ai][bj][m][0], b = acc[ai][bj][m][1];
                        v4u w; w.x = cvt_pk_bf16(a[0], a[1]); w.y = cvt_pk_bf16(a[2], a[3]); w.z = cvt_pk_bf16(b[0], b[1]); w.w = cvt_pk_bf16(b[2], b[3]);
                        *(v4u*)(US + ((size_t)((b_ * 64 + g) * S5_ROWS + crow)) * 256 + s * 16 + c0) = w;
                    }
                }
        } else if (kind == MK_G || kind == MK_GS || kind == MK_GR) {
            bf16* dst = kind == MK_G ? SG : (kind == MK_GS ? SGS : SGR);
            const int row0 = u.pm() * 256 + wr * 64 + fr, col0 = u.pn() * 256 + wc * 32 + 8 * fq;
#pragma unroll
            for (int ai = 0; ai < 2; ++ai)
#pragma unroll
                for (int m = 0; m < 4; ++m)
#pragma unroll
                    for (int bj = 0; bj < 2; ++bj) {
                        float v[8];
#pragma unroll
                        for (int n = 0; n < 2; ++n)
#pragma unroll
                            for (int j = 0; j < 4; ++j) { const float x = acc[ai][bj][m][n][j]; const float s = fast_sigmoid(x); v[4 * n + j] = kind == MK_G ? x * s : s; }
                        v4u w; w.x = cvt_pk_bf16(v[0], v[1]); w.y = cvt_pk_bf16(v[2], v[3]); w.z = cvt_pk_bf16(v[4], v[5]); w.w = cvt_pk_bf16(v[6], v[7]);
                        *(v4u*)(dst + (size_t)(row0 + ai * 128 + m * 16) * D + col0 + bj * 128) = w;
                    }
        } else if (kind == MK_Q || kind == MK_K) {
            const int p = wc >> 1, i0 = 16 * (wc & 1) + 4 * fq;
            const int d0 = 64 * p + i0;
#pragma unroll
            for (int ai = 0; ai < 2; ++ai)
#pragma unroll
                for (int m = 0; m < 4; ++m) {
                    const int row = u.pm() * 256 + ai * 128 + wr * 64 + m * 16 + fr;
                    const int l = row & (SEQ - 1), pos = p ? (l & 63) : (l >> 6), ic = l & (CH - 1);
                    const f32x4 cs0 = *(const f32x4*)(rope + pos * 32 + i0), cs1 = *(const f32x4*)(rope + pos * 32 + i0 + 2);
                    const float cc[4] = {cs0[0], cs0[2], cs1[0], cs1[2]}, ss[4] = {cs0[1], cs0[3], cs1[1], cs1[3]};
#pragma unroll
                    for (int bj = 0; bj < 2; ++bj) {
                        const int head = 2 * u.pn() + bj;
                        float y1[4], y2[4];
#pragma unroll
                        for (int j = 0; j < 4; ++j) { const float x1 = acc[ai][bj][m][0][j], x2 = acc[ai][bj][m][1][j]; y1[j] = x1 * cc[j] - x2 * ss[j]; y2[j] = x1 * ss[j] + x2 * cc[j]; }
                        const size_t off = (size_t)row * 1024 + head * 128 + d0;
                        if (kind == MK_K) {
                            v2u a, b; a.x = cvt_pk_bf16(y1[0], y1[1]); a.y = cvt_pk_bf16(y1[2], y1[3]); b.x = cvt_pk_bf16(y2[0], y2[1]); b.y = cvt_pk_bf16(y2[2], y2[3]);
                            *(v2u*)(KN + off) = a; *(v2u*)(KN + off + 32) = b;
                        } else {
                            const float qs = 0.08838834764831845f;
                            const float wf = qs * __builtin_amdgcn_exp2f((float)(ic + 1) * lg2[head]), wb = qs * __builtin_amdgcn_exp2f((float)(CH - ic) * lg2[8 + head]);
                            v2u a, b;
                            a.x = cvt_pk_bf16(y1[0] * qs, y1[1] * qs); a.y = cvt_pk_bf16(y1[2] * qs, y1[3] * qs); b.x = cvt_pk_bf16(y2[0] * qs, y2[1] * qs); b.y = cvt_pk_bf16(y2[2] * qs, y2[3] * qs);
                            *(v2u*)(Q + off) = a; *(v2u*)(Q + off + 32) = b;
                            a.x = cvt_pk_bf16(y1[0] * wf, y1[1] * wf); a.y = cvt_pk_bf16(y1[2] * wf, y1[3] * wf); b.x = cvt_pk_bf16(y2[0] * wf, y2[1] * wf); b.y = cvt_pk_bf16(y2[2] * wf, y2[3] * wf);
                            *(v2u*)(QF + off) = a; *(v2u*)(QF + off + 32) = b;
                            a.x = cvt_pk_bf16(y1[0] * wb, y1[1] * wb); a.y = cvt_pk_bf16(y1[2] * wb, y1[3] * wb); b.x = cvt_pk_bf16(y2[0] * wb, y2[1] * wb); b.y = cvt_pk_bf16(y2[2] * wb, y2[3] * wb);
                            *(v2u*)(QB + off) = a; *(v2u*)(QB + off + 32) = b;
                        }
                    }
                    asm volatile("" ::: "memory");
                }
        } else if (kind == MK_VT) {
            const bool isctx = u.pn() >= 32;
#pragma unroll
            for (int ai = 0; ai < 2; ++ai)
#pragma unroll
                for (int m = 0; m < 4; ++m) {
                    const int f = u.pm() * 256 + ai * 128 + wr * 64 + m * 16 + fr;
#pragma unroll
                    for (int bj = 0; bj < 2; ++bj) {
                        const f32x4 a = acc[ai][bj][m][0], b = acc[ai][bj][m][1];
                        v4u w; w.x = cvt_pk_bf16(a[0], a[1]); w.y = cvt_pk_bf16(a[2], a[3]); w.z = cvt_pk_bf16(b[0], b[1]); w.w = cvt_pk_bf16(b[2], b[3]);
                        const int tc = bj * 128 + wc * 32 + 8 * fq;
                        if (!isctx) { const int tok = u.pn() * 256 + tc, b_ = tok >> 12, l = tok & (SEQ - 1); *(v4u*)(VT + ((size_t)(b_ * 2048 + f) * SEQ + l)) = w; }
                        else { const int b_ = u.pn() - 32; *(v4u*)(VTC + ((size_t)(b_ * 2048 + f) * LC + tc)) = w; }
                    }
                }
        } else {
            const bool isctx = u.pn() >= 32;
            const int p = wr;
#pragma unroll
            for (int ai = 0; ai < 2; ++ai) {
                const int head = 2 * u.pm() + ai;
                const float lgf = lg2[head], lgb = lg2[8 + head];
#pragma unroll
                for (int mm = 0; mm < 2; ++mm) {
                    const int i = 16 * mm + fr, d1 = 64 * p + i;
#pragma unroll
                    for (int bj = 0; bj < 2; ++bj)
#pragma unroll
                        for (int n = 0; n < 2; ++n) {
                            float o1f[4], o2f[4], o1b[4], o2b[4];
                            const int tc = bj * 128 + wc * 32 + 8 * fq + 4 * n;
#pragma unroll
                            for (int j = 0; j < 4; ++j) {
                                const int t = tc + j;
                                const float x1 = acc[ai][bj][mm][n][j], x2 = acc[ai][bj][mm + 2][n][j];
                                float y1, y2; int ic;
                                if (!isctx) { const int l = (u.pn() * 256 + t) & (SEQ - 1), pos = p ? (l & 63) : (l >> 6); const f32x2 cs = rope[pos * 32 + i]; y1 = x1 * cs[0] - x2 * cs[1]; y2 = x1 * cs[1] + x2 * cs[0]; ic = l & (CH - 1); }
                                else { y1 = x1; y2 = x2; ic = t & (CH - 1); }
                                const float wf = __builtin_amdgcn_exp2f((float)(CH - 1 - ic) * lgf), wb = __builtin_amdgcn_exp2f((float)ic * lgb);
                                o1f[j] = y1 * wf; o2f[j] = y2 * wf; o1b[j] = y1 * wb; o2b[j] = y2 * wb;
                            }
                            v2u w1f, w2f, w1b, w2b;
                            w1f.x = cvt_pk_bf16(o1f[0], o1f[1]); w1f.y = cvt_pk_bf16(o1f[2], o1f[3]); w2f.x = cvt_pk_bf16(o2f[0], o2f[1]); w2f.y = cvt_pk_bf16(o2f[2], o2f[3]);
                            w1b.x = cvt_pk_bf16(o1b[0], o1b[1]); w1b.y = cvt_pk_bf16(o1b[2], o1b[3]); w2b.x = cvt_pk_bf16(o2b[0], o2b[1]); w2b.y = cvt_pk_bf16(o2b[2], o2b[3]);
                            if (!isctx) {
                                const int tok = u.pn() * 256 + tc, b_ = tok >> 12, l = tok & (SEQ - 1);
                                const size_t o1 = ((size_t)((b_ * NH + head) * DK + d1)) * SEQ + l, o2 = o1 + (size_t)32 * SEQ;
                                *(v2u*)(KFT + o1) = w1f; *(v2u*)(KFT + o2) = w2f; *(v2u*)(KBT + o1) = w1b; *(v2u*)(KBT + o2) = w2b;
                            } else {
                                const int b_ = u.pn() - 32;
                                const size_t o1 = ((size_t)((b_ * NH + head) * DK + d1)) * LC + tc, o2 = o1 + (size_t)32 * LC;
                                *(v2u*)(KFTC + o1) = w1f; *(v2u*)(KFTC + o2) = w2f; *(v2u*)(KBTC + o1) = w1b; *(v2u*)(KBTC + o2) = w2b;
                            }
                            asm volatile("" ::: "memory");
                        }
                }
            }
        }
    }
};
struct MixOrder {
    const char* U; const char* WM; int G, c;
    static constexpr int N_NORM = 32 * 36, N_CTXS = 8, N_SWAP = 12 * 34, NWG = N_NORM + N_CTXS + N_SWAP;
    __device__ __forceinline__ bool next(int i, pg8::Unit& u) const {
        const long L = (long)i * G + c; if (L >= NWG) return false;
        int w = pg8::xcd_remap((int)L, NWG);
        const size_t tstep = (size_t)256 * D * 2;
        int at, bt, pm, pn, kind;
        bool swapped = false;
        if (w < N_NORM) {
            const int nig = 8 * 36, gid = w / nig, r = w % nig, ct = r >> 3;
            pm = gid * 8 + (r & 7); at = pm;
            if (ct < 4) { bt = ct; kind = MK_S; pn = ct; } else if (ct < 8) { bt = ct; kind = MK_Q; pn = ct - 4; } else if (ct < 12) { bt = ct; kind = MK_K; pn = ct - 8; }
            else if (ct < 20) { bt = ct + 8; kind = MK_G; pn = ct - 12; } else if (ct < 28) { bt = ct + 8; kind = MK_GS; pn = ct - 20; } else { bt = ct + 8; kind = MK_GR; pn = ct - 28; }
        } else if (w < N_NORM + N_CTXS) {
            w -= N_NORM; pm = 32 + (w & 1); at = pm; bt = w >> 1; pn = bt; kind = MK_S;
        } else {
            w -= N_NORM + N_CTXS; swapped = true;
            const int tt = w / 12, ft = w % 12;
            bt = tt; pn = tt;
            if (ft < 4) { at = 44 + ft; pm = ft; kind = MK_KT; } else { at = 12 + ft - 4; pm = ft - 4; kind = MK_VT; }
        }
        const char* abase = swapped ? WM : U; const char* bbase = swapped ? U : WM;
        u = pg8::make_unit(abase + (size_t)at * tstep, bbase + (size_t)bt * tstep, pm, pn, kind, D / 64, 0);
        return true;
    }
};

constexpr int RING_BYTES = 131072, LDSCTL_OFF = RING_BYTES, MISC_OFF = LDSCTL_OFF + 320, LDS_BYTES = 147456;
struct Args { const float* in[22]; float* out; unsigned char* ws; };
struct Frame {
    LAS unsigned char* lds; volatile LAS unsigned* MISC; unsigned* ctl;
    int wave, vcu, G;
    float* out; unsigned char* ws;
};
typedef const Args __attribute__((address_space(4)))* KArgsPtr;
__device__ __forceinline__ KArgsPtr kargs() { KArgsPtr p = (KArgsPtr)__builtin_amdgcn_kernarg_segment_ptr(); asm volatile("" : "+s"(p)); return p; }
#define FIN(k) ((const float*)kargs()->in[k])

__device__ __forceinline__ int map_pair(int n, int half) { const int h = n < half ? n : n - half, up = n >= half; return 256 * (h >> 7) + 128 * up + (h & 127); }
__device__ __forceinline__ int map_mix(int n) {
    if (n < 1024 || n >= 3072) return n;
    const int base = n & ~127, d = n & 127, p = d >> 6, e = d & 63, s = e >> 5, i = e & 31, t = 32 * p + i;
    return base + 32 * (t >> 4) + 8 * ((t >> 2) & 3) + 4 * s + (t & 3);
}
template <int MAPID>
__device__ __forceinline__ void transpose_item(const float* W, int ldw, int K, int nblk, bf16* WT, int row_off, int half, LAS float* scr, int item, int lane) {
    const int kb = item / nblk, nb = item % nblk, k0 = 64 * kb, n0 = 32 * nb;
#pragma unroll 8
    for (int i = 0; i < 32; ++i) { const int kk = 2 * i + (lane >> 5); scr[kk * 33 + (lane & 31)] = W[(size_t)(k0 + kk) * ldw + n0 + (lane & 31)]; }
    LDS_WAIT(); asm volatile("" ::: "memory");
    const int c = lane & 7;
#pragma unroll
    for (int j = 0; j < 4; ++j) { const int n = (lane >> 3) + 8 * j; const LAS float* s = scr + (8 * c) * 33 + n;
        v4u o; o.x = pk2(s[0 * 33], s[1 * 33]); o.y = pk2(s[2 * 33], s[3 * 33]); o.z = pk2(s[4 * 33], s[5 * 33]); o.w = pk2(s[6 * 33], s[7 * 33]);
        const int nn = n0 + n; const int dr = MAPID == 0 ? nn : (MAPID == 1 ? map_pair(nn, half) : map_mix(nn));
        *(v4u*)(WT + (size_t)(row_off + dr) * K + k0 + 8 * c) = o; }
    LDS_WAIT(); asm volatile("" ::: "memory");
}
__device__ __forceinline__ void sincos_d(double x, double& s, double& c) {
    const double TWO_PI = 6.283185307179586476925286766559;
    x -= TWO_PI * __builtin_rint(x / TWO_PI);
    const double h = 0.125 * x, h2 = h * h;
    double sn = h * (1.0 + h2 * (-1.0 / 6 + h2 * (1.0 / 120 + h2 * (-1.0 / 5040 + h2 * (1.0 / 362880 + h2 * (-1.0 / 39916800 + h2 * (1.0 / 6227020800.0)))))));
    double cs = 1.0 + h2 * (-0.5 + h2 * (1.0 / 24 + h2 * (-1.0 / 720 + h2 * (1.0 / 40320 + h2 * (-1.0 / 3628800 + h2 * (1.0 / 479001600.0 + h2 * (-1.0 / 87178291200.0)))))));
#pragma unroll
    for (int k = 0; k < 3; ++k) { const double s2 = 2.0 * sn * cs, c2 = 1.0 - 2.0 * sn * sn; sn = s2; cs = c2; }
    s = sn; c = cs;
}
__device__ __forceinline__ double exp_d(double x) {
    const double y = x * (1.0 / 4096.0);
    double e = 1.0 + y * (1.0 + y * (0.5 + y * (1.0 / 6 + y * (1.0 / 24 + y * (1.0 / 120 + y * (1.0 / 720))))));
#pragma unroll
    for (int k = 0; k < 12; ++k) e = e * e;
    return e;
}
__device__ __forceinline__ double log1p_small_d(double z) {
    const double t = z / (2.0 + z), t2 = t * t;
    return 2.0 * t * (1.0 + t2 * (1.0 / 3 + t2 * (1.0 / 5 + t2 * (1.0 / 7 + t2 * (1.0 / 9 + t2 * (1.0 / 11))))));
}

__device__ __forceinline__ void phase_prologue(Frame& F0, const Args& args, const bool do_ada) {
    Frame& F = F0; int lane_ = lane_id(); asm volatile("" : "+v"(lane_));
    LAS float* scr = (LAS float*)(F.lds + F.wave * 16384);
    const int gw = F.vcu * NWAVES + F.wave, NGW = F.G * NWAVES;
    unsigned char* ws = F.ws;
    {
        const int gt = gw * 64 + lane_, NT = NGW * 64;
        unsigned char* tab = ws + WS_TAB;
        for (int idx = gt; idx < 2048; idx += NT) {
            const int pos = idx >> 5, i = idx & 31;
            const double inv = exp_d(-(double)i * (9.210340371976182736 / 32.0));
            double s, c; sincos_d((double)pos * inv, s, c);
            ((f32x2*)(tab + TAB_ROPE))[idx] = (f32x2){(float)c, (float)s};
        }
        for (int idx = gt; idx < 16; idx += NT) {
            const double x = (double)FIN(19)[idx];
            ((float*)(tab + TAB_LG2))[idx] = (float)(-log1p_small_d(exp_d(-x)) * 1.4426950408889634074);
        }
        for (int idx = gt; idx < 2 * 64 * 64; idx += NT) {
            const int dg = idx >> 6, p = idx & 63;
            const double lr = (double)FIN(10)[idx], li = (double)FIN(11)[idx], step = exp_d((double)FIN(12)[dg]);
            const double mag = exp_d(lr * step); double sn, cs; sincos_d(li * step, sn, cs);
            const double ar = mag * cs, ai = mag * sn, den = lr * lr + li * li, nr = ar - 1.0, ni = ai;
            const double kr = (nr * lr + ni * li) / den, ki = (ni * lr - nr * li) / den;
            ((float*)(tab + TAB_AR))[idx] = (float)ar; ((float*)(tab + TAB_AI))[idx] = (float)ai;
            float* brf = (float*)(ws + WS_S5BRF) + (size_t)idx * 32;
            const float* bre = FIN(13) + (size_t)idx * 16; const float* bim = FIN(14) + (size_t)idx * 16;
            for (int c = 0; c < 16; ++c) { const double br = (double)bre[c], bi = (double)bim[c];
                brf[2 * c] = (float)(kr * br - ki * bi); brf[2 * c + 1] = (float)(kr * bi + ki * br); }
        }
    }
    if (do_ada) {
        float* ADA = (float*)(ws + WS_CTL + CTL_ADA);
        const float* aw = FIN(4);
        for (int it = gw; it < 16 * 72; it += NGW) {
            const int kc = it / 72, cb = it % 72, k0 = kc * 128, col = cb * 256 + 4 * lane_;
            for (int i = lane_; i < 384; i += 64) { const int v = i >> 7, k = i & 127; const float x = v == 0 ? FIN(1)[k0 + k] : (v == 1 ? FIN(1)[D + k0 + k] : FIN(3)[k0 + k]); scr[i] = x / (1.0f + __expf(-x)); }
            LDS_WAIT(); asm volatile("" ::: "memory");
            f32x4 a0 = {0.f, 0.f, 0.f, 0.f}, a1 = a0, a2 = a0;
#pragma unroll 8
            for (int k = 0; k < 128; ++k) { const f32x4 w = *(const f32x4*)(aw + (size_t)(k0 + k) * NADA + col); a0 += w * scr[k]; a1 += w * scr[128 + k]; a2 += w * scr[256 + k]; }
#pragma unroll
            for (int j = 0; j < 4; ++j) { __hip_atomic_fetch_add(ADA + col + j, a0[j], RLX_AGENT); __hip_atomic_fetch_add(ADA + NADA + col + j, a1[j], RLX_AGENT); __hip_atomic_fetch_add(ADA + 2 * NADA + col + j, a2[j], RLX_AGENT); }
            LDS_WAIT(); asm volatile("" ::: "memory");
        }
    }
    {
        constexpr int I1 = (D / 64) * (NFF / 32), I2 = (DFF / 64) * (D / 32), IM = (D / 64) * (NMIX / 32), IK = (D / 64) * (1024 / 32), IG = (SW / 64) * (2 * D / 32), IP = (D / 64) * (D / 32);
        constexpr int NITEMS = 2 * I1 + 2 * I2 + IM + IK + IG + 2 * IP;
        for (int it = gw; it < NITEMS; it += NGW) {
            int r = it;
            if (r < I1) { transpose_item<1>(FIN(7), NFF, D, NFF / 32, (bf16*)(ws + WS_W1T), 0, DFF, scr, r, lane_); continue; } r -= I1;
            if (r < I2) { transpose_item<0>(FIN(8), D, DFF, D / 32, (bf16*)(ws + WS_W2T), 0, 0, scr, r, lane_); continue; } r -= I2;
            if (r < IM) { transpose_item<2>(FIN(9), NMIX, D, NMIX / 32, (bf16*)(ws + WS_WMT), 0, 0, scr, r, lane_); continue; } r -= IM;
            if (r < IK) { transpose_item<0>(FIN(9) + 2048, NMIX, D, 1024 / 32, (bf16*)(ws + WS_WMT), NMIX, 0, scr, r, lane_); continue; } r -= IK;
            if (r < IG) { transpose_item<1>(FIN(18), 2 * D, SW, 2 * D / 32, (bf16*)(ws + WS_WGT), 0, D, scr, r, lane_); continue; } r -= IG;
            if (r < IP) { transpose_item<0>(FIN(20), D, D, D / 32, (bf16*)(ws + WS_WPT), 0, 0, scr, r, lane_); continue; } r -= IP;
            if (r < IP) { transpose_item<0>(FIN(21), D, D, D / 32, (bf16*)(ws + WS_WOT), 0, 0, scr, r, lane_); continue; } r -= IP;
            if (r < I1) { transpose_item<1>(FIN(7) + (size_t)D * NFF, NFF, D, NFF / 32, (bf16*)(ws + WS_W3T), 0, DFF, scr, r, lane_); continue; } r -= I1;
            transpose_item<0>(FIN(8) + (size_t)DFF * D, D, DFF, D / 32, (bf16*)(ws + WS_W4T), 0, 0, scr, r, lane_);
        }
    }
}

template <int MODE>
__device__ __forceinline__ void phase_rows(Frame& F0, const Args& args) {
    Frame& F = F0; int lane_ = lane_id(); asm volatile("" : "+v"(lane_));
    const int gw = F.vcu * NWAVES + F.wave, NGW = F.G * NWAVES;
    const float* ADA = (const float*)(F.ws + WS_CTL + CTL_ADA);
    const float* adab = FIN(5); const float* ng = FIN(6);
    const float* O = (const float*)(F.ws + WS_OBUF);
    bf16* A = (bf16*)(F.ws + WS_ABUF);
    const int nrows = (MODE <= 1) ? MT : MX;
    for (int r = gw; r < nrows; r += NGW) {
        const int av = r < MX ? (r >> 12) : 2;
        const float* ada = ADA + (size_t)av * NADA;
        f32x4 h[8];
        const float* hsrc = (MODE <= 1) ? (r < MX ? FIN(0) + (size_t)r * D : FIN(2) + (size_t)(r - MX) * D) : F.out + (size_t)r * D;
#pragma unroll
        for (int j = 0; j < 8; ++j) h[j] = *(const f32x4*)(hsrc + 256 * j + 4 * lane_);
        if (MODE >= 1) {
            constexpr int ipost = MODE - 1;
            const float resw = (MODE == 2) ? 1.0f : 0.5f;
            f32x4 o[8]; float ss = 0.f;
#pragma unroll
            for (int j = 0; j < 8; ++j) { o[j] = *(const f32x4*)(O + (size_t)r * D + 256 * j + 4 * lane_); ss += (o[j][0] * o[j][0] + o[j][1] * o[j][1]) + (o[j][2] * o[j][2] + o[j][3] * o[j][3]); }
            const float rstd = 1.0f / sqrtf(wave_sum(ss, lane_) * (1.0f / D) + EPS);
#pragma unroll
            for (int j = 0; j < 8; ++j) { const int c = 256 * j + 4 * lane_;
                const f32x4 gate = *(const f32x4*)(ada + (3 * ipost + 2) * D + c) + *(const f32x4*)(adab + (3 * ipost + 2) * D + c);
                const f32x4 g = *(const f32x4*)(ng + (2 * ipost + 1) * D + c);
                h[j] = h[j] + (resw * rstd) * (gate * (o[j] * g)); }
            if (r < MX) {
#pragma unroll
                for (int j = 0; j < 8; ++j) *(f32x4*)(F.out + (size_t)r * D + 256 * j + 4 * lane_) = h[j];
            }
        }
        if (MODE <= 2) {
            constexpr int ipre = MODE;
            float ss = 0.f;
#pragma unroll
            for (int j = 0; j < 8; ++j) ss += (h[j][0] * h[j][0] + h[j][1] * h[j][1]) + (h[j][2] * h[j][2] + h[j][3] * h[j][3]);
            const float rstd = 1.0f / sqrtf(wave_sum(ss, lane_) * (1.0f / D) + EPS);
#pragma unroll
            for (int j = 0; j < 8; ++j) { const int c = 256 * j + 4 * lane_;
                const f32x4 shift = *(const f32x4*)(ada + (3 * ipre) * D + c) + *(const f32x4*)(adab + (3 * ipre) * D + c);
                const f32x4 scale = *(const f32x4*)(ada + (3 * ipre + 1) * D + c) + *(const f32x4*)(adab + (3 * ipre + 1) * D + c);
                const f32x4 g = *(const f32x4*)(ng + (2 * ipre) * D + c);
                const f32x4 v = (h[j] * rstd) * g * (scale + 1.0f) + shift;
                v2u w; w.x = cvt_pk_bf16(v[0], v[1]); w.y = cvt_pk_bf16(v[2], v[3]);
                *(v2u*)(A + (size_t)r * D + c) = w; }
        }
    }
}

__device__ __forceinline__ void cpow_f(float ar, float ai, int k, float& pr, float& pi) {
    float rr = 1.f, ri = 0.f, br = ar, bi = ai;
#pragma unroll
    for (int bit = 0; bit < 5; ++bit) { if (k & (1 << bit)) { const float t = rr * br - ri * bi; ri = rr * bi + ri * br; rr = t; } const float t2 = br * br - bi * bi; bi = 2.f * br * bi; br = t2; }
    pr = rr; pi = ri;
}
__device__ __forceinline__ void s5_tables1(Frame& F, const Args& args) {
    int lane_ = lane_id(); asm volatile("" : "+v"(lane_));
    const int gt = (F.vcu * NWAVES + F.wave) * 64 + lane_, NT = F.G * NWAVES * 64;
    const float* AR = (const float*)(F.ws + WS_TAB + TAB_AR); const float* AI = (const float*)(F.ws + WS_TAB + TAB_AI);
    const float* BRF = (const float*)(F.ws + WS_S5BRF);
    const float* cre = FIN(15); const float* cim = FIN(16);
    float* KT = (float*)(F.ws + WS_S5KT); bf16* WE = (bf16*)(F.ws + WS_S5WE); bf16* WY2 = (bf16*)(F.ws + WS_S5WY2);
    for (int idx = gt; idx < 64 * 2 * 16 * 16; idx += NT) {
        const int c = idx & 15, k = (idx >> 4) & 15, dir = (idx >> 8) & 1, g = idx >> 9, dg = dir * 64 + g;
        float acc[16];
#pragma unroll
        for (int j = 0; j < 16; ++j) acc[j] = 0.f;
        for (int p = 0; p < 64; ++p) {
            float pr, pi; cpow_f(AR[dg * 64 + p], AI[dg * 64 + p], k, pr, pi);
            const float Cr = cre[(dg * 16 + c) * 64 + p], Ci = cim[(dg * 16 + c) * 64 + p], Gr = Cr * pr - Ci * pi, Gi = Cr * pi + Ci * pr;
            const f32x4* b4 = (const f32x4*)(BRF + (size_t)(dg * 64 + p) * 32);
#pragma unroll
            for (int j = 0; j < 8; ++j) { const f32x4 v = b4[j]; acc[2 * j] += Gr * v[0] - Gi * v[1]; acc[2 * j + 1] += Gr * v[2] - Gi * v[3]; }
        }
        float* o = KT + ((size_t)((g * 2 + dir) * 16 + k) * 16 + c) * 16;
#pragma unroll
        for (int j = 0; j < 4; ++j) *(f32x4*)(o + 4 * j) = (f32x4){acc[4 * j], acc[4 * j + 1], acc[4 * j + 2], acc[4 * j + 3]};
    }
    for (int idx = gt; idx < 64 * 256 * 16; idx += NT) {
        const int s = idx & 15, r = (idx >> 4) & 255, g = idx >> 12, dir = r >> 7, part = (r >> 6) & 1, p = r & 63, dg = dir * 64 + g;
        float pr, pi; cpow_f(AR[dg * 64 + p], AI[dg * 64 + p], dir ? s : 15 - s, pr, pi);
        const f32x4* b4 = (const f32x4*)(BRF + (size_t)(dg * 64 + p) * 32);
        float v[16];
#pragma unroll
        for (int j = 0; j < 8; ++j) { const f32x4 q = b4[j]; v[2 * j] = part ? (pr * q[1] + pi * q[0]) : (pr * q[0] - pi * q[1]); v[2 * j + 1] = part ? (pr * q[3] + pi * q[2]) : (pr * q[2] - pi * q[3]); }
        bf16* o = WE + ((size_t)(g * 256 + r)) * 256 + s * 16;
        v4u w0, w1; w0.x = pk2(v[0], v[1]); w0.y = pk2(v[2], v[3]); w0.z = pk2(v[4], v[5]); w0.w = pk2(v[6], v[7]); w1.x = pk2(v[8], v[9]); w1.y = pk2(v[10], v[11]); w1.z = pk2(v[12], v[13]); w1.w = pk2(v[14], v[15]);
        *(v4u*)o = w0; *(v4u*)(o + 8) = w1;
    }
    for (int idx = gt; idx < 64 * 256 * 32; idx += NT) {
        const int cb = idx & 31, row = (idx >> 5) & 255, g = idx >> 13, t = row >> 4, c = row & 15, col0 = 8 * cb, dir = col0 >> 7, part = (col0 >> 6) & 1, p0 = col0 & 63, dg = dir * 64 + g;
        float v[8];
#pragma unroll
        for (int j = 0; j < 8; ++j) { const int p = p0 + j; float pr, pi; cpow_f(AR[dg * 64 + p], AI[dg * 64 + p], dir ? 16 - t : t + 1, pr, pi);
            const float Cr = cre[(dg * 16 + c) * 64 + p], Ci = cim[(dg * 16 + c) * 64 + p]; v[j] = part ? -(Cr * pi + Ci * pr) : (Cr * pr - Ci * pi); }
        v4u w; w.x = pk2(v[0], v[1]); w.y = pk2(v[2], v[3]); w.z = pk2(v[4], v[5]); w.w = pk2(v[6], v[7]);
        *(v4u*)(WY2 + ((size_t)(g * 256 + row)) * 256 + col0) = w;
    }
}
__device__ __forceinline__ void s5_tables2(Frame& F, const Args& args) {
    int lane_ = lane_id(); asm volatile("" : "+v"(lane_));
    const int gt = (F.vcu * NWAVES + F.wave) * 64 + lane_, NT = F.G * NWAVES * 64;
    const float* KT = (const float*)(F.ws + WS_S5KT); bf16* WY1 = (bf16*)(F.ws + WS_S5WY1); const float* dskip = FIN(17);
    for (int idx = gt; idx < 64 * 256 * 16; idx += NT) {
        const int s = idx & 15, row = (idx >> 4) & 255, g = idx >> 12, t = row >> 4, c = row & 15;
        float v[16];
#pragma unroll
        for (int j = 0; j < 16; ++j) v[j] = 0.f;
        if (s <= t) { const f32x4* k4 = (const f32x4*)(KT + ((size_t)((g * 2 + 0) * 16 + (t - s)) * 16 + c) * 16);
#pragma unroll
            for (int j = 0; j < 4; ++j) { const f32x4 q = k4[j]; v[4 * j] += q[0]; v[4 * j + 1] += q[1]; v[4 * j + 2] += q[2]; v[4 * j + 3] += q[3]; } }
        if (s >= t) { const f32x4* k4 = (const f32x4*)(KT + ((size_t)((g * 2 + 1) * 16 + (s - t)) * 16 + c) * 16);
#pragma unroll
            for (int j = 0; j < 4; ++j) { const f32x4 q = k4[j]; v[4 * j] += q[0]; v[4 * j + 1] += q[1]; v[4 * j + 2] += q[2]; v[4 * j + 3] += q[3]; } }
        if (s == t) { const float dk = dskip[16 * g + c];
#pragma unroll
            for (int j = 0; j < 16; ++j) v[j] += (j == c) ? dk : 0.f; }
        bf16* o = WY1 + ((size_t)(g * 256 + row)) * 256 + s * 16;
        v4u w0, w1; w0.x = pk2(v[0], v[1]); w0.y = pk2(v[2], v[3]); w0.z = pk2(v[4], v[5]); w0.w = pk2(v[6], v[7]); w1.x = pk2(v[8], v[9]); w1.y = pk2(v[10], v[11]); w1.z = pk2(v[12], v[13]); w1.w = pk2(v[14], v[15]);
        *(v4u*)o = w0; *(v4u*)(o + 8) = w1;
    }
}
struct S5EOrder {
    const char* ZU; const char* WE; int G, c;
    __device__ __forceinline__ bool next(int i, pg8::Unit& u) const {
        const long L = (long)i * G + c; if (L >= 256) return false;
        const int bg = (int)L >> 1, rt = (int)L & 1, g = bg & 63;
        u = pg8::make_unit(ZU + ((size_t)(bg * S5_ROWS + 256 * rt)) * 512, WE + (size_t)g * 256 * 512, bg, rt, 0, 4, 0); return true;
    }
};
struct EpiS5E {
    bf16* E;
    __device__ __forceinline__ void operator()(const Acc& acc, const pg8::Unit& u, int wr, int wc, int fr0, int fq0) const {
        int fr = fr0, fq = fq0; asm volatile("" : "+v"(fr), "+v"(fq));
#pragma unroll
        for (int ai = 0; ai < 2; ++ai)
#pragma unroll
            for (int m = 0; m < 4; ++m) {
                const int crow = 256 * u.pn() + ai * 128 + wr * 64 + m * 16 + fr;
                if (crow < S5_ROWS) {
#pragma unroll
                    for (int bj = 0; bj < 2; ++bj) {
                        const f32x4 a = acc[ai][bj][m][0], b = acc[ai][bj][m][1];
                        v4u w; w.x = cvt_pk_bf16(a[0], a[1]); w.y = cvt_pk_bf16(a[2], a[3]); w.z = cvt_pk_bf16(b[0], b[1]); w.w = cvt_pk_bf16(b[2], b[3]);
                        *(v4u*)(E + ((size_t)(u.pm() * S5_ROWS + crow)) * 256 + bj * 128 + wc * 32 + 8 * fq) = w;
                    }
                }
            }
    }
};
struct S5YOrder {
    const char* ZU; const char* ZH; const char* WY1; const char* WY2; int G, c;
    __device__ __forceinline__ bool next(int i, pg8::Unit& u) const {
        const int bg = (i >> 1) * G + c, seg = i & 1; if (bg >= NB * 64) return false;
        const int g = bg & 63;
        const char* a = seg == 0 ? ZU + ((size_t)(bg * S5_ROWS)) * 512 : ZH + ((size_t)(bg * 256)) * 512;
        const char* b = (seg == 0 ? WY1 : WY2) + (size_t)g * 256 * 512;
        u = pg8::make_unit(a, b, bg, 0, 0, 4, seg == 0 ? 1 : 0); return true;
    }
};
struct EpiS5Y {
    bf16* AGLU;
    __device__ __forceinline__ void operator()(const Acc& acc, const pg8::Unit& u, int wr, int wc, int fr0, int fq0) const {
        int fr = fr0, fq = fq0; asm volatile("" : "+v"(fr), "+v"(fq));
        const int b_ = u.pm() >> 6, g = u.pm() & 63;
#pragma unroll
        for (int ai = 0; ai < 2; ++ai)
#pragma unroll
            for (int m = 0; m < 4; ++m) {
                const int chunk = ai * 128 + wr * 64 + m * 16 + fr;
#pragma unroll
                for (int bj = 0; bj < 2; ++bj) {
                    const int cc = bj * 128 + wc * 32 + 8 * fq, t = cc >> 4, c0 = cc & 15;
                    const f32x4 a = acc[ai][bj][m][0], b = acc[ai][bj][m][1];
                    v4u w; w.x = cvt_pk_bf16(gelu_tanh(a[0]), gelu_tanh(a[1])); w.y = cvt_pk_bf16(gelu_tanh(a[2]), gelu_tanh(a[3])); w.z = cvt_pk_bf16(gelu_tanh(b[0]), gelu_tanh(b[1])); w.w = cvt_pk_bf16(gelu_tanh(b[2]), gelu_tanh(b[3]));
                    *(v4u*)(AGLU + ((size_t)(b_ * SEQ + chunk * 16 + t)) * SW + 16 * g + c0) = w;
                }
            }
    }
};
__device__ __forceinline__ void s5_scan_unit(Frame& F, int bg, int dir, int tid) {
    const bf16* E = (const bf16*)(F.ws + WS_S5E); bf16* ZH = (bf16*)(F.ws + WS_S5ZH);
    LAS bf16* EL = (LAS bf16*)F.lds;
    for (int i = tid; i < S5_ROWS * 16; i += NWAVES * 64) { const int row = i >> 4, ck = i & 15; *(LAS v4u*)(EL + row * 128 + ck * 8) = *(const v4u*)(E + ((size_t)(bg * S5_ROWS + row)) * 256 + dir * 128 + ck * 8); }
    __syncthreads();
    if (tid < 64) {
        const int p = tid, g = bg & 63;
        float ar = ((const float*)(F.ws + WS_TAB + TAB_AR))[(dir * 64 + g) * 64 + p], ai = ((const float*)(F.ws + WS_TAB + TAB_AI))[(dir * 64 + g) * 64 + p];
#pragma unroll
        for (int k = 0; k < 4; ++k) { const float nr = ar * ar - ai * ai, ni = 2.f * ar * ai; ar = nr; ai = ni; }
        float hr = 0.f, hi = 0.f;
#pragma unroll 8
        for (int k = 0; k < S5_ROWS; ++k) {
            const int row = dir ? (S5_ROWS - 1 - k) : (k < 16 ? 256 + k : k - 16);
            const float er = bflo((unsigned)EL[row * 128 + p]), ei = bflo((unsigned)EL[row * 128 + 64 + p]);
            EL[row * 128 + p] = (bf16)f2bf(hr); EL[row * 128 + 64 + p] = (bf16)f2bf(hi);
            const float nr = ar * hr - ai * hi + er, ni = ar * hi + ai * hr + ei; hr = nr; hi = ni;
        }
    }
    __syncthreads();
    for (int i = tid; i < 256 * 16; i += NWAVES * 64) { const int row = i >> 4, ck = i & 15; *(v4u*)(ZH + ((size_t)(bg * 256 + row)) * 256 + dir * 128 + ck * 8) = *(const LAS v4u*)(EL + row * 128 + ck * 8); }
    __syncthreads();
}

__device__ __forceinline__ void phase_rstate(Frame& F) {
    const bf16* KFT = (const bf16*)(F.ws + WS_KFT); const bf16* KBT = (const bf16*)(F.ws + WS_KBT);
    const bf16* KFTC = (const bf16*)(F.ws + WS_KFTC); const bf16* KBTC = (const bf16*)(F.ws + WS_KBTC);
    const bf16* VT = (const bf16*)(F.ws + WS_VT); const bf16* VTC = (const bf16*)(F.ws + WS_VTC);
    bf16* SIN = (bf16*)(F.ws + WS_OBUF);
    const float* lg2 = (const float*)(F.ws + WS_TAB + TAB_LG2);
    int lane = lane_id(); asm volatile("" : "+v"(lane));
    const int fr = lane & 15, fq = lane >> 4, w = F.wave;
    for (int unit = F.vcu; unit < NB * NH * 2 * 8; unit += F.G) {
        const int sl = unit & 7, dir = (unit >> 3) & 1, h = (unit >> 4) & 7, b = unit >> 7;
        const float gC = __builtin_amdgcn_exp2f((float)CH * lg2[dir * 8 + h]);
        const int bh = b * NH + h;
        const int drow = 16 * w + fr;
        f32x4 st[2] = {{0.f, 0.f, 0.f, 0.f}, {0.f, 0.f, 0.f, 0.f}};
        const bf16* kT = dir ? KBT : KFT; const bf16* kTc = dir ? KBTC : KFTC;
#define RS_PTRS(k, kp, vp, vstep) do { if ((k) < 2) { const int cc_ = dir ? (1 - (k)) : (k); kp = kTc + ((size_t)(bh * DK + drow)) * LC + cc_ * CH; vp = VTC + ((size_t)(bh * DV + 32 * sl + fr)) * LC + cc_ * CH; vstep = (size_t)16 * LC; } \
        else { const int n_ = dir ? (33 - (k)) : ((k) - 2); kp = kT + ((size_t)(bh * DK + drow)) * SEQ + n_ * CH; vp = VT + ((size_t)(bh * DV + 32 * sl + fr)) * SEQ + n_ * CH; vstep = (size_t)16 * SEQ; } } while (0)
#define RS_LOAD(kf, vf, kp, vp, vstep) do { _Pragma("unroll") for (int ks = 0; ks < 4; ++ks) { kf[ks] = *(const bf16x8*)(kp + 32 * ks + 8 * fq); vf[0][ks] = *(const bf16x8*)(vp + 32 * ks + 8 * fq); vf[1][ks] = *(const bf16x8*)(vp + vstep + 32 * ks + 8 * fq); } } while (0)
#define RS_STEP(k, kf, vf) do { const int n_ = (k) < 2 ? -1 : (dir ? (33 - (k)) : ((k) - 2)); \
        if (n_ >= 0) { _Pragma("unroll") for (int et = 0; et < 2; ++et) { v2u o; o.x = cvt_pk_bf16(st[et][0], st[et][1]); o.y = cvt_pk_bf16(st[et][2], st[et][3]); \
            *(v2u*)(SIN + ((((size_t)(bh * 2 + dir) * NCH + n_) * DV + 32 * sl + 16 * et + fr) * DK + 16 * w + 4 * fq)) = o; } } \
        _Pragma("unroll") for (int et = 0; et < 2; ++et) { f32x4 kv = {0.f, 0.f, 0.f, 0.f}; \
            _Pragma("unroll") for (int ks = 0; ks < 4; ++ks) kv = __builtin_amdgcn_mfma_f32_16x16x32_bf16(kf[ks], vf[et][ks], kv, 0, 0, 0); \
            st[et] = st[et] * gC + kv; } } while (0)
        bf16x8 kfA[4], vfA[2][4], kfB[4], vfB[2][4];
        { const bf16* kp; const bf16* vp; size_t vs; RS_PTRS(0, kp, vp, vs); RS_LOAD(kfA, vfA, kp, vp, vs); }
        for (int k = 0; k < 34; k += 2) {
            { const bf16* kp; const bf16* vp; size_t vs; RS_PTRS(k + 1, kp, vp, vs); RS_LOAD(kfB, vfB, kp, vp, vs); }
            RS_STEP(k, kfA, vfA);
            if (k + 2 < 34) { const bf16* kp; const bf16* vp; size_t vs; RS_PTRS(k + 2, kp, vp, vs); RS_LOAD(kfA, vfA, kp, vp, vs); }
            RS_STEP(k + 1, kfB, vfB);
        }
#undef RS_PTRS
#undef RS_LOAD
#undef RS_STEP
    }
}

__device__ __forceinline__ void phase_rout(Frame& F) {
    const bf16* Q = (const bf16*)(F.ws + WS_Q); const bf16* QF = (const bf16*)(F.ws + WS_QF); const bf16* QB = (const bf16*)(F.ws + WS_QB);
    const bf16* KN = (const bf16*)(F.ws + WS_K); const bf16* VT = (const bf16*)(F.ws + WS_VT);
    const bf16* SIN = (const bf16*)(F.ws + WS_OBUF);
    bf16* SG = (bf16*)(F.ws + WS_HBUF);
    const float* lg2 = (const float*)(F.ws + WS_TAB + TAB_LG2);
    int lane = lane_id(); asm volatile("" : "+v"(lane));
    const int fr0 = lane & 15, fq0 = lane >> 4, w = F.wave;
    for (int unit = F.vcu; unit < NB * NH * NCH; unit += F.G) {
        const int n = unit & 31, h = (unit >> 5) & 7, b = unit >> 8, bh = b * NH + h;
        int fr = fr0, fq = fq0; asm volatile("" : "+v"(fr), "+v"(fq));
        const float lgf = lg2[h], lgb = lg2[8 + h];
        const int tok0 = b * SEQ + n * CH;
        const int i = 16 * w + fr;
        const size_t qoff = (size_t)(tok0 + i) * 1024 + h * DK;
        f32x4 sc[8];
        {
            bf16x8 qf[4];
#pragma unroll
            for (int ks = 0; ks < 4; ++ks) qf[ks] = *(const bf16x8*)(Q + qoff + 32 * ks + 8 * fq);
#pragma unroll
            for (int jt = 0; jt < 8; ++jt) {
                f32x4 a = {0.f, 0.f, 0.f, 0.f};
#pragma unroll
                for (int ks = 0; ks < 4; ++ks) { const bf16x8 kf = *(const bf16x8*)(KN + (size_t)(tok0 + 16 * jt + fr) * 1024 + h * DK + 32 * ks + 8 * fq); a = __builtin_amdgcn_mfma_f32_16x16x32_bf16(kf, qf[ks], a, 0, 0, 0); }
#pragma unroll
                for (int r = 0; r < 4; ++r) { const int j = 16 * jt + 4 * fq + r, df = i - j; a[r] *= df >= 0 ? __builtin_amdgcn_exp2f((float)df * lgf) : __builtin_amdgcn_exp2f((float)(-df) * lgb); }
                sc[jt] = a;
                asm volatile("" ::: "memory");
            }
        }
        f32x4 o[16];
#pragma unroll
        for (int et = 0; et < 16; ++et) o[et] = (f32x4){0.f, 0.f, 0.f, 0.f};
#pragma unroll
        for (int ks = 0; ks < 4; ++ks) {
            v4u pw; pw.x = cvt_pk_bf16(sc[2 * ks][0], sc[2 * ks][1]); pw.y = cvt_pk_bf16(sc[2 * ks][2], sc[2 * ks][3]); pw.z = cvt_pk_bf16(sc[2 * ks + 1][0], sc[2 * ks + 1][1]); pw.w = cvt_pk_bf16(sc[2 * ks + 1][2], sc[2 * ks + 1][3]);
            const bf16x8 pf = __builtin_bit_cast(bf16x8, pw);
#pragma unroll
            for (int et = 0; et < 16; ++et) {
                const bf16* vp = VT + ((size_t)(bh * DV + 16 * et + fr)) * SEQ + n * CH + 32 * ks + 4 * fq;
                const v2u lo = *(const v2u*)vp, hi2 = *(const v2u*)(vp + 16);
                v4u vw; vw.x = lo.x; vw.y = lo.y; vw.z = hi2.x; vw.w = hi2.y;
                o[et] = __builtin_amdgcn_mfma_f32_16x16x32_bf16(__builtin_bit_cast(bf16x8, vw), pf, o[et], 0, 0, 0);
                if ((et & 3) == 3) asm volatile("" ::: "memory");
            }
        }
#pragma unroll
        for (int dir = 0; dir < 2; ++dir) {
            const bf16* sp = SIN + (((size_t)(bh * 2 + dir) * NCH + n) * DV) * DK;
            const bf16* qd = dir ? QB : QF;
#pragma unroll
            for (int ks = 0; ks < 4; ++ks) {
                const bf16x8 qf = *(const bf16x8*)(qd + qoff + 32 * ks + 8 * fq);
#pragma unroll
                for (int et = 0; et < 16; ++et) { const bf16x8 sf = *(const bf16x8*)(sp + (size_t)(16 * et + fr) * DK + 32 * ks + 8 * fq); o[et] = __builtin_amdgcn_mfma_f32_16x16x32_bf16(sf, qf, o[et], 0, 0, 0);
                    if ((et & 3) == 3) asm volatile("" ::: "memory"); }
            }
        }
        float ss = 0.f;
#pragma unroll
        for (int et = 0; et < 16; ++et) ss += (o[et][0] * o[et][0] + o[et][1] * o[et][1]) + (o[et][2] * o[et][2] + o[et][3] * o[et][3]);
        ss += shfl_xor_l(ss, 16, lane); ss += shfl_xor_l(ss, 32, lane);
        const float rinv = 1.0f / sqrtf(ss * (1.0f / DV) + EPS);
        bf16* gp = SG + (size_t)(tok0 + i) * D + h * DV + 4 * fq;
#pragma unroll
        for (int et = 0; et < 16; ++et) { const v2u gg = *(const v2u*)(gp + 16 * et);
            v2u ow; ow.x = cvt_pk_bf16(o[et][0] * rinv * bflo(gg.x), o[et][1] * rinv * bfhi(gg.x)); ow.y = cvt_pk_bf16(o[et][2] * rinv * bflo(gg.y), o[et][3] * rinv * bfhi(gg.y));
            *(v2u*)(gp + 16 * et) = ow; }
    }
}

__global__ void __launch_bounds__(NWAVES * 64, 2) fwd_megakernel(Args args) {
    extern __shared__ __attribute__((aligned(16))) unsigned char lds[];
    Frame F;
    F.lds = (LAS unsigned char*)lds;
    F.MISC = (volatile LAS unsigned*)(F.lds + MISC_OFF);
    F.wave = __builtin_amdgcn_readfirstlane((int)threadIdx.x >> 6);
    F.G = gridDim.x; { const int bx = blockIdx.x; F.vcu = (F.G % 8 == 0) ? (bx % 8) * (F.G / 8) + bx / 8 : bx; }
    F.out = kargs()->out; F.ws = kargs()->ws; F.ctl = (unsigned*)(F.ws + WS_CTL);
    for (int u = (int)threadIdx.x; u < (LDS_BYTES - LDSCTL_OFF) / 4; u += NWAVES * 64) ((LAS unsigned*)(F.lds + LDSCTL_OFF))[u] = 0u;
    __syncthreads();
    XcdBarrier bar = xcd_barrier_post(F.ctl + CW_BAR, F.MISC + 8);
    unsigned char* ws = F.ws;
    const int G = F.G, cid = (int)blockIdx.x;
#define GRID_BAR() xcd_barrier(bar)

#ifndef PHM
#define PHM 0xFFFFF
#endif
#define PH(k) ((PHM >> (k)) & 1)
#ifndef REPM
#define REPM 0
#endif
#define NREP(k) (1 + ((REPM >> (k)) & 1))
#if PH(0)
    phase_prologue(F, args, true);
#if NREP(0) > 1
    phase_prologue(F, args, false);
#endif
#endif
    GRID_BAR();
#if PH(1)
    phase_rows<0>(F, args);
    s5_tables1(F, args);
#endif
    GRID_BAR();
#if PH(2)
    {
        pg8::GridOrder S; S.init(ws + WS_ABUF, ws + WS_W1T, D, MT / 256, NFF / 256, G, cid);
        EpiSwiGLU E{(bf16*)(ws + WS_HBUF)};
        pg8::gemm_phase(F.lds, D, S, E, F.wave);
    }
#if NREP(2) > 1
    {
        pg8::GridOrder S; S.init(ws + WS_ABUF, ws + WS_W1T, D, MT / 256, NFF / 256, G, cid);
        EpiSwiGLU E{(bf16*)(ws + WS_HBUF)};
        pg8::gemm_phase(F.lds, D, S, E, F.wave);
    }
#endif
#endif
    GRID_BAR();
#if PH(3)
    {
        pg8::GridOrder S; S.init(ws + WS_HBUF, ws + WS_W2T, DFF, MT / 256, D / 256, G, cid);
        EpiF32 E{(float*)(ws + WS_OBUF), D};
        pg8::gemm_phase(F.lds, DFF, S, E, F.wave);
    }
#if NREP(3) > 1
    {
        pg8::GridOrder S; S.init(ws + WS_HBUF, ws + WS_W2T, DFF, MT / 256, D / 256, G, cid);
        EpiF32 E{(float*)(ws + WS_OBUF), D};
        pg8::gemm_phase(F.lds, DFF, S, E, F.wave);
    }
#endif
#endif
    GRID_BAR();
#if PH(4)
    phase_rows<1>(F, args);
    s5_tables2(F, args);
#endif
    GRID_BAR();
#if PH(5)
    {
        MixOrder S{(const char*)(ws + WS_ABUF), (const char*)(ws + WS_WMT), G, cid};
        EpiMix E{ws};
        pg8::gemm_phase(F.lds, D, S, E, F.wave);
    }
#if NREP(5) > 1
    {
        MixOrder S{(const char*)(ws + WS_ABUF), (const char*)(ws + WS_WMT), G, cid};
        EpiMix E{ws};
        pg8::gemm_phase(F.lds, D, S, E, F.wave);
    }
#endif
#endif
    GRID_BAR();
#if PH(6)
    phase_rstate(F);
#if NREP(6) > 1
    phase_rstate(F);
#endif
#endif
#if PH(7)
    {
        S5EOrder S{(const char*)(ws + WS_US), (const char*)(ws + WS_S5WE), G, cid};
        EpiS5E E{(bf16*)(ws + WS_S5E)};
        pg8::gemm_phase(F.lds, 256, S, E, F.wave);
    }
#endif
    GRID_BAR();
#if PH(8)
    {
        int tid_ = F.wave * 64 + lane_id(); asm volatile("" : "+v"(tid_));
        for (int bg = cid; bg < NB * 64; bg += G) { s5_scan_unit(F, bg, 0, tid_); s5_scan_unit(F, bg, 1, tid_); }
        asm volatile("s_waitcnt vmcnt(0)" ::: "memory"); __syncthreads();
        S5YOrder S{(const char*)(ws + WS_US), (const char*)(ws + WS_S5ZH), (const char*)(ws + WS_S5WY1), (const char*)(ws + WS_S5WY2), G, cid};
        EpiS5Y E{(bf16*)(ws + WS_AGLU)};
        pg8::gemm_phase(F.lds, 256, S, E, F.wave);
    }
    phase_rout(F);
#endif
    GRID_BAR();
#if PH(9)
    {
        pg8::GridOrder S; S.init(ws + WS_AGLU, ws + WS_WGT, SW, MX / 256, 2 * D / 256, G, cid);
        EpiGLU E{(const bf16*)(ws + WS_HBUF + 32 * MiB), (bf16*)(ws + WS_Q)};
        pg8::gemm_phase(F.lds, SW, S, E, F.wave);
    }
#if NREP(9) > 1
    {
        pg8::GridOrder S; S.init(ws + WS_AGLU, ws + WS_WGT, SW, MX / 256, 2 * D / 256, G, cid);
        EpiGLU E{(const bf16*)(ws + WS_HBUF + 32 * MiB), (bf16*)(ws + WS_Q)};
        pg8::gemm_phase(F.lds, SW, S, E, F.wave);
    }
#endif
#endif
    GRID_BAR();
#if PH(10)
    {
        pg8::GridOrder S; S.init(ws + WS_HBUF, ws + WS_WPT, D, MX / 256, D / 256, G, cid);
        EpiMerge E{(const bf16*)(ws + WS_HBUF + 64 * MiB), (bf16*)(ws + WS_Q)};
        pg8::gemm_phase(F.lds, D, S, E, F.wave);
    }
#if NREP(10) > 1
    {
        pg8::GridOrder S; S.init(ws + WS_HBUF, ws + WS_WPT, D, MX / 256, D / 256, G, cid);
        EpiMerge E{(const bf16*)(ws + WS_HBUF + 64 * MiB), (bf16*)(ws + WS_Q)};
        pg8::gemm_phase(F.lds, D, S, E, F.wave);
    }
#endif
#endif
    GRID_BAR();
#if PH(11)
    {
        pg8::GridOrder S; S.init(ws + WS_Q, ws + WS_WOT, D, MX / 256, D / 256, G, cid);
        EpiF32 E{(float*)(ws + WS_OBUF), D};
        pg8::gemm_phase(F.lds, D, S, E, F.wave);
    }
#if NREP(11) > 1
    {
        pg8::GridOrder S; S.init(ws + WS_Q, ws + WS_WOT, D, MX / 256, D / 256, G, cid);
        EpiF32 E{(float*)(ws + WS_OBUF), D};
        pg8::gemm_phase(F.lds, D, S, E, F.wave);
    }
#endif
#endif
    GRID_BAR();
#if PH(12)
    phase_rows<2>(F, args);
#if NREP(12) > 1
    phase_rows<2>(F, args);
#endif
#endif
    GRID_BAR();
#if PH(13)
    {
        pg8::GridOrder S; S.init(ws + WS_ABUF, ws + WS_W3T, D, MX / 256, NFF / 256, G, cid);
        EpiSwiGLU E{(bf16*)(ws + WS_HBUF)};
        pg8::gemm_phase(F.lds, D, S, E, F.wave);
    }
#if NREP(13) > 1
    {
        pg8::GridOrder S; S.init(ws + WS_ABUF, ws + WS_W3T, D, MX / 256, NFF / 256, G, cid);
        EpiSwiGLU E{(bf16*)(ws + WS_HBUF)};
        pg8::gemm_phase(F.lds, D, S, E, F.wave);
    }
#endif
#endif
    GRID_BAR();
#if PH(14)
    {
        pg8::GridOrder S; S.init(ws + WS_HBUF, ws + WS_W4T, DFF, MX / 256, D / 256, G, cid);
        EpiF32 E{(float*)(ws + WS_OBUF), D};
        pg8::gemm_phase(F.lds, DFF, S, E, F.wave);
    }
#if NREP(14) > 1
    {
        pg8::GridOrder S; S.init(ws + WS_HBUF, ws + WS_W4T, DFF, MX / 256, D / 256, G, cid);
        EpiF32 E{(float*)(ws + WS_OBUF), D};
        pg8::gemm_phase(F.lds, DFF, S, E, F.wave);
    }
#endif
#endif
    GRID_BAR();
#if PH(15)
    phase_rows<3>(F, args);
#if NREP(15) > 1
    phase_rows<3>(F, args);
#endif
#endif
}

extern "C" void kernel_launch(void* const* d_in, const int* in_sizes, int n_in, void* d_out, int out_size, void* d_ws, size_t ws_size, hipStream_t stream) {
    static int grid = 0;
    if (grid == 0) {
        if (n_in != 22 || in_sizes[0] != MX * D || out_size != MX * D || ws_size < WS_END) { fprintf(stderr, "kernel_launch: unexpected problem (n_in %d, in0 %d, out %d, ws %zu, need %zu)\n", n_in, n_in > 0 ? in_sizes[0] : -1, out_size, ws_size, (size_t)WS_END); grid = -1; return; }
        int dev = 0, cus = 0, per_cu = 0;
        if (hipGetDevice(&dev) != hipSuccess || hipDeviceGetAttribute(&cus, hipDeviceAttributeMultiprocessorCount, dev) != hipSuccess) { grid = -1; return; }
        if (hipFuncSetAttribute((const void*)fwd_megakernel, hipFuncAttributeMaxDynamicSharedMemorySize, LDS_BYTES) != hipSuccess) { fprintf(stderr, "kernel_launch: hipFuncSetAttribute failed\n"); grid = -1; return; }
        if (hipOccupancyMaxActiveBlocksPerMultiprocessor(&per_cu, (const void*)fwd_megakernel, NWAVES * 64, LDS_BYTES) != hipSuccess || per_cu < 1) { fprintf(stderr, "kernel_launch: occupancy query says %d blocks per CU\n", per_cu); grid = -1; (void)hipGetLastError(); return; }
        grid = cus;
    }
    if (grid < 0) return;
    if (hipMemsetAsync((char*)d_ws + WS_CTL, 0, CTL_ZERO_BYTES, stream) != hipSuccess) return;
    Args a{};
    for (int i = 0; i < 22; ++i) a.in[i] = (const float*)d_in[i];
    a.out = (float*)d_out; a.ws = (unsigned char*)d_ws;
    void* kargs[] = {&a};
    hipError_t e = hipLaunchCooperativeKernel((const void*)fwd_megakernel, dim3(grid), dim3(NWAVES * 64), kargs, LDS_BYTES, stream);
    if (e != hipSuccess) fprintf(stderr, "kernel_launch: cooperative launch failed: %s (grid %d)\n", hipGetErrorString(e), grid);
}
```

```cpp
#include <hip/hip_runtime.h>
#include <cstdio>
#include <cstdint>

#define GAS __attribute__((address_space(1)))
#define LAS __attribute__((address_space(3)))
typedef unsigned short bf16;
typedef unsigned v4u __attribute__((ext_vector_type(4)));
typedef unsigned v2u __attribute__((ext_vector_type(2)));
typedef float f32x4 __attribute__((ext_vector_type(4)));
typedef float f32x2 __attribute__((ext_vector_type(2)));
typedef short bf16x8 __attribute__((ext_vector_type(8)));
typedef short bf16x4 __attribute__((ext_vector_type(4)));

constexpr int D = 2048, NB = 2, SEQ = 4096, MX = NB * SEQ, LC = 256, MC = NB * LC, MT = MX + MC;
constexpr int DFF = 5632, NFF = 2 * DFF, SW = 1024, NMIX = 11264, NH = 8, DK = 128, DV = 256, CH = 128, NCH = SEQ / CH;
constexpr int NADA = 9 * D;
constexpr float EPS = 1e-6f;
constexpr int NWAVES = 8;

constexpr size_t MiB = 1u << 20;
constexpr size_t WS_CTL = 0, CTL_ZERO_BYTES = 1 * MiB;
constexpr size_t WS_W1T = 1 * MiB, WS_W2T = 45 * MiB, WS_WMT = 67 * MiB, WS_WGT = 115 * MiB, WS_WPT = 123 * MiB, WS_WOT = 131 * MiB, WS_W3T = 139 * MiB, WS_W4T = 183 * MiB;
constexpr size_t WS_ABUF = 205 * MiB;
constexpr size_t WS_HBUF = 239 * MiB;
constexpr size_t WS_OBUF = 335 * MiB;
constexpr size_t WS_US = 403 * MiB;
constexpr size_t WS_Q = 420 * MiB, WS_QF = 436 * MiB, WS_QB = 452 * MiB;
constexpr size_t WS_K = 468 * MiB;
constexpr size_t WS_KFT = 484 * MiB, WS_KBT = 500 * MiB, WS_KFTC = 516 * MiB, WS_KBTC = 517 * MiB;
constexpr size_t WS_VT = 518 * MiB, WS_VTC = 550 * MiB;
constexpr size_t WS_YF = 552 * MiB;
constexpr size_t WS_S5WE = WS_YF, WS_S5WY1 = WS_YF + 8 * MiB, WS_S5WY2 = WS_YF + 16 * MiB, WS_S5KT = WS_YF + 24 * MiB, WS_S5BRF = WS_YF + 26 * MiB;
constexpr size_t WS_S5E = WS_ABUF, WS_S5ZH = WS_ABUF + 17 * MiB;
constexpr int S5_ROWS = 272;
constexpr size_t WS_AGLU = 584 * MiB;
constexpr size_t WS_TAB = 600 * MiB;
constexpr size_t WS_END = 602 * MiB;
constexpr size_t TAB_ROPE = 0, TAB_LG2 = 16384, TAB_AR = 32768, TAB_AI = 65536, TAB_END = 131072;
constexpr int CW_BAR = 4096;
constexpr size_t CTL_ADA = 65536;

#define RLX_AGENT __ATOMIC_RELAXED, __HIP_MEMORY_SCOPE_AGENT
#define LDS_WAIT() asm volatile("s_waitcnt lgkmcnt(0)" ::: "memory")
#define VM_WAIT() asm volatile("s_waitcnt vmcnt(0)" ::: "memory")

__device__ __forceinline__ unsigned f2bf(float f) { unsigned u = __builtin_bit_cast(unsigned, f); return (u + 0x7fffu + ((u >> 16) & 1u)) >> 16; }
__device__ __forceinline__ unsigned pk2(float lo, float hi) { return f2bf(lo) | (f2bf(hi) << 16); }
__device__ __forceinline__ unsigned cvt_pk_bf16(float lo, float hi) { unsigned r; asm volatile("v_cvt_pk_bf16_f32 %0, %1, %2" : "=v"(r) : "v"(lo), "v"(hi)); return r; }
__device__ __forceinline__ float bflo(unsigned w) { return __builtin_bit_cast(float, w << 16); }
__device__ __forceinline__ float bfhi(unsigned w) { return __builtin_bit_cast(float, w & 0xffff0000u); }
__device__ __forceinline__ float fast_sigmoid(float x) { return __builtin_amdgcn_rcpf(1.0f + __builtin_amdgcn_exp2f(-1.4426950408889634f * x)); }
__device__ __forceinline__ float fast_silu(float x) { return x * fast_sigmoid(x); }
__device__ __forceinline__ float gelu_tanh(float x) { const float u = 0.7978845608028654f * (x + 0.044715f * x * x * x); return x * fast_sigmoid(2.0f * u); }
__device__ __forceinline__ int lane_id() { return (int)__builtin_amdgcn_mbcnt_hi(~0u, __builtin_amdgcn_mbcnt_lo(~0u, 0u)); }
__device__ __forceinline__ float shfl_xor_l(float v, int mask, int lane) { return __builtin_bit_cast(float, __builtin_amdgcn_ds_bpermute((lane ^ mask) << 2, __builtin_bit_cast(int, v))); }
__device__ __forceinline__ float wave_sum(float v, int lane) {
#pragma unroll
    for (int o = 1; o < 64; o <<= 1) v += shfl_xor_l(v, o, lane);
    return v;
}

#define XB_TMO      128
#define XB_XCNT(j)  (256  + 64 * (j))
#define XB_XSUB(j)  (1280 + 64 * (j))
#define XB_XGEN(j)  (2304 + 64 * (j))
#define XB_TOP      3328
#define XB_TOPGEN   3392
#define XCD_BAR_WORDS 3456
#define XB_SPIN_CAP (1u << 18)
__device__ __forceinline__ unsigned xb_ld(unsigned* p)              { return __hip_atomic_load(p, __ATOMIC_RELAXED, __HIP_MEMORY_SCOPE_AGENT); }
__device__ __forceinline__ unsigned xb_add(unsigned* p, unsigned v) { return __hip_atomic_fetch_add(p, v, __ATOMIC_RELAXED, __HIP_MEMORY_SCOPE_AGENT); }
__device__ __forceinline__ unsigned xb_xcc_id() { return (unsigned)__builtin_amdgcn_s_getreg((3 << 11) | 20) & 0xFu; }
#define XB_SPIN(cond, bar) do { unsigned _sp = 0; while (cond) { __builtin_amdgcn_s_sleep(1); \
    if ((++_sp & 255u) == 0u) { if (xb_ld(&(bar)[XB_TMO])) break; if (_sp > XB_SPIN_CAP) { atomicAdd(&(bar)[XB_TMO], 1u); break; } } } } while (0)
struct XcdBarrier { unsigned* bar; unsigned x; volatile LAS unsigned* st; };
__device__ __forceinline__ XcdBarrier xcd_barrier_post(unsigned* bar, volatile LAS unsigned* st) {
    XcdBarrier b; b.bar = bar; b.x = xb_xcc_id(); b.st = st;
    if (threadIdx.x == 0) (void)xb_add(&bar[XB_XCNT(b.x)], 1u);
    return b;
}
__device__ __forceinline__ void xcd_barrier_complete(unsigned* bar, unsigned x, unsigned& nloc, unsigned& nx) {
    const unsigned G = gridDim.x * gridDim.y * gridDim.z;
    unsigned sum, cnt, mine, sp = 0u;
    for (;;) {
        sum = 0u; cnt = 0u; mine = 0u;
#pragma unroll
        for (unsigned j = 0; j < 16; ++j) { const unsigned c = xb_ld(&bar[XB_XCNT(j)]); sum += c; cnt += (c > 0u) ? 1u : 0u; mine = (j == x) ? c : mine; }
        if (sum == G) break;
        __builtin_amdgcn_s_sleep(1);
        if ((++sp & 255u) == 0u) { if (xb_ld(&bar[XB_TMO])) break; if (sp > XB_SPIN_CAP) { atomicAdd(&bar[XB_TMO], 1u); break; } }
    }
    nloc = mine > 0u ? mine : 1u; nx = cnt > 0u ? cnt : 1u;
}
__device__ __forceinline__ void xcd_barrier(const XcdBarrier& b) {
    asm volatile("s_waitcnt vmcnt(0)" ::: "memory");
    __syncthreads();
    if (threadIdx.x == 0) {
        unsigned* bar = b.bar;
        __builtin_amdgcn_s_waitcnt(0);
        unsigned nloc = b.st[0], nx = b.st[1];
        if (nloc == 0u) { xcd_barrier_complete(bar, b.x, nloc, nx); b.st[0] = nloc; b.st[1] = nx; }
        const unsigned old = xb_add(&bar[XB_XSUB(b.x)], 1u);
        const unsigned gen = old / nloc;
        if (old + 1u == (gen + 1u) * nloc) {
            __builtin_amdgcn_fence(__ATOMIC_RELEASE, "agent");
            asm volatile("s_waitcnt vmcnt(0)" ::: "memory");
            const unsigned og = xb_add(&bar[XB_TOP], 1u);
            const unsigned tg = og / nx;
            if (og + 1u == (tg + 1u) * nx) xb_add(&bar[XB_TOPGEN], 1u);
            else XB_SPIN(xb_ld(&bar[XB_TOPGEN]) == tg, bar);
            __builtin_amdgcn_fence(__ATOMIC_ACQUIRE, "agent");
            xb_add(&bar[XB_XGEN(b.x)], 1u);
            asm volatile("s_waitcnt vmcnt(0)" ::: "memory");
        } else {
            XB_SPIN(xb_ld(&bar[XB_XGEN(b.x)]) == gen, bar);
            __builtin_amdgcn_fence(__ATOMIC_ACQUIRE, "agent");
            asm volatile("s_waitcnt vmcnt(0)" ::: "memory");
        }
    }
    __syncthreads();
}

namespace pg8 {
constexpr int BM = 256, BK = 64, HALF = 128, HTB = HALF * BK * 2, STAGE_BYTES = 8 * HTB, NXCD = 8;
__device__ __forceinline__ int lds_byte(int r, int c) { const int st = (r >> 4) * 2 + (c >> 5), rr = r & 15, cc = c & 31, ob = rr * 64 + cc * 2; return st * 1024 + (ob ^ (((ob >> 9) & 1) << 5)); }
__device__ __forceinline__ void stage_rc(int b, int& R, int& C) { const int st = b / 1024, sb = b % 1024, swz = sb ^ (((sb >> 9) & 1) << 5); R = (st >> 1) * 16 + swz / 64; C = (st & 1) * 32 + (swz % 64) / 2; }
__device__ __forceinline__ int perm32(int rho) { const int n = rho >> 4, i = rho & 15; return 8 * (i >> 2) + 4 * n + (i & 3); }

struct Unit {
    const char* A; const char* B; unsigned info;
    __device__ __forceinline__ int pm() const { return (int)(info & 255u); }
    __device__ __forceinline__ int pn() const { return (int)((info >> 8) & 255u); }
    __device__ __forceinline__ int kind() const { return (int)((info >> 16) & 15u); }
    __device__ __forceinline__ int nt() const { return (int)((info >> 20) & 255u); }
    __device__ __forceinline__ int cont() const { return (int)((info >> 28) & 1u); }
};
__device__ __forceinline__ Unit make_unit(const char* A, const char* B, int pm, int pn, int kind, int nt, int cont) { return Unit{A, B, (unsigned)pm | ((unsigned)pn << 8) | ((unsigned)kind << 16) | ((unsigned)nt << 20) | ((unsigned)cont << 28)}; }
__device__ __forceinline__ int xcd_remap(int L, int nwg) { const int q = nwg / NXCD, r = nwg % NXCD, xcd = L % NXCD, off = L / NXCD; return (xcd < r ? xcd * (q + 1) : r * (q + 1) + (xcd - r) * q) + off; }

template <class Epi, class Sched>
__device__ __forceinline__ void gemm_phase(LAS unsigned char* lds, const int K, const Sched& S, const Epi& E, const int wave_) {
    int tid = wave_ * 64 + lane_id(); asm volatile("" : "+v"(tid));
    const int wid = wave_, lane = tid & 63, wr = wid >> 2, wc = wid & 3, fr = lane & 15, fq = lane >> 4;
    unsigned voffA[2], voffB[2];
#pragma unroll
    for (int i = 0; i < 2; ++i) { int R, C; stage_rc(tid * 16 + i * 8192, R, C); const int Rb = (R & ~31) + perm32(R & 31);
        voffA[i] = (unsigned)(R * K + C) * 2u; voffB[i] = (unsigned)(Rb * K + C) * 2u; }
    const size_t kstep = (size_t)(BK * 2);
    const size_t hstep = (size_t)HALF * K * 2;
    const unsigned ldsw = (unsigned)wid * 1024u;
    const int aoff = lds_byte(wr * 64 + fr, fq * 8), boff = lds_byte(wc * 32 + fr, fq * 8);
#define PG8_SA(b, h) (((b) * 2 + (h)) * HTB)
#define PG8_SB(b, h) ((4 + (b) * 2 + (h)) * HTB)
#define PG8_STAGE(bufoff, gbase, voff) do { _Pragma("unroll") for (int _i = 0; _i < 2; ++_i) \
        __builtin_amdgcn_global_load_lds((const unsigned*)((const char*)(gbase) + (voff)[_i]), (LAS unsigned*)(lds + (bufoff) + ldsw + _i * 8192), 16, 0, 0); } while (0)
#define PG8_LDA(dst, b, h) do { _Pragma("unroll") for (int m = 0; m < 4; ++m) _Pragma("unroll") for (int k = 0; k < 2; ++k) dst[m][k] = *(const LAS bf16x8*)(lds + PG8_SA(b, h) + aoff + m * 2048 + k * 1024); } while (0)
#define PG8_LDB(dst, b, h) do { _Pragma("unroll") for (int n = 0; n < 2; ++n) _Pragma("unroll") for (int k = 0; k < 2; ++k) dst[n][k] = *(const LAS bf16x8*)(lds + PG8_SB(b, h) + boff + n * 2048 + k * 1024); } while (0)
#define PG8_MMA(ai, bj, At, Bt) do { __builtin_amdgcn_s_setprio(1); _Pragma("unroll") for (int m = 0; m < 4; ++m) _Pragma("unroll") for (int n = 0; n < 2; ++n) _Pragma("unroll") for (int k = 0; k < 2; ++k) \
        acc[ai][bj][m][n] = __builtin_amdgcn_mfma_f32_16x16x32_bf16(Bt[n][k], At[m][k], acc[ai][bj][m][n], 0, 0, 0); __builtin_amdgcn_s_setprio(0); } while (0)
#define PG8_WAIT_V(n) asm volatile("s_waitcnt vmcnt(" #n ")" ::: "memory")
#define PG8_WAIT_L(n) asm volatile("s_waitcnt lgkmcnt(" #n ")" ::: "memory")
#define PG8_BAR __builtin_amdgcn_s_barrier()
#define PG8_SCHED __builtin_amdgcn_sched_barrier(0)
    Unit cur, nxt; int ui = 0;
    if (!S.next(0, cur)) return;
    f32x4 acc[2][2][4][2];
#pragma unroll
    for (int a = 0; a < 2; ++a)
#pragma unroll
        for (int b = 0; b < 2; ++b)
#pragma unroll
            for (int m = 0; m < 4; ++m)
#pragma unroll
                for (int n = 0; n < 2; ++n) acc[a][b][m][n] = (f32x4){0.f, 0.f, 0.f, 0.f};
    bf16x8 At[4][2], B0[2][2], B1[2][2];
    const char* cA = cur.A; const char* cB = cur.B;
    PG8_STAGE(PG8_SB(0, 0), cB, voffB); PG8_STAGE(PG8_SB(0, 1), cB + hstep, voffB); PG8_STAGE(PG8_SA(0, 0), cA, voffA); PG8_STAGE(PG8_SA(0, 1), cA + hstep, voffA);
    if (wr == 1) PG8_BAR;
    PG8_WAIT_V(2); PG8_BAR;
    PG8_STAGE(PG8_SB(1, 0), cB + kstep, voffB); PG8_STAGE(PG8_SA(1, 0), cA + kstep, voffA); PG8_STAGE(PG8_SB(1, 1), cB + hstep + kstep, voffB);
    PG8_WAIT_V(6); PG8_BAR;
    for (;;) {
        const bool has_next = S.next(ui + 1, nxt);
        const char* nA = has_next ? nxt.A : cA; const char* nB = has_next ? nxt.B : cB;
        const int nt = cur.nt();
        for (int t = 0; t < nt; t += 2) {
            const bool last = (t == nt - 2);
            const char* a1 = cA + (size_t)(t + 1) * kstep;
            const char* a2 = last ? nA : cA + (size_t)(t + 2) * kstep; const char* b2 = last ? nB : cB + (size_t)(t + 2) * kstep;
            const char* a3 = a2 + kstep; const char* b3 = b2 + kstep;
            PG8_LDB(B0, 0, 0); PG8_LDB(B1, 0, 1); PG8_SCHED; PG8_LDA(At, 0, 0); PG8_STAGE(PG8_SA(1, 1), a1 + hstep, voffA);
            PG8_WAIT_V(8); PG8_WAIT_L(0); PG8_BAR; PG8_MMA(0, 0, At, B0); PG8_MMA(0, 1, At, B1); PG8_BAR; PG8_SCHED;
            PG8_LDA(At, 0, 1); PG8_STAGE(PG8_SB(0, 0), b2, voffB); PG8_STAGE(PG8_SB(0, 1), b2 + hstep, voffB); PG8_STAGE(PG8_SA(0, 0), a2, voffA);
            PG8_WAIT_V(8); PG8_WAIT_L(0); PG8_BAR; PG8_MMA(1, 0, At, B0); PG8_MMA(1, 1, At, B1); PG8_BAR; PG8_SCHED;
            PG8_LDB(B0, 1, 0); PG8_LDB(B1, 1, 1); PG8_SCHED; PG8_LDA(At, 1, 0); PG8_STAGE(PG8_SA(0, 1), a2 + hstep, voffA);
            PG8_WAIT_V(8); PG8_WAIT_L(0); PG8_BAR; PG8_MMA(0, 0, At, B0); PG8_MMA(0, 1, At, B1); PG8_BAR; PG8_SCHED;
            PG8_LDA(At, 1, 1); PG8_STAGE(PG8_SB(1, 0), b3, voffB); PG8_STAGE(PG8_SB(1, 1), b3 + hstep, voffB); PG8_STAGE(PG8_SA(1, 0), a3, voffA);
            PG8_WAIT_V(8); PG8_WAIT_L(0); PG8_BAR; PG8_MMA(1, 0, At, B0); PG8_MMA(1, 1, At, B1); PG8_BAR; PG8_SCHED;
        }
        if (wr == 0) PG8_BAR;
        if (!cur.cont()) E(acc, cur, wr, wc, fr, fq);
        if (!has_next) break;
        if (!cur.cont()) {
#pragma unroll
        for (int a = 0; a < 2; ++a)
#pragma unroll
            for (int b = 0; b < 2; ++b)
#pragma unroll
                for (int m = 0; m < 4; ++m)
#pragma unroll
                    for (int n = 0; n < 2; ++n) acc[a][b][m][n] = (f32x4){0.f, 0.f, 0.f, 0.f};
        }
        cur = nxt; cA = nA; cB = nB; ++ui;
        if (wr == 1) PG8_BAR;
    }
    PG8_WAIT_V(0);
    PG8_BAR;
#undef PG8_SA
#undef PG8_SB
#undef PG8_STAGE
#undef PG8_LDA
#undef PG8_LDB
#undef PG8_MMA
#undef PG8_WAIT_V
#undef PG8_WAIT_L
#undef PG8_BAR
#undef PG8_SCHED
}

struct GridOrder {
    const char* A; const char* B; size_t tstep; int nM, nN, nwg, G, c, nt;
    __device__ __forceinline__ void init(const void* A_, const void* B_, int K, int nM_, int nN_, int G_, int c_) { A = (const char*)A_; B = (const char*)B_; tstep = (size_t)BM * K * 2; nM = nM_; nN = nN_; nwg = nM * nN; G = G_; c = c_; nt = K / BK; }
    __device__ __forceinline__ bool next(int i, Unit& u) const {
        const long L = (long)i * G + c; if (L >= nwg) return false;
        const int wgid = xcd_remap((int)L, nwg);
        const int nig = 8 * nN, gid = wgid / nig, fm = gid * 8, gsz = (nM - fm) < 8 ? (nM - fm) : 8;
        const int pm = fm + ((wgid % nig) % gsz), pn = (wgid % nig) / gsz;
        u = make_unit(A + (size_t)pm * tstep, B + (size_t)pn * tstep, pm, pn, 0, nt, 0); return true;
    }
};
}

typedef f32x4 Acc[2][2][4][2];
struct EpiSwiGLU {
    bf16* Hid;
    __device__ __forceinline__ void operator()(const Acc& acc, const pg8::Unit& u, int wr, int wc, int fr0, int fq0) const {
        int fr = fr0, fq = fq0; asm volatile("" : "+v"(fr), "+v"(fq));
        const int row0 = u.pm() * 256 + wr * 64 + fr, col0 = u.pn() * 128 + wc * 32 + 8 * fq;
#pragma unroll
        for (int ai = 0; ai < 2; ++ai)
#pragma unroll
            for (int m = 0; m < 4; ++m) {
                float v[8];
#pragma unroll
                for (int n = 0; n < 2; ++n)
#pragma unroll
                    for (int j = 0; j < 4; ++j) v[4 * n + j] = fast_silu(acc[ai][0][m][n][j]) * acc[ai][1][m][n][j];
                v4u w; w.x = cvt_pk_bf16(v[0], v[1]); w.y = cvt_pk_bf16(v[2], v[3]); w.z = cvt_pk_bf16(v[4], v[5]); w.w = cvt_pk_bf16(v[6], v[7]);
                *(v4u*)(Hid + (size_t)(row0 + ai * 128 + m * 16) * DFF + col0) = w;
            }
    }
};
struct EpiO16 {
    bf16* C; int ldc;
    __device__ __forceinline__ void operator()(const Acc& acc, const pg8::Unit& u, int wr, int wc, int fr0, int fq0) const {
        int fr = fr0, fq = fq0; asm volatile("" : "+v"(fr), "+v"(fq));
        const int row0 = u.pm() * 256 + wr * 64 + fr, col0 = u.pn() * 256 + wc * 32 + 8 * fq;
#pragma unroll
        for (int ai = 0; ai < 2; ++ai)
#pragma unroll
            for (int m = 0; m < 4; ++m) { bf16* rowp = C + (size_t)(row0 + ai * 128 + m * 16) * ldc + col0;
#pragma unroll
                for (int bj = 0; bj < 2; ++bj) { const f32x4 a = acc[ai][bj][m][0], b = acc[ai][bj][m][1];
                    v4u w; w.x = cvt_pk_bf16(a[0], a[1]); w.y = cvt_pk_bf16(a[2], a[3]); w.z = cvt_pk_bf16(b[0], b[1]); w.w = cvt_pk_bf16(b[2], b[3]);
                    *(v4u*)(rowp + bj * 128) = w; } }
    }
};
struct EpiGLU {
    const bf16* SGS; bf16* out;
    __device__ __forceinline__ void operator()(const Acc& acc, const pg8::Unit& u, int wr, int wc, int fr0, int fq0) const {
        int fr = fr0, fq = fq0; asm volatile("" : "+v"(fr), "+v"(fq));
        const int row0 = u.pm() * 256 + wr * 64 + fr, col0 = u.pn() * 128 + wc * 32 + 8 * fq;
#pragma unroll
        for (int ai = 0; ai < 2; ++ai)
#pragma unroll
            for (int m = 0; m < 4; ++m) {
                const size_t off = (size_t)(row0 + ai * 128 + m * 16) * D + col0;
                const v4u s = *(const v4u*)(SGS + off);
                const float sg[8] = {bflo(s.x), bfhi(s.x), bflo(s.y), bfhi(s.y), bflo(s.z), bfhi(s.z), bflo(s.w), bfhi(s.w)};
                float v[8];
#pragma unroll
                for (int n = 0; n < 2; ++n)
#pragma unroll
                    for (int j = 0; j < 4; ++j) v[4 * n + j] = acc[ai][0][m][n][j] * fast_sigmoid(acc[ai][1][m][n][j]) * sg[4 * n + j];
                v4u w; w.x = cvt_pk_bf16(v[0], v[1]); w.y = cvt_pk_bf16(v[2], v[3]); w.z = cvt_pk_bf16(v[4], v[5]); w.w = cvt_pk_bf16(v[6], v[7]);
                *(v4u*)(out + off) = w;
            }
    }
};
struct EpiMerge {
    const bf16* SGR; bf16* mg;
    __device__ __forceinline__ void operator()(const Acc& acc, const pg8::Unit& u, int wr, int wc, int fr0, int fq0) const {
        int fr = fr0, fq = fq0; asm volatile("" : "+v"(fr), "+v"(fq));
        const int row0 = u.pm() * 256 + wr * 64 + fr, col0 = u.pn() * 256 + wc * 32 + 8 * fq;
#pragma unroll
        for (int ai = 0; ai < 2; ++ai)
#pragma unroll
            for (int m = 0; m < 4; ++m)
#pragma unroll
                for (int bj = 0; bj < 2; ++bj) {
                    const size_t off = (size_t)(row0 + ai * 128 + m * 16) * D + col0 + bj * 128;
                    const v4u s = *(const v4u*)(SGR + off), p = *(const v4u*)(mg + off);
                    const float sg[8] = {bflo(s.x), bfhi(s.x), bflo(s.y), bfhi(s.y), bflo(s.z), bfhi(s.z), bflo(s.w), bfhi(s.w)};
                    const float pp[8] = {bflo(p.x), bfhi(p.x), bflo(p.y), bfhi(p.y), bflo(p.z), bfhi(p.z), bflo(p.w), bfhi(p.w)};
                    float v[8];
#pragma unroll
                    for (int n = 0; n < 2; ++n)
#pragma unroll
                        for (int j = 0; j < 4; ++j) v[4 * n + j] = pp[4 * n + j] + sg[4 * n + j] * acc[ai][bj][m][n][j];
                    v4u w; w.x = cvt_pk_bf16(v[0], v[1]); w.y = cvt_pk_bf16(v[2], v[3]); w.z = cvt_pk_bf16(v[4], v[5]); w.w = cvt_pk_bf16(v[6], v[7]);
                    *(v4u*)(mg + off) = w;
                }
    }
};

constexpr int CTX_SPLIT = 4;
constexpr size_t WS_SLAB = WS_Q;
struct Ffn1DownOrder {
    const char* A; const char* B; int G, c;
    static constexpr int NBIG = (MX / 256) * (D / 256), NSMALL = (MC / 256) * (D / 256) * CTX_SPLIT;
    __device__ __forceinline__ bool next(int i, pg8::Unit& u) const {
        const long L = (long)i * G + c; if (L >= NBIG + NSMALL) return false;
        const size_t tstep = (size_t)256 * DFF * 2;
        int pm, pn, kind, nt; size_t koff;
        if (L < NBIG) { const int w = pg8::xcd_remap((int)L, NBIG); const int nig = 8 * 8, gid = w / nig, r = w % nig; pm = gid * 8 + (r & 7); pn = r >> 3; kind = 0; nt = DFF / 64; koff = 0; }
        else { const int w = (int)L - NBIG, sp = w & 3, t = w >> 2; pm = 32 + (t & 1); pn = t >> 1; kind = 1 + sp; nt = DFF / 64 / CTX_SPLIT; koff = (size_t)sp * (DFF / CTX_SPLIT) * 2; }
        u = pg8::make_unit(A + (size_t)pm * tstep + koff, B + (size_t)pn * tstep + koff, pm, pn, kind, nt, 0); return true;
    }
};
struct EpiFfn1Down {
    bf16* O; float* slab;
    __device__ __forceinline__ void operator()(const Acc& acc, const pg8::Unit& u, int wr, int wc, int fr0, int fq0) const {
        int fr = fr0, fq = fq0; asm volatile("" : "+v"(fr), "+v"(fq));
        const int row0 = u.pm() * 256 + wr * 64 + fr, col0 = u.pn() * 256 + wc * 32 + 8 * fq;
        if (u.kind() == 0) {
#pragma unroll
            for (int ai = 0; ai < 2; ++ai)
#pragma unroll
                for (int m = 0; m < 4; ++m) { bf16* rowp = O + (size_t)(row0 + ai * 128 + m * 16) * D + col0;
#pragma unroll
                    for (int bj = 0; bj < 2; ++bj) { const f32x4 a = acc[ai][bj][m][0], b = acc[ai][bj][m][1];
                        v4u w; w.x = cvt_pk_bf16(a[0], a[1]); w.y = cvt_pk_bf16(a[2], a[3]); w.z = cvt_pk_bf16(b[0], b[1]); w.w = cvt_pk_bf16(b[2], b[3]);
                        *(v4u*)(rowp + bj * 128) = w; } }
        } else {
            float* C = slab + (size_t)(u.kind() - 1) * MC * D - (size_t)MX * D;
#pragma unroll
            for (int ai = 0; ai < 2; ++ai)
#pragma unroll
                for (int m = 0; m < 4; ++m) { float* rowp = C + (size_t)(row0 + ai * 128 + m * 16) * D + col0;
#pragma unroll
                    for (int bj = 0; bj < 2; ++bj) { *(f32x4*)(rowp + bj * 128) = acc[ai][bj][m][0]; *(f32x4*)(rowp + bj * 128 + 4) = acc[ai][bj][m][1]; } }
        }
    }
};

enum { MK_S = 0, MK_Q = 1, MK_K = 2, MK_G = 3, MK_GS = 4, MK_GR = 5, MK_KT = 6, MK_VT = 7 };
struct EpiMix {
    unsigned char* ws;
    __device__ __forceinline__ void operator()(const Acc& acc, const pg8::Unit& u, int wr, int wc, int fr0, int fq0) const {
        int fr = fr0, fq = fq0; asm volatile("" : "+v"(fr), "+v"(fq));
        bf16* const US = (bf16*)(ws + WS_US); bf16* const Q = (bf16*)(ws + WS_Q); bf16* const QF = (bf16*)(ws + WS_QF); bf16* const QB = (bf16*)(ws + WS_QB); bf16* const KN = (bf16*)(ws + WS_K);
        bf16* const SG = (bf16*)(ws + WS_HBUF); bf16* const SGS = (bf16*)(ws + WS_HBUF + 32 * MiB); bf16* const SGR = (bf16*)(ws + WS_HBUF + 64 * MiB);
        bf16* const KFT = (bf16*)(ws + WS_KFT); bf16* const KBT = (bf16*)(ws + WS_KBT); bf16* const KFTC = (bf16*)(ws + WS_KFTC); bf16* const KBTC = (bf16*)(ws + WS_KBTC);
        bf16* const VT = (bf16*)(ws + WS_VT); bf16* const VTC = (bf16*)(ws + WS_VTC);
        const f32x2* const rope = (const f32x2*)(ws + WS_TAB + TAB_ROPE);
        const float* const lg2 = (const float*)(ws + WS_TAB + TAB_LG2);
        const int kind = u.kind();
        if (kind == MK_S) {
#pragma unroll
            for (int ai = 0; ai < 2; ++ai)
#pragma unroll
                for (int m = 0; m < 4; ++m) {
                    const int row = u.pm() * 256 + ai * 128 + wr * 64 + m * 16 + fr;
                    int b_, crow;
                    if (row < MX) { b_ = row >> 12; crow = (row & (SEQ - 1)) >> 4; } else { b_ = (row - MX) >> 8; crow = 256 + (((row - MX) & (LC - 1)) >> 4); }
                    const int s = row & 15;
#pragma unroll
                    for (int bj = 0; bj < 2; ++bj) {
                        const int ch = u.pn() * 256 + bj * 128 + wc * 32 + 8 * fq, g = ch >> 4, c0 = ch & 15;
                        const f32x4 a = acc[ai][bj][m][0], b = acc[ai][bj][m][1];
                        v4u w; w.x = cvt_pk_bf16(a[0], a[1]); w.y = cvt_pk_bf16(a[2], a[3]); w.z = cvt_pk_bf16(b[0], b[1]); w.w = cvt_pk_bf16(b[2], b[3]);
                        *(v4u*)(US + ((size_t)((b_ * 64 + g) * S5_ROWS + crow)) * 256 + s * 16 + c0) = w;
                    }
                }
        } else if (kind == MK_G || kind == MK_GS || kind == MK_GR) {
            bf16* dst = kind == MK_G ? SG : (kind == MK_GS ? SGS : SGR);
            const int row0 = u.pm() * 256 + wr * 64 + fr, col0 = u.pn() * 256 + wc * 32 + 8 * fq;
#pragma unroll
            for (int ai = 0; ai < 2; ++ai)
#pragma unroll
                for (int m = 0; m < 4; ++m)
#pragma unroll
                    for (int bj = 0; bj < 2; ++bj) {
                        float v[8];
#pragma unroll
                        for (int n = 0; n < 2; ++n)
#pragma unroll
                            for (int j = 0; j < 4; ++j) { const float x = acc[ai][bj][m][n][j]; const float s = fast_sigmoid(x); v[4 * n + j] = kind == MK_G ? x * s : s; }
                        v4u w; w.x = cvt_pk_bf16(v[0], v[1]); w.y = cvt_pk_bf16(v[2], v[3]); w.z = cvt_pk_bf16(v[4], v[5]); w.w = cvt_pk_bf16(v[6], v[7]);
                        *(v4u*)(dst + (size_t)(row0 + ai * 128 + m * 16) * D + col0 + bj * 128) = w;
                    }
        } else if (kind == MK_Q || kind == MK_K) {
            const int p = wc >> 1, i0 = 16 * (wc & 1) + 4 * fq;
            const int d0 = 64 * p + i0;
            const bool isctx = u.pm() >= 32;
            f32x4 cs0[8], cs1[8];
#pragma unroll
            for (int am = 0; am < 8; ++am) {
                const int row = u.pm() * 256 + (am >> 2) * 128 + wr * 64 + (am & 3) * 16 + fr;
                const int l = row & (SEQ - 1), pos = p ? (l & 63) : (l >> 6);
                if (!isctx) { cs0[am] = *(const f32x4*)(rope + pos * 32 + i0); cs1[am] = *(const f32x4*)(rope + pos * 32 + i0 + 2); }
                else { cs0[am] = (f32x4){1.f, 0.f, 1.f, 0.f}; cs1[am] = cs0[am]; }
            }
#pragma unroll
            for (int ai = 0; ai < 2; ++ai)
#pragma unroll
                for (int m = 0; m < 4; ++m) {
                    const int am = ai * 4 + m;
                    const int row = u.pm() * 256 + ai * 128 + wr * 64 + m * 16 + fr;
                    const int ic = row & (CH - 1);
                    const float cc[4] = {cs0[am][0], cs0[am][2], cs1[am][0], cs1[am][2]}, ss[4] = {cs0[am][1], cs0[am][3], cs1[am][1], cs1[am][3]};
#pragma unroll
                    for (int bj = 0; bj < 2; ++bj) {
                        const int head = 2 * u.pn() + bj;
                        float y1[4], y2[4];
#pragma unroll
                        for (int j = 0; j < 4; ++j) { const float x1 = acc[ai][bj][m][0][j], x2 = acc[ai][bj][m][1][j]; y1[j] = x1 * cc[j] - x2 * ss[j]; y2[j] = x1 * ss[j] + x2 * cc[j]; }
                        v2u a, b;
                        if (kind == MK_K) {
                            const float wf = __builtin_amdgcn_exp2f((float)(CH - 1 - ic) * lg2[head]), wb = __builtin_amdgcn_exp2f((float)ic * lg2[8 + head]);
                            bf16* kfp; bf16* kbp; size_t off;
                            if (!isctx) { off = (size_t)row * 1024 + head * 128 + d0; kfp = KFT; kbp = KBT;
                                a.x = cvt_pk_bf16(y1[0], y1[1]); a.y = cvt_pk_bf16(y1[2], y1[3]); b.x = cvt_pk_bf16(y2[0], y2[1]); b.y = cvt_pk_bf16(y2[2], y2[3]);
                                *(v2u*)(KN + off) = a; *(v2u*)(KN + off + 32) = b; }
                            else { off = (size_t)(row - MX) * 1024 + head * 128 + d0; kfp = KFTC; kbp = KBTC; }
                            a.x = cvt_pk_bf16(y1[0] * wf, y1[1] * wf); a.y = cvt_pk_bf16(y1[2] * wf, y1[3] * wf); b.x = cvt_pk_bf16(y2[0] * wf, y2[1] * wf); b.y = cvt_pk_bf16(y2[2] * wf, y2[3] * wf);
                            *(v2u*)(kfp + off) = a; *(v2u*)(kfp + off + 32) = b;
                            a.x = cvt_pk_bf16(y1[0] * wb, y1[1] * wb); a.y = cvt_pk_bf16(y1[2] * wb, y1[3] * wb); b.x = cvt_pk_bf16(y2[0] * wb, y2[1] * wb); b.y = cvt_pk_bf16(y2[2] * wb, y2[3] * wb);
                            *(v2u*)(kbp + off) = a; *(v2u*)(kbp + off + 32) = b;
                        } else {
                            const size_t off = (size_t)row * 1024 + head * 128 + d0;
                            const float qs = 0.08838834764831845f;
                            const float wf = qs * __builtin_amdgcn_exp2f((float)(ic + 1) * lg2[head]), wb = qs * __builtin_amdgcn_exp2f((float)(CH - ic) * lg2[8 + head]);
                            a.x = cvt_pk_bf16(y1[0] * qs, y1[1] * qs); a.y = cvt_pk_bf16(y1[2] * qs, y1[3] * qs); b.x = cvt_pk_bf16(y2[0] * qs, y2[1] * qs); b.y = cvt_pk_bf16(y2[2] * qs, y2[3] * qs);
                            *(v2u*)(Q + off) = a; *(v2u*)(Q + off + 32) = b;
                            a.x = cvt_pk_bf16(y1[0] * wf, y1[1] * wf); a.y = cvt_pk_bf16(y1[2] * wf, y1[3] * wf); b.x = cvt_pk_bf16(y2[0] * wf, y2[1] * wf); b.y = cvt_pk_bf16(y2[2] * wf, y2[3] * wf);
                            *(v2u*)(QF + off) = a; *(v2u*)(QF + off + 32) = b;
                            a.x = cvt_pk_bf16(y1[0] * wb, y1[1] * wb); a.y = cvt_pk_bf16(y1[2] * wb, y1[3] * wb); b.x = cvt_pk_bf16(y2[0] * wb, y2[1] * wb); b.y = cvt_pk_bf16(y2[2] * wb, y2[3] * wb);
                            *(v2u*)(QB + off) = a; *(v2u*)(QB + off + 32) = b;
                        }
                    }
                }
        } else if (kind == MK_VT) {
            const bool isctx = u.pn() >= 32;
#pragma unroll
            for (int ai = 0; ai < 2; ++ai)
#pragma unroll
                for (int m = 0; m < 4; ++m) {
                    const int f = u.pm() * 256 + ai * 128 + wr * 64 + m * 16 + fr;
#pragma unroll
                    for (int bj = 0; bj < 2; ++bj) {
                        const f32x4 a = acc[ai][bj][m][0], b = acc[ai][bj][m][1];
                        v4u w; w.x = cvt_pk_bf16(a[0], a[1]); w.y = cvt_pk_bf16(a[2], a[3]); w.z = cvt_pk_bf16(b[0], b[1]); w.w = cvt_pk_bf16(b[2], b[3]);
                        const int tc = bj * 128 + wc * 32 + 8 * fq;
                        if (!isctx) { const int tok = u.pn() * 256 + tc, b_ = tok >> 12, l = tok & (SEQ - 1); *(v4u*)(VT + ((size_t)(b_ * 2048 + f) * SEQ + l)) = w; }
                        else { const int b_ = u.pn() - 32; *(v4u*)(VTC + ((size_t)(b_ * 2048 + f) * LC + tc)) = w; }
                    }
                }
        }
    }
};
struct MixOrder {
    const char* U; const char* WM; int G, c;
    static constexpr int N_NORM = 32 * 36, N_CTXS = 16, N_SWAP = 8 * 34, NWG = N_NORM + N_CTXS + N_SWAP;
    __device__ __forceinline__ bool next(int i, pg8::Unit& u) const {
        const long L = (long)i * G + c; if (L >= NWG) return false;
        int w = pg8::xcd_remap((int)L, NWG);
        const size_t tstep = (size_t)256 * D * 2;
        int at, bt, pm, pn, kind;
        bool swapped = false;
        if (w < N_NORM) {
            const int nig = 8 * 36, gid = w / nig, r = w % nig, ct = r >> 3;
            pm = gid * 8 + (r & 7); at = pm;
            if (ct < 4) { bt = ct; kind = MK_S; pn = ct; } else if (ct < 8) { bt = ct; kind = MK_Q; pn = ct - 4; } else if (ct < 12) { bt = ct; kind = MK_K; pn = ct - 8; }
            else if (ct < 20) { bt = ct + 8; kind = MK_G; pn = ct - 12; } else if (ct < 28) { bt = ct + 8; kind = MK_GS; pn = ct - 20; } else { bt = ct + 8; kind = MK_GR; pn = ct - 28; }
        } else if (w < N_NORM + N_CTXS) {
            w -= N_NORM; pm = 32 + (w & 1); at = pm; const int ct = w >> 1;
            if (ct < 4) { bt = ct; pn = ct; kind = MK_S; } else { bt = ct + 4; pn = ct - 4; kind = MK_K; }
        } else {
            w -= N_NORM + N_CTXS; swapped = true;
            const int tt = w >> 3, ft = w & 7;
            bt = tt; pn = tt; at = 12 + ft; pm = ft; kind = MK_VT;
        }
        const char* abase = swapped ? WM : U; const char* bbase = swapped ? U : WM;
        u = pg8::make_unit(abase + (size_t)at * tstep, bbase + (size_t)bt * tstep, pm, pn, kind, D / 64, 0);
        return true;
    }
};

constexpr int RING_BYTES = 131072, LDSCTL_OFF = 143360, MISC_OFF = LDSCTL_OFF + 320, LDS_BYTES = 147456;
struct Args { const float* in[22]; float* out; unsigned char* ws; };
struct Frame {
    LAS unsigned char* lds; volatile LAS unsigned* MISC; unsigned* ctl;
    int wave, vcu, G;
    float* out; unsigned char* ws;
};
typedef const Args __attribute__((address_space(4)))* KArgsPtr;
__device__ __forceinline__ KArgsPtr kargs() { KArgsPtr p = (KArgsPtr)__builtin_amdgcn_kernarg_segment_ptr(); asm volatile("" : "+s"(p)); return p; }
#define FIN(k) ((const float*)kargs()->in[k])

__device__ __forceinline__ int map_pair(int n, int half) { const int h = n < half ? n : n - half, up = n >= half; return 256 * (h >> 7) + 128 * up + (h & 127); }
__device__ __forceinline__ int map_mix(int n) {
    if (n < 1024 || n >= 3072) return n;
    const int base = n & ~127, d = n & 127, p = d >> 6, e = d & 63, s = e >> 5, i = e & 31, t = 32 * p + i;
    return base + 32 * (t >> 4) + 8 * ((t >> 2) & 3) + 4 * s + (t & 3);
}
template <int MAPID>
__device__ __forceinline__ void transpose_item(const float* W, int ldw, int K, int nblk, bf16* WT, int row_off, int half, LAS float* scr, int item, int lane) {
    const int kb = item / nblk, nb = item % nblk, k0 = 64 * kb, n0 = 32 * nb;
#pragma unroll 8
    for (int i = 0; i < 32; ++i) { const int kk = 2 * i + (lane >> 5); scr[kk * 33 + (lane & 31)] = W[(size_t)(k0 + kk) * ldw + n0 + (lane & 31)]; }
    LDS_WAIT(); asm volatile("" ::: "memory");
    const int c = lane & 7;
#pragma unroll
    for (int j = 0; j < 4; ++j) { const int n = (lane >> 3) + 8 * j; const LAS float* s = scr + (8 * c) * 33 + n;
        v4u o; o.x = pk2(s[0 * 33], s[1 * 33]); o.y = pk2(s[2 * 33], s[3 * 33]); o.z = pk2(s[4 * 33], s[5 * 33]); o.w = pk2(s[6 * 33], s[7 * 33]);
        const int nn = n0 + n; const int dr = MAPID == 0 ? nn : (MAPID == 1 ? map_pair(nn, half) : map_mix(nn));
        *(v4u*)(WT + (size_t)(row_off + dr) * K + k0 + 8 * c) = o; }
    LDS_WAIT(); asm volatile("" ::: "memory");
}
__device__ __forceinline__ void sincos_d(double x, double& s, double& c) {
    const double TWO_PI = 6.283185307179586476925286766559;
    x -= TWO_PI * __builtin_rint(x / TWO_PI);
    const double h = 0.125 * x, h2 = h * h;
    double sn = h * (1.0 + h2 * (-1.0 / 6 + h2 * (1.0 / 120 + h2 * (-1.0 / 5040 + h2 * (1.0 / 362880 + h2 * (-1.0 / 39916800 + h2 * (1.0 / 6227020800.0)))))));
    double cs = 1.0 + h2 * (-0.5 + h2 * (1.0 / 24 + h2 * (-1.0 / 720 + h2 * (1.0 / 40320 + h2 * (-1.0 / 3628800 + h2 * (1.0 / 479001600.0 + h2 * (-1.0 / 87178291200.0)))))));
#pragma unroll
    for (int k = 0; k < 3; ++k) { const double s2 = 2.0 * sn * cs, c2 = 1.0 - 2.0 * sn * sn; sn = s2; cs = c2; }
    s = sn; c = cs;
}
__device__ __forceinline__ double exp_d(double x) {
    const double y = x * (1.0 / 4096.0);
    double e = 1.0 + y * (1.0 + y * (0.5 + y * (1.0 / 6 + y * (1.0 / 24 + y * (1.0 / 120 + y * (1.0 / 720))))));
#pragma unroll
    for (int k = 0; k < 12; ++k) e = e * e;
    return e;
}
__device__ __forceinline__ double log1p_small_d(double z) {
    const double t = z / (2.0 + z), t2 = t * t;
    return 2.0 * t * (1.0 + t2 * (1.0 / 3 + t2 * (1.0 / 5 + t2 * (1.0 / 7 + t2 * (1.0 / 9 + t2 * (1.0 / 11))))));
}

__device__ __forceinline__ void phase_prologue(Frame& F0, const Args& args, const bool do_ada) {
    Frame& F = F0; int lane_ = lane_id(); asm volatile("" : "+v"(lane_));
    LAS float* scr = (LAS float*)(F.lds + F.wave * 16384);
    const int gw = F.vcu * NWAVES + F.wave, NGW = F.G * NWAVES;
    unsigned char* ws = F.ws;
    {
        const int gt = gw * 64 + lane_, NT = NGW * 64;
        unsigned char* tab = ws + WS_TAB;
        for (int idx = gt; idx < 2048; idx += NT) {
            const int pos = idx >> 5, i = idx & 31;
            const double inv = exp_d(-(double)i * (9.210340371976182736 / 32.0));
            double s, c; sincos_d((double)pos * inv, s, c);
            ((f32x2*)(tab + TAB_ROPE))[idx] = (f32x2){(float)c, (float)s};
        }
        for (int idx = gt; idx < 16; idx += NT) {
            const double x = (double)FIN(19)[idx];
            ((float*)(tab + TAB_LG2))[idx] = (float)(-log1p_small_d(exp_d(-x)) * 1.4426950408889634074);
        }
        for (int idx = gt; idx < 2 * 64 * 64; idx += NT) {
            const int dg = idx >> 6, p = idx & 63;
            const double lr = (double)FIN(10)[idx], li = (double)FIN(11)[idx], step = exp_d((double)FIN(12)[dg]);
            const double mag = exp_d(lr * step); double sn, cs; sincos_d(li * step, sn, cs);
            const double ar = mag * cs, ai = mag * sn, den = lr * lr + li * li, nr = ar - 1.0, ni = ai;
            const double kr = (nr * lr + ni * li) / den, ki = (ni * lr - nr * li) / den;
            ((float*)(tab + TAB_AR))[idx] = (float)ar; ((float*)(tab + TAB_AI))[idx] = (float)ai;
            float* brf = (float*)(ws + WS_S5BRF) + (size_t)idx * 32;
            const float* bre = FIN(13) + (size_t)idx * 16; const float* bim = FIN(14) + (size_t)idx * 16;
            for (int c = 0; c < 16; ++c) { const double br = (double)bre[c], bi = (double)bim[c];
                brf[2 * c] = (float)(kr * br - ki * bi); brf[2 * c + 1] = (float)(kr * bi + ki * br); }
        }
    }
    if (do_ada) {
        float* ADA = (float*)(ws + WS_CTL + CTL_ADA);
        const float* aw = FIN(4);
        for (int it = gw; it < 16 * 72; it += NGW) {
            const int kc = it / 72, cb = it % 72, k0 = kc * 128, col = cb * 256 + 4 * lane_;
            for (int i = lane_; i < 384; i += 64) { const int v = i >> 7, k = i & 127; const float x = v == 0 ? FIN(1)[k0 + k] : (v == 1 ? FIN(1)[D + k0 + k] : FIN(3)[k0 + k]); scr[i] = x / (1.0f + __expf(-x)); }
            LDS_WAIT(); asm volatile("" ::: "memory");
            f32x4 a0 = {0.f, 0.f, 0.f, 0.f}, a1 = a0, a2 = a0;
#pragma unroll 8
            for (int k = 0; k < 128; ++k) { const f32x4 w = *(const f32x4*)(aw + (size_t)(k0 + k) * NADA + col); a0 += w * scr[k]; a1 += w * scr[128 + k]; a2 += w * scr[256 + k]; }
#pragma unroll
            for (int j = 0; j < 4; ++j) { __hip_atomic_fetch_add(ADA + col + j, a0[j], RLX_AGENT); __hip_atomic_fetch_add(ADA + NADA + col + j, a1[j], RLX_AGENT); __hip_atomic_fetch_add(ADA + 2 * NADA + col + j, a2[j], RLX_AGENT); }
            LDS_WAIT(); asm volatile("" ::: "memory");
        }
    }
    {
        constexpr int I1 = (D / 64) * (NFF / 32), I2 = (DFF / 64) * (D / 32), IM = (D / 64) * (NMIX / 32), IK = (D / 64) * (1024 / 32), IG = (SW / 64) * (2 * D / 32), IP = (D / 64) * (D / 32);
        constexpr int NITEMS = 2 * I1 + 2 * I2 + IM + IG + 2 * IP;
        for (int it = gw; it < NITEMS; it += NGW) {
            int r = it;
            if (r < I2) { transpose_item<0>(FIN(8) + (size_t)DFF * D, D, DFF, D / 32, (bf16*)(ws + WS_W4T), 0, 0, scr, r, lane_); continue; } r -= I2;
            if (r < I1) { transpose_item<1>(FIN(7) + (size_t)D * NFF, NFF, D, NFF / 32, (bf16*)(ws + WS_W3T), 0, DFF, scr, r, lane_); continue; } r -= I1;
            if (r < IP) { transpose_item<0>(FIN(21), D, D, D / 32, (bf16*)(ws + WS_WOT), 0, 0, scr, r, lane_); continue; } r -= IP;
            if (r < IP) { transpose_item<0>(FIN(20), D, D, D / 32, (bf16*)(ws + WS_WPT), 0, 0, scr, r, lane_); continue; } r -= IP;
            if (r < IG) { transpose_item<1>(FIN(18), 2 * D, SW, 2 * D / 32, (bf16*)(ws + WS_WGT), 0, D, scr, r, lane_); continue; } r -= IG;
            if (r < IM) { transpose_item<2>(FIN(9), NMIX, D, NMIX / 32, (bf16*)(ws + WS_WMT), 0, 0, scr, r, lane_); continue; } r -= IM;
            if (r < I2) { transpose_item<0>(FIN(8), D, DFF, D / 32, (bf16*)(ws + WS_W2T), 0, 0, scr, r, lane_); continue; } r -= I2;
            transpose_item<1>(FIN(7), NFF, D, NFF / 32, (bf16*)(ws + WS_W1T), 0, DFF, scr, r, lane_);
        }
    }
}

template <int MODE>
__device__ __forceinline__ void phase_rows(Frame& F0, const Args& args) {
    Frame& F = F0; int lane_ = lane_id(); asm volatile("" : "+v"(lane_));
    const int gw = F.vcu * NWAVES + F.wave, NGW = F.G * NWAVES;
    const float* ADA = (const float*)(F.ws + WS_CTL + CTL_ADA);
    const float* adab = FIN(5); const float* ng = FIN(6);
    const bf16* O = (const bf16*)(F.ws + WS_OBUF);
    bf16* A = (bf16*)(F.ws + WS_ABUF);
    const int nrows = (MODE <= 1) ? MT : MX;
    for (int r = gw; r < nrows; r += NGW) {
        const int av = r < MX ? (r >> 12) : 2;
        const float* ada = ADA + (size_t)av * NADA;
        f32x4 h[8];
        const float* hsrc = (MODE <= 1) ? (r < MX ? FIN(0) + (size_t)r * D : FIN(2) + (size_t)(r - MX) * D) : F.out + (size_t)r * D;
#pragma unroll
        for (int j = 0; j < 8; ++j) h[j] = *(const f32x4*)(hsrc + 256 * j + 4 * lane_);
        if (MODE >= 1) {
            constexpr int ipost = MODE - 1;
            const float resw = (MODE == 2) ? 1.0f : 0.5f;
            f32x4 o[8]; float ss = 0.f;
#pragma unroll
            for (int j = 0; j < 8; ++j) {
                if (MODE == 1 && r >= MX) { const float* sl = (const float*)(F.ws + WS_SLAB) + (size_t)(r - MX) * D + 256 * j + 4 * lane_; f32x4 a = *(const f32x4*)sl;
#pragma unroll
                    for (int s = 1; s < CTX_SPLIT; ++s) a += *(const f32x4*)(sl + (size_t)s * MC * D);
                    o[j] = a; }
                else { const v2u t = *(const v2u*)(O + (size_t)r * D + 256 * j + 4 * lane_); o[j] = (f32x4){bflo(t.x), bfhi(t.x), bflo(t.y), bfhi(t.y)}; }
                ss += (o[j][0] * o[j][0] + o[j][1] * o[j][1]) + (o[j][2] * o[j][2] + o[j][3] * o[j][3]); }
            const float rstd = 1.0f / sqrtf(wave_sum(ss, lane_) * (1.0f / D) + EPS);
#pragma unroll
            for (int j = 0; j < 8; ++j) { const int c = 256 * j + 4 * lane_;
                const f32x4 gate = *(const f32x4*)(ada + (3 * ipost + 2) * D + c) + *(const f32x4*)(adab + (3 * ipost + 2) * D + c);
                const f32x4 g = *(const f32x4*)(ng + (2 * ipost + 1) * D + c);
                h[j] = h[j] + (resw * rstd) * (gate * (o[j] * g)); }
            if (r < MX) {
#pragma unroll
                for (int j = 0; j < 8; ++j) *(f32x4*)(F.out + (size_t)r * D + 256 * j + 4 * lane_) = h[j];
            }
        }
        if (MODE <= 2) {
            constexpr int ipre = MODE;
            float ss = 0.f;
#pragma unroll
            for (int j = 0; j < 8; ++j) ss += (h[j][0] * h[j][0] + h[j][1] * h[j][1]) + (h[j][2] * h[j][2] + h[j][3] * h[j][3]);
            const float rstd = 1.0f / sqrtf(wave_sum(ss, lane_) * (1.0f / D) + EPS);
#pragma unroll
            for (int j = 0; j < 8; ++j) { const int c = 256 * j + 4 * lane_;
                const f32x4 shift = *(const f32x4*)(ada + (3 * ipre) * D + c) + *(const f32x4*)(adab + (3 * ipre) * D + c);
                const f32x4 scale = *(const f32x4*)(ada + (3 * ipre + 1) * D + c) + *(const f32x4*)(adab + (3 * ipre + 1) * D + c);
                const f32x4 g = *(const f32x4*)(ng + (2 * ipre) * D + c);
                const f32x4 v = (h[j] * rstd) * g * (scale + 1.0f) + shift;
                v2u w; w.x = cvt_pk_bf16(v[0], v[1]); w.y = cvt_pk_bf16(v[2], v[3]);
                *(v2u*)(A + (size_t)r * D + c) = w; }
        }
    }
}

__device__ __forceinline__ void cpow_f(float ar, float ai, int k, float& pr, float& pi) {
    float rr = 1.f, ri = 0.f, br = ar, bi = ai;
#pragma unroll
    for (int bit = 0; bit < 5; ++bit) { if (k & (1 << bit)) { const float t = rr * br - ri * bi; ri = rr * bi + ri * br; rr = t; } const float t2 = br * br - bi * bi; bi = 2.f * br * bi; br = t2; }
    pr = rr; pi = ri;
}
__device__ __forceinline__ void s5_tables1(Frame& F, const Args& args) {
    int lane_ = lane_id(); asm volatile("" : "+v"(lane_));
    const int gt = (F.vcu * NWAVES + F.wave) * 64 + lane_, NT = F.G * NWAVES * 64;
    const float* AR = (const float*)(F.ws + WS_TAB + TAB_AR); const float* AI = (const float*)(F.ws + WS_TAB + TAB_AI);
    const float* BRF = (const float*)(F.ws + WS_S5BRF);
    const float* cre = FIN(15); const float* cim = FIN(16);
    float* KT = (float*)(F.ws + WS_S5KT); bf16* WE = (bf16*)(F.ws + WS_S5WE); bf16* WY2 = (bf16*)(F.ws + WS_S5WY2);
    for (int idx = gt; idx < 64 * 2 * 16 * 16; idx += NT) {
        const int c = idx & 15, k = (idx >> 4) & 15, dir = (idx >> 8) & 1, g = idx >> 9, dg = dir * 64 + g;
        float acc[16];
#pragma unroll
        for (int j = 0; j < 16; ++j) acc[j] = 0.f;
        for (int p = 0; p < 64; ++p) {
            float pr, pi; cpow_f(AR[dg * 64 + p], AI[dg * 64 + p], k, pr, pi);
            const float Cr = cre[(dg * 16 + c) * 64 + p], Ci = cim[(dg * 16 + c) * 64 + p], Gr = Cr * pr - Ci * pi, Gi = Cr * pi + Ci * pr;
            const f32x4* b4 = (const f32x4*)(BRF + (size_t)(dg * 64 + p) * 32);
#pragma unroll
            for (int j = 0; j < 8; ++j) { const f32x4 v = b4[j]; acc[2 * j] += Gr * v[0] - Gi * v[1]; acc[2 * j + 1] += Gr * v[2] - Gi * v[3]; }
        }
        float* o = KT + ((size_t)((g * 2 + dir) * 16 + k) * 16 + c) * 16;
#pragma unroll
        for (int j = 0; j < 4; ++j) *(f32x4*)(o + 4 * j) = (f32x4){acc[4 * j], acc[4 * j + 1], acc[4 * j + 2], acc[4 * j + 3]};
    }
    for (int idx = gt; idx < 64 * 256 * 16; idx += NT) {
        const int s = idx & 15, r = (idx >> 4) & 255, g = idx >> 12, dir = r >> 7, part = (r >> 6) & 1, p = r & 63, dg = dir * 64 + g;
        float pr, pi; cpow_f(AR[dg * 64 + p], AI[dg * 64 + p], dir ? s : 15 - s, pr, pi);
        const f32x4* b4 = (const f32x4*)(BRF + (size_t)(dg * 64 + p) * 32);
        float v[16];
#pragma unroll
        for (int j = 0; j < 8; ++j) { const f32x4 q = b4[j]; v[2 * j] = part ? (pr * q[1] + pi * q[0]) : (pr * q[0] - pi * q[1]); v[2 * j + 1] = part ? (pr * q[3] + pi * q[2]) : (pr * q[2] - pi * q[3]); }
        bf16* o = WE + ((size_t)(g * 256 + r)) * 256 + s * 16;
        v4u w0, w1; w0.x = pk2(v[0], v[1]); w0.y = pk2(v[2], v[3]); w0.z = pk2(v[4], v[5]); w0.w = pk2(v[6], v[7]); w1.x = pk2(v[8], v[9]); w1.y = pk2(v[10], v[11]); w1.z = pk2(v[12], v[13]); w1.w = pk2(v[14], v[15]);
        *(v4u*)o = w0; *(v4u*)(o + 8) = w1;
    }
    for (int idx = gt; idx < 64 * 256 * 32; idx += NT) {
        const int cb = idx & 31, row = (idx >> 5) & 255, g = idx >> 13, t = row >> 4, c = row & 15, col0 = 8 * cb, dir = col0 >> 7, part = (col0 >> 6) & 1, p0 = col0 & 63, dg = dir * 64 + g;
        float v[8];
#pragma unroll
        for (int j = 0; j < 8; ++j) { const int p = p0 + j; float pr, pi; cpow_f(AR[dg * 64 + p], AI[dg * 64 + p], dir ? 16 - t : t + 1, pr, pi);
            const float Cr = cre[(dg * 16 + c) * 64 + p], Ci = cim[(dg * 16 + c) * 64 + p]; v[j] = part ? -(Cr * pi + Ci * pr) : (Cr * pr - Ci * pi); }
        v4u w; w.x = pk2(v[0], v[1]); w.y = pk2(v[2], v[3]); w.z = pk2(v[4], v[5]); w.w = pk2(v[6], v[7]);
        *(v4u*)(WY2 + ((size_t)(g * 256 + row)) * 256 + col0) = w;
    }
}
__device__ __forceinline__ void s5_tables2(Frame& F, const Args& args) {
    int lane_ = lane_id(); asm volatile("" : "+v"(lane_));
    const int gt = (F.vcu * NWAVES + F.wave) * 64 + lane_, NT = F.G * NWAVES * 64;
    const float* KT = (const float*)(F.ws + WS_S5KT); bf16* WY1 = (bf16*)(F.ws + WS_S5WY1); const float* dskip = FIN(17);
    for (int idx = gt; idx < 64 * 256 * 16; idx += NT) {
        const int s = idx & 15, row = (idx >> 4) & 255, g = idx >> 12, t = row >> 4, c = row & 15;
        float v[16];
#pragma unroll
        for (int j = 0; j < 16; ++j) v[j] = 0.f;
        if (s <= t) { const f32x4* k4 = (const f32x4*)(KT + ((size_t)((g * 2 + 0) * 16 + (t - s)) * 16 + c) * 16);
#pragma unroll
            for (int j = 0; j < 4; ++j) { const f32x4 q = k4[j]; v[4 * j] += q[0]; v[4 * j + 1] += q[1]; v[4 * j + 2] += q[2]; v[4 * j + 3] += q[3]; } }
        if (s >= t) { const f32x4* k4 = (const f32x4*)(KT + ((size_t)((g * 2 + 1) * 16 + (s - t)) * 16 + c) * 16);
#pragma unroll
            for (int j = 0; j < 4; ++j) { const f32x4 q = k4[j]; v[4 * j] += q[0]; v[4 * j + 1] += q[1]; v[4 * j + 2] += q[2]; v[4 * j + 3] += q[3]; } }
        if (s == t) { const float dk = dskip[16 * g + c];
#pragma unroll
            for (int j = 0; j < 16; ++j) v[j] += (j == c) ? dk : 0.f; }
        bf16* o = WY1 + ((size_t)(g * 256 + row)) * 256 + s * 16;
        v4u w0, w1; w0.x = pk2(v[0], v[1]); w0.y = pk2(v[2], v[3]); w0.z = pk2(v[4], v[5]); w0.w = pk2(v[6], v[7]); w1.x = pk2(v[8], v[9]); w1.y = pk2(v[10], v[11]); w1.z = pk2(v[12], v[13]); w1.w = pk2(v[14], v[15]);
        *(v4u*)o = w0; *(v4u*)(o + 8) = w1;
    }
}
struct S5EOrder {
    const char* ZU; const char* WE; int G, c;
    __device__ __forceinline__ bool next(int i, pg8::Unit& u) const {
        const long L = (long)i * G + c; if (L >= 256) return false;
        const int bg = (int)L >> 1, rt = (int)L & 1, g = bg & 63;
        u = pg8::make_unit(ZU + ((size_t)(bg * S5_ROWS + 256 * rt)) * 512, WE + (size_t)g * 256 * 512, bg, rt, 0, 4, 0); return true;
    }
};
struct EpiS5E {
    bf16* E;
    __device__ __forceinline__ void operator()(const Acc& acc, const pg8::Unit& u, int wr, int wc, int fr0, int fq0) const {
        int fr = fr0, fq = fq0; asm volatile("" : "+v"(fr), "+v"(fq));
#pragma unroll
        for (int ai = 0; ai < 2; ++ai)
#pragma unroll
            for (int m = 0; m < 4; ++m) {
                const int crow = 256 * u.pn() + ai * 128 + wr * 64 + m * 16 + fr;
                if (crow < S5_ROWS) {
#pragma unroll
                    for (int bj = 0; bj < 2; ++bj) {
                        const f32x4 a = acc[ai][bj][m][0], b = acc[ai][bj][m][1];
                        v4u w; w.x = cvt_pk_bf16(a[0], a[1]); w.y = cvt_pk_bf16(a[2], a[3]); w.z = cvt_pk_bf16(b[0], b[1]); w.w = cvt_pk_bf16(b[2], b[3]);
                        *(v4u*)(E + ((size_t)(u.pm() * S5_ROWS + crow)) * 256 + bj * 128 + wc * 32 + 8 * fq) = w;
                    }
                }
            }
    }
};
struct S5YOrder {
    const char* ZU; const char* ZH; const char* WY1; const char* WY2; int G, c;
    __device__ __forceinline__ bool next(int i, pg8::Unit& u) const {
        const int bg = (i >> 1) * G + c, seg = i & 1; if (bg >= NB * 64) return false;
        const int g = bg & 63;
        const char* a = seg == 0 ? ZU + ((size_t)(bg * S5_ROWS)) * 512 : ZH + ((size_t)(bg * 256)) * 512;
        const char* b = (seg == 0 ? WY1 : WY2) + (size_t)g * 256 * 512;
        u = pg8::make_unit(a, b, bg, 0, 0, 4, seg == 0 ? 1 : 0); return true;
    }
};
struct EpiS5Y {
    bf16* AGLU;
    __device__ __forceinline__ void operator()(const Acc& acc, const pg8::Unit& u, int wr, int wc, int fr0, int fq0) const {
        int fr = fr0, fq = fq0; asm volatile("" : "+v"(fr), "+v"(fq));
        const int b_ = u.pm() >> 6, g = u.pm() & 63;
#pragma unroll
        for (int ai = 0; ai < 2; ++ai)
#pragma unroll
            for (int m = 0; m < 4; ++m) {
                const int chunk = ai * 128 + wr * 64 + m * 16 + fr;
#pragma unroll
                for (int bj = 0; bj < 2; ++bj) {
                    const int cc = bj * 128 + wc * 32 + 8 * fq, t = cc >> 4, c0 = cc & 15;
                    const f32x4 a = acc[ai][bj][m][0], b = acc[ai][bj][m][1];
                    v4u w; w.x = cvt_pk_bf16(gelu_tanh(a[0]), gelu_tanh(a[1])); w.y = cvt_pk_bf16(gelu_tanh(a[2]), gelu_tanh(a[3])); w.z = cvt_pk_bf16(gelu_tanh(b[0]), gelu_tanh(b[1])); w.w = cvt_pk_bf16(gelu_tanh(b[2]), gelu_tanh(b[3]));
                    *(v4u*)(AGLU + ((size_t)(b_ * SEQ + chunk * 16 + t)) * SW + 16 * g + c0) = w;
                }
            }
    }
};
__device__ __forceinline__ void s5_scan_unit(Frame& F, int bg, int dir, int tid) {
    const bf16* E = (const bf16*)(F.ws + WS_S5E); bf16* ZH = (bf16*)(F.ws + WS_S5ZH);
    LAS bf16* EL = (LAS bf16*)F.lds;
    for (int i = tid; i < S5_ROWS * 16; i += NWAVES * 64) { const int row = i >> 4, ck = i & 15; *(LAS v4u*)(EL + row * 128 + ck * 8) = *(const v4u*)(E + ((size_t)(bg * S5_ROWS + row)) * 256 + dir * 128 + ck * 8); }
    __syncthreads();
    if (tid < 64) {
        const int p = tid, g = bg & 63;
        float ar = ((const float*)(F.ws + WS_TAB + TAB_AR))[(dir * 64 + g) * 64 + p], ai = ((const float*)(F.ws + WS_TAB + TAB_AI))[(dir * 64 + g) * 64 + p];
#pragma unroll
        for (int k = 0; k < 4; ++k) { const float nr = ar * ar - ai * ai, ni = 2.f * ar * ai; ar = nr; ai = ni; }
        float hr = 0.f, hi = 0.f;
#pragma unroll 8
        for (int k = 0; k < S5_ROWS; ++k) {
            const int row = dir ? (S5_ROWS - 1 - k) : (k < 16 ? 256 + k : k - 16);
            const float er = bflo((unsigned)EL[row * 128 + p]), ei = bflo((unsigned)EL[row * 128 + 64 + p]);
            EL[row * 128 + p] = (bf16)f2bf(hr); EL[row * 128 + 64 + p] = (bf16)f2bf(hi);
            const float nr = ar * hr - ai * hi + er, ni = ar * hi + ai * hr + ei; hr = nr; hi = ni;
        }
    }
    __syncthreads();
    for (int i = tid; i < 256 * 16; i += NWAVES * 64) { const int row = i >> 4, ck = i & 15; *(v4u*)(ZH + ((size_t)(bg * 256 + row)) * 256 + dir * 128 + ck * 8) = *(const LAS v4u*)(EL + row * 128 + ck * 8); }
    __syncthreads();
}

constexpr int RS_PITCH = 136;
constexpr int RS_BUF = (128 + 32) * RS_PITCH * 2;
__device__ __forceinline__ void phase_rstate(Frame& F) {
    const bf16* KFT = (const bf16*)(F.ws + WS_KFT); const bf16* KBT = (const bf16*)(F.ws + WS_KBT);
    const bf16* KFTC = (const bf16*)(F.ws + WS_KFTC); const bf16* KBTC = (const bf16*)(F.ws + WS_KBTC);
    const bf16* VT = (const bf16*)(F.ws + WS_VT); const bf16* VTC = (const bf16*)(F.ws + WS_VTC);
    bf16* SIN = (bf16*)(F.ws + WS_OBUF);
    const float* lg2 = (const float*)(F.ws + WS_TAB + TAB_LG2);
    const int lane0 = lane_id();
    const int w = F.wave;
    for (int unit = F.vcu; unit < NB * NH * 2 * 8; unit += F.G) {
        int lane = lane0; asm volatile("" : "+v"(lane));
        const int tid = w * 64 + lane, fr = lane & 15, fq = lane >> 4;
        const int sl = unit & 7, dir = (unit >> 3) & 1, h = (unit >> 4) & 7, b = unit >> 7;
        const float gC = __builtin_amdgcn_exp2f((float)CH * lg2[dir * 8 + h]);
        const int bh = b * NH + h;
        const bf16* kT = dir ? KBT : KFT; const bf16* kTc = dir ? KBTC : KFTC;
        const int prow = tid >> 4, pc = tid & 15;
        f32x4 st[2] = {{0.f, 0.f, 0.f, 0.f}, {0.f, 0.f, 0.f, 0.f}};
#define RS_ISSUE(k, R) do { if ((k) < 34) { const bf16* kb_; const bf16* vb_; int ls_; \
            if ((k) < 2) { const int cc_ = dir ? (1 - (k)) : (k); ls_ = LC; kb_ = kTc + (size_t)(b * LC + cc_ * CH) * 1024 + h * DK; vb_ = VTC + (size_t)(bh * DV + 32 * sl) * LC + cc_ * CH; } \
            else { const int n_ = dir ? (33 - (k)) : ((k) - 2); ls_ = SEQ; kb_ = kT + (size_t)(b * SEQ + n_ * CH) * 1024 + h * DK; vb_ = VT + (size_t)(bh * DV + 32 * sl) * SEQ + n_ * CH; } \
            _Pragma("unroll") for (int i_ = 0; i_ < 4; ++i_) R[i_] = *(const v4u*)(kb_ + (size_t)(prow + 32 * i_) * 1024 + pc * 8);     \
            R[4] = *(const v4u*)(vb_ + (size_t)prow * ls_ + pc * 8); } } while (0)
#define RS_STEP(k, R) do { LAS bf16* buf_ = (LAS bf16*)(F.lds + ((k) & 1) * RS_BUF); \
            _Pragma("unroll") for (int i_ = 0; i_ < 4; ++i_) *(LAS v4u*)(buf_ + (prow + 32 * i_) * RS_PITCH + pc * 8) = R[i_]; \
            *(LAS v4u*)(buf_ + (128 + prow) * RS_PITCH + pc * 8) = R[4]; } while (0)
#define RS_COMP(k) do { const LAS bf16* buf_ = (const LAS bf16*)(F.lds + ((k) & 1) * RS_BUF); \
            const int n_ = (k) < 2 ? -1 : (dir ? (33 - (k)) : ((k) - 2)); \
            if (n_ >= 0) { _Pragma("unroll") for (int et = 0; et < 2; ++et) { v2u o; o.x = cvt_pk_bf16(st[et][0], st[et][1]); o.y = cvt_pk_bf16(st[et][2], st[et][3]); \
                *(v2u*)(SIN + ((((size_t)(bh * 2 + dir) * NCH + n_) * DV + 32 * sl + 16 * et + fr) * DK + 16 * w + 4 * fq)) = o; } } \
            bf16x8 kf_[4];                         \
            { const unsigned ta_ = (unsigned)(size_t)buf_ + (unsigned)((8 * fq + (fr >> 2)) * (RS_PITCH * 2) + (16 * w + 4 * (fr & 3)) * 2); v2u t0_, t1_, t2_, t3_, t4_, t5_, t6_, t7_; \
              asm volatile("ds_read_b64_tr_b16 %0, %8\n\tds_read_b64_tr_b16 %1, %8 offset:1088\n\tds_read_b64_tr_b16 %2, %8 offset:8704\n\tds_read_b64_tr_b16 %3, %8 offset:9792\n\t" \
                           "ds_read_b64_tr_b16 %4, %8 offset:17408\n\tds_read_b64_tr_b16 %5, %8 offset:18496\n\tds_read_b64_tr_b16 %6, %8 offset:26112\n\tds_read_b64_tr_b16 %7, %8 offset:27200\n\ts_waitcnt lgkmcnt(0)" \
                           : "=&v"(t0_), "=&v"(t1_), "=&v"(t2_), "=&v"(t3_), "=&v"(t4_), "=&v"(t5_), "=&v"(t6_), "=&v"(t7_) : "v"(ta_) : "memory"); \
              kf_[0] = __builtin_bit_cast(bf16x8, (v4u){t0_.x, t0_.y, t1_.x, t1_.y}); kf_[1] = __builtin_bit_cast(bf16x8, (v4u){t2_.x, t2_.y, t3_.x, t3_.y}); \
              kf_[2] = __builtin_bit_cast(bf16x8, (v4u){t4_.x, t4_.y, t5_.x, t5_.y}); kf_[3] = __builtin_bit_cast(bf16x8, (v4u){t6_.x, t6_.y, t7_.x, t7_.y}); } \
            _Pragma("unroll") for (int et = 0; et < 2; ++et) { f32x4 kv = {0.f, 0.f, 0.f, 0.f}; \
                _Pragma("unroll") for (int ks = 0; ks < 4; ++ks) { const bf16x8 vf_ = *(const LAS bf16x8*)(buf_ + (128 + 16 * et + fr) * RS_PITCH + 32 * ks + 8 * fq); kv = __builtin_amdgcn_mfma_f32_16x16x32_bf16(kf_[ks], vf_, kv, 0, 0, 0); } \
                st[et] = st[et] * gC + kv; } } while (0)
        v4u RA[5], RB[5], RC[5];
        RS_ISSUE(0, RA); RS_ISSUE(1, RB);
        for (int k = 0; k < 34; k += 3) {
            RS_ISSUE(k + 2, RC);
            RS_STEP(k, RA); __syncthreads(); RS_COMP(k);
            RS_ISSUE(k + 3, RA);
            if (k + 1 < 34) { RS_STEP(k + 1, RB); __syncthreads(); RS_COMP(k + 1); }
            RS_ISSUE(k + 4, RB);
            if (k + 2 < 34) { RS_STEP(k + 2, RC); __syncthreads(); RS_COMP(k + 2); }
        }
        __syncthreads();
#undef RS_ISSUE
#undef RS_STEP
#undef RS_COMP
    }
}

constexpr int RO_PITCH = 136;
constexpr int RO_SLOT = 256 * RO_PITCH * 2;
__device__ __forceinline__ void phase_rout(Frame& F) {
    const bf16* Q = (const bf16*)(F.ws + WS_Q); const bf16* QF = (const bf16*)(F.ws + WS_QF); const bf16* QB = (const bf16*)(F.ws + WS_QB);
    const bf16* KN = (const bf16*)(F.ws + WS_K); const bf16* VT = (const bf16*)(F.ws + WS_VT);
    const bf16* SIN = (const bf16*)(F.ws + WS_OBUF);
    bf16* SG = (bf16*)(F.ws + WS_HBUF);
    const float* lg2 = (const float*)(F.ws + WS_TAB + TAB_LG2);
    LAS bf16* SA = (LAS bf16*)F.lds; LAS bf16* SB = (LAS bf16*)(F.lds + RO_SLOT);
    const int lane0 = lane_id();
    const int w = F.wave;
    for (int unit = F.vcu; unit < NB * NH * NCH; unit += F.G) {
        int lane = lane0; asm volatile("" : "+v"(lane));
        const int tid = w * 64 + lane, fr = lane & 15, fq = lane >> 4;
        const int n = unit & 31, h = (unit >> 5) & 7, b = unit >> 8, bh = b * NH + h;
        const float lgf = lg2[h], lgb = lg2[8 + h];
        const int tok0 = b * SEQ + n * CH;
        const int i = 16 * w + fr;
        const size_t qoff = (size_t)(tok0 + i) * 1024 + h * DK;
        {
            v4u kr[4], vr[8];
#pragma unroll
            for (int it = 0; it < 4; ++it) { const int q = tid + 512 * it, j = q >> 4, pc = q & 15; kr[it] = *(const v4u*)(KN + (size_t)(tok0 + j) * 1024 + h * DK + pc * 8); }
#pragma unroll
            for (int it = 0; it < 8; ++it) { const int q = tid + 512 * it, e = q >> 4, pc = q & 15; vr[it] = *(const v4u*)(VT + ((size_t)(bh * DV + e)) * SEQ + n * CH + pc * 8); }
#pragma unroll
            for (int it = 0; it < 4; ++it) { const int q = tid + 512 * it, j = q >> 4, pc = q & 15; *(LAS v4u*)(SB + j * RO_PITCH + pc * 8) = kr[it]; }
#pragma unroll
            for (int it = 0; it < 8; ++it) { const int q = tid + 512 * it, e = q >> 4, pc = q & 15; *(LAS v4u*)(SA + e * RO_PITCH + pc * 8) = vr[it]; }
        }
        bf16x8 qf[4];
#pragma unroll
        for (int ks = 0; ks < 4; ++ks) qf[ks] = *(const bf16x8*)(Q + qoff + 32 * ks + 8 * fq);
        __syncthreads();
        f32x4 sc[8];
#pragma unroll
        for (int jt = 0; jt < 8; ++jt) {
            f32x4 a = {0.f, 0.f, 0.f, 0.f};
#pragma unroll
            for (int ks = 0; ks < 4; ++ks) { const bf16x8 kf = *(const LAS bf16x8*)(SB + (16 * jt + fr) * RO_PITCH + 32 * ks + 8 * fq); a = __builtin_amdgcn_mfma_f32_16x16x32_bf16(kf, qf[ks], a, 0, 0, 0); }
#pragma unroll
            for (int r = 0; r < 4; ++r) { const int j = 16 * jt + 4 * fq + r, df = i - j; a[r] *= df >= 0 ? __builtin_amdgcn_exp2f((float)df * lgf) : __builtin_amdgcn_exp2f((float)(-df) * lgb); }
            sc[jt] = a;
        }
        f32x4 o[16];
#pragma unroll
        for (int et = 0; et < 16; ++et) o[et] = (f32x4){0.f, 0.f, 0.f, 0.f};
#pragma unroll
        for (int ks = 0; ks < 4; ++ks) {
            v4u pw; pw.x = cvt_pk_bf16(sc[2 * ks][0], sc[2 * ks][1]); pw.y = cvt_pk_bf16(sc[2 * ks][2], sc[2 * ks][3]); pw.z = cvt_pk_bf16(sc[2 * ks + 1][0], sc[2 * ks + 1][1]); pw.w = cvt_pk_bf16(sc[2 * ks + 1][2], sc[2 * ks + 1][3]);
            const bf16x8 pf = __builtin_bit_cast(bf16x8, pw);
#pragma unroll
            for (int et = 0; et < 16; ++et) {
                const LAS bf16* vp = SA + (16 * et + fr) * RO_PITCH + 32 * ks + 4 * fq;
                const v2u lo = *(const LAS v2u*)vp, hi2 = *(const LAS v2u*)(vp + 16);
                v4u vw; vw.x = lo.x; vw.y = lo.y; vw.z = hi2.x; vw.w = hi2.y;
                o[et] = __builtin_amdgcn_mfma_f32_16x16x32_bf16(__builtin_bit_cast(bf16x8, vw), pf, o[et], 0, 0, 0);
            }
        }
        __syncthreads();
        {
            const bf16* sf = SIN + (((size_t)(bh * 2 + 0) * NCH + n) * DV) * DK; const bf16* sb = SIN + (((size_t)(bh * 2 + 1) * NCH + n) * DV) * DK;
            v4u fr_[8], br_[8];
#pragma unroll
            for (int it = 0; it < 8; ++it) { const int q = tid + 512 * it; fr_[it] = *(const v4u*)(sf + (size_t)q * 8); br_[it] = *(const v4u*)(sb + (size_t)q * 8); }
#pragma unroll
            for (int it = 0; it < 8; ++it) { const int q = tid + 512 * it, e = q >> 4, pc = q & 15; *(LAS v4u*)(SA + e * RO_PITCH + pc * 8) = fr_[it]; *(LAS v4u*)(SB + e * RO_PITCH + pc * 8) = br_[it]; }
        }
        bf16x8 qff[4], qbf[4];
#pragma unroll
        for (int ks = 0; ks < 4; ++ks) { qff[ks] = *(const bf16x8*)(QF + qoff + 32 * ks + 8 * fq); qbf[ks] = *(const bf16x8*)(QB + qoff + 32 * ks + 8 * fq); }
        __syncthreads();
#pragma unroll
        for (int ks = 0; ks < 4; ++ks)
#pragma unroll
            for (int et = 0; et < 16; ++et) {
                const bf16x8 s1 = *(const LAS bf16x8*)(SA + (16 * et + fr) * RO_PITCH + 32 * ks + 8 * fq), s2 = *(const LAS bf16x8*)(SB + (16 * et + fr) * RO_PITCH + 32 * ks + 8 * fq);
                o[et] = __builtin_amdgcn_mfma_f32_16x16x32_bf16(s1, qff[ks], o[et], 0, 0, 0);
                o[et] = __builtin_amdgcn_mfma_f32_16x16x32_bf16(s2, qbf[ks], o[et], 0, 0, 0);
            }
        float ss = 0.f;
#pragma unroll
        for (int et = 0; et < 16; ++et) ss += (o[et][0] * o[et][0] + o[et][1] * o[et][1]) + (o[et][2] * o[et][2] + o[et][3] * o[et][3]);
        ss += shfl_xor_l(ss, 16, lane); ss += shfl_xor_l(ss, 32, lane);
        const float rinv = 1.0f / sqrtf(ss * (1.0f / DV) + EPS);
        bf16* gp = SG + (size_t)(tok0 + i) * D + h * DV + 4 * fq;
#pragma unroll
        for (int et = 0; et < 16; ++et) { const v2u gg = *(const v2u*)(gp + 16 * et);
            v2u ow; ow.x = cvt_pk_bf16(o[et][0] * rinv * bflo(gg.x), o[et][1] * rinv * bfhi(gg.x)); ow.y = cvt_pk_bf16(o[et][2] * rinv * bflo(gg.y), o[et][3] * rinv * bfhi(gg.y));
            *(v2u*)(gp + 16 * et) = ow; }
        __syncthreads();
    }
}

__global__ void __launch_bounds__(NWAVES * 64, 2) fwd_megakernel(Args args) {
    extern __shared__ __attribute__((aligned(16))) unsigned char lds[];
    Frame F;
    F.lds = (LAS unsigned char*)lds;
    F.MISC = (volatile LAS unsigned*)(F.lds + MISC_OFF);
    F.wave = __builtin_amdgcn_readfirstlane((int)threadIdx.x >> 6);
    F.G = gridDim.x; { const int bx = blockIdx.x; F.vcu = (F.G % 8 == 0) ? (bx % 8) * (F.G / 8) + bx / 8 : bx; }
    F.out = kargs()->out; F.ws = kargs()->ws; F.ctl = (unsigned*)(F.ws + WS_CTL);
    for (int u = (int)threadIdx.x; u < (LDS_BYTES - LDSCTL_OFF) / 4; u += NWAVES * 64) ((LAS unsigned*)(F.lds + LDSCTL_OFF))[u] = 0u;
    __syncthreads();
    XcdBarrier bar = xcd_barrier_post(F.ctl + CW_BAR, F.MISC + 8);
    unsigned char* ws = F.ws;
    const int G = F.G, cid = (int)blockIdx.x;
#define GRID_BAR() xcd_barrier(bar)

#ifndef PHM
#define PHM 0xFFFFF
#endif
#define PH(k) ((PHM >> (k)) & 1)
#ifndef REPM
#define REPM 0
#endif
#define NREP(k) (1 + ((REPM >> (k)) & 1))
#if PH(0)
    phase_prologue(F, args, true);
#if NREP(0) > 1
    phase_prologue(F, args, false);
#endif
#endif
    GRID_BAR();
#if PH(1)
    phase_rows<0>(F, args);
    s5_tables1(F, args);
#endif
    GRID_BAR();
#if PH(2)
    {
        pg8::GridOrder S; S.init(ws + WS_ABUF, ws + WS_W1T, D, MT / 256, NFF / 256, G, cid);
        EpiSwiGLU E{(bf16*)(ws + WS_HBUF)};
        pg8::gemm_phase(F.lds, D, S, E, F.wave);
    }
#if NREP(2) > 1
    {
        pg8::GridOrder S; S.init(ws + WS_ABUF, ws + WS_W1T, D, MT / 256, NFF / 256, G, cid);
        EpiSwiGLU E{(bf16*)(ws + WS_HBUF)};
        pg8::gemm_phase(F.lds, D, S, E, F.wave);
    }
#endif
#endif
    GRID_BAR();
#if PH(3)
    {
        Ffn1DownOrder S{(const char*)(ws + WS_HBUF), (const char*)(ws + WS_W2T), G, cid};
        EpiFfn1Down E{(bf16*)(ws + WS_OBUF), (float*)(ws + WS_SLAB)};
        pg8::gemm_phase(F.lds, DFF, S, E, F.wave);
    }
#if NREP(3) > 1
    {
        pg8::GridOrder S; S.init(ws + WS_HBUF, ws + WS_W2T, DFF, MT / 256, D / 256, G, cid);
        EpiO16 E{(bf16*)(ws + WS_OBUF), D};
        pg8::gemm_phase(F.lds, DFF, S, E, F.wave);
    }
#endif
#endif
    GRID_BAR();
#if PH(4)
    phase_rows<1>(F, args);
    s5_tables2(F, args);
#endif
    GRID_BAR();
#if PH(5)
    {
        MixOrder S{(const char*)(ws + WS_ABUF), (const char*)(ws + WS_WMT), G, cid};
        EpiMix E{ws};
        pg8::gemm_phase(F.lds, D, S, E, F.wave);
    }
#if NREP(5) > 1
    {
        MixOrder S{(const char*)(ws + WS_ABUF), (const char*)(ws + WS_WMT), G, cid};
        EpiMix E{ws};
        pg8::gemm_phase(F.lds, D, S, E, F.wave);
    }
#endif
#endif
    GRID_BAR();
#if PH(6)
    phase_rstate(F);
#if NREP(6) > 1
    phase_rstate(F);
#endif
#endif
#if PH(7)
    {
        S5EOrder S{(const char*)(ws + WS_US), (const char*)(ws + WS_S5WE), G, cid};
        EpiS5E E{(bf16*)(ws + WS_S5E)};
        pg8::gemm_phase(F.lds, 256, S, E, F.wave);
    }
#endif
    GRID_BAR();
#if PH(8)
    {
        int tid_ = F.wave * 64 + lane_id(); asm volatile("" : "+v"(tid_));
        for (int bg = cid; bg < NB * 64; bg += G) { s5_scan_unit(F, bg, 0, tid_); s5_scan_unit(F, bg, 1, tid_); }
        asm volatile("s_waitcnt vmcnt(0)" ::: "memory"); __syncthreads();
        S5YOrder S{(const char*)(ws + WS_US), (const char*)(ws + WS_S5ZH), (const char*)(ws + WS_S5WY1), (const char*)(ws + WS_S5WY2), G, cid};
        EpiS5Y E{(bf16*)(ws + WS_AGLU)};
        pg8::gemm_phase(F.lds, 256, S, E, F.wave);
    }
    phase_rout(F);
#endif
    GRID_BAR();
#if PH(9)
    {
        pg8::GridOrder S; S.init(ws + WS_AGLU, ws + WS_WGT, SW, MX / 256, 2 * D / 256, G, cid);
        EpiGLU E{(const bf16*)(ws + WS_HBUF + 32 * MiB), (bf16*)(ws + WS_Q)};
        pg8::gemm_phase(F.lds, SW, S, E, F.wave);
    }
#if NREP(9) > 1
    {
        pg8::GridOrder S; S.init(ws + WS_AGLU, ws + WS_WGT, SW, MX / 256, 2 * D / 256, G, cid);
        EpiGLU E{(const bf16*)(ws + WS_HBUF + 32 * MiB), (bf16*)(ws + WS_Q)};
        pg8::gemm_phase(F.lds, SW, S, E, F.wave);
    }
#endif
#endif
    GRID_BAR();
#if PH(10)
    {
        pg8::GridOrder S; S.init(ws + WS_HBUF, ws + WS_WPT, D, MX / 256, D / 256, G, cid);
        EpiMerge E{(const bf16*)(ws + WS_HBUF + 64 * MiB), (bf16*)(ws + WS_Q)};
        pg8::gemm_phase(F.lds, D, S, E, F.wave);
    }
#if NREP(10) > 1
    {
        pg8::GridOrder S; S.init(ws + WS_HBUF, ws + WS_WPT, D, MX / 256, D / 256, G, cid);
        EpiMerge E{(const bf16*)(ws + WS_HBUF + 64 * MiB), (bf16*)(ws + WS_Q)};
        pg8::gemm_phase(F.lds, D, S, E, F.wave);
    }
#endif
#endif
    GRID_BAR();
#if PH(11)
    {
        pg8::GridOrder S; S.init(ws + WS_Q, ws + WS_WOT, D, MX / 256, D / 256, G, cid);
        EpiO16 E{(bf16*)(ws + WS_OBUF), D};
        pg8::gemm_phase(F.lds, D, S, E, F.wave);
    }
#if NREP(11) > 1
    {
        pg8::GridOrder S; S.init(ws + WS_Q, ws + WS_WOT, D, MX / 256, D / 256, G, cid);
        EpiO16 E{(bf16*)(ws + WS_OBUF), D};
        pg8::gemm_phase(F.lds, D, S, E, F.wave);
    }
#endif
#endif
    GRID_BAR();
#if PH(12)
    phase_rows<2>(F, args);
#if NREP(12) > 1
    phase_rows<2>(F, args);
#endif
#endif
    GRID_BAR();
#if PH(13)
    {
        pg8::GridOrder S; S.init(ws + WS_ABUF, ws + WS_W3T, D, MX / 256, NFF / 256, G, cid);
        EpiSwiGLU E{(bf16*)(ws + WS_HBUF)};
        pg8::gemm_phase(F.lds, D, S, E, F.wave);
    }
#if NREP(13) > 1
    {
        pg8::GridOrder S; S.init(ws + WS_ABUF, ws + WS_W3T, D, MX / 256, NFF / 256, G, cid);
        EpiSwiGLU E{(bf16*)(ws + WS_HBUF)};
        pg8::gemm_phase(F.lds, D, S, E, F.wave);
    }
#endif
#endif
    GRID_BAR();
#if PH(14)
    {
        pg8::GridOrder S; S.init(ws + WS_HBUF, ws + WS_W4T, DFF, MX / 256, D / 256, G, cid);
        EpiO16 E{(bf16*)(ws + WS_OBUF), D};
        pg8::gemm_phase(F.lds, DFF, S, E, F.wave);
    }
#if NREP(14) > 1
    {
        pg8::GridOrder S; S.init(ws + WS_HBUF, ws + WS_W4T, DFF, MX / 256, D / 256, G, cid);
        EpiO16 E{(bf16*)(ws + WS_OBUF), D};
        pg8::gemm_phase(F.lds, DFF, S, E, F.wave);
    }
#endif
#endif
    GRID_BAR();
#if PH(15)
    phase_rows<3>(F, args);
#if NREP(15) > 1
    phase_rows<3>(F, args);
#endif
#endif
}

extern "C" void kernel_launch(void* const* d_in, const int* in_sizes, int n_in, void* d_out, int out_size, void* d_ws, size_t ws_size, hipStream_t stream) {
    static int grid = 0;
    if (grid == 0) {
        if (n_in != 22 || in_sizes[0] != MX * D || out_size != MX * D || ws_size < WS_END) { fprintf(stderr, "kernel_launch: unexpected problem (n_in %d, in0 %d, out %d, ws %zu, need %zu)\n", n_in, n_in > 0 ? in_sizes[0] : -1, out_size, ws_size, (size_t)WS_END); grid = -1; return; }
        int dev = 0, cus = 0, per_cu = 0;
        if (hipGetDevice(&dev) != hipSuccess || hipDeviceGetAttribute(&cus, hipDeviceAttributeMultiprocessorCount, dev) != hipSuccess) { grid = -1; return; }
        if (hipFuncSetAttribute((const void*)fwd_megakernel, hipFuncAttributeMaxDynamicSharedMemorySize, LDS_BYTES) != hipSuccess) { fprintf(stderr, "kernel_launch: hipFuncSetAttribute failed\n"); grid = -1; return; }
        if (hipOccupancyMaxActiveBlocksPerMultiprocessor(&per_cu, (const void*)fwd_megakernel, NWAVES * 64, LDS_BYTES) != hipSuccess || per_cu < 1) { fprintf(stderr, "kernel_launch: occupancy query says %d blocks per CU\n", per_cu); grid = -1; (void)hipGetLastError(); return; }
        grid = cus;
    }
    if (grid < 0) return;
    if (hipMemsetAsync((char*)d_ws + WS_CTL, 0, CTL_ZERO_BYTES, stream) != hipSuccess) return;
    Args a{};
    for (int i = 0; i < 22; ++i) a.in[i] = (const float*)d_in[i];
    a.out = (float*)d_out; a.ws = (unsigned char*)d_ws;
    void* kargs[] = {&a};
    hipError_t e = hipLaunchCooperativeKernel((const void*)fwd_megakernel, dim3(grid), dim3(NWAVES * 64), kargs, LDS_BYTES, stream);
    if (e != hipSuccess) fprintf(stderr, "kernel_launch: cooperative launch failed: %s (grid %d)\n", hipGetErrorString(e), grid);
}
```

```cpp
#include <hip/hip_runtime.h>
#include <cstdio>
#include <cstdint>

#define GAS __attribute__((address_space(1)))
#define LAS __attribute__((address_space(3)))
typedef unsigned short bf16;
typedef unsigned v4u __attribute__((ext_vector_type(4)));
typedef unsigned v2u __attribute__((ext_vector_type(2)));
typedef float f32x4 __attribute__((ext_vector_type(4)));
typedef float f32x2 __attribute__((ext_vector_type(2)));
typedef short bf16x8 __attribute__((ext_vector_type(8)));
typedef short bf16x4 __attribute__((ext_vector_type(4)));

constexpr int D = 2048, NB = 2, SEQ = 4096, MX = NB * SEQ, LC = 256, MC = NB * LC, MT = MX + MC;
constexpr int DFF = 5632, NFF = 2 * DFF, SW = 1024, NMIX = 11264, NH = 8, DK = 128, DV = 256, CH = 128, NCH = SEQ / CH;
constexpr int NADA = 9 * D;
constexpr float EPS = 1e-6f;
constexpr int NWAVES = 8;

constexpr size_t MiB = 1u << 20;
constexpr size_t WS_CTL = 0, CTL_ZERO_BYTES = 1 * MiB;
constexpr size_t WS_W1T = 1 * MiB, WS_W2T = 45 * MiB, WS_WMT = 67 * MiB, WS_WGT = 115 * MiB, WS_WPT = 123 * MiB, WS_WOT = 131 * MiB, WS_W3T = 139 * MiB, WS_W4T = 183 * MiB;
constexpr size_t WS_ABUF = 205 * MiB;
constexpr size_t WS_HBUF = 239 * MiB;
constexpr size_t WS_OBUF = 335 * MiB;
constexpr size_t WS_US = 403 * MiB;
constexpr size_t WS_Q = 420 * MiB, WS_QF = 436 * MiB, WS_QB = 452 * MiB;
constexpr size_t WS_K = 468 * MiB;
constexpr size_t WS_KFT = 484 * MiB, WS_KBT = 500 * MiB, WS_KFTC = 516 * MiB, WS_KBTC = 517 * MiB;
constexpr size_t WS_VT = 518 * MiB, WS_VTC = 550 * MiB;
constexpr size_t WS_YF = 552 * MiB;
constexpr size_t WS_S5WE = WS_YF, WS_S5WY1 = WS_YF + 8 * MiB, WS_S5WY2 = WS_YF + 16 * MiB, WS_S5KT = WS_YF + 24 * MiB, WS_S5BRF = WS_YF + 26 * MiB, WS_S5APOW = WS_YF + 28 * MiB;
constexpr size_t WS_S5E = WS_ABUF, WS_S5ZH = WS_ABUF + 17 * MiB;
constexpr int S5_ROWS = 272;
constexpr size_t WS_AGLU = 584 * MiB;
constexpr size_t WS_TAB = 600 * MiB;
constexpr size_t WS_END = 602 * MiB;
constexpr size_t TAB_ROPE = 0, TAB_LG2 = 16384, TAB_AR = 32768, TAB_AI = 65536, TAB_END = 131072;
constexpr int CW_BAR = 4096;
constexpr size_t CTL_ADA = 65536;

#define RLX_AGENT __ATOMIC_RELAXED, __HIP_MEMORY_SCOPE_AGENT
#define LDS_WAIT() asm volatile("s_waitcnt lgkmcnt(0)" ::: "memory")
#define VM_WAIT() asm volatile("s_waitcnt vmcnt(0)" ::: "memory")

__device__ __forceinline__ unsigned f2bf(float f) { unsigned u = __builtin_bit_cast(unsigned, f); return (u + 0x7fffu + ((u >> 16) & 1u)) >> 16; }
__device__ __forceinline__ unsigned pk2(float lo, float hi) { return f2bf(lo) | (f2bf(hi) << 16); }
__device__ __forceinline__ unsigned cvt_pk_bf16(float lo, float hi) { unsigned r; asm volatile("v_cvt_pk_bf16_f32 %0, %1, %2" : "=v"(r) : "v"(lo), "v"(hi)); return r; }
__device__ __forceinline__ float bflo(unsigned w) { return __builtin_bit_cast(float, w << 16); }
__device__ __forceinline__ float bfhi(unsigned w) { return __builtin_bit_cast(float, w & 0xffff0000u); }
__device__ __forceinline__ float fast_sigmoid(float x) { return __builtin_amdgcn_rcpf(1.0f + __builtin_amdgcn_exp2f(-1.4426950408889634f * x)); }
__device__ __forceinline__ float fast_silu(float x) { return x * fast_sigmoid(x); }
__device__ __forceinline__ float gelu_tanh(float x) { const float u = 0.7978845608028654f * (x + 0.044715f * x * x * x); return x * fast_sigmoid(2.0f * u); }
__device__ __forceinline__ int lane_id() { return (int)__builtin_amdgcn_mbcnt_hi(~0u, __builtin_amdgcn_mbcnt_lo(~0u, 0u)); }
__device__ __forceinline__ float shfl_xor_l(float v, int mask, int lane) { return __builtin_bit_cast(float, __builtin_amdgcn_ds_bpermute((lane ^ mask) << 2, __builtin_bit_cast(int, v))); }
__device__ __forceinline__ float wave_sum(float v, int lane) {
#pragma unroll
    for (int o = 1; o < 64; o <<= 1) v += shfl_xor_l(v, o, lane);
    return v;
}

#define XB_TMO      128
#define XB_XCNT(j)  (256  + 64 * (j))
#define XB_XSUB(j)  (1280 + 64 * (j))
#define XB_XGEN(j)  (2304 + 64 * (j))
#define XB_TOP      3328
#define XB_TOPGEN   3392
#define XCD_BAR_WORDS 3456
#define XB_SPIN_CAP (1u << 18)
__device__ __forceinline__ unsigned xb_ld(unsigned* p)              { return __hip_atomic_load(p, __ATOMIC_RELAXED, __HIP_MEMORY_SCOPE_AGENT); }
__device__ __forceinline__ unsigned xb_add(unsigned* p, unsigned v) { return __hip_atomic_fetch_add(p, v, __ATOMIC_RELAXED, __HIP_MEMORY_SCOPE_AGENT); }
__device__ __forceinline__ unsigned xb_xcc_id() { return (unsigned)__builtin_amdgcn_s_getreg((3 << 11) | 20) & 0xFu; }
#define XB_SPIN(cond, bar) do { unsigned _sp = 0; while (cond) { __builtin_amdgcn_s_sleep(1); \
    if ((++_sp & 255u) == 0u) { if (xb_ld(&(bar)[XB_TMO])) break; if (_sp > XB_SPIN_CAP) { atomicAdd(&(bar)[XB_TMO], 1u); break; } } } } while (0)
struct XcdBarrier { unsigned* bar; unsigned x; volatile LAS unsigned* st; };
__device__ __forceinline__ XcdBarrier xcd_barrier_post(unsigned* bar, volatile LAS unsigned* st) {
    XcdBarrier b; b.bar = bar; b.x = xb_xcc_id(); b.st = st;
    if (threadIdx.x == 0) (void)xb_add(&bar[XB_XCNT(b.x)], 1u);
    return b;
}
__device__ __forceinline__ void xcd_barrier_complete(unsigned* bar, unsigned x, unsigned& nloc, unsigned& nx) {
    const unsigned G = gridDim.x * gridDim.y * gridDim.z;
    unsigned sum, cnt, mine, sp = 0u;
    for (;;) {
        sum = 0u; cnt = 0u; mine = 0u;
#pragma unroll
        for (unsigned j = 0; j < 16; ++j) { const unsigned c = xb_ld(&bar[XB_XCNT(j)]); sum += c; cnt += (c > 0u) ? 1u : 0u; mine = (j == x) ? c : mine; }
        if (sum == G) break;
        __builtin_amdgcn_s_sleep(1);
        if ((++sp & 255u) == 0u) { if (xb_ld(&bar[XB_TMO])) break; if (sp > XB_SPIN_CAP) { atomicAdd(&bar[XB_TMO], 1u); break; } }
    }
    nloc = mine > 0u ? mine : 1u; nx = cnt > 0u ? cnt : 1u;
}
__device__ __forceinline__ void xcd_barrier(const XcdBarrier& b) {
    asm volatile("s_waitcnt vmcnt(0)" ::: "memory");
    __syncthreads();
    if (threadIdx.x == 0) {
        unsigned* bar = b.bar;
        __builtin_amdgcn_s_waitcnt(0);
        unsigned nloc = b.st[0], nx = b.st[1];
        if (nloc == 0u) { xcd_barrier_complete(bar, b.x, nloc, nx); b.st[0] = nloc; b.st[1] = nx; }
        const unsigned old = xb_add(&bar[XB_XSUB(b.x)], 1u);
        const unsigned gen = old / nloc;
        if (old + 1u == (gen + 1u) * nloc) {
            __builtin_amdgcn_fence(__ATOMIC_RELEASE, "agent");
            asm volatile("s_waitcnt vmcnt(0)" ::: "memory");
            const unsigned og = xb_add(&bar[XB_TOP], 1u);
            const unsigned tg = og / nx;
            if (og + 1u == (tg + 1u) * nx) xb_add(&bar[XB_TOPGEN], 1u);
            else XB_SPIN(xb_ld(&bar[XB_TOPGEN]) == tg, bar);
            __builtin_amdgcn_fence(__ATOMIC_ACQUIRE, "agent");
            xb_add(&bar[XB_XGEN(b.x)], 1u);
            asm volatile("s_waitcnt vmcnt(0)" ::: "memory");
        } else {
            XB_SPIN(xb_ld(&bar[XB_XGEN(b.x)]) == gen, bar);
            __builtin_amdgcn_fence(__ATOMIC_ACQUIRE, "agent");
            asm volatile("s_waitcnt vmcnt(0)" ::: "memory");
        }
    }
    __syncthreads();
}

namespace pg8 {
constexpr int BM = 256, BK = 64, HALF = 128, HTB = HALF * BK * 2, STAGE_BYTES = 8 * HTB, NXCD = 8;
__device__ __forceinline__ int lds_byte(int r, int c) { const int st = (r >> 4) * 2 + (c >> 5), rr = r & 15, cc = c & 31, ob = rr * 64 + cc * 2; return st * 1024 + (ob ^ (((ob >> 9) & 1) << 5)); }
__device__ __forceinline__ void stage_rc(int b, int& R, int& C) { const int st = b / 1024, sb = b % 1024, swz = sb ^ (((sb >> 9) & 1) << 5); R = (st >> 1) * 16 + swz / 64; C = (st & 1) * 32 + (swz % 64) / 2; }
__device__ __forceinline__ int perm32(int rho) { const int n = rho >> 4, i = rho & 15; return 8 * (i >> 2) + 4 * n + (i & 3); }

struct Unit {
    const char* A; const char* B; unsigned info;
    __device__ __forceinline__ int pm() const { return (int)(info & 255u); }
    __device__ __forceinline__ int pn() const { return (int)((info >> 8) & 255u); }
    __device__ __forceinline__ int kind() const { return (int)((info >> 16) & 15u); }
    __device__ __forceinline__ int nt() const { return (int)((info >> 20) & 255u); }
    __device__ __forceinline__ int cont() const { return (int)((info >> 28) & 1u); }
};
__device__ __forceinline__ Unit make_unit(const char* A, const char* B, int pm, int pn, int kind, int nt, int cont) { return Unit{A, B, (unsigned)pm | ((unsigned)pn << 8) | ((unsigned)kind << 16) | ((unsigned)nt << 20) | ((unsigned)cont << 28)}; }
__device__ __forceinline__ int xcd_remap(int L, int nwg) { const int q = nwg / NXCD, r = nwg % NXCD, xcd = L % NXCD, off = L / NXCD; return (xcd < r ? xcd * (q + 1) : r * (q + 1) + (xcd - r) * q) + off; }

template <class Epi, class Sched>
__device__ __forceinline__ void gemm_phase(LAS unsigned char* lds, const int K, const Sched& S, const Epi& E, const int wave_) {
    int tid = wave_ * 64 + lane_id(); asm volatile("" : "+v"(tid));
    const int wid = wave_, lane = tid & 63, wr = wid >> 2, wc = wid & 3, fr = lane & 15, fq = lane >> 4;
    unsigned voffA[2], voffB[2];
#pragma unroll
    for (int i = 0; i < 2; ++i) { int R, C; stage_rc(tid * 16 + i * 8192, R, C); const int Rb = (R & ~31) + perm32(R & 31);
        voffA[i] = (unsigned)(R * K + C) * 2u; voffB[i] = (unsigned)(Rb * K + C) * 2u; }
    const size_t kstep = (size_t)(BK * 2);
    const size_t hstep = (size_t)HALF * K * 2;
    const unsigned ldsw = (unsigned)wid * 1024u;
    const int aoff = lds_byte(wr * 64 + fr, fq * 8), boff = lds_byte(wc * 32 + fr, fq * 8);
#define PG8_SA(b, h) (((b) * 2 + (h)) * HTB)
#define PG8_SB(b, h) ((4 + (b) * 2 + (h)) * HTB)
#define PG8_STAGE(bufoff, gbase, voff) do { _Pragma("unroll") for (int _i = 0; _i < 2; ++_i) \
        __builtin_amdgcn_global_load_lds((const unsigned*)((const char*)(gbase) + (voff)[_i]), (LAS unsigned*)(lds + (bufoff) + ldsw + _i * 8192), 16, 0, 0); } while (0)
#define PG8_LDA(dst, b, h) do { _Pragma("unroll") for (int m = 0; m < 4; ++m) _Pragma("unroll") for (int k = 0; k < 2; ++k) dst[m][k] = *(const LAS bf16x8*)(lds + PG8_SA(b, h) + aoff + m * 2048 + k * 1024); } while (0)
#define PG8_LDB(dst, b, h) do { _Pragma("unroll") for (int n = 0; n < 2; ++n) _Pragma("unroll") for (int k = 0; k < 2; ++k) dst[n][k] = *(const LAS bf16x8*)(lds + PG8_SB(b, h) + boff + n * 2048 + k * 1024); } while (0)
#define PG8_MMA(ai, bj, At, Bt) do { __builtin_amdgcn_s_setprio(1); _Pragma("unroll") for (int m = 0; m < 4; ++m) _Pragma("unroll") for (int n = 0; n < 2; ++n) _Pragma("unroll") for (int k = 0; k < 2; ++k) \
        acc[ai][bj][m][n] = __builtin_amdgcn_mfma_f32_16x16x32_bf16(Bt[n][k], At[m][k], acc[ai][bj][m][n], 0, 0, 0); __builtin_amdgcn_s_setprio(0); } while (0)
#define PG8_WAIT_V(n) asm volatile("s_waitcnt vmcnt(" #n ")" ::: "memory")
#define PG8_WAIT_L(n) asm volatile("s_waitcnt lgkmcnt(" #n ")" ::: "memory")
#define PG8_BAR __builtin_amdgcn_s_barrier()
#define PG8_SCHED __builtin_amdgcn_sched_barrier(0)
    Unit cur, nxt; int ui = 0;
    if (!S.next(0, cur)) return;
    f32x4 acc[2][2][4][2];
#pragma unroll
    for (int a = 0; a < 2; ++a)
#pragma unroll
        for (int b = 0; b < 2; ++b)
#pragma unroll
            for (int m = 0; m < 4; ++m)
#pragma unroll
                for (int n = 0; n < 2; ++n) acc[a][b][m][n] = (f32x4){0.f, 0.f, 0.f, 0.f};
    bf16x8 At[4][2], B0[2][2], B1[2][2];
    const char* cA = cur.A; const char* cB = cur.B;
    PG8_STAGE(PG8_SB(0, 0), cB, voffB); PG8_STAGE(PG8_SB(0, 1), cB + hstep, voffB); PG8_STAGE(PG8_SA(0, 0), cA, voffA); PG8_STAGE(PG8_SA(0, 1), cA + hstep, voffA);
    if (wr == 1) PG8_BAR;
    PG8_WAIT_V(2); PG8_BAR;
    PG8_STAGE(PG8_SB(1, 0), cB + kstep, voffB); PG8_STAGE(PG8_SA(1, 0), cA + kstep, voffA); PG8_STAGE(PG8_SB(1, 1), cB + hstep + kstep, voffB);
    PG8_WAIT_V(6); PG8_BAR;
    for (;;) {
        const bool has_next = S.next(ui + 1, nxt);
        const char* nA = has_next ? nxt.A : cA; const char* nB = has_next ? nxt.B : cB;
        const int nt = cur.nt();
        for (int t = 0; t < nt; t += 2) {
            const bool last = (t == nt - 2);
            const char* a1 = cA + (size_t)(t + 1) * kstep;
            const char* a2 = last ? nA : cA + (size_t)(t + 2) * kstep; const char* b2 = last ? nB : cB + (size_t)(t + 2) * kstep;
            const char* a3 = a2 + kstep; const char* b3 = b2 + kstep;
            PG8_LDB(B0, 0, 0); PG8_LDB(B1, 0, 1); PG8_SCHED; PG8_LDA(At, 0, 0); PG8_STAGE(PG8_SA(1, 1), a1 + hstep, voffA);
            PG8_WAIT_V(8); PG8_WAIT_L(0); PG8_BAR; PG8_MMA(0, 0, At, B0); PG8_MMA(0, 1, At, B1); PG8_BAR; PG8_SCHED;
            PG8_LDA(At, 0, 1); PG8_STAGE(PG8_SB(0, 0), b2, voffB); PG8_STAGE(PG8_SB(0, 1), b2 + hstep, voffB); PG8_STAGE(PG8_SA(0, 0), a2, voffA);
            PG8_WAIT_V(8); PG8_WAIT_L(0); PG8_BAR; PG8_MMA(1, 0, At, B0); PG8_MMA(1, 1, At, B1); PG8_BAR; PG8_SCHED;
            PG8_LDB(B0, 1, 0); PG8_LDB(B1, 1, 1); PG8_SCHED; PG8_LDA(At, 1, 0); PG8_STAGE(PG8_SA(0, 1), a2 + hstep, voffA);
            PG8_WAIT_V(8); PG8_WAIT_L(0); PG8_BAR; PG8_MMA(0, 0, At, B0); PG8_MMA(0, 1, At, B1); PG8_BAR; PG8_SCHED;
            PG8_LDA(At, 1, 1); PG8_STAGE(PG8_SB(1, 0), b3, voffB); PG8_STAGE(PG8_SB(1, 1), b3 + hstep, voffB); PG8_STAGE(PG8_SA(1, 0), a3, voffA);
            PG8_WAIT_V(8); PG8_WAIT_L(0); PG8_BAR; PG8_MMA(1, 0, At, B0); PG8_MMA(1, 1, At, B1); PG8_BAR; PG8_SCHED;
        }
        if (wr == 0) PG8_BAR;
        if (!cur.cont()) E(acc, cur, wr, wc, fr, fq);
        if (!has_next) break;
        if (!cur.cont()) {
#pragma unroll
        for (int a = 0; a < 2; ++a)
#pragma unroll
            for (int b = 0; b < 2; ++b)
#pragma unroll
                for (int m = 0; m < 4; ++m)
#pragma unroll
                    for (int n = 0; n < 2; ++n) acc[a][b][m][n] = (f32x4){0.f, 0.f, 0.f, 0.f};
        }
        cur = nxt; cA = nA; cB = nB; ++ui;
        if (wr == 1) PG8_BAR;
    }
    PG8_WAIT_V(0);
    PG8_BAR;
#undef PG8_SA
#undef PG8_SB
#undef PG8_STAGE
#undef PG8_LDA
#undef PG8_LDB
#undef PG8_MMA
#undef PG8_WAIT_V
#undef PG8_WAIT_L
#undef PG8_BAR
#undef PG8_SCHED
}

struct GridOrder {
    const char* A; const char* B; size_t tstep; int nM, nN, nwg, G, c, nt;
    __device__ __forceinline__ void init(const void* A_, const void* B_, int K, int nM_, int nN_, int G_, int c_) { A = (const char*)A_; B = (const char*)B_; tstep = (size_t)BM * K * 2; nM = nM_; nN = nN_; nwg = nM * nN; G = G_; c = c_; nt = K / BK; }
    __device__ __forceinline__ bool next(int i, Unit& u) const {
        const long L = (long)i * G + c; if (L >= nwg) return false;
        const int wgid = xcd_remap((int)L, nwg);
        const int nig = 8 * nN, gid = wgid / nig, fm = gid * 8, gsz = (nM - fm) < 8 ? (nM - fm) : 8;
        const int pm = fm + ((wgid % nig) % gsz), pn = (wgid % nig) / gsz;
        u = make_unit(A + (size_t)pm * tstep, B + (size_t)pn * tstep, pm, pn, 0, nt, 0); return true;
    }
};
}

typedef f32x4 Acc[2][2][4][2];
struct EpiSwiGLU {
    bf16* Hid;
    __device__ __forceinline__ void operator()(const Acc& acc, const pg8::Unit& u, int wr, int wc, int fr0, int fq0) const {
        int fr = fr0, fq = fq0; asm volatile("" : "+v"(fr), "+v"(fq));
        const int row0 = u.pm() * 256 + wr * 64 + fr, col0 = u.pn() * 128 + wc * 32 + 8 * fq;
#pragma unroll
        for (int ai = 0; ai < 2; ++ai)
#pragma unroll
            for (int m = 0; m < 4; ++m) {
                float v[8];
#pragma unroll
                for (int n = 0; n < 2; ++n)
#pragma unroll
                    for (int j = 0; j < 4; ++j) v[4 * n + j] = fast_silu(acc[ai][0][m][n][j]) * acc[ai][1][m][n][j];
                v4u w; w.x = cvt_pk_bf16(v[0], v[1]); w.y = cvt_pk_bf16(v[2], v[3]); w.z = cvt_pk_bf16(v[4], v[5]); w.w = cvt_pk_bf16(v[6], v[7]);
                *(v4u*)(Hid + (size_t)(row0 + ai * 128 + m * 16) * DFF + col0) = w;
            }
    }
};
struct EpiO16 {
    bf16* C; int ldc;
    __device__ __forceinline__ void operator()(const Acc& acc, const pg8::Unit& u, int wr, int wc, int fr0, int fq0) const {
        int fr = fr0, fq = fq0; asm volatile("" : "+v"(fr), "+v"(fq));
        const int row0 = u.pm() * 256 + wr * 64 + fr, col0 = u.pn() * 256 + wc * 32 + 8 * fq;
#pragma unroll
        for (int ai = 0; ai < 2; ++ai)
#pragma unroll
            for (int m = 0; m < 4; ++m) { bf16* rowp = C + (size_t)(row0 + ai * 128 + m * 16) * ldc + col0;
#pragma unroll
                for (int bj = 0; bj < 2; ++bj) { const f32x4 a = acc[ai][bj][m][0], b = acc[ai][bj][m][1];
                    v4u w; w.x = cvt_pk_bf16(a[0], a[1]); w.y = cvt_pk_bf16(a[2], a[3]); w.z = cvt_pk_bf16(b[0], b[1]); w.w = cvt_pk_bf16(b[2], b[3]);
                    *(v4u*)(rowp + bj * 128) = w; } }
    }
};
struct EpiGLU {
    const bf16* SGS; bf16* out;
    __device__ __forceinline__ void operator()(const Acc& acc, const pg8::Unit& u, int wr, int wc, int fr0, int fq0) const {
        int fr = fr0, fq = fq0; asm volatile("" : "+v"(fr), "+v"(fq));
        const int row0 = u.pm() * 256 + wr * 64 + fr, col0 = u.pn() * 128 + wc * 32 + 8 * fq;
#pragma unroll
        for (int ai = 0; ai < 2; ++ai)
#pragma unroll
            for (int m = 0; m < 4; ++m) {
                const size_t off = (size_t)(row0 + ai * 128 + m * 16) * D + col0;
                const v4u s = *(const v4u*)(SGS + off);
                const float sg[8] = {bflo(s.x), bfhi(s.x), bflo(s.y), bfhi(s.y), bflo(s.z), bfhi(s.z), bflo(s.w), bfhi(s.w)};
                float v[8];
#pragma unroll
                for (int n = 0; n < 2; ++n)
#pragma unroll
                    for (int j = 0; j < 4; ++j) v[4 * n + j] = acc[ai][0][m][n][j] * fast_sigmoid(acc[ai][1][m][n][j]) * sg[4 * n + j];
                v4u w; w.x = cvt_pk_bf16(v[0], v[1]); w.y = cvt_pk_bf16(v[2], v[3]); w.z = cvt_pk_bf16(v[4], v[5]); w.w = cvt_pk_bf16(v[6], v[7]);
                *(v4u*)(out + off) = w;
            }
    }
};
struct EpiMerge {
    const bf16* SGR; bf16* mg;
    __device__ __forceinline__ void operator()(const Acc& acc, const pg8::Unit& u, int wr, int wc, int fr0, int fq0) const {
        int fr = fr0, fq = fq0; asm volatile("" : "+v"(fr), "+v"(fq));
        const int row0 = u.pm() * 256 + wr * 64 + fr, col0 = u.pn() * 256 + wc * 32 + 8 * fq;
#pragma unroll
        for (int ai = 0; ai < 2; ++ai)
#pragma unroll
            for (int m = 0; m < 4; ++m)
#pragma unroll
                for (int bj = 0; bj < 2; ++bj) {
                    const size_t off = (size_t)(row0 + ai * 128 + m * 16) * D + col0 + bj * 128;
                    const v4u s = *(const v4u*)(SGR + off), p = *(const v4u*)(mg + off);
                    const float sg[8] = {bflo(s.x), bfhi(s.x), bflo(s.y), bfhi(s.y), bflo(s.z), bfhi(s.z), bflo(s.w), bfhi(s.w)};
                    const float pp[8] = {bflo(p.x), bfhi(p.x), bflo(p.y), bfhi(p.y), bflo(p.z), bfhi(p.z), bflo(p.w), bfhi(p.w)};
                    float v[8];
#pragma unroll
                    for (int n = 0; n < 2; ++n)
#pragma unroll
                        for (int j = 0; j < 4; ++j) v[4 * n + j] = pp[4 * n + j] + sg[4 * n + j] * acc[ai][bj][m][n][j];
                    v4u w; w.x = cvt_pk_bf16(v[0], v[1]); w.y = cvt_pk_bf16(v[2], v[3]); w.z = cvt_pk_bf16(v[4], v[5]); w.w = cvt_pk_bf16(v[6], v[7]);
                    *(v4u*)(mg + off) = w;
                }
    }
};

constexpr int CTX_SPLIT = 4;
constexpr size_t WS_SLAB = WS_Q;
struct Ffn1DownOrder {
    const char* A; const char* B; int G, c;
    static constexpr int NBIG = (MX / 256) * (D / 256), NSMALL = (MC / 256) * (D / 256) * CTX_SPLIT;
    __device__ __forceinline__ bool next(int i, pg8::Unit& u) const {
        const long L = (long)i * G + c; if (L >= NBIG + NSMALL) return false;
        const size_t tstep = (size_t)256 * DFF * 2;
        int pm, pn, kind, nt; size_t koff;
        if (L < NBIG) { const int w = pg8::xcd_remap((int)L, NBIG); const int nig = 8 * 8, gid = w / nig, r = w % nig; pm = gid * 8 + (r & 7); pn = r >> 3; kind = 0; nt = DFF / 64; koff = 0; }
        else { const int w = (int)L - NBIG, sp = w & 3, t = w >> 2; pm = 32 + (t & 1); pn = t >> 1; kind = 1 + sp; nt = DFF / 64 / CTX_SPLIT; koff = (size_t)sp * (DFF / CTX_SPLIT) * 2; }
        u = pg8::make_unit(A + (size_t)pm * tstep + koff, B + (size_t)pn * tstep + koff, pm, pn, kind, nt, 0); return true;
    }
};
struct EpiFfn1Down {
    bf16* O; float* slab;
    __device__ __forceinline__ void operator()(const Acc& acc, const pg8::Unit& u, int wr, int wc, int fr0, int fq0) const {
        int fr = fr0, fq = fq0; asm volatile("" : "+v"(fr), "+v"(fq));
        const int row0 = u.pm() * 256 + wr * 64 + fr, col0 = u.pn() * 256 + wc * 32 + 8 * fq;
        if (u.kind() == 0) {
#pragma unroll
            for (int ai = 0; ai < 2; ++ai)
#pragma unroll
                for (int m = 0; m < 4; ++m) { bf16* rowp = O + (size_t)(row0 + ai * 128 + m * 16) * D + col0;
#pragma unroll
                    for (int bj = 0; bj < 2; ++bj) { const f32x4 a = acc[ai][bj][m][0], b = acc[ai][bj][m][1];
                        v4u w; w.x = cvt_pk_bf16(a[0], a[1]); w.y = cvt_pk_bf16(a[2], a[3]); w.z = cvt_pk_bf16(b[0], b[1]); w.w = cvt_pk_bf16(b[2], b[3]);
                        *(v4u*)(rowp + bj * 128) = w; } }
        } else {
            float* C = slab + (size_t)(u.kind() - 1) * MC * D - (size_t)MX * D;
#pragma unroll
            for (int ai = 0; ai < 2; ++ai)
#pragma unroll
                for (int m = 0; m < 4; ++m) { float* rowp = C + (size_t)(row0 + ai * 128 + m * 16) * D + col0;
#pragma unroll
                    for (int bj = 0; bj < 2; ++bj) { *(f32x4*)(rowp + bj * 128) = acc[ai][bj][m][0]; *(f32x4*)(rowp + bj * 128 + 4) = acc[ai][bj][m][1]; } }
        }
    }
};

enum { MK_S = 0, MK_Q = 1, MK_K = 2, MK_G = 3, MK_GS = 4, MK_GR = 5, MK_KT = 6, MK_VT = 7 };
struct EpiMix {
    unsigned char* ws;
    __device__ __forceinline__ void operator()(const Acc& acc, const pg8::Unit& u, int wr, int wc, int fr0, int fq0) const {
        int fr = fr0, fq = fq0; asm volatile("" : "+v"(fr), "+v"(fq));
        bf16* const US = (bf16*)(ws + WS_US); bf16* const Q = (bf16*)(ws + WS_Q); bf16* const QF = (bf16*)(ws + WS_QF); bf16* const QB = (bf16*)(ws + WS_QB); bf16* const KN = (bf16*)(ws + WS_K);
        bf16* const SG = (bf16*)(ws + WS_HBUF); bf16* const SGS = (bf16*)(ws + WS_HBUF + 32 * MiB); bf16* const SGR = (bf16*)(ws + WS_HBUF + 64 * MiB);
        bf16* const KFT = (bf16*)(ws + WS_KFT); bf16* const KBT = (bf16*)(ws + WS_KBT); bf16* const KFTC = (bf16*)(ws + WS_KFTC); bf16* const KBTC = (bf16*)(ws + WS_KBTC);
        bf16* const VT = (bf16*)(ws + WS_VT); bf16* const VTC = (bf16*)(ws + WS_VTC);
        const f32x2* const rope = (const f32x2*)(ws + WS_TAB + TAB_ROPE);
        const float* const lg2 = (const float*)(ws + WS_TAB + TAB_LG2);
        const int kind = u.kind();
        if (kind == MK_S) {
#pragma unroll
            for (int ai = 0; ai < 2; ++ai)
#pragma unroll
                for (int m = 0; m < 4; ++m) {
                    const int row = u.pm() * 256 + ai * 128 + wr * 64 + m * 16 + fr;
                    int b_, crow;
                    if (row < MX) { b_ = row >> 12; crow = (row & (SEQ - 1)) >> 4; } else { b_ = (row - MX) >> 8; crow = 256 + (((row - MX) & (LC - 1)) >> 4); }
                    const int s = row & 15;
#pragma unroll
                    for (int bj = 0; bj < 2; ++bj) {
                        const int ch = u.pn() * 256 + bj * 128 + wc * 32 + 8 * fq, g = ch >> 4, c0 = ch & 15;
                        const f32x4 a = acc[ai][bj][m][0], b = acc[ai][bj][m][1];
                        v4u w; w.x = cvt_pk_bf16(a[0], a[1]); w.y = cvt_pk_bf16(a[2], a[3]); w.z = cvt_pk_bf16(b[0], b[1]); w.w = cvt_pk_bf16(b[2], b[3]);
                        *(v4u*)(US + ((size_t)((b_ * 64 + g) * S5_ROWS + crow)) * 256 + s * 16 + c0) = w;
                    }
                }
        } else if (kind == MK_G || kind == MK_GS || kind == MK_GR) {
            bf16* dst = kind == MK_G ? SG : (kind == MK_GS ? SGS : SGR);
            const int row0 = u.pm() * 256 + wr * 64 + fr, col0 = u.pn() * 256 + wc * 32 + 8 * fq;
#pragma unroll
            for (int ai = 0; ai < 2; ++ai)
#pragma unroll
                for (int m = 0; m < 4; ++m)
#pragma unroll
                    for (int bj = 0; bj < 2; ++bj) {
                        float v[8];
#pragma unroll
                        for (int n = 0; n < 2; ++n)
#pragma unroll
                            for (int j = 0; j < 4; ++j) { const float x = acc[ai][bj][m][n][j]; const float s = fast_sigmoid(x); v[4 * n + j] = kind == MK_G ? x * s : s; }
                        v4u w; w.x = cvt_pk_bf16(v[0], v[1]); w.y = cvt_pk_bf16(v[2], v[3]); w.z = cvt_pk_bf16(v[4], v[5]); w.w = cvt_pk_bf16(v[6], v[7]);
                        *(v4u*)(dst + (size_t)(row0 + ai * 128 + m * 16) * D + col0 + bj * 128) = w;
                    }
        } else if (kind == MK_Q || kind == MK_K) {
            const int p = wc >> 1, i0 = 16 * (wc & 1) + 4 * fq;
            const int d0 = 64 * p + i0;
            const bool isctx = u.pm() >= 32;
            f32x4 cs0[8], cs1[8];
#pragma unroll
            for (int am = 0; am < 8; ++am) {
                const int row = u.pm() * 256 + (am >> 2) * 128 + wr * 64 + (am & 3) * 16 + fr;
                const int l = row & (SEQ - 1), pos = p ? (l & 63) : (l >> 6);
                if (!isctx) { cs0[am] = *(const f32x4*)(rope + pos * 32 + i0); cs1[am] = *(const f32x4*)(rope + pos * 32 + i0 + 2); }
                else { cs0[am] = (f32x4){1.f, 0.f, 1.f, 0.f}; cs1[am] = cs0[am]; }
            }
#pragma unroll
            for (int ai = 0; ai < 2; ++ai)
#pragma unroll
                for (int m = 0; m < 4; ++m) {
                    const int am = ai * 4 + m;
                    const int row = u.pm() * 256 + ai * 128 + wr * 64 + m * 16 + fr;
                    const float cc[4] = {cs0[am][0], cs0[am][2], cs1[am][0], cs1[am][2]}, ss[4] = {cs0[am][1], cs0[am][3], cs1[am][1], cs1[am][3]};
#pragma unroll
                    for (int bj = 0; bj < 2; ++bj) {
                        const int head = 2 * u.pn() + bj;
                        float y1[4], y2[4];
#pragma unroll
                        for (int j = 0; j < 4; ++j) { const float x1 = acc[ai][bj][m][0][j], x2 = acc[ai][bj][m][1][j]; y1[j] = x1 * cc[j] - x2 * ss[j]; y2[j] = x1 * ss[j] + x2 * cc[j]; }
                        const int cpos = 32 * wc + 8 * fq;
                        v4u w;
                        if (kind == MK_K) {
                            w.x = cvt_pk_bf16(y1[0], y1[1]); w.y = cvt_pk_bf16(y1[2], y1[3]); w.z = cvt_pk_bf16(y2[0], y2[1]); w.w = cvt_pk_bf16(y2[2], y2[3]);
                            if (!isctx) *(v4u*)(KN + (size_t)row * 1024 + head * 128 + cpos) = w;
                            else *(v4u*)(KFTC + (size_t)(row - MX) * 1024 + head * 128 + cpos) = w;
                        } else {
                            const float qs = 0.08838834764831845f;
                            w.x = cvt_pk_bf16(y1[0] * qs, y1[1] * qs); w.y = cvt_pk_bf16(y1[2] * qs, y1[3] * qs); w.z = cvt_pk_bf16(y2[0] * qs, y2[1] * qs); w.w = cvt_pk_bf16(y2[2] * qs, y2[3] * qs);
                            *(v4u*)(Q + (size_t)row * 1024 + head * 128 + cpos) = w;
                        }
                    }
                }
        } else if (kind == MK_VT) {
            const bool isctx = u.pn() >= 32;
#pragma unroll
            for (int ai = 0; ai < 2; ++ai)
#pragma unroll
                for (int m = 0; m < 4; ++m) {
                    const int f = u.pm() * 256 + ai * 128 + wr * 64 + m * 16 + fr;
#pragma unroll
                    for (int bj = 0; bj < 2; ++bj) {
                        const f32x4 a = acc[ai][bj][m][0], b = acc[ai][bj][m][1];
                        v4u w; w.x = cvt_pk_bf16(a[0], a[1]); w.y = cvt_pk_bf16(a[2], a[3]); w.z = cvt_pk_bf16(b[0], b[1]); w.w = cvt_pk_bf16(b[2], b[3]);
                        const int tc = bj * 128 + wc * 32 + 8 * fq;
                        if (!isctx) { const int tok = u.pn() * 256 + tc, b_ = tok >> 12, l = tok & (SEQ - 1); *(v4u*)(VT + ((size_t)(b_ * 2048 + f) * SEQ + l)) = w; }
                        else { const int b_ = u.pn() - 32; *(v4u*)(VTC + ((size_t)(b_ * 2048 + f) * LC + tc)) = w; }
                    }
                }
        }
    }
};
struct MixOrder {
    const char* U; const char* WM; int G, c;
    static constexpr int N_NORM = 32 * 36, N_CTXS = 16, N_SWAP = 8 * 34, NWG = N_NORM + N_CTXS + N_SWAP;
    __device__ __forceinline__ bool next(int i, pg8::Unit& u) const {
        const long L = (long)i * G + c; if (L >= NWG) return false;
        int w = pg8::xcd_remap((int)L, NWG);
        const size_t tstep = (size_t)256 * D * 2;
        int at, bt, pm, pn, kind;
        bool swapped = false;
        if (w < N_NORM) {
            const int nig = 8 * 36, gid = w / nig, r = w % nig, ct = r >> 3;
            pm = gid * 8 + (r & 7); at = pm;
            if (ct < 4) { bt = ct; kind = MK_S; pn = ct; } else if (ct < 8) { bt = ct; kind = MK_Q; pn = ct - 4; } else if (ct < 12) { bt = ct; kind = MK_K; pn = ct - 8; }
            else if (ct < 20) { bt = ct + 8; kind = MK_G; pn = ct - 12; } else if (ct < 28) { bt = ct + 8; kind = MK_GS; pn = ct - 20; } else { bt = ct + 8; kind = MK_GR; pn = ct - 28; }
        } else if (w < N_NORM + N_CTXS) {
            w -= N_NORM; pm = 32 + (w & 1); at = pm; const int ct = w >> 1;
            if (ct < 4) { bt = ct; pn = ct; kind = MK_S; } else { bt = ct + 4; pn = ct - 4; kind = MK_K; }
        } else {
            w -= N_NORM + N_CTXS; swapped = true;
            const int tt = w >> 3, ft = w & 7;
            bt = tt; pn = tt; at = 12 + ft; pm = ft; kind = MK_VT;
        }
        const char* abase = swapped ? WM : U; const char* bbase = swapped ? U : WM;
        u = pg8::make_unit(abase + (size_t)at * tstep, bbase + (size_t)bt * tstep, pm, pn, kind, D / 64, 0);
        return true;
    }
};

constexpr int RING_BYTES = 131072, LDSCTL_OFF = 143360, MISC_OFF = LDSCTL_OFF + 320, LDS_BYTES = 147456;
struct Args { const float* in[22]; float* out; unsigned char* ws; };
struct Frame {
    LAS unsigned char* lds; volatile LAS unsigned* MISC; unsigned* ctl;
    int wave, vcu, G;
    float* out; unsigned char* ws;
};
typedef const Args __attribute__((address_space(4)))* KArgsPtr;
__device__ __forceinline__ KArgsPtr kargs() { KArgsPtr p = (KArgsPtr)__builtin_amdgcn_kernarg_segment_ptr(); asm volatile("" : "+s"(p)); return p; }
#define FIN(k) ((const float*)kargs()->in[k])

__device__ __forceinline__ int map_pair(int n, int half) { const int h = n < half ? n : n - half, up = n >= half; return 256 * (h >> 7) + 128 * up + (h & 127); }
__device__ __forceinline__ int map_mix(int n) {
    if (n < 1024 || n >= 3072) return n;
    const int base = n & ~127, d = n & 127, p = d >> 6, e = d & 63, s = e >> 5, i = e & 31, t = 32 * p + i;
    return base + 32 * (t >> 4) + 8 * ((t >> 2) & 3) + 4 * s + (t & 3);
}
template <int MAPID>
__device__ __forceinline__ void transpose_item(const float* W, int ldw, int K, int nblk, bf16* WT, int row_off, int half, LAS float* scr, int item, int lane) {
    const int kb = item / nblk, nb = item % nblk, k0 = 64 * kb, n0 = 32 * nb;
    float wv[32];
#pragma unroll
    for (int i = 0; i < 32; ++i) wv[i] = W[(size_t)(k0 + 2 * i + (lane >> 5)) * ldw + n0 + (lane & 31)];
#pragma unroll
    for (int i = 0; i < 32; ++i) scr[(2 * i + (lane >> 5)) * 33 + (lane & 31)] = wv[i];
    LDS_WAIT(); asm volatile("" ::: "memory");
    const int c = lane & 7;
#pragma unroll
    for (int j = 0; j < 4; ++j) { const int n = (lane >> 3) + 8 * j; const LAS float* s = scr + (8 * c) * 33 + n;
        v4u o; o.x = pk2(s[0 * 33], s[1 * 33]); o.y = pk2(s[2 * 33], s[3 * 33]); o.z = pk2(s[4 * 33], s[5 * 33]); o.w = pk2(s[6 * 33], s[7 * 33]);
        const int nn = n0 + n; const int dr = MAPID == 0 ? nn : (MAPID == 1 ? map_pair(nn, half) : map_mix(nn));
        *(v4u*)(WT + (size_t)(row_off + dr) * K + k0 + 8 * c) = o; }
    LDS_WAIT(); asm volatile("" ::: "memory");
}
__device__ __forceinline__ void sincos_d(double x, double& s, double& c) {
    const double TWO_PI = 6.283185307179586476925286766559;
    x -= TWO_PI * __builtin_rint(x / TWO_PI);
    const double h = 0.125 * x, h2 = h * h;
    double sn = h * (1.0 + h2 * (-1.0 / 6 + h2 * (1.0 / 120 + h2 * (-1.0 / 5040 + h2 * (1.0 / 362880 + h2 * (-1.0 / 39916800 + h2 * (1.0 / 6227020800.0)))))));
    double cs = 1.0 + h2 * (-0.5 + h2 * (1.0 / 24 + h2 * (-1.0 / 720 + h2 * (1.0 / 40320 + h2 * (-1.0 / 3628800 + h2 * (1.0 / 479001600.0 + h2 * (-1.0 / 87178291200.0)))))));
#pragma unroll
    for (int k = 0; k < 3; ++k) { const double s2 = 2.0 * sn * cs, c2 = 1.0 - 2.0 * sn * sn; sn = s2; cs = c2; }
    s = sn; c = cs;
}
__device__ __forceinline__ double exp_d(double x) {
    const double y = x * (1.0 / 4096.0);
    double e = 1.0 + y * (1.0 + y * (0.5 + y * (1.0 / 6 + y * (1.0 / 24 + y * (1.0 / 120 + y * (1.0 / 720))))));
#pragma unroll
    for (int k = 0; k < 12; ++k) e = e * e;
    return e;
}
__device__ __forceinline__ double log1p_small_d(double z) {
    const double t = z / (2.0 + z), t2 = t * t;
    return 2.0 * t * (1.0 + t2 * (1.0 / 3 + t2 * (1.0 / 5 + t2 * (1.0 / 7 + t2 * (1.0 / 9 + t2 * (1.0 / 11))))));
}

__device__ __forceinline__ void phase_prologue(Frame& F0, const Args& args, const bool do_ada) {
    Frame& F = F0; int lane_ = lane_id(); asm volatile("" : "+v"(lane_));
    LAS float* scr = (LAS float*)(F.lds + F.wave * 16384);
    const int gw = F.vcu * NWAVES + F.wave, NGW = F.G * NWAVES;
    unsigned char* ws = F.ws;
    {
        const int gt = gw * 64 + lane_, NT = NGW * 64;
        unsigned char* tab = ws + WS_TAB;
        for (int idx = gt; idx < 2048; idx += NT) {
            const int pos = idx >> 5, i = idx & 31;
            const double inv = exp_d(-(double)i * (9.210340371976182736 / 32.0));
            double s, c; sincos_d((double)pos * inv, s, c);
            ((f32x2*)(tab + TAB_ROPE))[idx] = (f32x2){(float)c, (float)s};
        }
        for (int idx = gt; idx < 16; idx += NT) {
            const double x = (double)FIN(19)[idx];
            ((float*)(tab + TAB_LG2))[idx] = (float)(-log1p_small_d(exp_d(-x)) * 1.4426950408889634074);
        }
        for (int idx = gt; idx < 2 * 64 * 64; idx += NT) {
            const int dg = idx >> 6, p = idx & 63;
            const double lr = (double)FIN(10)[idx], li = (double)FIN(11)[idx], step = exp_d((double)FIN(12)[dg]);
            const double mag = exp_d(lr * step); double sn, cs; sincos_d(li * step, sn, cs);
            const double ar = mag * cs, ai = mag * sn, den = lr * lr + li * li, nr = ar - 1.0, ni = ai;
            const double kr = (nr * lr + ni * li) / den, ki = (ni * lr - nr * li) / den;
            ((float*)(tab + TAB_AR))[idx] = (float)ar; ((float*)(tab + TAB_AI))[idx] = (float)ai;
            { f32x2* apw = (f32x2*)(ws + WS_S5APOW) + (size_t)dg * 17 * 64 + p; double pr = 1.0, pi = 0.0;
              for (int k = 0; k < 17; ++k) { apw[k * 64] = (f32x2){(float)pr, (float)pi}; const double t = pr * ar - pi * ai; pi = pr * ai + pi * ar; pr = t; } }
            float* brf = (float*)(ws + WS_S5BRF) + (size_t)idx * 32;
            const float* bre = FIN(13) + (size_t)idx * 16; const float* bim = FIN(14) + (size_t)idx * 16;
            for (int c = 0; c < 16; ++c) { const double br = (double)bre[c], bi = (double)bim[c];
                brf[2 * c] = (float)(kr * br - ki * bi); brf[2 * c + 1] = (float)(kr * bi + ki * br); }
        }
    }
    if (do_ada) {
        float* ADA = (float*)(ws + WS_CTL + CTL_ADA);
        const float* aw = FIN(4);
        for (int it = gw; it < 16 * 72; it += NGW) {
            const int kc = it / 72, cb = it % 72, k0 = kc * 128, col = cb * 256 + 4 * lane_;
            for (int i = lane_; i < 384; i += 64) { const int v = i >> 7, k = i & 127; const float x = v == 0 ? FIN(1)[k0 + k] : (v == 1 ? FIN(1)[D + k0 + k] : FIN(3)[k0 + k]); scr[i] = x / (1.0f + __expf(-x)); }
            LDS_WAIT(); asm volatile("" ::: "memory");
            f32x4 a0 = {0.f, 0.f, 0.f, 0.f}, a1 = a0, a2 = a0;
#pragma unroll 8
            for (int k = 0; k < 128; ++k) { const f32x4 w = *(const f32x4*)(aw + (size_t)(k0 + k) * NADA + col); a0 += w * scr[k]; a1 += w * scr[128 + k]; a2 += w * scr[256 + k]; }
#pragma unroll
            for (int j = 0; j < 4; ++j) { __hip_atomic_fetch_add(ADA + col + j, a0[j], RLX_AGENT); __hip_atomic_fetch_add(ADA + NADA + col + j, a1[j], RLX_AGENT); __hip_atomic_fetch_add(ADA + 2 * NADA + col + j, a2[j], RLX_AGENT); }
            LDS_WAIT(); asm volatile("" ::: "memory");
        }
    }
    {
        constexpr int I1 = (D / 64) * (NFF / 32), I2 = (DFF / 64) * (D / 32), IM = (D / 64) * (NMIX / 32), IK = (D / 64) * (1024 / 32), IG = (SW / 64) * (2 * D / 32), IP = (D / 64) * (D / 32);
        constexpr int NITEMS = 2 * I1 + 2 * I2 + IM + IG + 2 * IP;
        for (int it = gw; it < NITEMS; it += NGW) {
            int r = it;
            if (r < I2) { transpose_item<0>(FIN(8) + (size_t)DFF * D, D, DFF, D / 32, (bf16*)(ws + WS_W4T), 0, 0, scr, r, lane_); continue; } r -= I2;
            if (r < I1) { transpose_item<1>(FIN(7) + (size_t)D * NFF, NFF, D, NFF / 32, (bf16*)(ws + WS_W3T), 0, DFF, scr, r, lane_); continue; } r -= I1;
            if (r < IP) { transpose_item<0>(FIN(21), D, D, D / 32, (bf16*)(ws + WS_WOT), 0, 0, scr, r, lane_); continue; } r -= IP;
            if (r < IP) { transpose_item<0>(FIN(20), D, D, D / 32, (bf16*)(ws + WS_WPT), 0, 0, scr, r, lane_); continue; } r -= IP;
            if (r < IG) { transpose_item<1>(FIN(18), 2 * D, SW, 2 * D / 32, (bf16*)(ws + WS_WGT), 0, D, scr, r, lane_); continue; } r -= IG;
            if (r < IM) { transpose_item<2>(FIN(9), NMIX, D, NMIX / 32, (bf16*)(ws + WS_WMT), 0, 0, scr, r, lane_); continue; } r -= IM;
            if (r < I2) { transpose_item<0>(FIN(8), D, DFF, D / 32, (bf16*)(ws + WS_W2T), 0, 0, scr, r, lane_); continue; } r -= I2;
            transpose_item<1>(FIN(7), NFF, D, NFF / 32, (bf16*)(ws + WS_W1T), 0, DFF, scr, r, lane_);
        }
    }
}

template <int MODE>
__device__ __forceinline__ void phase_rows(Frame& F0, const Args& args) {
    Frame& F = F0; int lane_ = lane_id(); asm volatile("" : "+v"(lane_));
    const int gw = F.vcu * NWAVES + F.wave, NGW = F.G * NWAVES;
    const float* ADA = (const float*)(F.ws + WS_CTL + CTL_ADA);
    const float* adab = FIN(5); const float* ng = FIN(6);
    const bf16* O = (const bf16*)(F.ws + WS_OBUF);
    bf16* A = (bf16*)(F.ws + WS_ABUF);
    const int nrows = (MODE <= 1) ? MT : MX;
    for (int r = gw; r < nrows; r += NGW) {
        const int av = r < MX ? (r >> 12) : 2;
        const float* ada = ADA + (size_t)av * NADA;
        f32x4 h[8];
        const float* hsrc = (MODE <= 1) ? (r < MX ? FIN(0) + (size_t)r * D : FIN(2) + (size_t)(r - MX) * D) : F.out + (size_t)r * D;
#pragma unroll
        for (int j = 0; j < 8; ++j) h[j] = *(const f32x4*)(hsrc + 256 * j + 4 * lane_);
        if (MODE >= 1) {
            constexpr int ipost = MODE - 1;
            const float resw = (MODE == 2) ? 1.0f : 0.5f;
            f32x4 o[8]; float ss = 0.f;
#pragma unroll
            for (int j = 0; j < 8; ++j) {
                if (MODE == 1 && r >= MX) { const float* sl = (const float*)(F.ws + WS_SLAB) + (size_t)(r - MX) * D + 256 * j + 4 * lane_; f32x4 a = *(const f32x4*)sl;
#pragma unroll
                    for (int s = 1; s < CTX_SPLIT; ++s) a += *(const f32x4*)(sl + (size_t)s * MC * D);
                    o[j] = a; }
                else { const v2u t = *(const v2u*)(O + (size_t)r * D + 256 * j + 4 * lane_); o[j] = (f32x4){bflo(t.x), bfhi(t.x), bflo(t.y), bfhi(t.y)}; }
                ss += (o[j][0] * o[j][0] + o[j][1] * o[j][1]) + (o[j][2] * o[j][2] + o[j][3] * o[j][3]); }
            const float rstd = 1.0f / sqrtf(wave_sum(ss, lane_) * (1.0f / D) + EPS);
#pragma unroll
            for (int j = 0; j < 8; ++j) { const int c = 256 * j + 4 * lane_;
                const f32x4 gate = *(const f32x4*)(ada + (3 * ipost + 2) * D + c) + *(const f32x4*)(adab + (3 * ipost + 2) * D + c);
                const f32x4 g = *(const f32x4*)(ng + (2 * ipost + 1) * D + c);
                h[j] = h[j] + (resw * rstd) * (gate * (o[j] * g)); }
            if (r < MX) {
#pragma unroll
                for (int j = 0; j < 8; ++j) *(f32x4*)(F.out + (size_t)r * D + 256 * j + 4 * lane_) = h[j];
            }
        }
        if (MODE <= 2) {
            constexpr int ipre = MODE;
            float ss = 0.f;
#pragma unroll
            for (int j = 0; j < 8; ++j) ss += (h[j][0] * h[j][0] + h[j][1] * h[j][1]) + (h[j][2] * h[j][2] + h[j][3] * h[j][3]);
            const float rstd = 1.0f / sqrtf(wave_sum(ss, lane_) * (1.0f / D) + EPS);
#pragma unroll
            for (int j = 0; j < 8; ++j) { const int c = 256 * j + 4 * lane_;
                const f32x4 shift = *(const f32x4*)(ada + (3 * ipre) * D + c) + *(const f32x4*)(adab + (3 * ipre) * D + c);
                const f32x4 scale = *(const f32x4*)(ada + (3 * ipre + 1) * D + c) + *(const f32x4*)(adab + (3 * ipre + 1) * D + c);
                const f32x4 g = *(const f32x4*)(ng + (2 * ipre) * D + c);
                const f32x4 v = (h[j] * rstd) * g * (scale + 1.0f) + shift;
                v2u w; w.x = cvt_pk_bf16(v[0], v[1]); w.y = cvt_pk_bf16(v[2], v[3]);
                *(v2u*)(A + (size_t)r * D + c) = w; }
        }
    }
}

__device__ __forceinline__ void cpow_f(float ar, float ai, int k, float& pr, float& pi) {
    float rr = 1.f, ri = 0.f, br = ar, bi = ai;
#pragma unroll
    for (int bit = 0; bit < 5; ++bit) { if (k & (1 << bit)) { const float t = rr * br - ri * bi; ri = rr * bi + ri * br; rr = t; } const float t2 = br * br - bi * bi; bi = 2.f * br * bi; br = t2; }
    pr = rr; pi = ri;
}
__device__ __forceinline__ void s5_tables1(Frame& F, const Args& args) {
    int lane_ = lane_id(); asm volatile("" : "+v"(lane_));
    const int gt = (F.vcu * NWAVES + F.wave) * 64 + lane_, NT = F.G * NWAVES * 64;
    const f32x2* APW = (const f32x2*)(F.ws + WS_S5APOW);
    const float* BRF = (const float*)(F.ws + WS_S5BRF);
    const float* cre = FIN(15); const float* cim = FIN(16);
    float* KT = (float*)(F.ws + WS_S5KT); bf16* WE = (bf16*)(F.ws + WS_S5WE); bf16* WY2 = (bf16*)(F.ws + WS_S5WY2);
    for (int idx = gt; idx < 64 * 2 * 16 * 16 * 4; idx += NT) {
        const int c4 = idx & 3, c = (idx >> 2) & 15, k = (idx >> 6) & 15, dir = (idx >> 10) & 1, g = idx >> 11, dg = dir * 64 + g;
        const f32x2* ap = APW + (size_t)(dg * 17 + k) * 64; const float* cr = cre + (dg * 16 + c) * 64; const float* ci = cim + (dg * 16 + c) * 64;
        const float* br = BRF + (size_t)dg * 64 * 32 + c4 * 8;
        f32x4 acc = {0.f, 0.f, 0.f, 0.f};
#pragma unroll 8
        for (int p = 0; p < 64; ++p) {
            const f32x2 a = ap[p]; const float Cr = cr[p], Ci = ci[p], Gr = Cr * a[0] - Ci * a[1], Gi = Cr * a[1] + Ci * a[0];
            const f32x4 b0 = *(const f32x4*)(br + p * 32), b1 = *(const f32x4*)(br + p * 32 + 4);
            acc[0] += Gr * b0[0] - Gi * b0[1]; acc[1] += Gr * b0[2] - Gi * b0[3]; acc[2] += Gr * b1[0] - Gi * b1[1]; acc[3] += Gr * b1[2] - Gi * b1[3];
        }
        *(f32x4*)(KT + ((size_t)((g * 2 + dir) * 16 + k) * 16 + c) * 16 + c4 * 4) = acc;
    }
    for (int idx = gt; idx < 64 * 256 * 16; idx += NT) {
        const int s = idx & 15, r = (idx >> 4) & 255, g = idx >> 12, dir = r >> 7, part = (r >> 6) & 1, p = r & 63, dg = dir * 64 + g;
        const f32x2 a = APW[(size_t)(dg * 17 + (dir ? s : 15 - s)) * 64 + p]; const float pr = a[0], pi = a[1];
        const f32x4* b4 = (const f32x4*)(BRF + (size_t)(dg * 64 + p) * 32);
        float v[16];
#pragma unroll
        for (int j = 0; j < 8; ++j) { const f32x4 q = b4[j]; v[2 * j] = part ? (pr * q[1] + pi * q[0]) : (pr * q[0] - pi * q[1]); v[2 * j + 1] = part ? (pr * q[3] + pi * q[2]) : (pr * q[2] - pi * q[3]); }
        bf16* o = WE + ((size_t)(g * 256 + r)) * 256 + s * 16;
        v4u w0, w1; w0.x = pk2(v[0], v[1]); w0.y = pk2(v[2], v[3]); w0.z = pk2(v[4], v[5]); w0.w = pk2(v[6], v[7]); w1.x = pk2(v[8], v[9]); w1.y = pk2(v[10], v[11]); w1.z = pk2(v[12], v[13]); w1.w = pk2(v[14], v[15]);
        *(v4u*)o = w0; *(v4u*)(o + 8) = w1;
    }
    for (int idx = gt; idx < 64 * 256 * 32; idx += NT) {
        const int cb = idx & 31, row = (idx >> 5) & 255, g = idx >> 13, t = row >> 4, c = row & 15, col0 = 8 * cb, dir = col0 >> 7, part = (col0 >> 6) & 1, p0 = col0 & 63, dg = dir * 64 + g;
        const f32x2* ap = APW + (size_t)(dg * 17 + (dir ? 16 - t : t + 1)) * 64 + p0; const float* cr = cre + (dg * 16 + c) * 64 + p0; const float* ci = cim + (dg * 16 + c) * 64 + p0;
        float v[8];
#pragma unroll
        for (int j = 0; j < 8; ++j) { const f32x2 a = ap[j]; const float Cr = cr[j], Ci = ci[j]; v[j] = part ? -(Cr * a[1] + Ci * a[0]) : (Cr * a[0] - Ci * a[1]); }
        v4u w; w.x = pk2(v[0], v[1]); w.y = pk2(v[2], v[3]); w.z = pk2(v[4], v[5]); w.w = pk2(v[6], v[7]);
        *(v4u*)(WY2 + ((size_t)(g * 256 + row)) * 256 + col0) = w;
    }
}
__device__ __forceinline__ void s5_tables2(Frame& F, const Args& args) {
    int lane_ = lane_id(); asm volatile("" : "+v"(lane_));
    const int gt = (F.vcu * NWAVES + F.wave) * 64 + lane_, NT = F.G * NWAVES * 64;
    const float* KT = (const float*)(F.ws + WS_S5KT); bf16* WY1 = (bf16*)(F.ws + WS_S5WY1); const float* dskip = FIN(17);
    for (int idx = gt; idx < 64 * 256 * 16; idx += NT) {
        const int s = idx & 15, row = (idx >> 4) & 255, g = idx >> 12, t = row >> 4, c = row & 15;
        float v[16];
#pragma unroll
        for (int j = 0; j < 16; ++j) v[j] = 0.f;
        if (s <= t) { const f32x4* k4 = (const f32x4*)(KT + ((size_t)((g * 2 + 0) * 16 + (t - s)) * 16 + c) * 16);
#pragma unroll
            for (int j = 0; j < 4; ++j) { const f32x4 q = k4[j]; v[4 * j] += q[0]; v[4 * j + 1] += q[1]; v[4 * j + 2] += q[2]; v[4 * j + 3] += q[3]; } }
        if (s >= t) { const f32x4* k4 = (const f32x4*)(KT + ((size_t)((g * 2 + 1) * 16 + (s - t)) * 16 + c) * 16);
#pragma unroll
            for (int j = 0; j < 4; ++j) { const f32x4 q = k4[j]; v[4 * j] += q[0]; v[4 * j + 1] += q[1]; v[4 * j + 2] += q[2]; v[4 * j + 3] += q[3]; } }
        if (s == t) { const float dk = dskip[16 * g + c];
#pragma unroll
            for (int j = 0; j < 16; ++j) v[j] += (j == c) ? dk : 0.f; }
        bf16* o = WY1 + ((size_t)(g * 256 + row)) * 256 + s * 16;
        v4u w0, w1; w0.x = pk2(v[0], v[1]); w0.y = pk2(v[2], v[3]); w0.z = pk2(v[4], v[5]); w0.w = pk2(v[6], v[7]); w1.x = pk2(v[8], v[9]); w1.y = pk2(v[10], v[11]); w1.z = pk2(v[12], v[13]); w1.w = pk2(v[14], v[15]);
        *(v4u*)o = w0; *(v4u*)(o + 8) = w1;
    }
}
struct S5EOrder {
    const char* ZU; const char* WE; int G, c;
    __device__ __forceinline__ bool next(int i, pg8::Unit& u) const {
        const long L = (long)i * G + c; if (L >= 256) return false;
        const int bg = (int)L >> 1, rt = (int)L & 1, g = bg & 63;
        u = pg8::make_unit(ZU + ((size_t)(bg * S5_ROWS + 256 * rt)) * 512, WE + (size_t)g * 256 * 512, bg, rt, 0, 4, 0); return true;
    }
};
struct EpiS5E {
    bf16* E;
    __device__ __forceinline__ void operator()(const Acc& acc, const pg8::Unit& u, int wr, int wc, int fr0, int fq0) const {
        int fr = fr0, fq = fq0; asm volatile("" : "+v"(fr), "+v"(fq));
#pragma unroll
        for (int ai = 0; ai < 2; ++ai)
#pragma unroll
            for (int m = 0; m < 4; ++m) {
                const int crow = 256 * u.pn() + ai * 128 + wr * 64 + m * 16 + fr;
                if (crow < S5_ROWS) {
#pragma unroll
                    for (int bj = 0; bj < 2; ++bj) {
                        const f32x4 a = acc[ai][bj][m][0], b = acc[ai][bj][m][1];
                        v4u w; w.x = cvt_pk_bf16(a[0], a[1]); w.y = cvt_pk_bf16(a[2], a[3]); w.z = cvt_pk_bf16(b[0], b[1]); w.w = cvt_pk_bf16(b[2], b[3]);
                        *(v4u*)(E + ((size_t)(u.pm() * S5_ROWS + crow)) * 256 + bj * 128 + wc * 32 + 8 * fq) = w;
                    }
                }
            }
    }
};
struct S5YOrder {
    const char* ZU; const char* ZH; const char* WY1; const char* WY2; int G, c;
    __device__ __forceinline__ bool next(int i, pg8::Unit& u) const {
        const int bg = (i >> 1) * G + c, seg = i & 1; if (bg >= NB * 64) return false;
        const int g = bg & 63;
        const char* a = seg == 0 ? ZU + ((size_t)(bg * S5_ROWS)) * 512 : ZH + ((size_t)(bg * 256)) * 512;
        const char* b = (seg == 0 ? WY1 : WY2) + (size_t)g * 256 * 512;
        u = pg8::make_unit(a, b, bg, 0, 0, 4, seg == 0 ? 1 : 0); return true;
    }
};
struct EpiS5Y {
    bf16* AGLU;
    __device__ __forceinline__ void operator()(const Acc& acc, const pg8::Unit& u, int wr, int wc, int fr0, int fq0) const {
        int fr = fr0, fq = fq0; asm volatile("" : "+v"(fr), "+v"(fq));
        const int b_ = u.pm() >> 6, g = u.pm() & 63;
#pragma unroll
        for (int ai = 0; ai < 2; ++ai)
#pragma unroll
            for (int m = 0; m < 4; ++m) {
                const int chunk = ai * 128 + wr * 64 + m * 16 + fr;
#pragma unroll
                for (int bj = 0; bj < 2; ++bj) {
                    const int cc = bj * 128 + wc * 32 + 8 * fq, t = cc >> 4, c0 = cc & 15;
                    const f32x4 a = acc[ai][bj][m][0], b = acc[ai][bj][m][1];
                    v4u w; w.x = cvt_pk_bf16(gelu_tanh(a[0]), gelu_tanh(a[1])); w.y = cvt_pk_bf16(gelu_tanh(a[2]), gelu_tanh(a[3])); w.z = cvt_pk_bf16(gelu_tanh(b[0]), gelu_tanh(b[1])); w.w = cvt_pk_bf16(gelu_tanh(b[2]), gelu_tanh(b[3]));
                    *(v4u*)(AGLU + ((size_t)(b_ * SEQ + chunk * 16 + t)) * SW + 16 * g + c0) = w;
                }
            }
    }
};
__device__ __forceinline__ void s5_scan_unit(Frame& F, int bg, int dir, int tid) {
    const bf16* E = (const bf16*)(F.ws + WS_S5E); bf16* ZH = (bf16*)(F.ws + WS_S5ZH);
    LAS bf16* EL = (LAS bf16*)F.lds;
    for (int i = tid; i < S5_ROWS * 16; i += NWAVES * 64) { const int row = i >> 4, ck = i & 15; *(LAS v4u*)(EL + row * 128 + ck * 8) = *(const v4u*)(E + ((size_t)(bg * S5_ROWS + row)) * 256 + dir * 128 + ck * 8); }
    __syncthreads();
    if (tid < 64) {
        const int p = tid, g = bg & 63;
        float ar = ((const float*)(F.ws + WS_TAB + TAB_AR))[(dir * 64 + g) * 64 + p], ai = ((const float*)(F.ws + WS_TAB + TAB_AI))[(dir * 64 + g) * 64 + p];
#pragma unroll
        for (int k = 0; k < 4; ++k) { const float nr = ar * ar - ai * ai, ni = 2.f * ar * ai; ar = nr; ai = ni; }
        float hr = 0.f, hi = 0.f;
#pragma unroll 8
        for (int k = 0; k < S5_ROWS; ++k) {
            const int row = dir ? (S5_ROWS - 1 - k) : (k < 16 ? 256 + k : k - 16);
            const float er = bflo((unsigned)EL[row * 128 + p]), ei = bflo((unsigned)EL[row * 128 + 64 + p]);
            EL[row * 128 + p] = (bf16)f2bf(hr); EL[row * 128 + 64 + p] = (bf16)f2bf(hi);
            const float nr = ar * hr - ai * hi + er, ni = ar * hi + ai * hr + ei; hr = nr; hi = ni;
        }
    }
    __syncthreads();
    for (int i = tid; i < 256 * 16; i += NWAVES * 64) { const int row = i >> 4, ck = i & 15; *(v4u*)(ZH + ((size_t)(bg * 256 + row)) * 256 + dir * 128 + ck * 8) = *(const LAS v4u*)(EL + row * 128 + ck * 8); }
    __syncthreads();
}

constexpr int RS_PITCH = 136;
constexpr int RS_BUF = (128 + 32) * RS_PITCH * 2;
__device__ __forceinline__ void phase_rstate(Frame& F) {
    const bf16* KNL = (const bf16*)(F.ws + WS_K); const bf16* KNC = (const bf16*)(F.ws + WS_KFTC);
    const bf16* VT = (const bf16*)(F.ws + WS_VT); const bf16* VTC = (const bf16*)(F.ws + WS_VTC);
    bf16* SIN = (bf16*)(F.ws + WS_OBUF);
    const float* lg2 = (const float*)(F.ws + WS_TAB + TAB_LG2);
    const int lane0 = lane_id();
    const int w = F.wave;
    for (int unit = F.vcu; unit < NB * NH * 2 * 8; unit += F.G) {
        int lane = lane0; asm volatile("" : "+v"(lane));
        const int tid = w * 64 + lane, fr = lane & 15, fq = lane >> 4;
        const int sl = unit & 7, dir = (unit >> 3) & 1, h = (unit >> 4) & 7, b = unit >> 7;
        const float gC = __builtin_amdgcn_exp2f((float)CH * lg2[dir * 8 + h]);
        const int bh = b * NH + h;
        const bf16* kT = KNL; const bf16* kTc = KNC;
        const int prow = tid >> 4, pc = tid & 15;
        float kw[4];
#pragma unroll
        for (int i_ = 0; i_ < 4; ++i_) { const int j = prow + 32 * i_; kw[i_] = __builtin_amdgcn_exp2f((float)(dir ? j : CH - 1 - j) * lg2[dir * 8 + h]); }
        f32x4 st[2] = {{0.f, 0.f, 0.f, 0.f}, {0.f, 0.f, 0.f, 0.f}};
#define RS_ISSUE(k, R) do { if ((k) < 34) { const bf16* kb_; const bf16* vb_; int ls_; \
            if ((k) < 2) { const int cc_ = dir ? (1 - (k)) : (k); ls_ = LC; kb_ = kTc + (size_t)(b * LC + cc_ * CH) * 1024 + h * DK; vb_ = VTC + (size_t)(bh * DV + 32 * sl) * LC + cc_ * CH; } \
            else { const int n_ = dir ? (33 - (k)) : ((k) - 2); ls_ = SEQ; kb_ = kT + (size_t)(b * SEQ + n_ * CH) * 1024 + h * DK; vb_ = VT + (size_t)(bh * DV + 32 * sl) * SEQ + n_ * CH; } \
            _Pragma("unroll") for (int i_ = 0; i_ < 4; ++i_) R[i_] = *(const v4u*)(kb_ + (size_t)(prow + 32 * i_) * 1024 + pc * 8);     \
            R[4] = *(const v4u*)(vb_ + (size_t)prow * ls_ + pc * 8); } } while (0)
#define RS_STEP(k, R) do { LAS bf16* buf_ = (LAS bf16*)(F.lds + ((k) & 1) * RS_BUF); \
            _Pragma("unroll") for (int i_ = 0; i_ < 4; ++i_) { const v4u r_ = R[i_]; const float w_ = kw[i_]; v4u s_; \
                s_.x = cvt_pk_bf16(bflo(r_.x) * w_, bfhi(r_.x) * w_); s_.y = cvt_pk_bf16(bflo(r_.y) * w_, bfhi(r_.y) * w_); s_.z = cvt_pk_bf16(bflo(r_.z) * w_, bfhi(r_.z) * w_); s_.w = cvt_pk_bf16(bflo(r_.w) * w_, bfhi(r_.w) * w_); \
                *(LAS v4u*)(buf_ + (prow + 32 * i_) * RS_PITCH + pc * 8) = s_; } \
            *(LAS v4u*)(buf_ + (128 + prow) * RS_PITCH + pc * 8) = R[4]; } while (0)
#define RS_COMP(k) do { const LAS bf16* buf_ = (const LAS bf16*)(F.lds + ((k) & 1) * RS_BUF); \
            const int n_ = (k) < 2 ? -1 : (dir ? (33 - (k)) : ((k) - 2)); \
            if (n_ >= 0) { _Pragma("unroll") for (int et = 0; et < 2; ++et) { v2u o; o.x = cvt_pk_bf16(st[et][0], st[et][1]); o.y = cvt_pk_bf16(st[et][2], st[et][3]); \
                *(v2u*)(SIN + ((((size_t)(bh * 2 + dir) * NCH + n_) * DV + 32 * sl + 16 * et + fr) * DK + 16 * w + 4 * fq)) = o; } } \
            bf16x8 kf_[4];                         \
            { const unsigned ta_ = (unsigned)(size_t)buf_ + (unsigned)((8 * fq + (fr >> 2)) * (RS_PITCH * 2) + (16 * w + 4 * (fr & 3)) * 2); v2u t0_, t1_, t2_, t3_, t4_, t5_, t6_, t7_; \
              asm volatile("ds_read_b64_tr_b16 %0, %8\n\tds_read_b64_tr_b16 %1, %8 offset:1088\n\tds_read_b64_tr_b16 %2, %8 offset:8704\n\tds_read_b64_tr_b16 %3, %8 offset:9792\n\t" \
                           "ds_read_b64_tr_b16 %4, %8 offset:17408\n\tds_read_b64_tr_b16 %5, %8 offset:18496\n\tds_read_b64_tr_b16 %6, %8 offset:26112\n\tds_read_b64_tr_b16 %7, %8 offset:27200\n\ts_waitcnt lgkmcnt(0)" \
                           : "=&v"(t0_), "=&v"(t1_), "=&v"(t2_), "=&v"(t3_), "=&v"(t4_), "=&v"(t5_), "=&v"(t6_), "=&v"(t7_) : "v"(ta_) : "memory"); \
              kf_[0] = __builtin_bit_cast(bf16x8, (v4u){t0_.x, t0_.y, t1_.x, t1_.y}); kf_[1] = __builtin_bit_cast(bf16x8, (v4u){t2_.x, t2_.y, t3_.x, t3_.y}); \
              kf_[2] = __builtin_bit_cast(bf16x8, (v4u){t4_.x, t4_.y, t5_.x, t5_.y}); kf_[3] = __builtin_bit_cast(bf16x8, (v4u){t6_.x, t6_.y, t7_.x, t7_.y}); } \
            _Pragma("unroll") for (int et = 0; et < 2; ++et) { f32x4 kv = {0.f, 0.f, 0.f, 0.f}; \
                _Pragma("unroll") for (int ks = 0; ks < 4; ++ks) { const bf16x8 vf_ = *(const LAS bf16x8*)(buf_ + (128 + 16 * et + fr) * RS_PITCH + 32 * ks + 8 * fq); kv = __builtin_amdgcn_mfma_f32_16x16x32_bf16(kf_[ks], vf_, kv, 0, 0, 0); } \
                st[et] = st[et] * gC + kv; } } while (0)
        v4u RA[5], RB[5], RC[5];
        RS_ISSUE(0, RA); RS_ISSUE(1, RB);
        for (int k = 0; k < 34; k += 3) {
            RS_ISSUE(k + 2, RC);
            RS_STEP(k, RA); __syncthreads(); RS_COMP(k);
            RS_ISSUE(k + 3, RA);
            if (k + 1 < 34) { RS_STEP(k + 1, RB); __syncthreads(); RS_COMP(k + 1); }
            RS_ISSUE(k + 4, RB);
            if (k + 2 < 34) { RS_STEP(k + 2, RC); __syncthreads(); RS_COMP(k + 2); }
        }
        __syncthreads();
#undef RS_ISSUE
#undef RS_STEP
#undef RS_COMP
    }
}

constexpr int RO_PITCH = 136;
constexpr int RO_SLOT = 256 * RO_PITCH * 2;
__device__ __forceinline__ void phase_rout(Frame& F) {
    const bf16* Q = (const bf16*)(F.ws + WS_Q);
    const bf16* KN = (const bf16*)(F.ws + WS_K); const bf16* VT = (const bf16*)(F.ws + WS_VT);
    const bf16* SIN = (const bf16*)(F.ws + WS_OBUF);
    bf16* SG = (bf16*)(F.ws + WS_HBUF);
    const float* lg2 = (const float*)(F.ws + WS_TAB + TAB_LG2);
    LAS bf16* SA = (LAS bf16*)F.lds; LAS bf16* SB = (LAS bf16*)(F.lds + RO_SLOT);
    const int lane0 = lane_id();
    const int w = F.wave;
    for (int unit = F.vcu; unit < NB * NH * NCH; unit += F.G) {
        int lane = lane0; asm volatile("" : "+v"(lane));
        const int tid = w * 64 + lane, fr = lane & 15, fq = lane >> 4;
        const int n = unit & 31, h = (unit >> 5) & 7, b = unit >> 8, bh = b * NH + h;
        const float lgf = lg2[h], lgb = lg2[8 + h];
        const int tok0 = b * SEQ + n * CH;
        const int i = 16 * w + fr;
        const size_t qoff = (size_t)(tok0 + i) * 1024 + h * DK;
        {
            v4u kr[4], vr[8];
#pragma unroll
            for (int it = 0; it < 4; ++it) { const int q = tid + 512 * it, j = q >> 4, pc = q & 15; kr[it] = *(const v4u*)(KN + (size_t)(tok0 + j) * 1024 + h * DK + pc * 8); }
#pragma unroll
            for (int it = 0; it < 8; ++it) { const int q = tid + 512 * it, e = q >> 4, pc = q & 15; vr[it] = *(const v4u*)(VT + ((size_t)(bh * DV + e)) * SEQ + n * CH + pc * 8); }
#pragma unroll
            for (int it = 0; it < 4; ++it) { const int q = tid + 512 * it, j = q >> 4, pc = q & 15; *(LAS v4u*)(SB + j * RO_PITCH + pc * 8) = kr[it]; }
#pragma unroll
            for (int it = 0; it < 8; ++it) { const int q = tid + 512 * it, e = q >> 4, pc = q & 15; *(LAS v4u*)(SA + e * RO_PITCH + pc * 8) = vr[it]; }
        }
        bf16x8 qf[4];
#pragma unroll
        for (int ks = 0; ks < 4; ++ks) qf[ks] = *(const bf16x8*)(Q + qoff + 32 * ks + 8 * fq);
        __syncthreads();
        f32x4 sc[8];
#pragma unroll
        for (int jt = 0; jt < 8; ++jt) {
            f32x4 a = {0.f, 0.f, 0.f, 0.f};
#pragma unroll
            for (int ks = 0; ks < 4; ++ks) { const bf16x8 kf = *(const LAS bf16x8*)(SB + (16 * jt + fr) * RO_PITCH + 32 * ks + 8 * fq); a = __builtin_amdgcn_mfma_f32_16x16x32_bf16(kf, qf[ks], a, 0, 0, 0); }
#pragma unroll
            for (int r = 0; r < 4; ++r) { const int j = 16 * jt + 4 * fq + r, df = i - j; a[r] *= df >= 0 ? __builtin_amdgcn_exp2f((float)df * lgf) : __builtin_amdgcn_exp2f((float)(-df) * lgb); }
            sc[jt] = a;
        }
        f32x4 o[16];
#pragma unroll
        for (int et = 0; et < 16; ++et) o[et] = (f32x4){0.f, 0.f, 0.f, 0.f};
#pragma unroll
        for (int ks = 0; ks < 4; ++ks) {
            v4u pw; pw.x = cvt_pk_bf16(sc[2 * ks][0], sc[2 * ks][1]); pw.y = cvt_pk_bf16(sc[2 * ks][2], sc[2 * ks][3]); pw.z = cvt_pk_bf16(sc[2 * ks + 1][0], sc[2 * ks + 1][1]); pw.w = cvt_pk_bf16(sc[2 * ks + 1][2], sc[2 * ks + 1][3]);
            const bf16x8 pf = __builtin_bit_cast(bf16x8, pw);
#pragma unroll
            for (int et = 0; et < 16; ++et) {
                const LAS bf16* vp = SA + (16 * et + fr) * RO_PITCH + 32 * ks + 4 * fq;
                const v2u lo = *(const LAS v2u*)vp, hi2 = *(const LAS v2u*)(vp + 16);
                v4u vw; vw.x = lo.x; vw.y = lo.y; vw.z = hi2.x; vw.w = hi2.y;
                o[et] = __builtin_amdgcn_mfma_f32_16x16x32_bf16(__builtin_bit_cast(bf16x8, vw), pf, o[et], 0, 0, 0);
            }
        }
        __syncthreads();
        {
            const bf16* sf = SIN + (((size_t)(bh * 2 + 0) * NCH + n) * DV) * DK; const bf16* sb = SIN + (((size_t)(bh * 2 + 1) * NCH + n) * DV) * DK;
            v4u fr_[8], br_[8];
#pragma unroll
            for (int it = 0; it < 8; ++it) { const int q = tid + 512 * it; fr_[it] = *(const v4u*)(sf + (size_t)q * 8); br_[it] = *(const v4u*)(sb + (size_t)q * 8); }
#pragma unroll
            for (int it = 0; it < 8; ++it) { const int q = tid + 512 * it, e = q >> 4, pc = q & 15; *(LAS v4u*)(SA + e * RO_PITCH + pc * 8) = fr_[it]; *(LAS v4u*)(SB + e * RO_PITCH + pc * 8) = br_[it]; }
        }
        bf16x8 qff[4], qbf[4];
        { const float wfq = __builtin_amdgcn_exp2f((float)(i + 1) * lgf), wbq = __builtin_amdgcn_exp2f((float)(CH - i) * lgb);
#pragma unroll
          for (int ks = 0; ks < 4; ++ks) { const v4u qw = __builtin_bit_cast(v4u, qf[ks]); v4u a, b2;
            a.x = cvt_pk_bf16(bflo(qw.x) * wfq, bfhi(qw.x) * wfq); a.y = cvt_pk_bf16(bflo(qw.y) * wfq, bfhi(qw.y) * wfq); a.z = cvt_pk_bf16(bflo(qw.z) * wfq, bfhi(qw.z) * wfq); a.w = cvt_pk_bf16(bflo(qw.w) * wfq, bfhi(qw.w) * wfq);
            b2.x = cvt_pk_bf16(bflo(qw.x) * wbq, bfhi(qw.x) * wbq); b2.y = cvt_pk_bf16(bflo(qw.y) * wbq, bfhi(qw.y) * wbq); b2.z = cvt_pk_bf16(bflo(qw.z) * wbq, bfhi(qw.z) * wbq); b2.w = cvt_pk_bf16(bflo(qw.w) * wbq, bfhi(qw.w) * wbq);
            qff[ks] = __builtin_bit_cast(bf16x8, a); qbf[ks] = __builtin_bit_cast(bf16x8, b2); } }
        __syncthreads();
#pragma unroll
        for (int ks = 0; ks < 4; ++ks)
#pragma unroll
            for (int et = 0; et < 16; ++et) {
                const bf16x8 s1 = *(const LAS bf16x8*)(SA + (16 * et + fr) * RO_PITCH + 32 * ks + 8 * fq), s2 = *(const LAS bf16x8*)(SB + (16 * et + fr) * RO_PITCH + 32 * ks + 8 * fq);
                o[et] = __builtin_amdgcn_mfma_f32_16x16x32_bf16(s1, qff[ks], o[et], 0, 0, 0);
                o[et] = __builtin_amdgcn_mfma_f32_16x16x32_bf16(s2, qbf[ks], o[et], 0, 0, 0);
            }
        float ss = 0.f;
#pragma unroll
        for (int et = 0; et < 16; ++et) ss += (o[et][0] * o[et][0] + o[et][1] * o[et][1]) + (o[et][2] * o[et][2] + o[et][3] * o[et][3]);
        ss += shfl_xor_l(ss, 16, lane); ss += shfl_xor_l(ss, 32, lane);
        const float rinv = 1.0f / sqrtf(ss * (1.0f / DV) + EPS);
        bf16* gp = SG + (size_t)(tok0 + i) * D + h * DV + 4 * fq;
#pragma unroll
        for (int et = 0; et < 16; ++et) { const v2u gg = *(const v2u*)(gp + 16 * et);
            v2u ow; ow.x = cvt_pk_bf16(o[et][0] * rinv * bflo(gg.x), o[et][1] * rinv * bfhi(gg.x)); ow.y = cvt_pk_bf16(o[et][2] * rinv * bflo(gg.y), o[et][3] * rinv * bfhi(gg.y));
            *(v2u*)(gp + 16 * et) = ow; }
        __syncthreads();
    }
}

__global__ void __launch_bounds__(NWAVES * 64, 2) fwd_megakernel(Args args) {
    extern __shared__ __attribute__((aligned(16))) unsigned char lds[];
    Frame F;
    F.lds = (LAS unsigned char*)lds;
    F.MISC = (volatile LAS unsigned*)(F.lds + MISC_OFF);
    F.wave = __builtin_amdgcn_readfirstlane((int)threadIdx.x >> 6);
    F.G = gridDim.x; { const int bx = blockIdx.x; F.vcu = (F.G % 8 == 0) ? (bx % 8) * (F.G / 8) + bx / 8 : bx; }
    F.out = kargs()->out; F.ws = kargs()->ws; F.ctl = (unsigned*)(F.ws + WS_CTL);
    for (int u = (int)threadIdx.x; u < (LDS_BYTES - LDSCTL_OFF) / 4; u += NWAVES * 64) ((LAS unsigned*)(F.lds + LDSCTL_OFF))[u] = 0u;
    __syncthreads();
    XcdBarrier bar = xcd_barrier_post(F.ctl + CW_BAR, F.MISC + 8);
    unsigned char* ws = F.ws;
    const int G = F.G, cid = (int)blockIdx.x;
#define GRID_BAR() xcd_barrier(bar)

#ifndef PHM
#define PHM 0xFFFFF
#endif
#define PH(k) ((PHM >> (k)) & 1)
#ifndef REPM
#define REPM 0
#endif
#define NREP(k) (1 + ((REPM >> (k)) & 1))
#if PH(0)
    phase_prologue(F, args, true);
#if NREP(0) > 1
    phase_prologue(F, args, false);
#endif
#endif
    GRID_BAR();
#if PH(1)
    phase_rows<0>(F, args);
    s5_tables1(F, args);
#endif
    GRID_BAR();
#if PH(2)
    {
        pg8::GridOrder S; S.init(ws + WS_ABUF, ws + WS_W1T, D, MT / 256, NFF / 256, G, cid);
        EpiSwiGLU E{(bf16*)(ws + WS_HBUF)};
        pg8::gemm_phase(F.lds, D, S, E, F.wave);
    }
#if NREP(2) > 1
    {
        pg8::GridOrder S; S.init(ws + WS_ABUF, ws + WS_W1T, D, MT / 256, NFF / 256, G, cid);
        EpiSwiGLU E{(bf16*)(ws + WS_HBUF)};
        pg8::gemm_phase(F.lds, D, S, E, F.wave);
    }
#endif
#endif
    GRID_BAR();
#if PH(3)
    {
        Ffn1DownOrder S{(const char*)(ws + WS_HBUF), (const char*)(ws + WS_W2T), G, cid};
        EpiFfn1Down E{(bf16*)(ws + WS_OBUF), (float*)(ws + WS_SLAB)};
        pg8::gemm_phase(F.lds, DFF, S, E, F.wave);
    }
#if NREP(3) > 1
    {
        pg8::GridOrder S; S.init(ws + WS_HBUF, ws + WS_W2T, DFF, MT / 256, D / 256, G, cid);
        EpiO16 E{(bf16*)(ws + WS_OBUF), D};
        pg8::gemm_phase(F.lds, DFF, S, E, F.wave);
    }
#endif
#endif
    GRID_BAR();
#if PH(4)
    phase_rows<1>(F, args);
    s5_tables2(F, args);
#endif
    GRID_BAR();
#if PH(5)
    {
        MixOrder S{(const char*)(ws + WS_ABUF), (const char*)(ws + WS_WMT), G, cid};
        EpiMix E{ws};
        pg8::gemm_phase(F.lds, D, S, E, F.wave);
    }
#if NREP(5) > 1
    {
        MixOrder S{(const char*)(ws + WS_ABUF), (const char*)(ws + WS_WMT), G, cid};
        EpiMix E{ws};
        pg8::gemm_phase(F.lds, D, S, E, F.wave);
    }
#endif
#endif
    GRID_BAR();
#if PH(6)
    phase_rstate(F);
#if NREP(6) > 1
    phase_rstate(F);
#endif
#endif
#if PH(7)
    {
        S5EOrder S{(const char*)(ws + WS_US), (const char*)(ws + WS_S5WE), G, cid};
        EpiS5E E{(bf16*)(ws + WS_S5E)};
        pg8::gemm_phase(F.lds, 256, S, E, F.wave);
    }
#endif
    GRID_BAR();
#if PH(8)
    {
        int tid_ = F.wave * 64 + lane_id(); asm volatile("" : "+v"(tid_));
        for (int bg = cid; bg < NB * 64; bg += G) { s5_scan_unit(F, bg, 0, tid_); s5_scan_unit(F, bg, 1, tid_); }
        asm volatile("s_waitcnt vmcnt(0)" ::: "memory"); __syncthreads();
        S5YOrder S{(const char*)(ws + WS_US), (const char*)(ws + WS_S5ZH), (const char*)(ws + WS_S5WY1), (const char*)(ws + WS_S5WY2), G, cid};
        EpiS5Y E{(bf16*)(ws + WS_AGLU)};
        pg8::gemm_phase(F.lds, 256, S, E, F.wave);
    }
    phase_rout(F);
#endif
    GRID_BAR();
#if PH(9)
    {
        pg8::GridOrder S; S.init(ws + WS_AGLU, ws + WS_WGT, SW, MX / 256, 2 * D / 256, G, cid);
        EpiGLU E{(const bf16*)(ws + WS_HBUF + 32 * MiB), (bf16*)(ws + WS_Q)};
        pg8::gemm_phase(F.lds, SW, S, E, F.wave);
    }
#if NREP(9) > 1
    {
        pg8::GridOrder S; S.init(ws + WS_AGLU, ws + WS_WGT, SW, MX / 256, 2 * D / 256, G, cid);
        EpiGLU E{(const bf16*)(ws + WS_HBUF + 32 * MiB), (bf16*)(ws + WS_Q)};
        pg8::gemm_phase(F.lds, SW, S, E, F.wave);
    }
#endif
#endif
    GRID_BAR();
#if PH(10)
    {
        pg8::GridOrder S; S.init(ws + WS_HBUF, ws + WS_WPT, D, MX / 256, D / 256, G, cid);
        EpiMerge E{(const bf16*)(ws + WS_HBUF + 64 * MiB), (bf16*)(ws + WS_Q)};
        pg8::gemm_phase(F.lds, D, S, E, F.wave);
    }
#if NREP(10) > 1
    {
        pg8::GridOrder S; S.init(ws + WS_HBUF, ws + WS_WPT, D, MX / 256, D / 256, G, cid);
        EpiMerge E{(const bf16*)(ws + WS_HBUF + 64 * MiB), (bf16*)(ws + WS_Q)};
        pg8::gemm_phase(F.lds, D, S, E, F.wave);
    }
#endif
#endif
    GRID_BAR();
#if PH(11)
    {
        pg8::GridOrder S; S.init(ws + WS_Q, ws + WS_WOT, D, MX / 256, D / 256, G, cid);
        EpiO16 E{(bf16*)(ws + WS_OBUF), D};
        pg8::gemm_phase(F.lds, D, S, E, F.wave);
    }
#if NREP(11) > 1
    {
        pg8::GridOrder S; S.init(ws + WS_Q, ws + WS_WOT, D, MX / 256, D / 256, G, cid);
        EpiO16 E{(bf16*)(ws + WS_OBUF), D};
        pg8::gemm_phase(F.lds, D, S, E, F.wave);
    }
#endif
#endif
    GRID_BAR();
#if PH(12)
    phase_rows<2>(F, args);
#if NREP(12) > 1
    phase_rows<2>(F, args);
#endif
#endif
    GRID_BAR();
#if PH(13)
    {
        pg8::GridOrder S; S.init(ws + WS_ABUF, ws + WS_W3T, D, MX / 256, NFF / 256, G, cid);
        EpiSwiGLU E{(bf16*)(ws + WS_HBUF)};
        pg8::gemm_phase(F.lds, D, S, E, F.wave);
    }
#if NREP(13) > 1
    {
        pg8::GridOrder S; S.init(ws + WS_ABUF, ws + WS_W3T, D, MX / 256, NFF / 256, G, cid);
        EpiSwiGLU E{(bf16*)(ws + WS_HBUF)};
        pg8::gemm_phase(F.lds, D, S, E, F.wave);
    }
#endif
#endif
    GRID_BAR();
#if PH(14)
    {
        pg8::GridOrder S; S.init(ws + WS_HBUF, ws + WS_W4T, DFF, MX / 256, D / 256, G, cid);
        EpiO16 E{(bf16*)(ws + WS_OBUF), D};
        pg8::gemm_phase(F.lds, DFF, S, E, F.wave);
    }
#if NREP(14) > 1
    {
        pg8::GridOrder S; S.init(ws + WS_HBUF, ws + WS_W4T, DFF, MX / 256, D / 256, G, cid);
        EpiO16 E{(bf16*)(ws + WS_OBUF), D};
        pg8::gemm_phase(F.lds, DFF, S, E, F.wave);
    }
#endif
#endif
    GRID_BAR();
#if PH(15)
    phase_rows<3>(F, args);
#if NREP(15) > 1
    phase_rows<3>(F, args);
#endif
#endif
}

extern "C" void kernel_launch(void* const* d_in, const int* in_sizes, int n_in, void* d_out, int out_size, void* d_ws, size_t ws_size, hipStream_t stream) {
    static int grid = 0;
    if (grid == 0) {
        if (n_in != 22 || in_sizes[0] != MX * D || out_size != MX * D || ws_size < WS_END) { fprintf(stderr, "kernel_launch: unexpected problem (n_in %d, in0 %d, out %d, ws %zu, need %zu)\n", n_in, n_in > 0 ? in_sizes[0] : -1, out_size, ws_size, (size_t)WS_END); grid = -1; return; }
        int dev = 0, cus = 0, per_cu = 0;
        if (hipGetDevice(&dev) != hipSuccess || hipDeviceGetAttribute(&cus, hipDeviceAttributeMultiprocessorCount, dev) != hipSuccess) { grid = -1; return; }
        if (hipFuncSetAttribute((const void*)fwd_megakernel, hipFuncAttributeMaxDynamicSharedMemorySize, LDS_BYTES) != hipSuccess) { fprintf(stderr, "kernel_launch: hipFuncSetAttribute failed\n"); grid = -1; return; }
        if (hipOccupancyMaxActiveBlocksPerMultiprocessor(&per_cu, (const void*)fwd_megakernel, NWAVES * 64, LDS_BYTES) != hipSuccess || per_cu < 1) { fprintf(stderr, "kernel_launch: occupancy query says %d blocks per CU\n", per_cu); grid = -1; (void)hipGetLastError(); return; }
        grid = cus;
    }
    if (grid < 0) return;
    if (hipMemsetAsync((char*)d_ws + WS_CTL, 0, CTL_ZERO_BYTES, stream) != hipSuccess) return;
    Args a{};
    for (int i = 0; i < 22; ++i) a.in[i] = (const float*)d_in[i];
    a.out = (float*)d_out; a.ws = (unsigned char*)d_ws;
    void* kargs[] = {&a};
    hipError_t e = hipLaunchCooperativeKernel((const void*)fwd_megakernel, dim3(grid), dim3(NWAVES * 64), kargs, LDS_BYTES, stream);
    if (e != hipSuccess) fprintf(stderr, "kernel_launch: cooperative launch failed: %s (grid %d)\n", hipGetErrorString(e), grid);
}
```

```cpp
#include <hip/hip_runtime.h>
#include <cstdio>
#include <cstdint>

#define GAS __attribute__((address_space(1)))
#define LAS __attribute__((address_space(3)))
typedef unsigned short bf16;
typedef unsigned v4u __attribute__((ext_vector_type(4)));
typedef unsigned v2u __attribute__((ext_vector_type(2)));
typedef float f32x4 __attribute__((ext_vector_type(4)));
typedef float f32x2 __attribute__((ext_vector_type(2)));
typedef short bf16x8 __attribute__((ext_vector_type(8)));
typedef short bf16x4 __attribute__((ext_vector_type(4)));

constexpr int D = 2048, NB = 2, SEQ = 4096, MX = NB * SEQ, LC = 256, MC = NB * LC, MT = MX + MC;
constexpr int DFF = 5632, NFF = 2 * DFF, SW = 1024, NMIX = 11264, NH = 8, DK = 128, DV = 256, CH = 128, NCH = SEQ / CH;
constexpr int NADA = 9 * D;
constexpr float EPS = 1e-6f;
constexpr int NWAVES = 8;

constexpr size_t MiB = 1u << 20;
constexpr size_t WS_CTL = 0, CTL_ZERO_BYTES = 1 * MiB;
constexpr size_t WS_W1T = 1 * MiB, WS_W2T = 45 * MiB, WS_WMT = 67 * MiB, WS_WGT = 115 * MiB, WS_WPT = 123 * MiB, WS_WOT = 131 * MiB, WS_W3T = 139 * MiB, WS_W4T = 183 * MiB;
constexpr size_t WS_ABUF = 205 * MiB;
constexpr size_t WS_HBUF = 239 * MiB;
constexpr size_t WS_OBUF = 335 * MiB;
constexpr size_t WS_US = 403 * MiB;
constexpr size_t WS_Q = 420 * MiB, WS_QF = 436 * MiB, WS_QB = 452 * MiB;
constexpr size_t WS_K = 468 * MiB;
constexpr size_t WS_KFT = 484 * MiB, WS_KBT = 500 * MiB, WS_KFTC = 516 * MiB, WS_KBTC = 517 * MiB;
constexpr size_t WS_STREAM = WS_KFT;
constexpr size_t WS_VT = 518 * MiB, WS_VTC = 550 * MiB;
constexpr size_t WS_YF = 552 * MiB;
constexpr size_t WS_S5WE = WS_YF, WS_S5WY1 = WS_YF + 8 * MiB, WS_S5WY2 = WS_YF + 16 * MiB, WS_S5KT = WS_YF + 24 * MiB, WS_S5BRF = WS_YF + 26 * MiB, WS_S5APOW = WS_YF + 28 * MiB;
constexpr size_t WS_S5E = WS_ABUF, WS_S5ZH = WS_ABUF + 17 * MiB;
constexpr int S5_ROWS = 272;
constexpr size_t WS_AGLU = 584 * MiB;
constexpr size_t WS_TAB = 600 * MiB;
constexpr size_t WS_END = 602 * MiB;
constexpr size_t TAB_ROPE = 0, TAB_LG2 = 16384, TAB_AR = 32768, TAB_AI = 65536, TAB_END = 131072;
constexpr int CW_BAR = 4096;
constexpr size_t CTL_ADA = 65536;

#define RLX_AGENT __ATOMIC_RELAXED, __HIP_MEMORY_SCOPE_AGENT
#define LDS_WAIT() asm volatile("s_waitcnt lgkmcnt(0)" ::: "memory")
#define VM_WAIT() asm volatile("s_waitcnt vmcnt(0)" ::: "memory")

__device__ __forceinline__ unsigned f2bf(float f) { unsigned u = __builtin_bit_cast(unsigned, f); return (u + 0x7fffu + ((u >> 16) & 1u)) >> 16; }
__device__ __forceinline__ unsigned pk2(float lo, float hi) { return f2bf(lo) | (f2bf(hi) << 16); }
__device__ __forceinline__ unsigned cvt_pk_bf16(float lo, float hi) { unsigned r; asm volatile("v_cvt_pk_bf16_f32 %0, %1, %2" : "=v"(r) : "v"(lo), "v"(hi)); return r; }
__device__ __forceinline__ float bflo(unsigned w) { return __builtin_bit_cast(float, w << 16); }
__device__ __forceinline__ float bfhi(unsigned w) { return __builtin_bit_cast(float, w & 0xffff0000u); }
__device__ __forceinline__ float fast_sigmoid(float x) { return __builtin_amdgcn_rcpf(1.0f + __builtin_amdgcn_exp2f(-1.4426950408889634f * x)); }
__device__ __forceinline__ float fast_silu(float x) { return x * fast_sigmoid(x); }
__device__ __forceinline__ float gelu_tanh(float x) { const float u = 0.7978845608028654f * (x + 0.044715f * x * x * x); return x * fast_sigmoid(2.0f * u); }
__device__ __forceinline__ int lane_id() { return (int)__builtin_amdgcn_mbcnt_hi(~0u, __builtin_amdgcn_mbcnt_lo(~0u, 0u)); }
__device__ __forceinline__ float shfl_xor_l(float v, int mask, int lane) { return __builtin_bit_cast(float, __builtin_amdgcn_ds_bpermute((lane ^ mask) << 2, __builtin_bit_cast(int, v))); }
__device__ __forceinline__ float wave_sum(float v, int lane) {
#pragma unroll
    for (int o = 1; o < 64; o <<= 1) v += shfl_xor_l(v, o, lane);
    return v;
}

#define XB_TMO      128
#define XB_XCNT(j)  (256  + 64 * (j))
#define XB_XSUB(j)  (1280 + 64 * (j))
#define XB_XGEN(j)  (2304 + 64 * (j))
#define XB_TOP      3328
#define XB_TOPGEN   3392
#define XCD_BAR_WORDS 3456
#define XB_SPIN_CAP (1u << 18)
__device__ __forceinline__ unsigned xb_ld(unsigned* p)              { return __hip_atomic_load(p, __ATOMIC_RELAXED, __HIP_MEMORY_SCOPE_AGENT); }
__device__ __forceinline__ unsigned xb_add(unsigned* p, unsigned v) { return __hip_atomic_fetch_add(p, v, __ATOMIC_RELAXED, __HIP_MEMORY_SCOPE_AGENT); }
__device__ __forceinline__ unsigned xb_xcc_id() { return (unsigned)__builtin_amdgcn_s_getreg((3 << 11) | 20) & 0xFu; }
#define XB_SPIN(cond, bar) do { unsigned _sp = 0; while (cond) { __builtin_amdgcn_s_sleep(1); \
    if ((++_sp & 255u) == 0u) { if (xb_ld(&(bar)[XB_TMO])) break; if (_sp > XB_SPIN_CAP) { atomicAdd(&(bar)[XB_TMO], 1u); break; } } } } while (0)
struct XcdBarrier { unsigned* bar; unsigned x; volatile LAS unsigned* st; };
__device__ __forceinline__ XcdBarrier xcd_barrier_post(unsigned* bar, volatile LAS unsigned* st) {
    XcdBarrier b; b.bar = bar; b.x = xb_xcc_id(); b.st = st;
    if (threadIdx.x == 0) (void)xb_add(&bar[XB_XCNT(b.x)], 1u);
    return b;
}
__device__ __forceinline__ void xcd_barrier_complete(unsigned* bar, unsigned x, unsigned& nloc, unsigned& nx) {
    const unsigned G = gridDim.x * gridDim.y * gridDim.z;
    unsigned sum, cnt, mine, sp = 0u;
    for (;;) {
        sum = 0u; cnt = 0u; mine = 0u;
#pragma unroll
        for (unsigned j = 0; j < 16; ++j) { const unsigned c = xb_ld(&bar[XB_XCNT(j)]); sum += c; cnt += (c > 0u) ? 1u : 0u; mine = (j == x) ? c : mine; }
        if (sum == G) break;
        __builtin_amdgcn_s_sleep(1);
        if ((++sp & 255u) == 0u) { if (xb_ld(&bar[XB_TMO])) break; if (sp > XB_SPIN_CAP) { atomicAdd(&bar[XB_TMO], 1u); break; } }
    }
    nloc = mine > 0u ? mine : 1u; nx = cnt > 0u ? cnt : 1u;
}
__device__ __forceinline__ void xcd_barrier(const XcdBarrier& b) {
    asm volatile("s_waitcnt vmcnt(0)" ::: "memory");
    __syncthreads();
    if (threadIdx.x == 0) {
        unsigned* bar = b.bar;
        __builtin_amdgcn_s_waitcnt(0);
        unsigned nloc = b.st[0], nx = b.st[1];
        if (nloc == 0u) { xcd_barrier_complete(bar, b.x, nloc, nx); b.st[0] = nloc; b.st[1] = nx; }
        const unsigned old = xb_add(&bar[XB_XSUB(b.x)], 1u);
        const unsigned gen = old / nloc;
        if (old + 1u == (gen + 1u) * nloc) {
            __builtin_amdgcn_fence(__ATOMIC_RELEASE, "agent");
            asm volatile("s_waitcnt vmcnt(0)" ::: "memory");
            const unsigned og = xb_add(&bar[XB_TOP], 1u);
            const unsigned tg = og / nx;
            if (og + 1u == (tg + 1u) * nx) xb_add(&bar[XB_TOPGEN], 1u);
            else XB_SPIN(xb_ld(&bar[XB_TOPGEN]) == tg, bar);
            __builtin_amdgcn_fence(__ATOMIC_ACQUIRE, "agent");
            xb_add(&bar[XB_XGEN(b.x)], 1u);
            asm volatile("s_waitcnt vmcnt(0)" ::: "memory");
        } else {
            XB_SPIN(xb_ld(&bar[XB_XGEN(b.x)]) == gen, bar);
            __builtin_amdgcn_fence(__ATOMIC_ACQUIRE, "agent");
            asm volatile("s_waitcnt vmcnt(0)" ::: "memory");
        }
    }
    __syncthreads();
}

namespace pg8 {
constexpr int BM = 256, BK = 64, HALF = 128, HTB = HALF * BK * 2, STAGE_BYTES = 8 * HTB, NXCD = 8;
__device__ __forceinline__ int lds_byte(int r, int c) { const int st = (r >> 4) * 2 + (c >> 5), rr = r & 15, cc = c & 31, ob = rr * 64 + cc * 2; return st * 1024 + (ob ^ (((ob >> 9) & 1) << 5)); }
__device__ __forceinline__ void stage_rc(int b, int& R, int& C) { const int st = b / 1024, sb = b % 1024, swz = sb ^ (((sb >> 9) & 1) << 5); R = (st >> 1) * 16 + swz / 64; C = (st & 1) * 32 + (swz % 64) / 2; }
__device__ __forceinline__ int perm32(int rho) { const int n = rho >> 4, i = rho & 15; return 8 * (i >> 2) + 4 * n + (i & 3); }

struct Unit {
    const char* A; const char* B; unsigned info;
    __device__ __forceinline__ int pm() const { return (int)(info & 255u); }
    __device__ __forceinline__ int pn() const { return (int)((info >> 8) & 255u); }
    __device__ __forceinline__ int kind() const { return (int)((info >> 16) & 15u); }
    __device__ __forceinline__ int nt() const { return (int)((info >> 20) & 255u); }
    __device__ __forceinline__ int cont() const { return (int)((info >> 28) & 1u); }
};
__device__ __forceinline__ Unit make_unit(const char* A, const char* B, int pm, int pn, int kind, int nt, int cont) { return Unit{A, B, (unsigned)pm | ((unsigned)pn << 8) | ((unsigned)kind << 16) | ((unsigned)nt << 20) | ((unsigned)cont << 28)}; }
__device__ __forceinline__ int xcd_remap(int L, int nwg) { const int q = nwg / NXCD, r = nwg % NXCD, xcd = L % NXCD, off = L / NXCD; return (xcd < r ? xcd * (q + 1) : r * (q + 1) + (xcd - r) * q) + off; }

template <class Epi, class Sched>
__device__ __forceinline__ void gemm_phase(LAS unsigned char* lds, const int K, const Sched& S, const Epi& E, const int wave_) {
    int tid = wave_ * 64 + lane_id(); asm volatile("" : "+v"(tid));
    const int wid = wave_, lane = tid & 63, wr = wid >> 2, wc = wid & 3, fr = lane & 15, fq = lane >> 4;
    unsigned voffA[2], voffB[2];
#pragma unroll
    for (int i = 0; i < 2; ++i) { int R, C; stage_rc(tid * 16 + i * 8192, R, C); const int Rb = (R & ~31) + perm32(R & 31);
        voffA[i] = (unsigned)(R * K + C) * 2u; voffB[i] = (unsigned)(Rb * K + C) * 2u; }
    const size_t kstep = (size_t)(BK * 2);
    const size_t hstep = (size_t)HALF * K * 2;
    const unsigned ldsw = (unsigned)wid * 1024u;
    const int aoff = lds_byte(wr * 64 + fr, fq * 8), boff = lds_byte(wc * 32 + fr, fq * 8);
#define PG8_SA(b, h) (((b) * 2 + (h)) * HTB)
#define PG8_SB(b, h) ((4 + (b) * 2 + (h)) * HTB)
#define PG8_STAGE(bufoff, gbase, voff) do { _Pragma("unroll") for (int _i = 0; _i < 2; ++_i) \
        __builtin_amdgcn_global_load_lds((const unsigned*)((const char*)(gbase) + (voff)[_i]), (LAS unsigned*)(lds + (bufoff) + ldsw + _i * 8192), 16, 0, 0); } while (0)
#define PG8_LDA(dst, b, h) do { _Pragma("unroll") for (int m = 0; m < 4; ++m) _Pragma("unroll") for (int k = 0; k < 2; ++k) dst[m][k] = *(const LAS bf16x8*)(lds + PG8_SA(b, h) + aoff + m * 2048 + k * 1024); } while (0)
#define PG8_LDB(dst, b, h) do { _Pragma("unroll") for (int n = 0; n < 2; ++n) _Pragma("unroll") for (int k = 0; k < 2; ++k) dst[n][k] = *(const LAS bf16x8*)(lds + PG8_SB(b, h) + boff + n * 2048 + k * 1024); } while (0)
#define PG8_MMA(ai, bj, At, Bt) do { __builtin_amdgcn_s_setprio(1); _Pragma("unroll") for (int m = 0; m < 4; ++m) _Pragma("unroll") for (int n = 0; n < 2; ++n) _Pragma("unroll") for (int k = 0; k < 2; ++k) \
        acc[ai][bj][m][n] = __builtin_amdgcn_mfma_f32_16x16x32_bf16(Bt[n][k], At[m][k], acc[ai][bj][m][n], 0, 0, 0); __builtin_amdgcn_s_setprio(0); } while (0)
#define PG8_WAIT_V(n) asm volatile("s_waitcnt vmcnt(" #n ")" ::: "memory")
#define PG8_WAIT_L(n) asm volatile("s_waitcnt lgkmcnt(" #n ")" ::: "memory")
#define PG8_BAR __builtin_amdgcn_s_barrier()
#define PG8_SCHED __builtin_amdgcn_sched_barrier(0)
    Unit cur, nxt; int ui = 0;
    if (!S.next(0, cur)) return;
    f32x4 acc[2][2][4][2];
#pragma unroll
    for (int a = 0; a < 2; ++a)
#pragma unroll
        for (int b = 0; b < 2; ++b)
#pragma unroll
            for (int m = 0; m < 4; ++m)
#pragma unroll
                for (int n = 0; n < 2; ++n) acc[a][b][m][n] = (f32x4){0.f, 0.f, 0.f, 0.f};
    bf16x8 At[4][2], B0[2][2], B1[2][2];
    const char* cA = cur.A; const char* cB = cur.B;
    PG8_STAGE(PG8_SB(0, 0), cB, voffB); PG8_STAGE(PG8_SB(0, 1), cB + hstep, voffB); PG8_STAGE(PG8_SA(0, 0), cA, voffA); PG8_STAGE(PG8_SA(0, 1), cA + hstep, voffA);
    if (wr == 1) PG8_BAR;
    PG8_WAIT_V(2); PG8_BAR;
    PG8_STAGE(PG8_SB(1, 0), cB + kstep, voffB); PG8_STAGE(PG8_SA(1, 0), cA + kstep, voffA); PG8_STAGE(PG8_SB(1, 1), cB + hstep + kstep, voffB);
    PG8_WAIT_V(6); PG8_BAR;
    for (;;) {
        const bool has_next = S.next(ui + 1, nxt);
        const char* nA = has_next ? nxt.A : cA; const char* nB = has_next ? nxt.B : cB;
        const int nt = cur.nt();
        for (int t = 0; t < nt; t += 2) {
            const bool last = (t == nt - 2);
            const char* a1 = cA + (size_t)(t + 1) * kstep;
            const char* a2 = last ? nA : cA + (size_t)(t + 2) * kstep; const char* b2 = last ? nB : cB + (size_t)(t + 2) * kstep;
            const char* a3 = a2 + kstep; const char* b3 = b2 + kstep;
            PG8_LDB(B0, 0, 0); PG8_LDB(B1, 0, 1); PG8_SCHED; PG8_LDA(At, 0, 0); PG8_STAGE(PG8_SA(1, 1), a1 + hstep, voffA);
            PG8_WAIT_V(8); PG8_WAIT_L(0); PG8_BAR; PG8_MMA(0, 0, At, B0); PG8_MMA(0, 1, At, B1); PG8_BAR; PG8_SCHED;
            PG8_LDA(At, 0, 1); PG8_STAGE(PG8_SB(0, 0), b2, voffB); PG8_STAGE(PG8_SB(0, 1), b2 + hstep, voffB); PG8_STAGE(PG8_SA(0, 0), a2, voffA);
            PG8_WAIT_V(8); PG8_WAIT_L(0); PG8_BAR; PG8_MMA(1, 0, At, B0); PG8_MMA(1, 1, At, B1); PG8_BAR; PG8_SCHED;
            PG8_LDB(B0, 1, 0); PG8_LDB(B1, 1, 1); PG8_SCHED; PG8_LDA(At, 1, 0); PG8_STAGE(PG8_SA(0, 1), a2 + hstep, voffA);
            PG8_WAIT_V(8); PG8_WAIT_L(0); PG8_BAR; PG8_MMA(0, 0, At, B0); PG8_MMA(0, 1, At, B1); PG8_BAR; PG8_SCHED;
            PG8_LDA(At, 1, 1); PG8_STAGE(PG8_SB(1, 0), b3, voffB); PG8_STAGE(PG8_SB(1, 1), b3 + hstep, voffB); PG8_STAGE(PG8_SA(1, 0), a3, voffA);
            PG8_WAIT_V(8); PG8_WAIT_L(0); PG8_BAR; PG8_MMA(1, 0, At, B0); PG8_MMA(1, 1, At, B1); PG8_BAR; PG8_SCHED;
        }
        if (wr == 0) PG8_BAR;
        if (!cur.cont()) E(acc, cur, wr, wc, fr, fq);
        if (!has_next) break;
        if (!cur.cont()) {
#pragma unroll
        for (int a = 0; a < 2; ++a)
#pragma unroll
            for (int b = 0; b < 2; ++b)
#pragma unroll
                for (int m = 0; m < 4; ++m)
#pragma unroll
                    for (int n = 0; n < 2; ++n) acc[a][b][m][n] = (f32x4){0.f, 0.f, 0.f, 0.f};
        }
        cur = nxt; cA = nA; cB = nB; ++ui;
        if (wr == 1) PG8_BAR;
    }
    PG8_WAIT_V(0);
    PG8_BAR;
#undef PG8_SA
#undef PG8_SB
#undef PG8_STAGE
#undef PG8_LDA
#undef PG8_LDB
#undef PG8_MMA
#undef PG8_WAIT_V
#undef PG8_WAIT_L
#undef PG8_BAR
#undef PG8_SCHED
}

struct GridOrder {
    const char* A; const char* B; size_t tstep; int nM, nN, nwg, G, c, nt;
    __device__ __forceinline__ void init(const void* A_, const void* B_, int K, int nM_, int nN_, int G_, int c_) { A = (const char*)A_; B = (const char*)B_; tstep = (size_t)BM * K * 2; nM = nM_; nN = nN_; nwg = nM * nN; G = G_; c = c_; nt = K / BK; }
    __device__ __forceinline__ bool next(int i, Unit& u) const {
        const long L = (long)i * G + c; if (L >= nwg) return false;
        const int wgid = xcd_remap((int)L, nwg);
        const int nig = 8 * nN, gid = wgid / nig, fm = gid * 8, gsz = (nM - fm) < 8 ? (nM - fm) : 8;
        const int pm = fm + ((wgid % nig) % gsz), pn = (wgid % nig) / gsz;
        u = make_unit(A + (size_t)pm * tstep, B + (size_t)pn * tstep, pm, pn, 0, nt, 0); return true;
    }
};
}

typedef f32x4 Acc[2][2][4][2];
struct EpiSwiGLU {
    bf16* Hid;
    __device__ __forceinline__ void operator()(const Acc& acc, const pg8::Unit& u, int wr, int wc, int fr0, int fq0) const {
        int fr = fr0, fq = fq0; asm volatile("" : "+v"(fr), "+v"(fq));
        const int row0 = u.pm() * 256 + wr * 64 + fr, col0 = u.pn() * 128 + wc * 32 + 8 * fq;
#pragma unroll
        for (int ai = 0; ai < 2; ++ai)
#pragma unroll
            for (int m = 0; m < 4; ++m) {
                float v[8];
#pragma unroll
                for (int n = 0; n < 2; ++n)
#pragma unroll
                    for (int j = 0; j < 4; ++j) v[4 * n + j] = fast_silu(acc[ai][0][m][n][j]) * acc[ai][1][m][n][j];
                v4u w; w.x = cvt_pk_bf16(v[0], v[1]); w.y = cvt_pk_bf16(v[2], v[3]); w.z = cvt_pk_bf16(v[4], v[5]); w.w = cvt_pk_bf16(v[6], v[7]);
                *(v4u*)(Hid + (size_t)(row0 + ai * 128 + m * 16) * DFF + col0) = w;
            }
    }
};
struct EpiO16 {
    bf16* C; int ldc;
    __device__ __forceinline__ void operator()(const Acc& acc, const pg8::Unit& u, int wr, int wc, int fr0, int fq0) const {
        int fr = fr0, fq = fq0; asm volatile("" : "+v"(fr), "+v"(fq));
        const int row0 = u.pm() * 256 + wr * 64 + fr, col0 = u.pn() * 256 + wc * 32 + 8 * fq;
#pragma unroll
        for (int ai = 0; ai < 2; ++ai)
#pragma unroll
            for (int m = 0; m < 4; ++m) { bf16* rowp = C + (size_t)(row0 + ai * 128 + m * 16) * ldc + col0;
#pragma unroll
                for (int bj = 0; bj < 2; ++bj) { const f32x4 a = acc[ai][bj][m][0], b = acc[ai][bj][m][1];
                    v4u w; w.x = cvt_pk_bf16(a[0], a[1]); w.y = cvt_pk_bf16(a[2], a[3]); w.z = cvt_pk_bf16(b[0], b[1]); w.w = cvt_pk_bf16(b[2], b[3]);
                    *(v4u*)(rowp + bj * 128) = w; } }
    }
};
struct EpiGLU {
    const bf16* SGS; bf16* out;
    __device__ __forceinline__ void operator()(const Acc& acc, const pg8::Unit& u, int wr, int wc, int fr0, int fq0) const {
        int fr = fr0, fq = fq0; asm volatile("" : "+v"(fr), "+v"(fq));
        const int row0 = u.pm() * 256 + wr * 64 + fr, col0 = u.pn() * 128 + wc * 32 + 8 * fq;
#pragma unroll
        for (int ai = 0; ai < 2; ++ai)
#pragma unroll
            for (int m = 0; m < 4; ++m) {
                const size_t off = (size_t)(row0 + ai * 128 + m * 16) * D + col0;
                const v4u s = *(const v4u*)(SGS + off);
                const float sg[8] = {bflo(s.x), bfhi(s.x), bflo(s.y), bfhi(s.y), bflo(s.z), bfhi(s.z), bflo(s.w), bfhi(s.w)};
                float v[8];
#pragma unroll
                for (int n = 0; n < 2; ++n)
#pragma unroll
                    for (int j = 0; j < 4; ++j) v[4 * n + j] = acc[ai][0][m][n][j] * fast_sigmoid(acc[ai][1][m][n][j]) * sg[4 * n + j];
                v4u w; w.x = cvt_pk_bf16(v[0], v[1]); w.y = cvt_pk_bf16(v[2], v[3]); w.z = cvt_pk_bf16(v[4], v[5]); w.w = cvt_pk_bf16(v[6], v[7]);
                *(v4u*)(out + off) = w;
            }
    }
};
struct EpiMerge {
    const bf16* SGR; bf16* mg;
    __device__ __forceinline__ void operator()(const Acc& acc, const pg8::Unit& u, int wr, int wc, int fr0, int fq0) const {
        int fr = fr0, fq = fq0; asm volatile("" : "+v"(fr), "+v"(fq));
        const int row0 = u.pm() * 256 + wr * 64 + fr, col0 = u.pn() * 256 + wc * 32 + 8 * fq;
#pragma unroll
        for (int ai = 0; ai < 2; ++ai)
#pragma unroll
            for (int m = 0; m < 4; ++m)
#pragma unroll
                for (int bj = 0; bj < 2; ++bj) {
                    const size_t off = (size_t)(row0 + ai * 128 + m * 16) * D + col0 + bj * 128;
                    const v4u s = *(const v4u*)(SGR + off), p = *(const v4u*)(mg + off);
                    const float sg[8] = {bflo(s.x), bfhi(s.x), bflo(s.y), bfhi(s.y), bflo(s.z), bfhi(s.z), bflo(s.w), bfhi(s.w)};
                    const float pp[8] = {bflo(p.x), bfhi(p.x), bflo(p.y), bfhi(p.y), bflo(p.z), bfhi(p.z), bflo(p.w), bfhi(p.w)};
                    float v[8];
#pragma unroll
                    for (int n = 0; n < 2; ++n)
#pragma unroll
                        for (int j = 0; j < 4; ++j) v[4 * n + j] = pp[4 * n + j] + sg[4 * n + j] * acc[ai][bj][m][n][j];
                    v4u w; w.x = cvt_pk_bf16(v[0], v[1]); w.y = cvt_pk_bf16(v[2], v[3]); w.z = cvt_pk_bf16(v[4], v[5]); w.w = cvt_pk_bf16(v[6], v[7]);
                    *(v4u*)(mg + off) = w;
                }
    }
};

constexpr int CTX_SPLIT = 4;
constexpr size_t WS_SLAB = WS_Q;
struct Ffn1DownOrder {
    const char* A; const char* B; int G, c;
    static constexpr int NBIG = (MX / 256) * (D / 256), NSMALL = (MC / 256) * (D / 256) * CTX_SPLIT;
    __device__ __forceinline__ bool next(int i, pg8::Unit& u) const {
        const long L = (long)i * G + c; if (L >= NBIG + NSMALL) return false;
        const size_t tstep = (size_t)256 * DFF * 2;
        int pm, pn, kind, nt; size_t koff;
        if (L < NBIG) { const int w = pg8::xcd_remap((int)L, NBIG); const int nig = 8 * 8, gid = w / nig, r = w % nig; pm = gid * 8 + (r & 7); pn = r >> 3; kind = 0; nt = DFF / 64; koff = 0; }
        else { const int w = (int)L - NBIG, sp = w & 3, t = w >> 2; pm = 32 + (t & 1); pn = t >> 1; kind = 1 + sp; nt = DFF / 64 / CTX_SPLIT; koff = (size_t)sp * (DFF / CTX_SPLIT) * 2; }
        u = pg8::make_unit(A + (size_t)pm * tstep + koff, B + (size_t)pn * tstep + koff, pm, pn, kind, nt, 0); return true;
    }
};
struct EpiFfn1Down {
    bf16* O; float* slab;
    __device__ __forceinline__ void operator()(const Acc& acc, const pg8::Unit& u, int wr, int wc, int fr0, int fq0) const {
        int fr = fr0, fq = fq0; asm volatile("" : "+v"(fr), "+v"(fq));
        const int row0 = u.pm() * 256 + wr * 64 + fr, col0 = u.pn() * 256 + wc * 32 + 8 * fq;
        if (u.kind() == 0) {
#pragma unroll
            for (int ai = 0; ai < 2; ++ai)
#pragma unroll
                for (int m = 0; m < 4; ++m) { bf16* rowp = O + (size_t)(row0 + ai * 128 + m * 16) * D + col0;
#pragma unroll
                    for (int bj = 0; bj < 2; ++bj) { const f32x4 a = acc[ai][bj][m][0], b = acc[ai][bj][m][1];
                        v4u w; w.x = cvt_pk_bf16(a[0], a[1]); w.y = cvt_pk_bf16(a[2], a[3]); w.z = cvt_pk_bf16(b[0], b[1]); w.w = cvt_pk_bf16(b[2], b[3]);
                        *(v4u*)(rowp + bj * 128) = w; } }
        } else {
            float* C = slab + (size_t)(u.kind() - 1) * MC * D - (size_t)MX * D;
#pragma unroll
            for (int ai = 0; ai < 2; ++ai)
#pragma unroll
                for (int m = 0; m < 4; ++m) { float* rowp = C + (size_t)(row0 + ai * 128 + m * 16) * D + col0;
#pragma unroll
                    for (int bj = 0; bj < 2; ++bj) { *(f32x4*)(rowp + bj * 128) = acc[ai][bj][m][0]; *(f32x4*)(rowp + bj * 128 + 4) = acc[ai][bj][m][1]; } }
        }
    }
};

enum { MK_S = 0, MK_Q = 1, MK_K = 2, MK_G = 3, MK_GS = 4, MK_GR = 5, MK_KT = 6, MK_VT = 7 };
struct EpiMix {
    unsigned char* ws;
    __device__ __forceinline__ void operator()(const Acc& acc, const pg8::Unit& u, int wr, int wc, int fr0, int fq0) const {
        int fr = fr0, fq = fq0; asm volatile("" : "+v"(fr), "+v"(fq));
        bf16* const US = (bf16*)(ws + WS_US); bf16* const Q = (bf16*)(ws + WS_Q); bf16* const QF = (bf16*)(ws + WS_QF); bf16* const QB = (bf16*)(ws + WS_QB); bf16* const KN = (bf16*)(ws + WS_K);
        bf16* const SG = (bf16*)(ws + WS_HBUF); bf16* const SGS = (bf16*)(ws + WS_HBUF + 32 * MiB); bf16* const SGR = (bf16*)(ws + WS_HBUF + 64 * MiB);
        bf16* const KFT = (bf16*)(ws + WS_KFT); bf16* const KBT = (bf16*)(ws + WS_KBT); bf16* const KFTC = (bf16*)(ws + WS_KFTC); bf16* const KBTC = (bf16*)(ws + WS_KBTC);
        bf16* const VT = (bf16*)(ws + WS_VT); bf16* const VTC = (bf16*)(ws + WS_VTC);
        const f32x2* const rope = (const f32x2*)(ws + WS_TAB + TAB_ROPE);
        const float* const lg2 = (const float*)(ws + WS_TAB + TAB_LG2);
        const int kind = u.kind();
        if (kind == MK_S) {
#pragma unroll
            for (int ai = 0; ai < 2; ++ai)
#pragma unroll
                for (int m = 0; m < 4; ++m) {
                    const int row = u.pm() * 256 + ai * 128 + wr * 64 + m * 16 + fr;
                    int b_, crow;
                    if (row < MX) { b_ = row >> 12; crow = (row & (SEQ - 1)) >> 4; } else { b_ = (row - MX) >> 8; crow = 256 + (((row - MX) & (LC - 1)) >> 4); }
                    const int s = row & 15;
#pragma unroll
                    for (int bj = 0; bj < 2; ++bj) {
                        const int ch = u.pn() * 256 + bj * 128 + wc * 32 + 8 * fq, g = ch >> 4, c0 = ch & 15;
                        const f32x4 a = acc[ai][bj][m][0], b = acc[ai][bj][m][1];
                        v4u w; w.x = cvt_pk_bf16(a[0], a[1]); w.y = cvt_pk_bf16(a[2], a[3]); w.z = cvt_pk_bf16(b[0], b[1]); w.w = cvt_pk_bf16(b[2], b[3]);
                        *(v4u*)(US + ((size_t)((b_ * 64 + g) * S5_ROWS + crow)) * 256 + s * 16 + c0) = w;
                    }
                }
        } else if (kind == MK_G || kind == MK_GS || kind == MK_GR) {
            bf16* dst = kind == MK_G ? SG : (kind == MK_GS ? SGS : SGR);
            const int row0 = u.pm() * 256 + wr * 64 + fr, col0 = u.pn() * 256 + wc * 32 + 8 * fq;
#pragma unroll
            for (int ai = 0; ai < 2; ++ai)
#pragma unroll
                for (int m = 0; m < 4; ++m)
#pragma unroll
                    for (int bj = 0; bj < 2; ++bj) {
                        float v[8];
#pragma unroll
                        for (int n = 0; n < 2; ++n)
#pragma unroll
                            for (int j = 0; j < 4; ++j) { const float x = acc[ai][bj][m][n][j]; const float s = fast_sigmoid(x); v[4 * n + j] = kind == MK_G ? x * s : s; }
                        v4u w; w.x = cvt_pk_bf16(v[0], v[1]); w.y = cvt_pk_bf16(v[2], v[3]); w.z = cvt_pk_bf16(v[4], v[5]); w.w = cvt_pk_bf16(v[6], v[7]);
                        *(v4u*)(dst + (size_t)(row0 + ai * 128 + m * 16) * D + col0 + bj * 128) = w;
                    }
        } else if (kind == MK_Q || kind == MK_K) {
            const int p = wc >> 1, i0 = 16 * (wc & 1) + 4 * fq;
            const int d0 = 64 * p + i0;
            const bool isctx = u.pm() >= 32;
            f32x4 cs0[8], cs1[8];
#pragma unroll
            for (int am = 0; am < 8; ++am) {
                const int row = u.pm() * 256 + (am >> 2) * 128 + wr * 64 + (am & 3) * 16 + fr;
                const int l = row & (SEQ - 1), pos = p ? (l & 63) : (l >> 6);
                if (!isctx) { cs0[am] = *(const f32x4*)(rope + pos * 32 + i0); cs1[am] = *(const f32x4*)(rope + pos * 32 + i0 + 2); }
                else { cs0[am] = (f32x4){1.f, 0.f, 1.f, 0.f}; cs1[am] = cs0[am]; }
            }
#pragma unroll
            for (int ai = 0; ai < 2; ++ai)
#pragma unroll
                for (int m = 0; m < 4; ++m) {
                    const int am = ai * 4 + m;
                    const int row = u.pm() * 256 + ai * 128 + wr * 64 + m * 16 + fr;
                    const float cc[4] = {cs0[am][0], cs0[am][2], cs1[am][0], cs1[am][2]}, ss[4] = {cs0[am][1], cs0[am][3], cs1[am][1], cs1[am][3]};
#pragma unroll
                    for (int bj = 0; bj < 2; ++bj) {
                        const int head = 2 * u.pn() + bj;
                        float y1[4], y2[4];
#pragma unroll
                        for (int j = 0; j < 4; ++j) { const float x1 = acc[ai][bj][m][0][j], x2 = acc[ai][bj][m][1][j]; y1[j] = x1 * cc[j] - x2 * ss[j]; y2[j] = x1 * ss[j] + x2 * cc[j]; }
                        const int cpos = 32 * wc + 8 * fq;
                        v4u w;
                        if (kind == MK_K) {
                            w.x = cvt_pk_bf16(y1[0], y1[1]); w.y = cvt_pk_bf16(y1[2], y1[3]); w.z = cvt_pk_bf16(y2[0], y2[1]); w.w = cvt_pk_bf16(y2[2], y2[3]);
                            if (!isctx) *(v4u*)(KN + (size_t)row * 1024 + head * 128 + cpos) = w;
                            else *(v4u*)(KFTC + (size_t)(row - MX) * 1024 + head * 128 + cpos) = w;
                        } else {
                            const float qs = 0.08838834764831845f;
                            w.x = cvt_pk_bf16(y1[0] * qs, y1[1] * qs); w.y = cvt_pk_bf16(y1[2] * qs, y1[3] * qs); w.z = cvt_pk_bf16(y2[0] * qs, y2[1] * qs); w.w = cvt_pk_bf16(y2[2] * qs, y2[3] * qs);
                            *(v4u*)(Q + (size_t)row * 1024 + head * 128 + cpos) = w;
                        }
                    }
                }
        } else if (kind == MK_VT) {
            const bool isctx = u.pn() >= 32;
#pragma unroll
            for (int ai = 0; ai < 2; ++ai)
#pragma unroll
                for (int m = 0; m < 4; ++m) {
                    const int f = u.pm() * 256 + ai * 128 + wr * 64 + m * 16 + fr;
#pragma unroll
                    for (int bj = 0; bj < 2; ++bj) {
                        const f32x4 a = acc[ai][bj][m][0], b = acc[ai][bj][m][1];
                        v4u w; w.x = cvt_pk_bf16(a[0], a[1]); w.y = cvt_pk_bf16(a[2], a[3]); w.z = cvt_pk_bf16(b[0], b[1]); w.w = cvt_pk_bf16(b[2], b[3]);
                        const int tc = bj * 128 + wc * 32 + 8 * fq;
                        if (!isctx) { const int tok = u.pn() * 256 + tc, b_ = tok >> 12, l = tok & (SEQ - 1); *(v4u*)(VT + ((size_t)(b_ * 2048 + f) * SEQ + l)) = w; }
                        else { const int b_ = u.pn() - 32; *(v4u*)(VTC + ((size_t)(b_ * 2048 + f) * LC + tc)) = w; }
                    }
                }
        }
    }
};
struct MixOrder {
    const char* U; const char* WM; int G, c;
    static constexpr int N_NORM = 32 * 36, N_CTXS = 16, N_SWAP = 8 * 34, NWG = N_NORM + N_CTXS + N_SWAP;
    __device__ __forceinline__ bool next(int i, pg8::Unit& u) const {
        const long L = (long)i * G + c; if (L >= NWG) return false;
        int w = pg8::xcd_remap((int)L, NWG);
        const size_t tstep = (size_t)256 * D * 2;
        int at, bt, pm, pn, kind;
        bool swapped = false;
        if (w < N_NORM) {
            const int nig = 8 * 36, gid = w / nig, r = w % nig, ct = r >> 3;
            pm = gid * 8 + (r & 7); at = pm;
            if (ct < 4) { bt = ct; kind = MK_S; pn = ct; } else if (ct < 8) { bt = ct; kind = MK_Q; pn = ct - 4; } else if (ct < 12) { bt = ct; kind = MK_K; pn = ct - 8; }
            else if (ct < 20) { bt = ct + 8; kind = MK_G; pn = ct - 12; } else if (ct < 28) { bt = ct + 8; kind = MK_GS; pn = ct - 20; } else { bt = ct + 8; kind = MK_GR; pn = ct - 28; }
        } else if (w < N_NORM + N_CTXS) {
            w -= N_NORM; pm = 32 + (w & 1); at = pm; const int ct = w >> 1;
            if (ct < 4) { bt = ct; pn = ct; kind = MK_S; } else { bt = ct + 4; pn = ct - 4; kind = MK_K; }
        } else {
            w -= N_NORM + N_CTXS; swapped = true;
            const int tt = w >> 3, ft = w & 7;
            bt = tt; pn = tt; at = 12 + ft; pm = ft; kind = MK_VT;
        }
        const char* abase = swapped ? WM : U; const char* bbase = swapped ? U : WM;
        u = pg8::make_unit(abase + (size_t)at * tstep, bbase + (size_t)bt * tstep, pm, pn, kind, D / 64, 0);
        return true;
    }
};

constexpr int RING_BYTES = 131072, LDSCTL_OFF = 143360, MISC_OFF = LDSCTL_OFF + 320, LDS_BYTES = 147456;
struct Args { const float* in[22]; float* out; unsigned char* ws; };
struct Frame {
    LAS unsigned char* lds; volatile LAS unsigned* MISC; unsigned* ctl;
    int wave, vcu, G;
    float* out; unsigned char* ws;
};
typedef const Args __attribute__((address_space(4)))* KArgsPtr;
__device__ __forceinline__ KArgsPtr kargs() { KArgsPtr p = (KArgsPtr)__builtin_amdgcn_kernarg_segment_ptr(); asm volatile("" : "+s"(p)); return p; }
#define FIN(k) ((const float*)kargs()->in[k])

__device__ __forceinline__ int map_pair(int n, int half) { const int h = n < half ? n : n - half, up = n >= half; return 256 * (h >> 7) + 128 * up + (h & 127); }
__device__ __forceinline__ int map_mix(int n) {
    if (n < 1024 || n >= 3072) return n;
    const int base = n & ~127, d = n & 127, p = d >> 6, e = d & 63, s = e >> 5, i = e & 31, t = 32 * p + i;
    return base + 32 * (t >> 4) + 8 * ((t >> 2) & 3) + 4 * s + (t & 3);
}
template <int MAPID>
__device__ __forceinline__ void transpose_item(const float* W, int ldw, int K, int nblk, bf16* WT, int row_off, int half, LAS float* scr, int item, int lane) {
    const int kb = item / nblk, nb = item % nblk, k0 = 64 * kb, n0 = 32 * nb;
    float wv[32];
#pragma unroll
    for (int i = 0; i < 32; ++i) wv[i] = W[(size_t)(k0 + 2 * i + (lane >> 5)) * ldw + n0 + (lane & 31)];
#pragma unroll
    for (int i = 0; i < 32; ++i) scr[(2 * i + (lane >> 5)) * 33 + (lane & 31)] = wv[i];
    LDS_WAIT(); asm volatile("" ::: "memory");
    const int c = lane & 7;
#pragma unroll
    for (int j = 0; j < 4; ++j) { const int n = (lane >> 3) + 8 * j; const LAS float* s = scr + (8 * c) * 33 + n;
        v4u o; o.x = pk2(s[0 * 33], s[1 * 33]); o.y = pk2(s[2 * 33], s[3 * 33]); o.z = pk2(s[4 * 33], s[5 * 33]); o.w = pk2(s[6 * 33], s[7 * 33]);
        const int nn = n0 + n; const int dr = MAPID == 0 ? nn : (MAPID == 1 ? map_pair(nn, half) : map_mix(nn));
        *(v4u*)(WT + (size_t)(row_off + dr) * K + k0 + 8 * c) = o; }
    LDS_WAIT(); asm volatile("" ::: "memory");
}
__device__ __forceinline__ void sincos_d(double x, double& s, double& c) {
    const double TWO_PI = 6.283185307179586476925286766559;
    x -= TWO_PI * __builtin_rint(x / TWO_PI);
    const double h = 0.125 * x, h2 = h * h;
    double sn = h * (1.0 + h2 * (-1.0 / 6 + h2 * (1.0 / 120 + h2 * (-1.0 / 5040 + h2 * (1.0 / 362880 + h2 * (-1.0 / 39916800 + h2 * (1.0 / 6227020800.0)))))));
    double cs = 1.0 + h2 * (-0.5 + h2 * (1.0 / 24 + h2 * (-1.0 / 720 + h2 * (1.0 / 40320 + h2 * (-1.0 / 3628800 + h2 * (1.0 / 479001600.0 + h2 * (-1.0 / 87178291200.0)))))));
#pragma unroll
    for (int k = 0; k < 3; ++k) { const double s2 = 2.0 * sn * cs, c2 = 1.0 - 2.0 * sn * sn; sn = s2; cs = c2; }
    s = sn; c = cs;
}
__device__ __forceinline__ double exp_d(double x) {
    const double y = x * (1.0 / 4096.0);
    double e = 1.0 + y * (1.0 + y * (0.5 + y * (1.0 / 6 + y * (1.0 / 24 + y * (1.0 / 120 + y * (1.0 / 720))))));
#pragma unroll
    for (int k = 0; k < 12; ++k) e = e * e;
    return e;
}
__device__ __forceinline__ double log1p_small_d(double z) {
    const double t = z / (2.0 + z), t2 = t * t;
    return 2.0 * t * (1.0 + t2 * (1.0 / 3 + t2 * (1.0 / 5 + t2 * (1.0 / 7 + t2 * (1.0 / 9 + t2 * (1.0 / 11))))));
}

constexpr int CV_I1 = (D / 64) * (NFF / 32), CV_I2 = (DFF / 64) * (D / 32), CV_IM = (D / 64) * (NMIX / 32), CV_IG = (SW / 64) * (2 * D / 32), CV_IP = (D / 64) * (D / 32);
constexpr int CV_N0 = CV_I1 + CV_I2, CV_N1 = CV_IM + CV_IG + 2 * CV_IP, CV_N2 = CV_I1 + CV_I2;
constexpr int CV_G1_CUS = 40, CV_G2_CUS = 192, CV_G3_CUS = 96;
constexpr int CV_L1_G1 = CV_G1_CUS * NWAVES * 12, CV_L1_G2 = CV_G2_CUS * NWAVES * 7, CV_L2_G3 = CV_G3_CUS * NWAVES * 14;
static_assert(CV_L1_G1 + CV_L1_G2 <= CV_N1 && CV_L2_G3 <= CV_N2, "conversion split");
__device__ __forceinline__ void conv_item(unsigned char* ws, int list, int r, LAS float* scr, int lane_) {
    if (list == 0) {
        if (r < CV_I1) { transpose_item<1>(FIN(7), NFF, D, NFF / 32, (bf16*)(ws + WS_W1T), 0, DFF, scr, r, lane_); return; } r -= CV_I1;
        transpose_item<0>(FIN(8), D, DFF, D / 32, (bf16*)(ws + WS_W2T), 0, 0, scr, r, lane_);
    } else if (list == 1) {
        if (r < CV_IM) { transpose_item<2>(FIN(9), NMIX, D, NMIX / 32, (bf16*)(ws + WS_WMT), 0, 0, scr, r, lane_); return; } r -= CV_IM;
        if (r < CV_IG) { transpose_item<1>(FIN(18), 2 * D, SW, 2 * D / 32, (bf16*)(ws + WS_WGT), 0, D, scr, r, lane_); return; } r -= CV_IG;
        if (r < CV_IP) { transpose_item<0>(FIN(20), D, D, D / 32, (bf16*)(ws + WS_WPT), 0, 0, scr, r, lane_); return; } r -= CV_IP;
        transpose_item<0>(FIN(21), D, D, D / 32, (bf16*)(ws + WS_WOT), 0, 0, scr, r, lane_);
    } else {
        if (r < CV_I1) { transpose_item<1>(FIN(7) + (size_t)D * NFF, NFF, D, NFF / 32, (bf16*)(ws + WS_W3T), 0, DFF, scr, r, lane_); return; } r -= CV_I1;
        transpose_item<0>(FIN(8) + (size_t)DFF * D, D, DFF, D / 32, (bf16*)(ws + WS_W4T), 0, 0, scr, r, lane_);
    }
}
__device__ __forceinline__ void conv_range(Frame& F, int list, int begin, int end, int wi, int nw) {
    int lane_ = lane_id(); asm volatile("" : "+v"(lane_));
    LAS float* scr = (LAS float*)(F.lds + F.wave * 16384);
    for (int it = begin + wi; it < end; it += nw) conv_item(F.ws, list, it, scr, lane_);
}

__device__ __forceinline__ void phase_prologue(Frame& F0, const Args& args, const bool do_ada) {
    Frame& F = F0; int lane_ = lane_id(); asm volatile("" : "+v"(lane_));
    LAS float* scr = (LAS float*)(F.lds + F.wave * 16384);
    const int gw = F.vcu * NWAVES + F.wave, NGW = F.G * NWAVES;
    unsigned char* ws = F.ws;
    {
        const int gt = gw * 64 + lane_, NT = NGW * 64;
        unsigned char* tab = ws + WS_TAB;
        for (int idx = gt; idx < 2048; idx += NT) {
            const int pos = idx >> 5, i = idx & 31;
            const double inv = exp_d(-(double)i * (9.210340371976182736 / 32.0));
            double s, c; sincos_d((double)pos * inv, s, c);
            ((f32x2*)(tab + TAB_ROPE))[idx] = (f32x2){(float)c, (float)s};
        }
        for (int idx = gt; idx < 16; idx += NT) {
            const double x = (double)FIN(19)[idx];
            ((float*)(tab + TAB_LG2))[idx] = (float)(-log1p_small_d(exp_d(-x)) * 1.4426950408889634074);
        }
        for (int idx = gt; idx < 2 * 64 * 64; idx += NT) {
            const int dg = idx >> 6, p = idx & 63;
            const double lr = (double)FIN(10)[idx], li = (double)FIN(11)[idx], step = exp_d((double)FIN(12)[dg]);
            const double mag = exp_d(lr * step); double sn, cs; sincos_d(li * step, sn, cs);
            const double ar = mag * cs, ai = mag * sn, den = lr * lr + li * li, nr = ar - 1.0, ni = ai;
            const double kr = (nr * lr + ni * li) / den, ki = (ni * lr - nr * li) / den;
            ((float*)(tab + TAB_AR))[idx] = (float)ar; ((float*)(tab + TAB_AI))[idx] = (float)ai;
            { f32x2* apw = (f32x2*)(ws + WS_S5APOW) + (size_t)dg * 17 * 64 + p; double pr = 1.0, pi = 0.0;
              for (int k = 0; k < 17; ++k) { apw[k * 64] = (f32x2){(float)pr, (float)pi}; const double t = pr * ar - pi * ai; pi = pr * ai + pi * ar; pr = t; } }
            float* brf = (float*)(ws + WS_S5BRF) + (size_t)idx * 32;
            const float* bre = FIN(13) + (size_t)idx * 16; const float* bim = FIN(14) + (size_t)idx * 16;
            for (int c = 0; c < 16; ++c) { const double br = (double)bre[c], bi = (double)bim[c];
                brf[2 * c] = (float)(kr * br - ki * bi); brf[2 * c + 1] = (float)(kr * bi + ki * br); }
        }
    }
    if (do_ada) {
        float* ADA = (float*)(ws + WS_CTL + CTL_ADA);
        const float* aw = FIN(4);
        for (int it = gw; it < 16 * 72; it += NGW) {
            const int kc = it / 72, cb = it % 72, k0 = kc * 128, col = cb * 256 + 4 * lane_;
            for (int i = lane_; i < 384; i += 64) { const int v = i >> 7, k = i & 127; const float x = v == 0 ? FIN(1)[k0 + k] : (v == 1 ? FIN(1)[D + k0 + k] : FIN(3)[k0 + k]); scr[i] = x / (1.0f + __expf(-x)); }
            LDS_WAIT(); asm volatile("" ::: "memory");
            f32x4 a0 = {0.f, 0.f, 0.f, 0.f}, a1 = a0, a2 = a0;
#pragma unroll 8
            for (int k = 0; k < 128; ++k) { const f32x4 w = *(const f32x4*)(aw + (size_t)(k0 + k) * NADA + col); a0 += w * scr[k]; a1 += w * scr[128 + k]; a2 += w * scr[256 + k]; }
#pragma unroll
            for (int j = 0; j < 4; ++j) { __hip_atomic_fetch_add(ADA + col + j, a0[j], RLX_AGENT); __hip_atomic_fetch_add(ADA + NADA + col + j, a1[j], RLX_AGENT); __hip_atomic_fetch_add(ADA + 2 * NADA + col + j, a2[j], RLX_AGENT); }
            LDS_WAIT(); asm volatile("" ::: "memory");
        }
    }
    {
        const bool tails = (F.G == 256);
        const int b1 = tails ? CV_L1_G1 + CV_L1_G2 : 0, b2 = tails ? CV_L2_G3 : 0;
        const int n0 = CV_N0, n1 = CV_N1 - b1, n2 = CV_N2 - b2;
        for (int it = gw; it < n0 + n1 + n2; it += NGW) {
            if (it < n2) conv_item(ws, 2, b2 + it, scr, lane_);
            else if (it < n2 + n1) conv_item(ws, 1, b1 + it - n2, scr, lane_);
            else conv_item(ws, 0, it - n2 - n1, scr, lane_);
        }
    }
}

template <int MODE>
__device__ __forceinline__ void phase_rows(Frame& F0, const Args& args) {
    Frame& F = F0; int lane_ = lane_id(); asm volatile("" : "+v"(lane_));
    const int gw = F.vcu * NWAVES + F.wave, NGW = F.G * NWAVES;
    const float* ADA = (const float*)(F.ws + WS_CTL + CTL_ADA);
    const float* adab = FIN(5); const float* ng = FIN(6);
    const bf16* O = (const bf16*)(F.ws + WS_OBUF);
    bf16* A = (bf16*)(F.ws + WS_ABUF);
    const int nrows = (MODE <= 1) ? MT : MX;
    for (int r = gw; r < nrows; r += NGW) {
        const int av = r < MX ? (r >> 12) : 2;
        const float* ada = ADA + (size_t)av * NADA;
        f32x4 h[8];
        if (MODE <= 1) { const float* hsrc = r < MX ? FIN(0) + (size_t)r * D : FIN(2) + (size_t)(r - MX) * D;
#pragma unroll
            for (int j = 0; j < 8; ++j) h[j] = *(const f32x4*)(hsrc + 256 * j + 4 * lane_); }
        else { const bf16* hsrc = (const bf16*)(F.ws + WS_STREAM) + (size_t)r * D;
#pragma unroll
            for (int j = 0; j < 8; ++j) { const v2u t = *(const v2u*)(hsrc + 256 * j + 4 * lane_); h[j] = (f32x4){bflo(t.x), bfhi(t.x), bflo(t.y), bfhi(t.y)}; } }
        if (MODE >= 1) {
            constexpr int ipost = MODE - 1;
            const float resw = (MODE == 2) ? 1.0f : 0.5f;
            f32x4 o[8]; float ss = 0.f;
#pragma unroll
            for (int j = 0; j < 8; ++j) {
                if (MODE == 1 && r >= MX) { const float* sl = (const float*)(F.ws + WS_SLAB) + (size_t)(r - MX) * D + 256 * j + 4 * lane_; f32x4 a = *(const f32x4*)sl;
#pragma unroll
                    for (int s = 1; s < CTX_SPLIT; ++s) a += *(const f32x4*)(sl + (size_t)s * MC * D);
                    o[j] = a; }
                else { const v2u t = *(const v2u*)(O + (size_t)r * D + 256 * j + 4 * lane_); o[j] = (f32x4){bflo(t.x), bfhi(t.x), bflo(t.y), bfhi(t.y)}; }
                ss += (o[j][0] * o[j][0] + o[j][1] * o[j][1]) + (o[j][2] * o[j][2] + o[j][3] * o[j][3]); }
            const float rstd = 1.0f / sqrtf(wave_sum(ss, lane_) * (1.0f / D) + EPS);
#pragma unroll
            for (int j = 0; j < 8; ++j) { const int c = 256 * j + 4 * lane_;
                const f32x4 gate = *(const f32x4*)(ada + (3 * ipost + 2) * D + c) + *(const f32x4*)(adab + (3 * ipost + 2) * D + c);
                const f32x4 g = *(const f32x4*)(ng + (2 * ipost + 1) * D + c);
                h[j] = h[j] + (resw * rstd) * (gate * (o[j] * g)); }
            if (r < MX) {
                if (MODE == 3) {
#pragma unroll
                    for (int j = 0; j < 8; ++j) *(f32x4*)(F.out + (size_t)r * D + 256 * j + 4 * lane_) = h[j];
                } else {
                    bf16* so = (bf16*)(F.ws + WS_STREAM) + (size_t)r * D;
#pragma unroll
                    for (int j = 0; j < 8; ++j) { v2u w; w.x = cvt_pk_bf16(h[j][0], h[j][1]); w.y = cvt_pk_bf16(h[j][2], h[j][3]); *(v2u*)(so + 256 * j + 4 * lane_) = w;
                        h[j] = (f32x4){bflo(w.x), bfhi(w.x), bflo(w.y), bfhi(w.y)}; }
                }
            }
        }
        if (MODE <= 2) {
            constexpr int ipre = MODE;
            float ss = 0.f;
#pragma unroll
            for (int j = 0; j < 8; ++j) ss += (h[j][0] * h[j][0] + h[j][1] * h[j][1]) + (h[j][2] * h[j][2] + h[j][3] * h[j][3]);
            const float rstd = 1.0f / sqrtf(wave_sum(ss, lane_) * (1.0f / D) + EPS);
#pragma unroll
            for (int j = 0; j < 8; ++j) { const int c = 256 * j + 4 * lane_;
                const f32x4 shift = *(const f32x4*)(ada + (3 * ipre) * D + c) + *(const f32x4*)(adab + (3 * ipre) * D + c);
                const f32x4 scale = *(const f32x4*)(ada + (3 * ipre + 1) * D + c) + *(const f32x4*)(adab + (3 * ipre + 1) * D + c);
                const f32x4 g = *(const f32x4*)(ng + (2 * ipre) * D + c);
                const f32x4 v = (h[j] * rstd) * g * (scale + 1.0f) + shift;
                v2u w; w.x = cvt_pk_bf16(v[0], v[1]); w.y = cvt_pk_bf16(v[2], v[3]);
                *(v2u*)(A + (size_t)r * D + c) = w; }
        }
    }
}

__device__ __forceinline__ void cpow_f(float ar, float ai, int k, float& pr, float& pi) {
    float rr = 1.f, ri = 0.f, br = ar, bi = ai;
#pragma unroll
    for (int bit = 0; bit < 5; ++bit) { if (k & (1 << bit)) { const float t = rr * br - ri * bi; ri = rr * bi + ri * br; rr = t; } const float t2 = br * br - bi * bi; bi = 2.f * br * bi; br = t2; }
    pr = rr; pi = ri;
}
__device__ __forceinline__ void s5_tables1(Frame& F, const Args& args) {
    int lane_ = lane_id(); asm volatile("" : "+v"(lane_));
    const int gt = (F.vcu * NWAVES + F.wave) * 64 + lane_, NT = F.G * NWAVES * 64;
    const f32x2* APW = (const f32x2*)(F.ws + WS_S5APOW);
    const float* BRF = (const float*)(F.ws + WS_S5BRF);
    const float* cre = FIN(15); const float* cim = FIN(16);
    float* KT = (float*)(F.ws + WS_S5KT); bf16* WE = (bf16*)(F.ws + WS_S5WE); bf16* WY2 = (bf16*)(F.ws + WS_S5WY2);
    for (int idx = gt; idx < 64 * 2 * 16 * 16 * 4; idx += NT) {
        const int c4 = idx & 3, c = (idx >> 2) & 15, k = (idx >> 6) & 15, dir = (idx >> 10) & 1, g = idx >> 11, dg = dir * 64 + g;
        const f32x2* ap = APW + (size_t)(dg * 17 + k) * 64; const float* cr = cre + (dg * 16 + c) * 64; const float* ci = cim + (dg * 16 + c) * 64;
        const float* br = BRF + (size_t)dg * 64 * 32 + c4 * 8;
        f32x4 acc = {0.f, 0.f, 0.f, 0.f};
#pragma unroll 8
        for (int p = 0; p < 64; ++p) {
            const f32x2 a = ap[p]; const float Cr = cr[p], Ci = ci[p], Gr = Cr * a[0] - Ci * a[1], Gi = Cr * a[1] + Ci * a[0];
            const f32x4 b0 = *(const f32x4*)(br + p * 32), b1 = *(const f32x4*)(br + p * 32 + 4);
            acc[0] += Gr * b0[0] - Gi * b0[1]; acc[1] += Gr * b0[2] - Gi * b0[3]; acc[2] += Gr * b1[0] - Gi * b1[1]; acc[3] += Gr * b1[2] - Gi * b1[3];
        }
        *(f32x4*)(KT + ((size_t)((g * 2 + dir) * 16 + k) * 16 + c) * 16 + c4 * 4) = acc;
    }
    for (int idx = gt; idx < 64 * 256 * 16; idx += NT) {
        const int s = idx & 15, r = (idx >> 4) & 255, g = idx >> 12, dir = r >> 7, part = (r >> 6) & 1, p = r & 63, dg = dir * 64 + g;
        const f32x2 a = APW[(size_t)(dg * 17 + (dir ? s : 15 - s)) * 64 + p]; const float pr = a[0], pi = a[1];
        const f32x4* b4 = (const f32x4*)(BRF + (size_t)(dg * 64 + p) * 32);
        float v[16];
#pragma unroll
        for (int j = 0; j < 8; ++j) { const f32x4 q = b4[j]; v[2 * j] = part ? (pr * q[1] + pi * q[0]) : (pr * q[0] - pi * q[1]); v[2 * j + 1] = part ? (pr * q[3] + pi * q[2]) : (pr * q[2] - pi * q[3]); }
        bf16* o = WE + ((size_t)(g * 256 + r)) * 256 + s * 16;
        v4u w0, w1; w0.x = pk2(v[0], v[1]); w0.y = pk2(v[2], v[3]); w0.z = pk2(v[4], v[5]); w0.w = pk2(v[6], v[7]); w1.x = pk2(v[8], v[9]); w1.y = pk2(v[10], v[11]); w1.z = pk2(v[12], v[13]); w1.w = pk2(v[14], v[15]);
        *(v4u*)o = w0; *(v4u*)(o + 8) = w1;
    }
    for (int idx = gt; idx < 64 * 256 * 32; idx += NT) {
        const int cb = idx & 31, row = (idx >> 5) & 255, g = idx >> 13, t = row >> 4, c = row & 15, col0 = 8 * cb, dir = col0 >> 7, part = (col0 >> 6) & 1, p0 = col0 & 63, dg = dir * 64 + g;
        const f32x2* ap = APW + (size_t)(dg * 17 + (dir ? 16 - t : t + 1)) * 64 + p0; const float* cr = cre + (dg * 16 + c) * 64 + p0; const float* ci = cim + (dg * 16 + c) * 64 + p0;
        float v[8];
#pragma unroll
        for (int j = 0; j < 8; ++j) { const f32x2 a = ap[j]; const float Cr = cr[j], Ci = ci[j]; v[j] = part ? -(Cr * a[1] + Ci * a[0]) : (Cr * a[0] - Ci * a[1]); }
        v4u w; w.x = pk2(v[0], v[1]); w.y = pk2(v[2], v[3]); w.z = pk2(v[4], v[5]); w.w = pk2(v[6], v[7]);
        *(v4u*)(WY2 + ((size_t)(g * 256 + row)) * 256 + col0) = w;
    }
}
__device__ __forceinline__ void s5_tables2(Frame& F, const Args& args) {
    int lane_ = lane_id(); asm volatile("" : "+v"(lane_));
    const int gt = (F.vcu * NWAVES + F.wave) * 64 + lane_, NT = F.G * NWAVES * 64;
    const float* KT = (const float*)(F.ws + WS_S5KT); bf16* WY1 = (bf16*)(F.ws + WS_S5WY1); const float* dskip = FIN(17);
    for (int idx = gt; idx < 64 * 256 * 16; idx += NT) {
        const int s = idx & 15, row = (idx >> 4) & 255, g = idx >> 12, t = row >> 4, c = row & 15;
        float v[16];
#pragma unroll
        for (int j = 0; j < 16; ++j) v[j] = 0.f;
        if (s <= t) { const f32x4* k4 = (const f32x4*)(KT + ((size_t)((g * 2 + 0) * 16 + (t - s)) * 16 + c) * 16);
#pragma unroll
            for (int j = 0; j < 4; ++j) { const f32x4 q = k4[j]; v[4 * j] += q[0]; v[4 * j + 1] += q[1]; v[4 * j + 2] += q[2]; v[4 * j + 3] += q[3]; } }
        if (s >= t) { const f32x4* k4 = (const f32x4*)(KT + ((size_t)((g * 2 + 1) * 16 + (s - t)) * 16 + c) * 16);
#pragma unroll
            for (int j = 0; j < 4; ++j) { const f32x4 q = k4[j]; v[4 * j] += q[0]; v[4 * j + 1] += q[1]; v[4 * j + 2] += q[2]; v[4 * j + 3] += q[3]; } }
        if (s == t) { const float dk = dskip[16 * g + c];
#pragma unroll
            for (int j = 0; j < 16; ++j) v[j] += (j == c) ? dk : 0.f; }
        bf16* o = WY1 + ((size_t)(g * 256 + row)) * 256 + s * 16;
        v4u w0, w1; w0.x = pk2(v[0], v[1]); w0.y = pk2(v[2], v[3]); w0.z = pk2(v[4], v[5]); w0.w = pk2(v[6], v[7]); w1.x = pk2(v[8], v[9]); w1.y = pk2(v[10], v[11]); w1.z = pk2(v[12], v[13]); w1.w = pk2(v[14], v[15]);
        *(v4u*)o = w0; *(v4u*)(o + 8) = w1;
    }
}
struct S5EOrder {
    const char* ZU; const char* WE; int G, c;
    __device__ __forceinline__ bool next(int i, pg8::Unit& u) const {
        const long L = (long)i * G + c; if (L >= 256) return false;
        const int bg = (int)L >> 1, rt = (int)L & 1, g = bg & 63;
        u = pg8::make_unit(ZU + ((size_t)(bg * S5_ROWS + 256 * rt)) * 512, WE + (size_t)g * 256 * 512, bg, rt, 0, 4, 0); return true;
    }
};
struct EpiS5E {
    bf16* E;
    __device__ __forceinline__ void operator()(const Acc& acc, const pg8::Unit& u, int wr, int wc, int fr0, int fq0) const {
        int fr = fr0, fq = fq0; asm volatile("" : "+v"(fr), "+v"(fq));
#pragma unroll
        for (int ai = 0; ai < 2; ++ai)
#pragma unroll
            for (int m = 0; m < 4; ++m) {
                const int crow = 256 * u.pn() + ai * 128 + wr * 64 + m * 16 + fr;
                if (crow < S5_ROWS) {
#pragma unroll
                    for (int bj = 0; bj < 2; ++bj) {
                        const f32x4 a = acc[ai][bj][m][0], b = acc[ai][bj][m][1];
                        v4u w; w.x = cvt_pk_bf16(a[0], a[1]); w.y = cvt_pk_bf16(a[2], a[3]); w.z = cvt_pk_bf16(b[0], b[1]); w.w = cvt_pk_bf16(b[2], b[3]);
                        *(v4u*)(E + ((size_t)(u.pm() * S5_ROWS + crow)) * 256 + bj * 128 + wc * 32 + 8 * fq) = w;
                    }
                }
            }
    }
};
struct S5YOrder {
    const char* ZU; const char* ZH; const char* WY1; const char* WY2; int G, c;
    __device__ __forceinline__ bool next(int i, pg8::Unit& u) const {
        const int bg = (i >> 1) * G + c, seg = i & 1; if (bg >= NB * 64) return false;
        const int g = bg & 63;
        const char* a = seg == 0 ? ZU + ((size_t)(bg * S5_ROWS)) * 512 : ZH + ((size_t)(bg * 256)) * 512;
        const char* b = (seg == 0 ? WY1 : WY2) + (size_t)g * 256 * 512;
        u = pg8::make_unit(a, b, bg, 0, 0, 4, seg == 0 ? 1 : 0); return true;
    }
};
struct EpiS5Y {
    bf16* AGLU;
    __device__ __forceinline__ void operator()(const Acc& acc, const pg8::Unit& u, int wr, int wc, int fr0, int fq0) const {
        int fr = fr0, fq = fq0; asm volatile("" : "+v"(fr), "+v"(fq));
        const int b_ = u.pm() >> 6, g = u.pm() & 63;
#pragma unroll
        for (int ai = 0; ai < 2; ++ai)
#pragma unroll
            for (int m = 0; m < 4; ++m) {
                const int chunk = ai * 128 + wr * 64 + m * 16 + fr;
#pragma unroll
                for (int bj = 0; bj < 2; ++bj) {
                    const int cc = bj * 128 + wc * 32 + 8 * fq, t = cc >> 4, c0 = cc & 15;
                    const f32x4 a = acc[ai][bj][m][0], b = acc[ai][bj][m][1];
                    v4u w; w.x = cvt_pk_bf16(gelu_tanh(a[0]), gelu_tanh(a[1])); w.y = cvt_pk_bf16(gelu_tanh(a[2]), gelu_tanh(a[3])); w.z = cvt_pk_bf16(gelu_tanh(b[0]), gelu_tanh(b[1])); w.w = cvt_pk_bf16(gelu_tanh(b[2]), gelu_tanh(b[3]));
                    *(v4u*)(AGLU + ((size_t)(b_ * SEQ + chunk * 16 + t)) * SW + 16 * g + c0) = w;
                }
            }
    }
};
__device__ __forceinline__ void s5_scan_unit(Frame& F, int bg, int dir, int tid) {
    const bf16* E = (const bf16*)(F.ws + WS_S5E); bf16* ZH = (bf16*)(F.ws + WS_S5ZH);
    LAS bf16* EL = (LAS bf16*)F.lds;
    for (int i = tid; i < S5_ROWS * 16; i += NWAVES * 64) { const int row = i >> 4, ck = i & 15; *(LAS v4u*)(EL + row * 128 + ck * 8) = *(const v4u*)(E + ((size_t)(bg * S5_ROWS + row)) * 256 + dir * 128 + ck * 8); }
    __syncthreads();
    if (tid < 64) {
        const int p = tid, g = bg & 63;
        float ar = ((const float*)(F.ws + WS_TAB + TAB_AR))[(dir * 64 + g) * 64 + p], ai = ((const float*)(F.ws + WS_TAB + TAB_AI))[(dir * 64 + g) * 64 + p];
#pragma unroll
        for (int k = 0; k < 4; ++k) { const float nr = ar * ar - ai * ai, ni = 2.f * ar * ai; ar = nr; ai = ni; }
        float hr = 0.f, hi = 0.f;
#pragma unroll 8
        for (int k = 0; k < S5_ROWS; ++k) {
            const int row = dir ? (S5_ROWS - 1 - k) : (k < 16 ? 256 + k : k - 16);
            const float er = bflo((unsigned)EL[row * 128 + p]), ei = bflo((unsigned)EL[row * 128 + 64 + p]);
            EL[row * 128 + p] = (bf16)f2bf(hr); EL[row * 128 + 64 + p] = (bf16)f2bf(hi);
            const float nr = ar * hr - ai * hi + er, ni = ar * hi + ai * hr + ei; hr = nr; hi = ni;
        }
    }
    __syncthreads();
    for (int i = tid; i < 256 * 16; i += NWAVES * 64) { const int row = i >> 4, ck = i & 15; *(v4u*)(ZH + ((size_t)(bg * 256 + row)) * 256 + dir * 128 + ck * 8) = *(const LAS v4u*)(EL + row * 128 + ck * 8); }
    __syncthreads();
}

constexpr int RS_PITCH = 136;
constexpr int RS_BUF = (128 + 32) * RS_PITCH * 2;
__device__ __forceinline__ void phase_rstate(Frame& F) {
    const bf16* KNL = (const bf16*)(F.ws + WS_K); const bf16* KNC = (const bf16*)(F.ws + WS_KFTC);
    const bf16* VT = (const bf16*)(F.ws + WS_VT); const bf16* VTC = (const bf16*)(F.ws + WS_VTC);
    bf16* SIN = (bf16*)(F.ws + WS_OBUF);
    const float* lg2 = (const float*)(F.ws + WS_TAB + TAB_LG2);
    const int lane0 = lane_id();
    const int w = F.wave;
    for (int unit = F.vcu; unit < NB * NH * 2 * 8; unit += F.G) {
        int lane = lane0; asm volatile("" : "+v"(lane));
        const int tid = w * 64 + lane, fr = lane & 15, fq = lane >> 4;
        const int sl = unit & 7, dir = (unit >> 3) & 1, h = (unit >> 4) & 7, b = unit >> 7;
        const float gC = __builtin_amdgcn_exp2f((float)CH * lg2[dir * 8 + h]);
        const int bh = b * NH + h;
        const bf16* kT = KNL; const bf16* kTc = KNC;
        const int prow = tid >> 4, pc = tid & 15;
        float kw[4];
#pragma unroll
        for (int i_ = 0; i_ < 4; ++i_) { const int j = prow + 32 * i_; kw[i_] = __builtin_amdgcn_exp2f((float)(dir ? j : CH - 1 - j) * lg2[dir * 8 + h]); }
        f32x4 st[2] = {{0.f, 0.f, 0.f, 0.f}, {0.f, 0.f, 0.f, 0.f}};
#define RS_ISSUE(k, R) do { if ((k) < 34) { const bf16* kb_; const bf16* vb_; int ls_; \
            if ((k) < 2) { const int cc_ = dir ? (1 - (k)) : (k); ls_ = LC; kb_ = kTc + (size_t)(b * LC + cc_ * CH) * 1024 + h * DK; vb_ = VTC + (size_t)(bh * DV + 32 * sl) * LC + cc_ * CH; } \
            else { const int n_ = dir ? (33 - (k)) : ((k) - 2); ls_ = SEQ; kb_ = kT + (size_t)(b * SEQ + n_ * CH) * 1024 + h * DK; vb_ = VT + (size_t)(bh * DV + 32 * sl) * SEQ + n_ * CH; } \
            _Pragma("unroll") for (int i_ = 0; i_ < 4; ++i_) R[i_] = *(const v4u*)(kb_ + (size_t)(prow + 32 * i_) * 1024 + pc * 8);     \
            R[4] = *(const v4u*)(vb_ + (size_t)prow * ls_ + pc * 8); } } while (0)
#define RS_STEP(k, R) do { LAS bf16* buf_ = (LAS bf16*)(F.lds + ((k) & 1) * RS_BUF); \
            _Pragma("unroll") for (int i_ = 0; i_ < 4; ++i_) { const v4u r_ = R[i_]; const float w_ = kw[i_]; v4u s_; \
                s_.x = cvt_pk_bf16(bflo(r_.x) * w_, bfhi(r_.x) * w_); s_.y = cvt_pk_bf16(bflo(r_.y) * w_, bfhi(r_.y) * w_); s_.z = cvt_pk_bf16(bflo(r_.z) * w_, bfhi(r_.z) * w_); s_.w = cvt_pk_bf16(bflo(r_.w) * w_, bfhi(r_.w) * w_); \
                *(LAS v4u*)(buf_ + (prow + 32 * i_) * RS_PITCH + pc * 8) = s_; } \
            *(LAS v4u*)(buf_ + (128 + prow) * RS_PITCH + pc * 8) = R[4]; } while (0)
#define RS_COMP(k) do { const LAS bf16* buf_ = (const LAS bf16*)(F.lds + ((k) & 1) * RS_BUF); \
            const int n_ = (k) < 2 ? -1 : (dir ? (33 - (k)) : ((k) - 2)); \
            if (n_ >= 0) { _Pragma("unroll") for (int et = 0; et < 2; ++et) { v2u o; o.x = cvt_pk_bf16(st[et][0], st[et][1]); o.y = cvt_pk_bf16(st[et][2], st[et][3]); \
                *(v2u*)(SIN + ((((size_t)(bh * 2 + dir) * NCH + n_) * DV + 32 * sl + 16 * et + fr) * DK + 16 * w + 4 * fq)) = o; } } \
            bf16x8 kf_[4];                         \
            { const unsigned ta_ = (unsigned)(size_t)buf_ + (unsigned)((8 * fq + (fr >> 2)) * (RS_PITCH * 2) + (16 * w + 4 * (fr & 3)) * 2); v2u t0_, t1_, t2_, t3_, t4_, t5_, t6_, t7_; \
              asm volatile("ds_read_b64_tr_b16 %0, %8\n\tds_read_b64_tr_b16 %1, %8 offset:1088\n\tds_read_b64_tr_b16 %2, %8 offset:8704\n\tds_read_b64_tr_b16 %3, %8 offset:9792\n\t" \
                           "ds_read_b64_tr_b16 %4, %8 offset:17408\n\tds_read_b64_tr_b16 %5, %8 offset:18496\n\tds_read_b64_tr_b16 %6, %8 offset:26112\n\tds_read_b64_tr_b16 %7, %8 offset:27200\n\ts_waitcnt lgkmcnt(0)" \
                           : "=&v"(t0_), "=&v"(t1_), "=&v"(t2_), "=&v"(t3_), "=&v"(t4_), "=&v"(t5_), "=&v"(t6_), "=&v"(t7_) : "v"(ta_) : "memory"); \
              kf_[0] = __builtin_bit_cast(bf16x8, (v4u){t0_.x, t0_.y, t1_.x, t1_.y}); kf_[1] = __builtin_bit_cast(bf16x8, (v4u){t2_.x, t2_.y, t3_.x, t3_.y}); \
              kf_[2] = __builtin_bit_cast(bf16x8, (v4u){t4_.x, t4_.y, t5_.x, t5_.y}); kf_[3] = __builtin_bit_cast(bf16x8, (v4u){t6_.x, t6_.y, t7_.x, t7_.y}); } \
            _Pragma("unroll") for (int et = 0; et < 2; ++et) { f32x4 kv = {0.f, 0.f, 0.f, 0.f}; \
                _Pragma("unroll") for (int ks = 0; ks < 4; ++ks) { const bf16x8 vf_ = *(const LAS bf16x8*)(buf_ + (128 + 16 * et + fr) * RS_PITCH + 32 * ks + 8 * fq); kv = __builtin_amdgcn_mfma_f32_16x16x32_bf16(kf_[ks], vf_, kv, 0, 0, 0); } \
                st[et] = st[et] * gC + kv; } } while (0)
        v4u RA[5], RB[5], RC[5];
        RS_ISSUE(0, RA); RS_ISSUE(1, RB);
        for (int k = 0; k < 34; k += 3) {
            RS_ISSUE(k + 2, RC);
            RS_STEP(k, RA); __syncthreads(); RS_COMP(k);
            RS_ISSUE(k + 3, RA);
            if (k + 1 < 34) { RS_STEP(k + 1, RB); __syncthreads(); RS_COMP(k + 1); }
            RS_ISSUE(k + 4, RB);
            if (k + 2 < 34) { RS_STEP(k + 2, RC); __syncthreads(); RS_COMP(k + 2); }
        }
        __syncthreads();
#undef RS_ISSUE
#undef RS_STEP
#undef RS_COMP
    }
}

constexpr int RO_PITCH = 136;
constexpr int RO_SLOT = 256 * RO_PITCH * 2;
__device__ __forceinline__ void phase_rout(Frame& F, const int cid) {
    const bf16* Q = (const bf16*)(F.ws + WS_Q);
    const bf16* KN = (const bf16*)(F.ws + WS_K); const bf16* VT = (const bf16*)(F.ws + WS_VT);
    const bf16* SIN = (const bf16*)(F.ws + WS_OBUF);
    bf16* SG = (bf16*)(F.ws + WS_HBUF);
    const float* lg2 = (const float*)(F.ws + WS_TAB + TAB_LG2);
    LAS bf16* SA = (LAS bf16*)F.lds; LAS bf16* SB = (LAS bf16*)(F.lds + RO_SLOT);
    const int lane0 = lane_id();
    const int w = F.wave;
    const bool split13 = (F.G == 256);
    const int ufirst = split13 ? (cid < 128 ? cid : 128 + (cid - 128) * 3) : F.vcu, ucount = split13 ? (cid < 128 ? 1 : 3) : (NB * NH * NCH - 1 - F.vcu) / F.G + 1, ustep = split13 ? 1 : F.G;
    for (int ui = 0; ui < ucount; ++ui) {
        const int unit = ufirst + ui * ustep;
        int lane = lane0; asm volatile("" : "+v"(lane));
        const int tid = w * 64 + lane, fr = lane & 15, fq = lane >> 4;
        const int n = unit & 31, h = (unit >> 5) & 7, b = unit >> 8, bh = b * NH + h;
        const float lgf = lg2[h], lgb = lg2[8 + h];
        const int tok0 = b * SEQ + n * CH;
        const int i = 16 * w + fr;
        const size_t qoff = (size_t)(tok0 + i) * 1024 + h * DK;
        {
            v4u kr[4], vr[8];
#pragma unroll
            for (int it = 0; it < 4; ++it) { const int q = tid + 512 * it, j = q >> 4, pc = q & 15; kr[it] = *(const v4u*)(KN + (size_t)(tok0 + j) * 1024 + h * DK + pc * 8); }
#pragma unroll
            for (int it = 0; it < 8; ++it) { const int q = tid + 512 * it, e = q >> 4, pc = q & 15; vr[it] = *(const v4u*)(VT + ((size_t)(bh * DV + e)) * SEQ + n * CH + pc * 8); }
#pragma unroll
            for (int it = 0; it < 4; ++it) { const int q = tid + 512 * it, j = q >> 4, pc = q & 15; *(LAS v4u*)(SB + j * RO_PITCH + pc * 8) = kr[it]; }
#pragma unroll
            for (int it = 0; it < 8; ++it) { const int q = tid + 512 * it, e = q >> 4, pc = q & 15; *(LAS v4u*)(SA + e * RO_PITCH + pc * 8) = vr[it]; }
        }
        bf16x8 qf[4];
#pragma unroll
        for (int ks = 0; ks < 4; ++ks) qf[ks] = *(const bf16x8*)(Q + qoff + 32 * ks + 8 * fq);
        __syncthreads();
        f32x4 sc[8];
#pragma unroll
        for (int jt = 0; jt < 8; ++jt) {
            f32x4 a = {0.f, 0.f, 0.f, 0.f};
#pragma unroll
            for (int ks = 0; ks < 4; ++ks) { const bf16x8 kf = *(const LAS bf16x8*)(SB + (16 * jt + fr) * RO_PITCH + 32 * ks + 8 * fq); a = __builtin_amdgcn_mfma_f32_16x16x32_bf16(kf, qf[ks], a, 0, 0, 0); }
#pragma unroll
            for (int r = 0; r < 4; ++r) { const int j = 16 * jt + 4 * fq + r, df = i - j; a[r] *= df >= 0 ? __builtin_amdgcn_exp2f((float)df * lgf) : __builtin_amdgcn_exp2f((float)(-df) * lgb); }
            sc[jt] = a;
        }
        f32x4 o[16];
#pragma unroll
        for (int et = 0; et < 16; ++et) o[et] = (f32x4){0.f, 0.f, 0.f, 0.f};
#pragma unroll
        for (int ks = 0; ks < 4; ++ks) {
            v4u pw; pw.x = cvt_pk_bf16(sc[2 * ks][0], sc[2 * ks][1]); pw.y = cvt_pk_bf16(sc[2 * ks][2], sc[2 * ks][3]); pw.z = cvt_pk_bf16(sc[2 * ks + 1][0], sc[2 * ks + 1][1]); pw.w = cvt_pk_bf16(sc[2 * ks + 1][2], sc[2 * ks + 1][3]);
            const bf16x8 pf = __builtin_bit_cast(bf16x8, pw);
#pragma unroll
            for (int et = 0; et < 16; ++et) {
                const LAS bf16* vp = SA + (16 * et + fr) * RO_PITCH + 32 * ks + 4 * fq;
                const v2u lo = *(const LAS v2u*)vp, hi2 = *(const LAS v2u*)(vp + 16);
                v4u vw; vw.x = lo.x; vw.y = lo.y; vw.z = hi2.x; vw.w = hi2.y;
                o[et] = __builtin_amdgcn_mfma_f32_16x16x32_bf16(__builtin_bit_cast(bf16x8, vw), pf, o[et], 0, 0, 0);
            }
        }
        __syncthreads();
        {
            const bf16* sf = SIN + (((size_t)(bh * 2 + 0) * NCH + n) * DV) * DK; const bf16* sb = SIN + (((size_t)(bh * 2 + 1) * NCH + n) * DV) * DK;
            v4u fr_[8], br_[8];
#pragma unroll
            for (int it = 0; it < 8; ++it) { const int q = tid + 512 * it; fr_[it] = *(const v4u*)(sf + (size_t)q * 8); br_[it] = *(const v4u*)(sb + (size_t)q * 8); }
#pragma unroll
            for (int it = 0; it < 8; ++it) { const int q = tid + 512 * it, e = q >> 4, pc = q & 15; *(LAS v4u*)(SA + e * RO_PITCH + pc * 8) = fr_[it]; *(LAS v4u*)(SB + e * RO_PITCH + pc * 8) = br_[it]; }
        }
        bf16x8 qff[4], qbf[4];
        { const float wfq = __builtin_amdgcn_exp2f((float)(i + 1) * lgf), wbq = __builtin_amdgcn_exp2f((float)(CH - i) * lgb);
#pragma unroll
          for (int ks = 0; ks < 4; ++ks) { const v4u qw = __builtin_bit_cast(v4u, qf[ks]); v4u a, b2;
            a.x = cvt_pk_bf16(bflo(qw.x) * wfq, bfhi(qw.x) * wfq); a.y = cvt_pk_bf16(bflo(qw.y) * wfq, bfhi(qw.y) * wfq); a.z = cvt_pk_bf16(bflo(qw.z) * wfq, bfhi(qw.z) * wfq); a.w = cvt_pk_bf16(bflo(qw.w) * wfq, bfhi(qw.w) * wfq);
            b2.x = cvt_pk_bf16(bflo(qw.x) * wbq, bfhi(qw.x) * wbq); b2.y = cvt_pk_bf16(bflo(qw.y) * wbq, bfhi(qw.y) * wbq); b2.z = cvt_pk_bf16(bflo(qw.z) * wbq, bfhi(qw.z) * wbq); b2.w = cvt_pk_bf16(bflo(qw.w) * wbq, bfhi(qw.w) * wbq);
            qff[ks] = __builtin_bit_cast(bf16x8, a); qbf[ks] = __builtin_bit_cast(bf16x8, b2); } }
        __syncthreads();
#pragma unroll
        for (int ks = 0; ks < 4; ++ks)
#pragma unroll
            for (int et = 0; et < 16; ++et) {
                const bf16x8 s1 = *(const LAS bf16x8*)(SA + (16 * et + fr) * RO_PITCH + 32 * ks + 8 * fq), s2 = *(const LAS bf16x8*)(SB + (16 * et + fr) * RO_PITCH + 32 * ks + 8 * fq);
                o[et] = __builtin_amdgcn_mfma_f32_16x16x32_bf16(s1, qff[ks], o[et], 0, 0, 0);
                o[et] = __builtin_amdgcn_mfma_f32_16x16x32_bf16(s2, qbf[ks], o[et], 0, 0, 0);
            }
        float ss = 0.f;
#pragma unroll
        for (int et = 0; et < 16; ++et) ss += (o[et][0] * o[et][0] + o[et][1] * o[et][1]) + (o[et][2] * o[et][2] + o[et][3] * o[et][3]);
        ss += shfl_xor_l(ss, 16, lane); ss += shfl_xor_l(ss, 32, lane);
        const float rinv = 1.0f / sqrtf(ss * (1.0f / DV) + EPS);
        bf16* gp = SG + (size_t)(tok0 + i) * D + h * DV + 4 * fq;
#pragma unroll
        for (int et = 0; et < 16; ++et) { const v2u gg = *(const v2u*)(gp + 16 * et);
            v2u ow; ow.x = cvt_pk_bf16(o[et][0] * rinv * bflo(gg.x), o[et][1] * rinv * bfhi(gg.x)); ow.y = cvt_pk_bf16(o[et][2] * rinv * bflo(gg.y), o[et][3] * rinv * bfhi(gg.y));
            *(v2u*)(gp + 16 * et) = ow; }
        __syncthreads();
    }
}

__global__ void __launch_bounds__(NWAVES * 64, 2) fwd_megakernel(Args args) {
    extern __shared__ __attribute__((aligned(16))) unsigned char lds[];
    Frame F;
    F.lds = (LAS unsigned char*)lds;
    F.MISC = (volatile LAS unsigned*)(F.lds + MISC_OFF);
    F.wave = __builtin_amdgcn_readfirstlane((int)threadIdx.x >> 6);
    F.G = gridDim.x; { const int bx = blockIdx.x; F.vcu = (F.G % 8 == 0) ? (bx % 8) * (F.G / 8) + bx / 8 : bx; }
    F.out = kargs()->out; F.ws = kargs()->ws; F.ctl = (unsigned*)(F.ws + WS_CTL);
    for (int u = (int)threadIdx.x; u < (LDS_BYTES - LDSCTL_OFF) / 4; u += NWAVES * 64) ((LAS unsigned*)(F.lds + LDSCTL_OFF))[u] = 0u;
    __syncthreads();
    XcdBarrier bar = xcd_barrier_post(F.ctl + CW_BAR, F.MISC + 8);
    unsigned char* ws = F.ws;
    const int G = F.G, cid = (int)blockIdx.x;
#define GRID_BAR() xcd_barrier(bar)

#ifndef PHM
#define PHM 0xFFFFF
#endif
#define PH(k) ((PHM >> (k)) & 1)
#ifndef REPM
#define REPM 0
#endif
#define NREP(k) (1 + ((REPM >> (k)) & 1))
#if PH(0)
    phase_prologue(F, args, true);
#if NREP(0) > 1
    phase_prologue(F, args, false);
#endif
#endif
    GRID_BAR();
#if PH(1)
    phase_rows<0>(F, args);
    s5_tables1(F, args);
#endif
    GRID_BAR();
#if PH(2)
    {
        pg8::GridOrder S; S.init(ws + WS_ABUF, ws + WS_W1T, D, MT / 256, NFF / 256, G, cid);
        EpiSwiGLU E{(bf16*)(ws + WS_HBUF)};
        pg8::gemm_phase(F.lds, D, S, E, F.wave);
    }
    if (G == 256 && cid >= 256 - CV_G1_CUS) conv_range(F, 1, 0, CV_L1_G1, (cid - (256 - CV_G1_CUS)) * NWAVES + F.wave, CV_G1_CUS * NWAVES);
#if NREP(2) > 1
    {
        pg8::GridOrder S; S.init(ws + WS_ABUF, ws + WS_W1T, D, MT / 256, NFF / 256, G, cid);
        EpiSwiGLU E{(bf16*)(ws + WS_HBUF)};
        pg8::gemm_phase(F.lds, D, S, E, F.wave);
    }
#endif
#endif
    GRID_BAR();
#if PH(3)
    {
        Ffn1DownOrder S{(const char*)(ws + WS_HBUF), (const char*)(ws + WS_W2T), G, cid};
        EpiFfn1Down E{(bf16*)(ws + WS_OBUF), (float*)(ws + WS_SLAB)};
        pg8::gemm_phase(F.lds, DFF, S, E, F.wave);
    }
    if (G == 256 && cid >= 256 - CV_G2_CUS) conv_range(F, 1, CV_L1_G1, CV_L1_G1 + CV_L1_G2, (cid - (256 - CV_G2_CUS)) * NWAVES + F.wave, CV_G2_CUS * NWAVES);
#if NREP(3) > 1
    {
        pg8::GridOrder S; S.init(ws + WS_HBUF, ws + WS_W2T, DFF, MT / 256, D / 256, G, cid);
        EpiO16 E{(bf16*)(ws + WS_OBUF), D};
        pg8::gemm_phase(F.lds, DFF, S, E, F.wave);
    }
#endif
#endif
    GRID_BAR();
#if PH(4)
    phase_rows<1>(F, args);
    s5_tables2(F, args);
#endif
    GRID_BAR();
#if PH(5)
    {
        MixOrder S{(const char*)(ws + WS_ABUF), (const char*)(ws + WS_WMT), G, cid};
        EpiMix E{ws};
        pg8::gemm_phase(F.lds, D, S, E, F.wave);
    }
    if (G == 256 && cid >= 256 - CV_G3_CUS) conv_range(F, 2, 0, CV_L2_G3, (cid - (256 - CV_G3_CUS)) * NWAVES + F.wave, CV_G3_CUS * NWAVES);
#if NREP(5) > 1
    {
        MixOrder S{(const char*)(ws + WS_ABUF), (const char*)(ws + WS_WMT), G, cid};
        EpiMix E{ws};
        pg8::gemm_phase(F.lds, D, S, E, F.wave);
    }
#endif
#endif
    GRID_BAR();
#if PH(6)
    phase_rstate(F);
#if NREP(6) > 1
    phase_rstate(F);
#endif
#endif
#if PH(7)
    {
        S5EOrder S{(const char*)(ws + WS_US), (const char*)(ws + WS_S5WE), G, cid};
        EpiS5E E{(bf16*)(ws + WS_S5E)};
        pg8::gemm_phase(F.lds, 256, S, E, F.wave);
    }
#endif
    GRID_BAR();
#if PH(8)
    {
        int tid_ = F.wave * 64 + lane_id(); asm volatile("" : "+v"(tid_));
        for (int bg = cid; bg < NB * 64; bg += G) { s5_scan_unit(F, bg, 0, tid_); s5_scan_unit(F, bg, 1, tid_); }
        asm volatile("s_waitcnt vmcnt(0)" ::: "memory"); __syncthreads();
        S5YOrder S{(const char*)(ws + WS_US), (const char*)(ws + WS_S5ZH), (const char*)(ws + WS_S5WY1), (const char*)(ws + WS_S5WY2), G, cid};
        EpiS5Y E{(bf16*)(ws + WS_AGLU)};
        pg8::gemm_phase(F.lds, 256, S, E, F.wave);
    }
    phase_rout(F, cid);
#endif
    GRID_BAR();
#if PH(9)
    {
        pg8::GridOrder S; S.init(ws + WS_AGLU, ws + WS_WGT, SW, MX / 256, 2 * D / 256, G, cid);
        EpiGLU E{(const bf16*)(ws + WS_HBUF + 32 * MiB), (bf16*)(ws + WS_Q)};
        pg8::gemm_phase(F.lds, SW, S, E, F.wave);
    }
#if NREP(9) > 1
    {
        pg8::GridOrder S; S.init(ws + WS_AGLU, ws + WS_WGT, SW, MX / 256, 2 * D / 256, G, cid);
        EpiGLU E{(const bf16*)(ws + WS_HBUF + 32 * MiB), (bf16*)(ws + WS_Q)};
        pg8::gemm_phase(F.lds, SW, S, E, F.wave);
    }
#endif
#endif
    GRID_BAR();
#if PH(10)
    {
        pg8::GridOrder S; S.init(ws + WS_HBUF, ws + WS_WPT, D, MX / 256, D / 256, G, cid);
        EpiMerge E{(const bf16*)(ws + WS_HBUF + 64 * MiB), (bf16*)(ws + WS_Q)};
        pg8::gemm_phase(F.lds, D, S, E, F.wave);
    }
#if NREP(10) > 1
    {
        pg8::GridOrder S; S.init(ws + WS_HBUF, ws + WS_WPT, D, MX / 256, D / 256, G, cid);
        EpiMerge E{(const bf16*)(ws + WS_HBUF + 64 * MiB), (bf16*)(ws + WS_Q)};
        pg8::gemm_phase(F.lds, D, S, E, F.wave);
    }
#endif
#endif
    GRID_BAR();
#if PH(11)
    {
        pg8::GridOrder S; S.init(ws + WS_Q, ws + WS_WOT, D, MX / 256, D / 256, G, cid);
        EpiO16 E{(bf16*)(ws + WS_OBUF), D};
        pg8::gemm_phase(F.lds, D, S, E, F.wave);
    }
#if NREP(11) > 1
    {
        pg8::GridOrder S; S.init(ws + WS_Q, ws + WS_WOT, D, MX / 256, D / 256, G, cid);
        EpiO16 E{(bf16*)(ws + WS_OBUF), D};
        pg8::gemm_phase(F.lds, D, S, E, F.wave);
    }
#endif
#endif
    GRID_BAR();
#if PH(12)
    phase_rows<2>(F, args);
#if NREP(12) > 1
    phase_rows<2>(F, args);
#endif
#endif
    GRID_BAR();
#if PH(13)
    {
        pg8::GridOrder S; S.init(ws + WS_ABUF, ws + WS_W3T, D, MX / 256, NFF / 256, G, cid);
        EpiSwiGLU E{(bf16*)(ws + WS_HBUF)};
        pg8::gemm_phase(F.lds, D, S, E, F.wave);
    }
#if NREP(13) > 1
    {
        pg8::GridOrder S; S.init(ws + WS_ABUF, ws + WS_W3T, D, MX / 256, NFF / 256, G, cid);
        EpiSwiGLU E{(bf16*)(ws + WS_HBUF)};
        pg8::gemm_phase(F.lds, D, S, E, F.wave);
    }
#endif
#endif
    GRID_BAR();
#if PH(14)
    {
        pg8::GridOrder S; S.init(ws + WS_HBUF, ws + WS_W4T, DFF, MX / 256, D / 256, G, cid);
        EpiO16 E{(bf16*)(ws + WS_OBUF), D};
        pg8::gemm_phase(F.lds, DFF, S, E, F.wave);
    }
#if NREP(14) > 1
    {
        pg8::GridOrder S; S.init(ws + WS_HBUF, ws + WS_W4T, DFF, MX / 256, D / 256, G, cid);
        EpiO16 E{(bf16*)(ws + WS_OBUF), D};
        pg8::gemm_phase(F.lds, DFF, S, E, F.wave);
    }
#endif
#endif
    GRID_BAR();
#if PH(15)
    phase_rows<3>(F, args);
#if NREP(15) > 1
    phase_rows<3>(F, args);
#endif
#endif
}

extern "C" void kernel_launch(void* const* d_in, const int* in_sizes, int n_in, void* d_out, int out_size, void* d_ws, size_t ws_size, hipStream_t stream) {
    static int grid = 0;
    if (grid == 0) {
        if (n_in != 22 || in_sizes[0] != MX * D || out_size != MX * D || ws_size < WS_END) { fprintf(stderr, "kernel_launch: unexpected problem (n_in %d, in0 %d, out %d, ws %zu, need %zu)\n", n_in, n_in > 0 ? in_sizes[0] : -1, out_size, ws_size, (size_t)WS_END); grid = -1; return; }
        int dev = 0, cus = 0, per_cu = 0;
        if (hipGetDevice(&dev) != hipSuccess || hipDeviceGetAttribute(&cus, hipDeviceAttributeMultiprocessorCount, dev) != hipSuccess) { grid = -1; return; }
        if (hipFuncSetAttribute((const void*)fwd_megakernel, hipFuncAttributeMaxDynamicSharedMemorySize, LDS_BYTES) != hipSuccess) { fprintf(stderr, "kernel_launch: hipFuncSetAttribute failed\n"); grid = -1; return; }
        if (hipOccupancyMaxActiveBlocksPerMultiprocessor(&per_cu, (const void*)fwd_megakernel, NWAVES * 64, LDS_BYTES) != hipSuccess || per_cu < 1) { fprintf(stderr, "kernel_launch: occupancy query says %d blocks per CU\n", per_cu); grid = -1; (void)hipGetLastError(); return; }
        grid = cus;
    }
    if (grid < 0) return;
    if (hipMemsetAsync((char*)d_ws + WS_CTL, 0, CTL_ZERO_BYTES, stream) != hipSuccess) return;
    Args a{};
    for (int i = 0; i < 22; ++i) a.in[i] = (const float*)d_in[i];
    a.out = (float*)d_out; a.ws = (unsigned char*)d_ws;
    void* kargs[] = {&a};
    hipError_t e = hipLaunchCooperativeKernel((const void*)fwd_megakernel, dim3(grid), dim3(NWAVES * 64), kargs, LDS_BYTES, stream);
    if (e != hipSuccess) fprintf(stderr, "kernel_launch: cooperative launch failed: %s (grid %d)\n", hipGetErrorString(e), grid);
}
```

```cpp
#include <hip/hip_runtime.h>
#include <cstdio>
#include <cstdint>

#define GAS __attribute__((address_space(1)))
#define LAS __attribute__((address_space(3)))
typedef unsigned short bf16;
typedef unsigned v4u __attribute__((ext_vector_type(4)));
typedef unsigned v2u __attribute__((ext_vector_type(2)));
typedef float f32x4 __attribute__((ext_vector_type(4)));
typedef float f32x2 __attribute__((ext_vector_type(2)));
typedef short bf16x8 __attribute__((ext_vector_type(8)));
typedef short bf16x4 __attribute__((ext_vector_type(4)));

constexpr int D = 2048, NB = 2, SEQ = 4096, MX = NB * SEQ, LC = 256, MC = NB * LC, MT = MX + MC;
constexpr int DFF = 5632, NFF = 2 * DFF, SW = 1024, NMIX = 11264, NH = 8, DK = 128, DV = 256, CH = 128, NCH = SEQ / CH;
constexpr int NADA = 9 * D;
constexpr float EPS = 1e-6f;
constexpr int NWAVES = 8;

constexpr size_t MiB = 1u << 20;
constexpr size_t WS_CTL = 0, CTL_ZERO_BYTES = 1 * MiB;
constexpr size_t WS_W1T = 1 * MiB, WS_W2T = 45 * MiB, WS_WMT = 67 * MiB, WS_WGT = 115 * MiB, WS_WPT = 123 * MiB, WS_WOT = 131 * MiB, WS_W3T = 139 * MiB, WS_W4T = 183 * MiB;
constexpr size_t WS_ABUF = 205 * MiB;
constexpr size_t WS_HBUF = 239 * MiB;
constexpr size_t WS_OBUF = 335 * MiB;
constexpr size_t WS_US = 403 * MiB;
constexpr size_t WS_Q = 420 * MiB, WS_QF = 436 * MiB, WS_QB = 452 * MiB;
constexpr size_t WS_K = 468 * MiB;
constexpr size_t WS_KFT = 484 * MiB, WS_KBT = 500 * MiB, WS_KFTC = 516 * MiB, WS_KBTC = 517 * MiB;
constexpr size_t WS_STREAM = WS_KFT;
constexpr size_t WS_VT = 518 * MiB, WS_VTC = 550 * MiB;
constexpr size_t WS_YF = 552 * MiB;
constexpr size_t WS_S5WE = WS_YF, WS_S5WY1 = WS_YF + 8 * MiB, WS_S5WY2 = WS_YF + 16 * MiB, WS_S5KT = WS_YF + 24 * MiB, WS_S5BRF = WS_YF + 26 * MiB, WS_S5APOW = WS_YF + 28 * MiB;
constexpr size_t WS_S5E = WS_ABUF, WS_S5ZH = WS_ABUF + 17 * MiB;
constexpr int S5_ROWS = 272;
constexpr size_t WS_AGLU = 584 * MiB;
constexpr size_t WS_TAB = 600 * MiB;
constexpr size_t WS_END = 602 * MiB;
constexpr size_t TAB_ROPE = 0, TAB_LG2 = 16384, TAB_AR = 32768, TAB_AI = 65536, TAB_END = 131072;
constexpr int CW_BAR = 4096;
constexpr size_t CTL_ADA = 65536;

#define RLX_AGENT __ATOMIC_RELAXED, __HIP_MEMORY_SCOPE_AGENT
#define LDS_WAIT() asm volatile("s_waitcnt lgkmcnt(0)" ::: "memory")
#define VM_WAIT() asm volatile("s_waitcnt vmcnt(0)" ::: "memory")

__device__ __forceinline__ unsigned f2bf(float f) { unsigned u = __builtin_bit_cast(unsigned, f); return (u + 0x7fffu + ((u >> 16) & 1u)) >> 16; }
__device__ __forceinline__ unsigned pk2(float lo, float hi) { return f2bf(lo) | (f2bf(hi) << 16); }
__device__ __forceinline__ unsigned cvt_pk_bf16(float lo, float hi) { unsigned r; asm volatile("v_cvt_pk_bf16_f32 %0, %1, %2" : "=v"(r) : "v"(lo), "v"(hi)); return r; }
__device__ __forceinline__ float bflo(unsigned w) { return __builtin_bit_cast(float, w << 16); }
__device__ __forceinline__ float bfhi(unsigned w) { return __builtin_bit_cast(float, w & 0xffff0000u); }
__device__ __forceinline__ float fast_sigmoid(float x) { return __builtin_amdgcn_rcpf(1.0f + __builtin_amdgcn_exp2f(-1.4426950408889634f * x)); }
__device__ __forceinline__ float fast_silu(float x) { return x * fast_sigmoid(x); }
__device__ __forceinline__ float gelu_tanh(float x) { const float u = 0.7978845608028654f * (x + 0.044715f * x * x * x); return x * fast_sigmoid(2.0f * u); }
__device__ __forceinline__ int lane_id() { return (int)__builtin_amdgcn_mbcnt_hi(~0u, __builtin_amdgcn_mbcnt_lo(~0u, 0u)); }
__device__ __forceinline__ float shfl_xor_l(float v, int mask, int lane) { return __builtin_bit_cast(float, __builtin_amdgcn_ds_bpermute((lane ^ mask) << 2, __builtin_bit_cast(int, v))); }
__device__ __forceinline__ float wave_sum(float v, int lane) {
#pragma unroll
    for (int o = 1; o < 64; o <<= 1) v += shfl_xor_l(v, o, lane);
    return v;
}

#define XB_TMO      128
#define XB_XCNT(j)  (256  + 64 * (j))
#define XB_XSUB(j)  (1280 + 64 * (j))
#define XB_XGEN(j)  (2304 + 64 * (j))
#define XB_TOP      3328
#define XB_TOPGEN   3392
#define XCD_BAR_WORDS 3456
#define XB_SPIN_CAP (1u << 18)
__device__ __forceinline__ unsigned xb_ld(unsigned* p)              { return __hip_atomic_load(p, __ATOMIC_RELAXED, __HIP_MEMORY_SCOPE_AGENT); }
__device__ __forceinline__ unsigned xb_add(unsigned* p, unsigned v) { return __hip_atomic_fetch_add(p, v, __ATOMIC_RELAXED, __HIP_MEMORY_SCOPE_AGENT); }
__device__ __forceinline__ unsigned xb_xcc_id() { return (unsigned)__builtin_amdgcn_s_getreg((3 << 11) | 20) & 0xFu; }
#define XB_SPIN(cond, bar) do { unsigned _sp = 0; while (cond) { __builtin_amdgcn_s_sleep(1); \
    if ((++_sp & 255u) == 0u) { if (xb_ld(&(bar)[XB_TMO])) break; if (_sp > XB_SPIN_CAP) { atomicAdd(&(bar)[XB_TMO], 1u); break; } } } } while (0)
struct XcdBarrier { unsigned* bar; unsigned x; volatile LAS unsigned* st; };
__device__ __forceinline__ XcdBarrier xcd_barrier_post(unsigned* bar, volatile LAS unsigned* st) {
    XcdBarrier b; b.bar = bar; b.x = xb_xcc_id(); b.st = st;
    if (threadIdx.x == 0) (void)xb_add(&bar[XB_XCNT(b.x)], 1u);
    return b;
}
__device__ __forceinline__ void xcd_barrier_complete(unsigned* bar, unsigned x, unsigned& nloc, unsigned& nx) {
    const unsigned G = gridDim.x * gridDim.y * gridDim.z;
    unsigned sum, cnt, mine, sp = 0u;
    for (;;) {
        sum = 0u; cnt = 0u; mine = 0u;
#pragma unroll
        for (unsigned j = 0; j < 16; ++j) { const unsigned c = xb_ld(&bar[XB_XCNT(j)]); sum += c; cnt += (c > 0u) ? 1u : 0u; mine = (j == x) ? c : mine; }
        if (sum == G) break;
        __builtin_amdgcn_s_sleep(1);
        if ((++sp & 255u) == 0u) { if (xb_ld(&bar[XB_TMO])) break; if (sp > XB_SPIN_CAP) { atomicAdd(&bar[XB_TMO], 1u); break; } }
    }
    nloc = mine > 0u ? mine : 1u; nx = cnt > 0u ? cnt : 1u;
}
__device__ __forceinline__ void xcd_barrier(const XcdBarrier& b) {
    asm volatile("s_waitcnt vmcnt(0)" ::: "memory");
    __syncthreads();
    if (threadIdx.x == 0) {
        unsigned* bar = b.bar;
        __builtin_amdgcn_s_waitcnt(0);
        unsigned nloc = b.st[0], nx = b.st[1];
        if (nloc == 0u) { xcd_barrier_complete(bar, b.x, nloc, nx); b.st[0] = nloc; b.st[1] = nx; }
        const unsigned old = xb_add(&bar[XB_XSUB(b.x)], 1u);
        const unsigned gen = old / nloc;
        if (old + 1u == (gen + 1u) * nloc) {
            __builtin_amdgcn_fence(__ATOMIC_RELEASE, "agent");
            asm volatile("s_waitcnt vmcnt(0)" ::: "memory");
            const unsigned og = xb_add(&bar[XB_TOP], 1u);
            const unsigned tg = og / nx;
            if (og + 1u == (tg + 1u) * nx) xb_add(&bar[XB_TOPGEN], 1u);
            else XB_SPIN(xb_ld(&bar[XB_TOPGEN]) == tg, bar);
            __builtin_amdgcn_fence(__ATOMIC_ACQUIRE, "agent");
            xb_add(&bar[XB_XGEN(b.x)], 1u);
            asm volatile("s_waitcnt vmcnt(0)" ::: "memory");
        } else {
            XB_SPIN(xb_ld(&bar[XB_XGEN(b.x)]) == gen, bar);
            __builtin_amdgcn_fence(__ATOMIC_ACQUIRE, "agent");
            asm volatile("s_waitcnt vmcnt(0)" ::: "memory");
        }
    }
    __syncthreads();
}

namespace pg8 {
constexpr int BM = 256, BK = 64, HALF = 128, HTB = HALF * BK * 2, STAGE_BYTES = 8 * HTB, NXCD = 8;
__device__ __forceinline__ int lds_byte(int r, int c) { const int st = (r >> 4) * 2 + (c >> 5), rr = r & 15, cc = c & 31, ob = rr * 64 + cc * 2; return st * 1024 + (ob ^ (((ob >> 9) & 1) << 5)); }
__device__ __forceinline__ void stage_rc(int b, int& R, int& C) { const int st = b / 1024, sb = b % 1024, swz = sb ^ (((sb >> 9) & 1) << 5); R = (st >> 1) * 16 + swz / 64; C = (st & 1) * 32 + (swz % 64) / 2; }
__device__ __forceinline__ int perm32(int rho) { const int n = rho >> 4, i = rho & 15; return 8 * (i >> 2) + 4 * n + (i & 3); }

struct Unit {
    const char* A; const char* B; unsigned info;
    __device__ __forceinline__ int pm() const { return (int)(info & 255u); }
    __device__ __forceinline__ int pn() const { return (int)((info >> 8) & 255u); }
    __device__ __forceinline__ int kind() const { return (int)((info >> 16) & 15u); }
    __device__ __forceinline__ int nt() const { return (int)((info >> 20) & 255u); }
    __device__ __forceinline__ int cont() const { return (int)((info >> 28) & 1u); }
};
__device__ __forceinline__ Unit make_unit(const char* A, const char* B, int pm, int pn, int kind, int nt, int cont) { return Unit{A, B, (unsigned)pm | ((unsigned)pn << 8) | ((unsigned)kind << 16) | ((unsigned)nt << 20) | ((unsigned)cont << 28)}; }
__device__ __forceinline__ int xcd_remap(int L, int nwg) { const int q = nwg / NXCD, r = nwg % NXCD, xcd = L % NXCD, off = L / NXCD; return (xcd < r ? xcd * (q + 1) : r * (q + 1) + (xcd - r) * q) + off; }

template <class Epi, class Sched>
__device__ __forceinline__ void gemm_phase(LAS unsigned char* lds, const int K, const Sched& S, const Epi& E, const int wave_) {
    int tid = wave_ * 64 + lane_id(); asm volatile("" : "+v"(tid));
    const int wid = wave_, lane = tid & 63, wr = wid >> 2, wc = wid & 3, fr = lane & 15, fq = lane >> 4;
    unsigned voffA[2], voffB[2];
#pragma unroll
    for (int i = 0; i < 2; ++i) { int R, C; stage_rc(tid * 16 + i * 8192, R, C); const int Rb = (R & ~31) + perm32(R & 31);
        voffA[i] = (unsigned)(R * K + C) * 2u; voffB[i] = (unsigned)(Rb * K + C) * 2u; }
    const size_t kstep = (size_t)(BK * 2);
    const size_t hstep = (size_t)HALF * K * 2;
    const unsigned ldsw = (unsigned)wid * 1024u;
    const int aoff = lds_byte(wr * 64 + fr, fq * 8), boff = lds_byte(wc * 32 + fr, fq * 8);
#define PG8_SA(b, h) (((b) * 2 + (h)) * HTB)
#define PG8_SB(b, h) ((4 + (b) * 2 + (h)) * HTB)
#define PG8_STAGE(bufoff, gbase, voff) do { _Pragma("unroll") for (int _i = 0; _i < 2; ++_i) \
        __builtin_amdgcn_global_load_lds((const unsigned*)((const char*)(gbase) + (voff)[_i]), (LAS unsigned*)(lds + (bufoff) + ldsw + _i * 8192), 16, 0, 0); } while (0)
#define PG8_LDA(dst, b, h) do { _Pragma("unroll") for (int m = 0; m < 4; ++m) _Pragma("unroll") for (int k = 0; k < 2; ++k) dst[m][k] = *(const LAS bf16x8*)(lds + PG8_SA(b, h) + aoff + m * 2048 + k * 1024); } while (0)
#define PG8_LDB(dst, b, h) do { _Pragma("unroll") for (int n = 0; n < 2; ++n) _Pragma("unroll") for (int k = 0; k < 2; ++k) dst[n][k] = *(const LAS bf16x8*)(lds + PG8_SB(b, h) + boff + n * 2048 + k * 1024); } while (0)
#define PG8_MMA(ai, bj, At, Bt) do { __builtin_amdgcn_s_setprio(1); _Pragma("unroll") for (int m = 0; m < 4; ++m) _Pragma("unroll") for (int n = 0; n < 2; ++n) _Pragma("unroll") for (int k = 0; k < 2; ++k) \
        acc[ai][bj][m][n] = __builtin_amdgcn_mfma_f32_16x16x32_bf16(Bt[n][k], At[m][k], acc[ai][bj][m][n], 0, 0, 0); __builtin_amdgcn_s_setprio(0); } while (0)
#define PG8_WAIT_V(n) asm volatile("s_waitcnt vmcnt(" #n ")" ::: "memory")
#define PG8_WAIT_L(n) asm volatile("s_waitcnt lgkmcnt(" #n ")" ::: "memory")
#define PG8_BAR __builtin_amdgcn_s_barrier()
#define PG8_SCHED __builtin_amdgcn_sched_barrier(0)
    Unit cur, nxt; int ui = 0;
    if (!S.next(0, cur)) return;
    f32x4 acc[2][2][4][2];
#pragma unroll
    for (int a = 0; a < 2; ++a)
#pragma unroll
        for (int b = 0; b < 2; ++b)
#pragma unroll
            for (int m = 0; m < 4; ++m)
#pragma unroll
                for (int n = 0; n < 2; ++n) acc[a][b][m][n] = (f32x4){0.f, 0.f, 0.f, 0.f};
    bf16x8 At[4][2], B0[2][2], B1[2][2];
    const char* cA = cur.A; const char* cB = cur.B;
    PG8_STAGE(PG8_SB(0, 0), cB, voffB); PG8_STAGE(PG8_SB(0, 1), cB + hstep, voffB); PG8_STAGE(PG8_SA(0, 0), cA, voffA); PG8_STAGE(PG8_SA(0, 1), cA + hstep, voffA);
    if (wr == 1) PG8_BAR;
    PG8_WAIT_V(2); PG8_BAR;
    PG8_STAGE(PG8_SB(1, 0), cB + kstep, voffB); PG8_STAGE(PG8_SA(1, 0), cA + kstep, voffA); PG8_STAGE(PG8_SB(1, 1), cB + hstep + kstep, voffB);
    PG8_WAIT_V(6); PG8_BAR;
    for (;;) {
        const bool has_next = S.next(ui + 1, nxt);
        const char* nA = has_next ? nxt.A : cA; const char* nB = has_next ? nxt.B : cB;
        const int nt = cur.nt();
        for (int t = 0; t < nt; t += 2) {
            const bool last = (t == nt - 2);
            const char* a1 = cA + (size_t)(t + 1) * kstep;
            const char* a2 = last ? nA : cA + (size_t)(t + 2) * kstep; const char* b2 = last ? nB : cB + (size_t)(t + 2) * kstep;
            const char* a3 = a2 + kstep; const char* b3 = b2 + kstep;
            PG8_LDB(B0, 0, 0); PG8_LDB(B1, 0, 1); PG8_SCHED; PG8_LDA(At, 0, 0); PG8_STAGE(PG8_SA(1, 1), a1 + hstep, voffA);
            PG8_WAIT_V(8); PG8_WAIT_L(0); PG8_BAR; PG8_MMA(0, 0, At, B0); PG8_MMA(0, 1, At, B1); PG8_BAR; PG8_SCHED;
            PG8_LDA(At, 0, 1); PG8_STAGE(PG8_SB(0, 0), b2, voffB); PG8_STAGE(PG8_SB(0, 1), b2 + hstep, voffB); PG8_STAGE(PG8_SA(0, 0), a2, voffA);
            PG8_WAIT_V(8); PG8_WAIT_L(0); PG8_BAR; PG8_MMA(1, 0, At, B0); PG8_MMA(1, 1, At, B1); PG8_BAR; PG8_SCHED;
            PG8_LDB(B0, 1, 0); PG8_LDB(B1, 1, 1); PG8_SCHED; PG8_LDA(At, 1, 0); PG8_STAGE(PG8_SA(0, 1), a2 + hstep, voffA);
            PG8_WAIT_V(8); PG8_WAIT_L(0); PG8_BAR; PG8_MMA(0, 0, At, B0); PG8_MMA(0, 1, At, B1); PG8_BAR; PG8_SCHED;
            PG8_LDA(At, 1, 1); PG8_STAGE(PG8_SB(1, 0), b3, voffB); PG8_STAGE(PG8_SB(1, 1), b3 + hstep, voffB); PG8_STAGE(PG8_SA(1, 0), a3, voffA);
            PG8_WAIT_V(8); PG8_WAIT_L(0); PG8_BAR; PG8_MMA(1, 0, At, B0); PG8_MMA(1, 1, At, B1); PG8_BAR; PG8_SCHED;
        }
        if (wr == 0) PG8_BAR;
        if (!cur.cont()) E(acc, cur, wr, wc, fr, fq);
        if (!has_next) break;
        if (!cur.cont()) {
#pragma unroll
        for (int a = 0; a < 2; ++a)
#pragma unroll
            for (int b = 0; b < 2; ++b)
#pragma unroll
                for (int m = 0; m < 4; ++m)
#pragma unroll
                    for (int n = 0; n < 2; ++n) acc[a][b][m][n] = (f32x4){0.f, 0.f, 0.f, 0.f};
        }
        cur = nxt; cA = nA; cB = nB; ++ui;
        if (wr == 1) PG8_BAR;
    }
    PG8_WAIT_V(0);
    PG8_BAR;
#undef PG8_SA
#undef PG8_SB
#undef PG8_STAGE
#undef PG8_LDA
#undef PG8_LDB
#undef PG8_MMA
#undef PG8_WAIT_V
#undef PG8_WAIT_L
#undef PG8_BAR
#undef PG8_SCHED
}

struct GridOrder {
    const char* A; const char* B; size_t tstep; int nM, nN, nwg, G, c, nt;
    __device__ __forceinline__ void init(const void* A_, const void* B_, int K, int nM_, int nN_, int G_, int c_) { A = (const char*)A_; B = (const char*)B_; tstep = (size_t)BM * K * 2; nM = nM_; nN = nN_; nwg = nM * nN; G = G_; c = c_; nt = K / BK; }
    __device__ __forceinline__ bool next(int i, Unit& u) const {
        const long L = (long)i * G + c; if (L >= nwg) return false;
        int wgid;
        if ((nwg & 63) == 0 && (nM & 7) == 0) {
            const int q = nwg >> 3, xcd = (int)L & 7, off = (int)L >> 3, blk = off >> 6;
            int o2 = off;
            if (blk < (q >> 6)) { const int rem = off & 63, half = rem >> 5, j = rem & 31; o2 = (blk << 6) + ((j >> 2) << 3) + half * 4 + (j & 3); }
            wgid = xcd * q + o2;
        } else wgid = xcd_remap((int)L, nwg);
        const int nig = 8 * nN, gid = wgid / nig, fm = gid * 8, gsz = (nM - fm) < 8 ? (nM - fm) : 8;
        const int pm = fm + ((wgid % nig) % gsz), pn = (wgid % nig) / gsz;
        u = make_unit(A + (size_t)pm * tstep, B + (size_t)pn * tstep, pm, pn, 0, nt, 0); return true;
    }
};
}

typedef f32x4 Acc[2][2][4][2];
struct EpiSwiGLU {
    bf16* Hid;
    __device__ __forceinline__ void operator()(const Acc& acc, const pg8::Unit& u, int wr, int wc, int fr0, int fq0) const {
        int fr = fr0, fq = fq0; asm volatile("" : "+v"(fr), "+v"(fq));
        const int row0 = u.pm() * 256 + wr * 64 + fr, col0 = u.pn() * 128 + wc * 32 + 8 * fq;
#pragma unroll
        for (int ai = 0; ai < 2; ++ai)
#pragma unroll
            for (int m = 0; m < 4; ++m) {
                float v[8];
#pragma unroll
                for (int n = 0; n < 2; ++n)
#pragma unroll
                    for (int j = 0; j < 4; ++j) v[4 * n + j] = fast_silu(acc[ai][0][m][n][j]) * acc[ai][1][m][n][j];
                v4u w; w.x = cvt_pk_bf16(v[0], v[1]); w.y = cvt_pk_bf16(v[2], v[3]); w.z = cvt_pk_bf16(v[4], v[5]); w.w = cvt_pk_bf16(v[6], v[7]);
                *(v4u*)(Hid + (size_t)(row0 + ai * 128 + m * 16) * DFF + col0) = w;
            }
    }
};
struct EpiO16 {
    bf16* C; int ldc;
    __device__ __forceinline__ void operator()(const Acc& acc, const pg8::Unit& u, int wr, int wc, int fr0, int fq0) const {
        int fr = fr0, fq = fq0; asm volatile("" : "+v"(fr), "+v"(fq));
        const int row0 = u.pm() * 256 + wr * 64 + fr, col0 = u.pn() * 256 + wc * 32 + 8 * fq;
#pragma unroll
        for (int ai = 0; ai < 2; ++ai)
#pragma unroll
            for (int m = 0; m < 4; ++m) { bf16* rowp = C + (size_t)(row0 + ai * 128 + m * 16) * ldc + col0;
#pragma unroll
                for (int bj = 0; bj < 2; ++bj) { const f32x4 a = acc[ai][bj][m][0], b = acc[ai][bj][m][1];
                    v4u w; w.x = cvt_pk_bf16(a[0], a[1]); w.y = cvt_pk_bf16(a[2], a[3]); w.z = cvt_pk_bf16(b[0], b[1]); w.w = cvt_pk_bf16(b[2], b[3]);
                    *(v4u*)(rowp + bj * 128) = w; } }
    }
};
struct EpiGLU {
    const bf16* SGS; bf16* out;
    __device__ __forceinline__ void operator()(const Acc& acc, const pg8::Unit& u, int wr, int wc, int fr0, int fq0) const {
        int fr = fr0, fq = fq0; asm volatile("" : "+v"(fr), "+v"(fq));
        const int row0 = u.pm() * 256 + wr * 64 + fr, col0 = u.pn() * 128 + wc * 32 + 8 * fq;
#pragma unroll
        for (int ai = 0; ai < 2; ++ai)
#pragma unroll
            for (int m = 0; m < 4; ++m) {
                const size_t off = (size_t)(row0 + ai * 128 + m * 16) * D + col0;
                const v4u s = *(const v4u*)(SGS + off);
                const float sg[8] = {bflo(s.x), bfhi(s.x), bflo(s.y), bfhi(s.y), bflo(s.z), bfhi(s.z), bflo(s.w), bfhi(s.w)};
                float v[8];
#pragma unroll
                for (int n = 0; n < 2; ++n)
#pragma unroll
                    for (int j = 0; j < 4; ++j) v[4 * n + j] = acc[ai][0][m][n][j] * fast_sigmoid(acc[ai][1][m][n][j]) * sg[4 * n + j];
                v4u w; w.x = cvt_pk_bf16(v[0], v[1]); w.y = cvt_pk_bf16(v[2], v[3]); w.z = cvt_pk_bf16(v[4], v[5]); w.w = cvt_pk_bf16(v[6], v[7]);
                *(v4u*)(out + off) = w;
            }
    }
};
struct EpiMerge {
    const bf16* SGR; bf16* mg;
    __device__ __forceinline__ void operator()(const Acc& acc, const pg8::Unit& u, int wr, int wc, int fr0, int fq0) const {
        int fr = fr0, fq = fq0; asm volatile("" : "+v"(fr), "+v"(fq));
        const int row0 = u.pm() * 256 + wr * 64 + fr, col0 = u.pn() * 256 + wc * 32 + 8 * fq;
#pragma unroll
        for (int ai = 0; ai < 2; ++ai)
#pragma unroll
            for (int m = 0; m < 4; ++m)
#pragma unroll
                for (int bj = 0; bj < 2; ++bj) {
                    const size_t off = (size_t)(row0 + ai * 128 + m * 16) * D + col0 + bj * 128;
                    const v4u s = *(const v4u*)(SGR + off), p = *(const v4u*)(mg + off);
                    const float sg[8] = {bflo(s.x), bfhi(s.x), bflo(s.y), bfhi(s.y), bflo(s.z), bfhi(s.z), bflo(s.w), bfhi(s.w)};
                    const float pp[8] = {bflo(p.x), bfhi(p.x), bflo(p.y), bfhi(p.y), bflo(p.z), bfhi(p.z), bflo(p.w), bfhi(p.w)};
                    float v[8];
#pragma unroll
                    for (int n = 0; n < 2; ++n)
#pragma unroll
                        for (int j = 0; j < 4; ++j) v[4 * n + j] = pp[4 * n + j] + sg[4 * n + j] * acc[ai][bj][m][n][j];
                    v4u w; w.x = cvt_pk_bf16(v[0], v[1]); w.y = cvt_pk_bf16(v[2], v[3]); w.z = cvt_pk_bf16(v[4], v[5]); w.w = cvt_pk_bf16(v[6], v[7]);
                    *(v4u*)(mg + off) = w;
                }
    }
};

constexpr int CTX_SPLIT = 4;
constexpr size_t WS_SLAB = WS_Q;
struct Ffn1DownOrder {
    const char* A; const char* B; int G, c;
    static constexpr int NBIG = (MX / 256) * (D / 256), NSMALL = (MC / 256) * (D / 256) * CTX_SPLIT;
    __device__ __forceinline__ bool next(int i, pg8::Unit& u) const {
        const long L = (long)i * G + c; if (L >= NBIG + NSMALL) return false;
        const size_t tstep = (size_t)256 * DFF * 2;
        int pm, pn, kind, nt; size_t koff;
        if (L < NBIG) { const int w = pg8::xcd_remap((int)L, NBIG); const int nig = 8 * 8, gid = w / nig, r = w % nig; pm = gid * 8 + (r & 7); pn = r >> 3; kind = 0; nt = DFF / 64; koff = 0; }
        else { const int w = (int)L - NBIG, sp = w & 3, t = w >> 2; pm = 32 + (t & 1); pn = t >> 1; kind = 1 + sp; nt = DFF / 64 / CTX_SPLIT; koff = (size_t)sp * (DFF / CTX_SPLIT) * 2; }
        u = pg8::make_unit(A + (size_t)pm * tstep + koff, B + (size_t)pn * tstep + koff, pm, pn, kind, nt, 0); return true;
    }
};
struct EpiFfn1Down {
    bf16* O; float* slab;
    __device__ __forceinline__ void operator()(const Acc& acc, const pg8::Unit& u, int wr, int wc, int fr0, int fq0) const {
        int fr = fr0, fq = fq0; asm volatile("" : "+v"(fr), "+v"(fq));
        const int row0 = u.pm() * 256 + wr * 64 + fr, col0 = u.pn() * 256 + wc * 32 + 8 * fq;
        if (u.kind() == 0) {
#pragma unroll
            for (int ai = 0; ai < 2; ++ai)
#pragma unroll
                for (int m = 0; m < 4; ++m) { bf16* rowp = O + (size_t)(row0 + ai * 128 + m * 16) * D + col0;
#pragma unroll
                    for (int bj = 0; bj < 2; ++bj) { const f32x4 a = acc[ai][bj][m][0], b = acc[ai][bj][m][1];
                        v4u w; w.x = cvt_pk_bf16(a[0], a[1]); w.y = cvt_pk_bf16(a[2], a[3]); w.z = cvt_pk_bf16(b[0], b[1]); w.w = cvt_pk_bf16(b[2], b[3]);
                        *(v4u*)(rowp + bj * 128) = w; } }
        } else {
            float* C = slab + (size_t)(u.kind() - 1) * MC * D - (size_t)MX * D;
#pragma unroll
            for (int ai = 0; ai < 2; ++ai)
#pragma unroll
                for (int m = 0; m < 4; ++m) { float* rowp = C + (size_t)(row0 + ai * 128 + m * 16) * D + col0;
#pragma unroll
                    for (int bj = 0; bj < 2; ++bj) { *(f32x4*)(rowp + bj * 128) = acc[ai][bj][m][0]; *(f32x4*)(rowp + bj * 128 + 4) = acc[ai][bj][m][1]; } }
        }
    }
};

enum { MK_S = 0, MK_Q = 1, MK_K = 2, MK_G = 3, MK_GS = 4, MK_GR = 5, MK_KT = 6, MK_VT = 7 };
struct EpiMix {
    unsigned char* ws;
    __device__ __forceinline__ void operator()(const Acc& acc, const pg8::Unit& u, int wr, int wc, int fr0, int fq0) const {
        int fr = fr0, fq = fq0; asm volatile("" : "+v"(fr), "+v"(fq));
        bf16* const US = (bf16*)(ws + WS_US); bf16* const Q = (bf16*)(ws + WS_Q); bf16* const KN = (bf16*)(ws + WS_K);
        bf16* const SG = (bf16*)(ws + WS_HBUF); bf16* const SGS = (bf16*)(ws + WS_HBUF + 32 * MiB); bf16* const SGR = (bf16*)(ws + WS_HBUF + 64 * MiB);
        bf16* const KFTC = (bf16*)(ws + WS_KFTC);
        bf16* const VT = (bf16*)(ws + WS_VT); bf16* const VTC = (bf16*)(ws + WS_VTC);
        const f32x2* const rope = (const f32x2*)(ws + WS_TAB + TAB_ROPE);
        const float* const lg2 = (const float*)(ws + WS_TAB + TAB_LG2);
        const int kind = u.kind();
        if (kind == MK_S) {
#pragma unroll
            for (int ai = 0; ai < 2; ++ai)
#pragma unroll
                for (int m = 0; m < 4; ++m) {
                    const int row = u.pm() * 256 + ai * 128 + wr * 64 + m * 16 + fr;
                    int b_, crow;
                    if (row < MX) { b_ = row >> 12; crow = (row & (SEQ - 1)) >> 4; } else { b_ = (row - MX) >> 8; crow = 256 + (((row - MX) & (LC - 1)) >> 4); }
                    const int s = row & 15;
#pragma unroll
                    for (int bj = 0; bj < 2; ++bj) {
                        const int ch = u.pn() * 256 + bj * 128 + wc * 32 + 8 * fq, g = ch >> 4, c0 = ch & 15;
                        const f32x4 a = acc[ai][bj][m][0], b = acc[ai][bj][m][1];
                        v4u w; w.x = cvt_pk_bf16(a[0], a[1]); w.y = cvt_pk_bf16(a[2], a[3]); w.z = cvt_pk_bf16(b[0], b[1]); w.w = cvt_pk_bf16(b[2], b[3]);
                        *(v4u*)(US + ((size_t)((b_ * 64 + g) * S5_ROWS + crow)) * 256 + s * 16 + c0) = w;
                    }
                }
        } else if (kind == MK_G || kind == MK_GS || kind == MK_GR) {
            bf16* dst = kind == MK_G ? SG : (kind == MK_GS ? SGS : SGR);
            const int row0 = u.pm() * 256 + wr * 64 + fr, col0 = u.pn() * 256 + wc * 32 + 8 * fq;
#pragma unroll
            for (int ai = 0; ai < 2; ++ai)
#pragma unroll
                for (int m = 0; m < 4; ++m)
#pragma unroll
                    for (int bj = 0; bj < 2; ++bj) {
                        float v[8];
#pragma unroll
                        for (int n = 0; n < 2; ++n)
#pragma unroll
                            for (int j = 0; j < 4; ++j) { const float x = acc[ai][bj][m][n][j]; const float s = fast_sigmoid(x); v[4 * n + j] = kind == MK_G ? x * s : s; }
                        v4u w; w.x = cvt_pk_bf16(v[0], v[1]); w.y = cvt_pk_bf16(v[2], v[3]); w.z = cvt_pk_bf16(v[4], v[5]); w.w = cvt_pk_bf16(v[6], v[7]);
                        *(v4u*)(dst + (size_t)(row0 + ai * 128 + m * 16) * D + col0 + bj * 128) = w;
                    }
        } else if (kind == MK_Q || kind == MK_K) {
            const int p = wc >> 1, i0 = 16 * (wc & 1) + 4 * fq;
            const int d0 = 64 * p + i0;
            const bool isctx = u.pm() >= 32;
            f32x4 cs0[8], cs1[8];
#pragma unroll
            for (int am = 0; am < 8; ++am) {
                const int row = u.pm() * 256 + (am >> 2) * 128 + wr * 64 + (am & 3) * 16 + fr;
                const int l = row & (SEQ - 1), pos = p ? (l & 63) : (l >> 6);
                if (!isctx) { cs0[am] = *(const f32x4*)(rope + pos * 32 + i0); cs1[am] = *(const f32x4*)(rope + pos * 32 + i0 + 2); }
                else { cs0[am] = (f32x4){1.f, 0.f, 1.f, 0.f}; cs1[am] = cs0[am]; }
            }
#pragma unroll
            for (int ai = 0; ai < 2; ++ai)
#pragma unroll
                for (int m = 0; m < 4; ++m) {
                    const int am = ai * 4 + m;
                    const int row = u.pm() * 256 + ai * 128 + wr * 64 + m * 16 + fr;
                    const float cc[4] = {cs0[am][0], cs0[am][2], cs1[am][0], cs1[am][2]}, ss[4] = {cs0[am][1], cs0[am][3], cs1[am][1], cs1[am][3]};
#pragma unroll
                    for (int bj = 0; bj < 2; ++bj) {
                        const int head = 2 * u.pn() + bj;
                        float y1[4], y2[4];
#pragma unroll
                        for (int j = 0; j < 4; ++j) { const float x1 = acc[ai][bj][m][0][j], x2 = acc[ai][bj][m][1][j]; y1[j] = x1 * cc[j] - x2 * ss[j]; y2[j] = x1 * ss[j] + x2 * cc[j]; }
                        const int cpos = 32 * wc + 8 * fq;
                        v4u w;
                        if (kind == MK_K) {
                            w.x = cvt_pk_bf16(y1[0], y1[1]); w.y = cvt_pk_bf16(y1[2], y1[3]); w.z = cvt_pk_bf16(y2[0], y2[1]); w.w = cvt_pk_bf16(y2[2], y2[3]);
                            if (!isctx) *(v4u*)(KN + (size_t)row * 1024 + head * 128 + cpos) = w;
                            else *(v4u*)(KFTC + (size_t)(row - MX) * 1024 + head * 128 + cpos) = w;
                        } else {
                            const float qs = 0.08838834764831845f;
                            w.x = cvt_pk_bf16(y1[0] * qs, y1[1] * qs); w.y = cvt_pk_bf16(y1[2] * qs, y1[3] * qs); w.z = cvt_pk_bf16(y2[0] * qs, y2[1] * qs); w.w = cvt_pk_bf16(y2[2] * qs, y2[3] * qs);
                            *(v4u*)(Q + (size_t)row * 1024 + head * 128 + cpos) = w;
                        }
                    }
                }
        } else if (kind == MK_VT) {
            const bool isctx = u.pn() >= 32;
#pragma unroll
            for (int ai = 0; ai < 2; ++ai)
#pragma unroll
                for (int m = 0; m < 4; ++m) {
                    const int f = u.pm() * 256 + ai * 128 + wr * 64 + m * 16 + fr;
#pragma unroll
                    for (int bj = 0; bj < 2; ++bj) {
                        const f32x4 a = acc[ai][bj][m][0], b = acc[ai][bj][m][1];
                        v4u w; w.x = cvt_pk_bf16(a[0], a[1]); w.y = cvt_pk_bf16(a[2], a[3]); w.z = cvt_pk_bf16(b[0], b[1]); w.w = cvt_pk_bf16(b[2], b[3]);
                        const int tc = bj * 128 + wc * 32 + 8 * fq;
                        if (!isctx) { const int tok = u.pn() * 256 + tc, b_ = tok >> 12, l = tok & (SEQ - 1); *(v4u*)(VT + ((size_t)(b_ * 2048 + f) * SEQ + l)) = w; }
                        else { const int b_ = u.pn() - 32; *(v4u*)(VTC + ((size_t)(b_ * 2048 + f) * LC + tc)) = w; }
                    }
                }
        }
    }
};
struct MixOrder {
    const char* U; const char* WM; int G, c;
    static constexpr int N_NORM = 32 * 36, N_CTXS = 16, N_SWAP = 8 * 34, NWG = N_NORM + N_CTXS + N_SWAP;
    __device__ __forceinline__ bool next(int i, pg8::Unit& u) const {
        const long L = (long)i * G + c; if (L >= NWG) return false;
        int w = pg8::xcd_remap((int)L, NWG);
        const size_t tstep = (size_t)256 * D * 2;
        int at, bt, pm, pn, kind;
        bool swapped = false;
        if (w < N_NORM) {
            const int nig = 8 * 36, gid = w / nig, r = w % nig, ct = r >> 3;
            pm = gid * 8 + (r & 7); at = pm;
            if (ct < 4) { bt = ct; kind = MK_S; pn = ct; } else if (ct < 8) { bt = ct; kind = MK_Q; pn = ct - 4; } else if (ct < 12) { bt = ct; kind = MK_K; pn = ct - 8; }
            else if (ct < 20) { bt = ct + 8; kind = MK_G; pn = ct - 12; } else if (ct < 28) { bt = ct + 8; kind = MK_GS; pn = ct - 20; } else { bt = ct + 8; kind = MK_GR; pn = ct - 28; }
        } else if (w < N_NORM + N_CTXS) {
            w -= N_NORM; pm = 32 + (w & 1); at = pm; const int ct = w >> 1;
            if (ct < 4) { bt = ct; pn = ct; kind = MK_S; } else { bt = ct + 4; pn = ct - 4; kind = MK_K; }
        } else {
            w -= N_NORM + N_CTXS; swapped = true;
            const int tt = w >> 3, ft = w & 7;
            bt = tt; pn = tt; at = 12 + ft; pm = ft; kind = MK_VT;
        }
        const char* abase = swapped ? WM : U; const char* bbase = swapped ? U : WM;
        u = pg8::make_unit(abase + (size_t)at * tstep, bbase + (size_t)bt * tstep, pm, pn, kind, D / 64, 0);
        return true;
    }
};

constexpr int RING_BYTES = 131072, LDSCTL_OFF = 143360, MISC_OFF = LDSCTL_OFF + 320, LDS_BYTES = 147456;
struct Args { const float* in[22]; float* out; unsigned char* ws; };
struct Frame {
    LAS unsigned char* lds; volatile LAS unsigned* MISC; unsigned* ctl;
    int wave, vcu, G;
    float* out; unsigned char* ws;
};
typedef const Args __attribute__((address_space(4)))* KArgsPtr;
__device__ __forceinline__ KArgsPtr kargs() { KArgsPtr p = (KArgsPtr)__builtin_amdgcn_kernarg_segment_ptr(); asm volatile("" : "+s"(p)); return p; }
#define FIN(k) ((const float*)kargs()->in[k])

__device__ __forceinline__ int map_pair(int n, int half) { const int h = n < half ? n : n - half, up = n >= half; return 256 * (h >> 7) + 128 * up + (h & 127); }
__device__ __forceinline__ int map_mix(int n) {
    if (n < 1024 || n >= 3072) return n;
    const int base = n & ~127, d = n & 127, p = d >> 6, e = d & 63, s = e >> 5, i = e & 31, t = 32 * p + i;
    return base + 32 * (t >> 4) + 8 * ((t >> 2) & 3) + 4 * s + (t & 3);
}
template <int MAPID>
__device__ __forceinline__ void transpose_item(const float* W, int ldw, int K, int nblk, bf16* WT, int row_off, int half, LAS float* scr, int item, int lane) {
    const int kb = item / nblk, nb = item % nblk, k0 = 64 * kb, n0 = 32 * nb;
    float wv[32];
#pragma unroll
    for (int i = 0; i < 32; ++i) wv[i] = W[(size_t)(k0 + 2 * i + (lane >> 5)) * ldw + n0 + (lane & 31)];
#pragma unroll
    for (int i = 0; i < 32; ++i) scr[(2 * i + (lane >> 5)) * 33 + (lane & 31)] = wv[i];
    LDS_WAIT(); asm volatile("" ::: "memory");
    const int c = lane & 7;
#pragma unroll
    for (int j = 0; j < 4; ++j) { const int n = (lane >> 3) + 8 * j; const LAS float* s = scr + (8 * c) * 33 + n;
        v4u o; o.x = pk2(s[0 * 33], s[1 * 33]); o.y = pk2(s[2 * 33], s[3 * 33]); o.z = pk2(s[4 * 33], s[5 * 33]); o.w = pk2(s[6 * 33], s[7 * 33]);
        const int nn = n0 + n; const int dr = MAPID == 0 ? nn : (MAPID == 1 ? map_pair(nn, half) : map_mix(nn));
        *(v4u*)(WT + (size_t)(row_off + dr) * K + k0 + 8 * c) = o; }
    LDS_WAIT(); asm volatile("" ::: "memory");
}
__device__ __forceinline__ void sincos_d(double x, double& s, double& c) {
    const double TWO_PI = 6.283185307179586476925286766559;
    x -= TWO_PI * __builtin_rint(x / TWO_PI);
    const double h = 0.125 * x, h2 = h * h;
    double sn = h * (1.0 + h2 * (-1.0 / 6 + h2 * (1.0 / 120 + h2 * (-1.0 / 5040 + h2 * (1.0 / 362880 + h2 * (-1.0 / 39916800 + h2 * (1.0 / 6227020800.0)))))));
    double cs = 1.0 + h2 * (-0.5 + h2 * (1.0 / 24 + h2 * (-1.0 / 720 + h2 * (1.0 / 40320 + h2 * (-1.0 / 3628800 + h2 * (1.0 / 479001600.0 + h2 * (-1.0 / 87178291200.0)))))));
#pragma unroll
    for (int k = 0; k < 3; ++k) { const double s2 = 2.0 * sn * cs, c2 = 1.0 - 2.0 * sn * sn; sn = s2; cs = c2; }
    s = sn; c = cs;
}
__device__ __forceinline__ double exp_d(double x) {
    const double y = x * (1.0 / 4096.0);
    double e = 1.0 + y * (1.0 + y * (0.5 + y * (1.0 / 6 + y * (1.0 / 24 + y * (1.0 / 120 + y * (1.0 / 720))))));
#pragma unroll
    for (int k = 0; k < 12; ++k) e = e * e;
    return e;
}
__device__ __forceinline__ double log1p_small_d(double z) {
    const double t = z / (2.0 + z), t2 = t * t;
    return 2.0 * t * (1.0 + t2 * (1.0 / 3 + t2 * (1.0 / 5 + t2 * (1.0 / 7 + t2 * (1.0 / 9 + t2 * (1.0 / 11))))));
}

constexpr int CV_I1 = (D / 64) * (NFF / 32), CV_I2 = (DFF / 64) * (D / 32), CV_IM = (D / 64) * (NMIX / 32), CV_IG = (SW / 64) * (2 * D / 32), CV_IP = (D / 64) * (D / 32);
constexpr int CV_N0 = CV_I1 + CV_I2, CV_N1 = CV_IM + CV_IG + 2 * CV_IP, CV_N2 = CV_I1 + CV_I2;
constexpr int CV_G1_CUS = 40, CV_G2_CUS = 192, CV_G3_CUS = 96;
constexpr int CV_L1_G1 = CV_G1_CUS * NWAVES * 12, CV_L1_G2 = CV_G2_CUS * NWAVES * 7, CV_L2_G3 = CV_G3_CUS * NWAVES * 14;
static_assert(CV_L1_G1 + CV_L1_G2 <= CV_N1 && CV_L2_G3 <= CV_N2, "conversion split");
__device__ __forceinline__ void conv_item(unsigned char* ws, int list, int r, LAS float* scr, int lane_) {
    if (list == 0) {
        if (r < CV_I1) { transpose_item<1>(FIN(7), NFF, D, NFF / 32, (bf16*)(ws + WS_W1T), 0, DFF, scr, r, lane_); return; } r -= CV_I1;
        transpose_item<0>(FIN(8), D, DFF, D / 32, (bf16*)(ws + WS_W2T), 0, 0, scr, r, lane_);
    } else if (list == 1) {
        if (r < CV_IM) { transpose_item<2>(FIN(9), NMIX, D, NMIX / 32, (bf16*)(ws + WS_WMT), 0, 0, scr, r, lane_); return; } r -= CV_IM;
        if (r < CV_IG) { transpose_item<1>(FIN(18), 2 * D, SW, 2 * D / 32, (bf16*)(ws + WS_WGT), 0, D, scr, r, lane_); return; } r -= CV_IG;
        if (r < CV_IP) { transpose_item<0>(FIN(20), D, D, D / 32, (bf16*)(ws + WS_WPT), 0, 0, scr, r, lane_); return; } r -= CV_IP;
        transpose_item<0>(FIN(21), D, D, D / 32, (bf16*)(ws + WS_WOT), 0, 0, scr, r, lane_);
    } else {
        if (r < CV_I1) { transpose_item<1>(FIN(7) + (size_t)D * NFF, NFF, D, NFF / 32, (bf16*)(ws + WS_W3T), 0, DFF, scr, r, lane_); return; } r -= CV_I1;
        transpose_item<0>(FIN(8) + (size_t)DFF * D, D, DFF, D / 32, (bf16*)(ws + WS_W4T), 0, 0, scr, r, lane_);
    }
}
__device__ __forceinline__ void conv_range(Frame& F, int list, int begin, int end, int wi, int nw) {
    int lane_ = lane_id(); asm volatile("" : "+v"(lane_));
    LAS float* scr = (LAS float*)(F.lds + F.wave * 16384);
    for (int it = begin + wi; it < end; it += nw) conv_item(F.ws, list, it, scr, lane_);
}

__device__ __forceinline__ void phase_prologue(Frame& F0, const Args& args, const bool do_ada) {
    Frame& F = F0; int lane_ = lane_id(); asm volatile("" : "+v"(lane_));
    LAS float* scr = (LAS float*)(F.lds + F.wave * 16384);
    const int gw = F.vcu * NWAVES + F.wave, NGW = F.G * NWAVES;
    unsigned char* ws = F.ws;
    {
        const int gt = gw * 64 + lane_, NT = NGW * 64;
        unsigned char* tab = ws + WS_TAB;
        for (int idx = gt; idx < 2048; idx += NT) {
            const int pos = idx >> 5, i = idx & 31;
            const double inv = exp_d(-(double)i * (9.210340371976182736 / 32.0));
            double s, c; sincos_d((double)pos * inv, s, c);
            ((f32x2*)(tab + TAB_ROPE))[idx] = (f32x2){(float)c, (float)s};
        }
        for (int idx = gt; idx < 16; idx += NT) {
            const double x = (double)FIN(19)[idx];
            ((float*)(tab + TAB_LG2))[idx] = (float)(-log1p_small_d(exp_d(-x)) * 1.4426950408889634074);
        }
        for (int idx = gt; idx < 2 * 64 * 64; idx += NT) {
            const int dg = idx >> 6, p = idx & 63;
            const double lr = (double)FIN(10)[idx], li = (double)FIN(11)[idx], step = exp_d((double)FIN(12)[dg]);
            const double mag = exp_d(lr * step); double sn, cs; sincos_d(li * step, sn, cs);
            const double ar = mag * cs, ai = mag * sn, den = lr * lr + li * li, nr = ar - 1.0, ni = ai;
            const double kr = (nr * lr + ni * li) / den, ki = (ni * lr - nr * li) / den;
            ((float*)(tab + TAB_AR))[idx] = (float)ar; ((float*)(tab + TAB_AI))[idx] = (float)ai;
            { f32x2* apw = (f32x2*)(ws + WS_S5APOW) + (size_t)dg * 17 * 64 + p; double pr = 1.0, pi = 0.0;
              for (int k = 0; k < 17; ++k) { apw[k * 64] = (f32x2){(float)pr, (float)pi}; const double t = pr * ar - pi * ai; pi = pr * ai + pi * ar; pr = t; } }
            float* brf = (float*)(ws + WS_S5BRF) + (size_t)idx * 32;
            const float* bre = FIN(13) + (size_t)idx * 16; const float* bim = FIN(14) + (size_t)idx * 16;
            for (int c = 0; c < 16; ++c) { const double br = (double)bre[c], bi = (double)bim[c];
                brf[2 * c] = (float)(kr * br - ki * bi); brf[2 * c + 1] = (float)(kr * bi + ki * br); }
        }
    }
    if (do_ada) {
        float* ADA = (float*)(ws + WS_CTL + CTL_ADA);
        const float* aw = FIN(4);
        for (int it = gw; it < 16 * 72; it += NGW) {
            const int kc = it / 72, cb = it % 72, k0 = kc * 128, col = cb * 256 + 4 * lane_;
            for (int i = lane_; i < 384; i += 64) { const int v = i >> 7, k = i & 127; const float x = v == 0 ? FIN(1)[k0 + k] : (v == 1 ? FIN(1)[D + k0 + k] : FIN(3)[k0 + k]); scr[i] = x / (1.0f + __expf(-x)); }
            LDS_WAIT(); asm volatile("" ::: "memory");
            f32x4 a0 = {0.f, 0.f, 0.f, 0.f}, a1 = a0, a2 = a0;
#pragma unroll 8
            for (int k = 0; k < 128; ++k) { const f32x4 w = *(const f32x4*)(aw + (size_t)(k0 + k) * NADA + col); a0 += w * scr[k]; a1 += w * scr[128 + k]; a2 += w * scr[256 + k]; }
#pragma unroll
            for (int j = 0; j < 4; ++j) { __hip_atomic_fetch_add(ADA + col + j, a0[j], RLX_AGENT); __hip_atomic_fetch_add(ADA + NADA + col + j, a1[j], RLX_AGENT); __hip_atomic_fetch_add(ADA + 2 * NADA + col + j, a2[j], RLX_AGENT); }
            LDS_WAIT(); asm volatile("" ::: "memory");
        }
    }
    {
        const bool tails = (F.G == 256);
        const int b1 = tails ? CV_L1_G1 + CV_L1_G2 : 0, b2 = tails ? CV_L2_G3 : 0;
        const int n0 = CV_N0, n1 = CV_N1 - b1, n2 = CV_N2 - b2;
        for (int it = gw; it < n0 + n1 + n2; it += NGW) {
            if (it < n2) conv_item(ws, 2, b2 + it, scr, lane_);
            else if (it < n2 + n1) conv_item(ws, 1, b1 + it - n2, scr, lane_);
            else conv_item(ws, 0, it - n2 - n1, scr, lane_);
        }
    }
}

template <int MODE>
__device__ __forceinline__ void phase_rows(Frame& F0, const Args& args) {
    Frame& F = F0; int lane_ = lane_id(); asm volatile("" : "+v"(lane_));
    const int gw = F.vcu * NWAVES + F.wave, NGW = F.G * NWAVES;
    const float* ADA = (const float*)(F.ws + WS_CTL + CTL_ADA);
    const float* adab = FIN(5); const float* ng = FIN(6);
    const bf16* O = (const bf16*)(F.ws + WS_OBUF);
    bf16* A = (bf16*)(F.ws + WS_ABUF);
    const int nrows = (MODE <= 1) ? MT : MX;
    for (int r = gw; r < nrows; r += NGW) {
        const int av = r < MX ? (r >> 12) : 2;
        const float* ada = ADA + (size_t)av * NADA;
        f32x4 h[8];
        if (MODE <= 1) { const float* hsrc = r < MX ? FIN(0) + (size_t)r * D : FIN(2) + (size_t)(r - MX) * D;
#pragma unroll
            for (int j = 0; j < 8; ++j) h[j] = *(const f32x4*)(hsrc + 256 * j + 4 * lane_); }
        else { const bf16* hsrc = (const bf16*)(F.ws + WS_STREAM) + (size_t)r * D;
#pragma unroll
            for (int j = 0; j < 8; ++j) { const v2u t = *(const v2u*)(hsrc + 256 * j + 4 * lane_); h[j] = (f32x4){bflo(t.x), bfhi(t.x), bflo(t.y), bfhi(t.y)}; } }
        if (MODE >= 1) {
            constexpr int ipost = MODE - 1;
            const float resw = (MODE == 2) ? 1.0f : 0.5f;
            f32x4 o[8]; float ss = 0.f;
#pragma unroll
            for (int j = 0; j < 8; ++j) {
                if (MODE == 1 && r >= MX) { const float* sl = (const float*)(F.ws + WS_SLAB) + (size_t)(r - MX) * D + 256 * j + 4 * lane_; f32x4 a = *(const f32x4*)sl;
#pragma unroll
                    for (int s = 1; s < CTX_SPLIT; ++s) a += *(const f32x4*)(sl + (size_t)s * MC * D);
                    o[j] = a; }
                else { const v2u t = *(const v2u*)(O + (size_t)r * D + 256 * j + 4 * lane_); o[j] = (f32x4){bflo(t.x), bfhi(t.x), bflo(t.y), bfhi(t.y)}; }
                ss += (o[j][0] * o[j][0] + o[j][1] * o[j][1]) + (o[j][2] * o[j][2] + o[j][3] * o[j][3]); }
            const float rstd = 1.0f / sqrtf(wave_sum(ss, lane_) * (1.0f / D) + EPS);
#pragma unroll
            for (int j = 0; j < 8; ++j) { const int c = 256 * j + 4 * lane_;
                const f32x4 gate = *(const f32x4*)(ada + (3 * ipost + 2) * D + c) + *(const f32x4*)(adab + (3 * ipost + 2) * D + c);
                const f32x4 g = *(const f32x4*)(ng + (2 * ipost + 1) * D + c);
                h[j] = h[j] + (resw * rstd) * (gate * (o[j] * g)); }
            if (r < MX) {
                if (MODE == 3) {
#pragma unroll
                    for (int j = 0; j < 8; ++j) *(f32x4*)(F.out + (size_t)r * D + 256 * j + 4 * lane_) = h[j];
                } else {
                    bf16* so = (bf16*)(F.ws + WS_STREAM) + (size_t)r * D;
#pragma unroll
                    for (int j = 0; j < 8; ++j) { v2u w; w.x = cvt_pk_bf16(h[j][0], h[j][1]); w.y = cvt_pk_bf16(h[j][2], h[j][3]); *(v2u*)(so + 256 * j + 4 * lane_) = w;
                        h[j] = (f32x4){bflo(w.x), bfhi(w.x), bflo(w.y), bfhi(w.y)}; }
                }
            }
        }
        if (MODE <= 2) {
            constexpr int ipre = MODE;
            float ss = 0.f;
#pragma unroll
            for (int j = 0; j < 8; ++j) ss += (h[j][0] * h[j][0] + h[j][1] * h[j][1]) + (h[j][2] * h[j][2] + h[j][3] * h[j][3]);
            const float rstd = 1.0f / sqrtf(wave_sum(ss, lane_) * (1.0f / D) + EPS);
#pragma unroll
            for (int j = 0; j < 8; ++j) { const int c = 256 * j + 4 * lane_;
                const f32x4 shift = *(const f32x4*)(ada + (3 * ipre) * D + c) + *(const f32x4*)(adab + (3 * ipre) * D + c);
                const f32x4 scale = *(const f32x4*)(ada + (3 * ipre + 1) * D + c) + *(const f32x4*)(adab + (3 * ipre + 1) * D + c);
                const f32x4 g = *(const f32x4*)(ng + (2 * ipre) * D + c);
                const f32x4 v = (h[j] * rstd) * g * (scale + 1.0f) + shift;
                v2u w; w.x = cvt_pk_bf16(v[0], v[1]); w.y = cvt_pk_bf16(v[2], v[3]);
                *(v2u*)(A + (size_t)r * D + c) = w; }
        }
    }
}

__device__ __forceinline__ void s5_tables1(Frame& F, const Args& args) {
    int lane_ = lane_id(); asm volatile("" : "+v"(lane_));
    const int gt = (F.vcu * NWAVES + F.wave) * 64 + lane_, NT = F.G * NWAVES * 64;
    const f32x2* APW = (const f32x2*)(F.ws + WS_S5APOW);
    const float* BRF = (const float*)(F.ws + WS_S5BRF);
    const float* cre = FIN(15); const float* cim = FIN(16);
    float* KT = (float*)(F.ws + WS_S5KT); bf16* WE = (bf16*)(F.ws + WS_S5WE); bf16* WY2 = (bf16*)(F.ws + WS_S5WY2);
    for (int idx = gt; idx < 64 * 2 * 16 * 16 * 4; idx += NT) {
        const int c4 = idx & 3, c = (idx >> 2) & 15, k = (idx >> 6) & 15, dir = (idx >> 10) & 1, g = idx >> 11, dg = dir * 64 + g;
        const f32x2* ap = APW + (size_t)(dg * 17 + k) * 64; const float* cr = cre + (dg * 16 + c) * 64; const float* ci = cim + (dg * 16 + c) * 64;
        const float* br = BRF + (size_t)dg * 64 * 32 + c4 * 8;
        f32x4 acc = {0.f, 0.f, 0.f, 0.f};
#pragma unroll 8
        for (int p = 0; p < 64; ++p) {
            const f32x2 a = ap[p]; const float Cr = cr[p], Ci = ci[p], Gr = Cr * a[0] - Ci * a[1], Gi = Cr * a[1] + Ci * a[0];
            const f32x4 b0 = *(const f32x4*)(br + p * 32), b1 = *(const f32x4*)(br + p * 32 + 4);
            acc[0] += Gr * b0[0] - Gi * b0[1]; acc[1] += Gr * b0[2] - Gi * b0[3]; acc[2] += Gr * b1[0] - Gi * b1[1]; acc[3] += Gr * b1[2] - Gi * b1[3];
        }
        *(f32x4*)(KT + ((size_t)((g * 2 + dir) * 16 + k) * 16 + c) * 16 + c4 * 4) = acc;
    }
    for (int idx = gt; idx < 64 * 256 * 16; idx += NT) {
        const int s = idx & 15, r = (idx >> 4) & 255, g = idx >> 12, dir = r >> 7, part = (r >> 6) & 1, p = r & 63, dg = dir * 64 + g;
        const f32x2 a = APW[(size_t)(dg * 17 + (dir ? s : 15 - s)) * 64 + p]; const float pr = a[0], pi = a[1];
        const f32x4* b4 = (const f32x4*)(BRF + (size_t)(dg * 64 + p) * 32);
        float v[16];
#pragma unroll
        for (int j = 0; j < 8; ++j) { const f32x4 q = b4[j]; v[2 * j] = part ? (pr * q[1] + pi * q[0]) : (pr * q[0] - pi * q[1]); v[2 * j + 1] = part ? (pr * q[3] + pi * q[2]) : (pr * q[2] - pi * q[3]); }
        bf16* o = WE + ((size_t)(g * 256 + r)) * 256 + s * 16;
        v4u w0, w1; w0.x = pk2(v[0], v[1]); w0.y = pk2(v[2], v[3]); w0.z = pk2(v[4], v[5]); w0.w = pk2(v[6], v[7]); w1.x = pk2(v[8], v[9]); w1.y = pk2(v[10], v[11]); w1.z = pk2(v[12], v[13]); w1.w = pk2(v[14], v[15]);
        *(v4u*)o = w0; *(v4u*)(o + 8) = w1;
    }
    for (int idx = gt; idx < 64 * 256 * 32; idx += NT) {
        const int cb = idx & 31, row = (idx >> 5) & 255, g = idx >> 13, t = row >> 4, c = row & 15, col0 = 8 * cb, dir = col0 >> 7, part = (col0 >> 6) & 1, p0 = col0 & 63, dg = dir * 64 + g;
        const f32x2* ap = APW + (size_t)(dg * 17 + (dir ? 16 - t : t + 1)) * 64 + p0; const float* cr = cre + (dg * 16 + c) * 64 + p0; const float* ci = cim + (dg * 16 + c) * 64 + p0;
        float v[8];
#pragma unroll
        for (int j = 0; j < 8; ++j) { const f32x2 a = ap[j]; const float Cr = cr[j], Ci = ci[j]; v[j] = part ? -(Cr * a[1] + Ci * a[0]) : (Cr * a[0] - Ci * a[1]); }
        v4u w; w.x = pk2(v[0], v[1]); w.y = pk2(v[2], v[3]); w.z = pk2(v[4], v[5]); w.w = pk2(v[6], v[7]);
        *(v4u*)(WY2 + ((size_t)(g * 256 + row)) * 256 + col0) = w;
    }
}
__device__ __forceinline__ void s5_tables2(Frame& F, const Args& args) {
    int lane_ = lane_id(); asm volatile("" : "+v"(lane_));
    const int gt = (F.vcu * NWAVES + F.wave) * 64 + lane_, NT = F.G * NWAVES * 64;
    const float* KT = (const float*)(F.ws + WS_S5KT); bf16* WY1 = (bf16*)(F.ws + WS_S5WY1); const float* dskip = FIN(17);
    for (int idx = gt; idx < 64 * 256 * 16; idx += NT) {
        const int s = idx & 15, row = (idx >> 4) & 255, g = idx >> 12, t = row >> 4, c = row & 15;
        float v[16];
#pragma unroll
        for (int j = 0; j < 16; ++j) v[j] = 0.f;
        if (s <= t) { const f32x4* k4 = (const f32x4*)(KT + ((size_t)((g * 2 + 0) * 16 + (t - s)) * 16 + c) * 16);
#pragma unroll
            for (int j = 0; j < 4; ++j) { const f32x4 q = k4[j]; v[4 * j] += q[0]; v[4 * j + 1] += q[1]; v[4 * j + 2] += q[2]; v[4 * j + 3] += q[3]; } }
        if (s >= t) { const f32x4* k4 = (const f32x4*)(KT + ((size_t)((g * 2 + 1) * 16 + (s - t)) * 16 + c) * 16);
#pragma unroll
            for (int j = 0; j < 4; ++j) { const f32x4 q = k4[j]; v[4 * j] += q[0]; v[4 * j + 1] += q[1]; v[4 * j + 2] += q[2]; v[4 * j + 3] += q[3]; } }
        if (s == t) { const float dk = dskip[16 * g + c];
#pragma unroll
            for (int j = 0; j < 16; ++j) v[j] += (j == c) ? dk : 0.f; }
        bf16* o = WY1 + ((size_t)(g * 256 + row)) * 256 + s * 16;
        v4u w0, w1; w0.x = pk2(v[0], v[1]); w0.y = pk2(v[2], v[3]); w0.z = pk2(v[4], v[5]); w0.w = pk2(v[6], v[7]); w1.x = pk2(v[8], v[9]); w1.y = pk2(v[10], v[11]); w1.z = pk2(v[12], v[13]); w1.w = pk2(v[14], v[15]);
        *(v4u*)o = w0; *(v4u*)(o + 8) = w1;
    }
}
struct S5EOrder {
    const char* ZU; const char* WE; int G, c;
    __device__ __forceinline__ bool next(int i, pg8::Unit& u) const {
        const long L = (long)i * G + c; if (L >= 256) return false;
        const int bg = (int)L >> 1, rt = (int)L & 1, g = bg & 63;
        u = pg8::make_unit(ZU + ((size_t)(bg * S5_ROWS + 256 * rt)) * 512, WE + (size_t)g * 256 * 512, bg, rt, 0, 4, 0); return true;
    }
};
struct EpiS5E {
    bf16* E;
    __device__ __forceinline__ void operator()(const Acc& acc, const pg8::Unit& u, int wr, int wc, int fr0, int fq0) const {
        int fr = fr0, fq = fq0; asm volatile("" : "+v"(fr), "+v"(fq));
#pragma unroll
        for (int ai = 0; ai < 2; ++ai)
#pragma unroll
            for (int m = 0; m < 4; ++m) {
                const int crow = 256 * u.pn() + ai * 128 + wr * 64 + m * 16 + fr;
                if (crow < S5_ROWS) {
#pragma unroll
                    for (int bj = 0; bj < 2; ++bj) {
                        const f32x4 a = acc[ai][bj][m][0], b = acc[ai][bj][m][1];
                        v4u w; w.x = cvt_pk_bf16(a[0], a[1]); w.y = cvt_pk_bf16(a[2], a[3]); w.z = cvt_pk_bf16(b[0], b[1]); w.w = cvt_pk_bf16(b[2], b[3]);
                        *(v4u*)(E + ((size_t)(u.pm() * S5_ROWS + crow)) * 256 + bj * 128 + wc * 32 + 8 * fq) = w;
                    }
                }
            }
    }
};
struct S5YOrder {
    const char* ZU; const char* ZH; const char* WY1; const char* WY2; int G, c;
    __device__ __forceinline__ bool next(int i, pg8::Unit& u) const {
        const int bg = (i >> 1) * G + c, seg = i & 1; if (bg >= NB * 64) return false;
        const int g = bg & 63;
        const char* a = seg == 0 ? ZU + ((size_t)(bg * S5_ROWS)) * 512 : ZH + ((size_t)(bg * 256)) * 512;
        const char* b = (seg == 0 ? WY1 : WY2) + (size_t)g * 256 * 512;
        u = pg8::make_unit(a, b, bg, 0, 0, 4, seg == 0 ? 1 : 0); return true;
    }
};
struct EpiS5Y {
    bf16* AGLU;
    __device__ __forceinline__ void operator()(const Acc& acc, const pg8::Unit& u, int wr, int wc, int fr0, int fq0) const {
        int fr = fr0, fq = fq0; asm volatile("" : "+v"(fr), "+v"(fq));
        const int b_ = u.pm() >> 6, g = u.pm() & 63;
#pragma unroll
        for (int ai = 0; ai < 2; ++ai)
#pragma unroll
            for (int m = 0; m < 4; ++m) {
                const int chunk = ai * 128 + wr * 64 + m * 16 + fr;
#pragma unroll
                for (int bj = 0; bj < 2; ++bj) {
                    const int cc = bj * 128 + wc * 32 + 8 * fq, t = cc >> 4, c0 = cc & 15;
                    const f32x4 a = acc[ai][bj][m][0], b = acc[ai][bj][m][1];
                    v4u w; w.x = cvt_pk_bf16(gelu_tanh(a[0]), gelu_tanh(a[1])); w.y = cvt_pk_bf16(gelu_tanh(a[2]), gelu_tanh(a[3])); w.z = cvt_pk_bf16(gelu_tanh(b[0]), gelu_tanh(b[1])); w.w = cvt_pk_bf16(gelu_tanh(b[2]), gelu_tanh(b[3]));
                    *(v4u*)(AGLU + ((size_t)(b_ * SEQ + chunk * 16 + t)) * SW + 16 * g + c0) = w;
                }
            }
    }
};
__device__ __forceinline__ void s5_scan_bg(Frame& F, int bg, int tid) {
    const bf16* E = (const bf16*)(F.ws + WS_S5E); bf16* ZH = (bf16*)(F.ws + WS_S5ZH);
    LAS bf16* EL = (LAS bf16*)F.lds;
    { v4u ev[17];
      static_assert(S5_ROWS * 32 == 17 * NWAVES * 64, "E block pieces");
#pragma unroll
      for (int k = 0; k < 17; ++k) ev[k] = *(const v4u*)(E + (size_t)bg * S5_ROWS * 256 + (size_t)(tid + k * NWAVES * 64) * 8);
#pragma unroll
      for (int k = 0; k < 17; ++k) *(LAS v4u*)(EL + (tid + k * NWAVES * 64) * 8) = ev[k]; }
    __syncthreads();
    if (tid < 128) {
        const int dir = tid >> 6, p = tid & 63, g = bg & 63;
        float ar = ((const float*)(F.ws + WS_TAB + TAB_AR))[(dir * 64 + g) * 64 + p], ai = ((const float*)(F.ws + WS_TAB + TAB_AI))[(dir * 64 + g) * 64 + p];
#pragma unroll
        for (int k = 0; k < 4; ++k) { const float nr = ar * ar - ai * ai, ni = 2.f * ar * ai; ar = nr; ai = ni; }
        LAS bf16* col = EL + dir * 128 + p;
        float hr = 0.f, hi = 0.f;
        for (int k0 = 0; k0 < S5_ROWS; k0 += 16) {
            float er[16], ei[16], orr[16], oi[16];
#pragma unroll
            for (int j = 0; j < 16; ++j) { const int k = k0 + j, row = dir ? (S5_ROWS - 1 - k) : (k < 16 ? 256 + k : k - 16); er[j] = bflo((unsigned)col[row * 256]); ei[j] = bflo((unsigned)col[row * 256 + 64]); }
#pragma unroll
            for (int j = 0; j < 16; ++j) { orr[j] = hr; oi[j] = hi; const float nr = ar * hr - ai * hi + er[j], ni = ar * hi + ai * hr + ei[j]; hr = nr; hi = ni; }
#pragma unroll
            for (int j = 0; j < 16; ++j) { const int k = k0 + j, row = dir ? (S5_ROWS - 1 - k) : (k < 16 ? 256 + k : k - 16); col[row * 256] = (bf16)f2bf(orr[j]); col[row * 256 + 64] = (bf16)f2bf(oi[j]); }
        }
    }
    __syncthreads();
#pragma unroll
    for (int k = 0; k < 16; ++k) { const int i = tid + k * NWAVES * 64; *(v4u*)(ZH + (size_t)bg * 256 * 256 + (size_t)i * 8) = *(const LAS v4u*)(EL + i * 8); }
    __syncthreads();
}

constexpr int RS_PITCH = 136;
constexpr int RS_BUF = (128 + 32) * RS_PITCH * 2;
__device__ __forceinline__ void phase_rstate(Frame& F) {
    const bf16* KNL = (const bf16*)(F.ws + WS_K); const bf16* KNC = (const bf16*)(F.ws + WS_KFTC);
    const bf16* VT = (const bf16*)(F.ws + WS_VT); const bf16* VTC = (const bf16*)(F.ws + WS_VTC);
    bf16* SIN = (bf16*)(F.ws + WS_OBUF);
    const float* lg2 = (const float*)(F.ws + WS_TAB + TAB_LG2);
    const int lane0 = lane_id();
    const int w = F.wave;
    for (int unit = F.vcu; unit < NB * NH * 2 * 8; unit += F.G) {
        int lane = lane0; asm volatile("" : "+v"(lane));
        const int tid = w * 64 + lane, fr = lane & 15, fq = lane >> 4;
        const int sl = unit & 7, dir = (unit >> 3) & 1, h = (unit >> 4) & 7, b = unit >> 7;
        const float gC = __builtin_amdgcn_exp2f((float)CH * lg2[dir * 8 + h]);
        const int bh = b * NH + h;
        const bf16* kT = KNL; const bf16* kTc = KNC;
        const int prow = tid >> 4, pc = tid & 15;
        float kw[4];
#pragma unroll
        for (int i_ = 0; i_ < 4; ++i_) { const int j = prow + 32 * i_; kw[i_] = __builtin_amdgcn_exp2f((float)(dir ? j : CH - 1 - j) * lg2[dir * 8 + h]); }
        f32x4 st[2] = {{0.f, 0.f, 0.f, 0.f}, {0.f, 0.f, 0.f, 0.f}};
#define RS_ISSUE(k, R) do { if ((k) < 34) { const bf16* kb_; const bf16* vb_; int ls_; \
            if ((k) < 2) { const int cc_ = dir ? (1 - (k)) : (k); ls_ = LC; kb_ = kTc + (size_t)(b * LC + cc_ * CH) * 1024 + h * DK; vb_ = VTC + (size_t)(bh * DV + 32 * sl) * LC + cc_ * CH; } \
            else { const int n_ = dir ? (33 - (k)) : ((k) - 2); ls_ = SEQ; kb_ = kT + (size_t)(b * SEQ + n_ * CH) * 1024 + h * DK; vb_ = VT + (size_t)(bh * DV + 32 * sl) * SEQ + n_ * CH; } \
            _Pragma("unroll") for (int i_ = 0; i_ < 4; ++i_) R[i_] = *(const v4u*)(kb_ + (size_t)(prow + 32 * i_) * 1024 + pc * 8);     \
            R[4] = *(const v4u*)(vb_ + (size_t)prow * ls_ + pc * 8); } } while (0)
#define RS_STEP(k, R) do { LAS bf16* buf_ = (LAS bf16*)(F.lds + ((k) & 1) * RS_BUF); \
            _Pragma("unroll") for (int i_ = 0; i_ < 4; ++i_) { const v4u r_ = R[i_]; const float w_ = kw[i_]; v4u s_; \
                s_.x = cvt_pk_bf16(bflo(r_.x) * w_, bfhi(r_.x) * w_); s_.y = cvt_pk_bf16(bflo(r_.y) * w_, bfhi(r_.y) * w_); s_.z = cvt_pk_bf16(bflo(r_.z) * w_, bfhi(r_.z) * w_); s_.w = cvt_pk_bf16(bflo(r_.w) * w_, bfhi(r_.w) * w_); \
                *(LAS v4u*)(buf_ + (prow + 32 * i_) * RS_PITCH + pc * 8) = s_; } \
            *(LAS v4u*)(buf_ + (128 + prow) * RS_PITCH + pc * 8) = R[4]; } while (0)
#define RS_COMP(k) do { const LAS bf16* buf_ = (const LAS bf16*)(F.lds + ((k) & 1) * RS_BUF); \
            const int n_ = (k) < 2 ? -1 : (dir ? (33 - (k)) : ((k) - 2)); \
            if (n_ >= 0) { _Pragma("unroll") for (int et = 0; et < 2; ++et) { v2u o; o.x = cvt_pk_bf16(st[et][0], st[et][1]); o.y = cvt_pk_bf16(st[et][2], st[et][3]); \
                *(v2u*)(SIN + ((((size_t)(bh * 2 + dir) * NCH + n_) * DV + 32 * sl + 16 * et + fr) * DK + 16 * w + 4 * fq)) = o; } } \
            bf16x8 kf_[4];                         \
            { const unsigned ta_ = (unsigned)(size_t)buf_ + (unsigned)((8 * fq + (fr >> 2)) * (RS_PITCH * 2) + (16 * w + 4 * (fr & 3)) * 2); v2u t0_, t1_, t2_, t3_, t4_, t5_, t6_, t7_; \
              asm volatile("ds_read_b64_tr_b16 %0, %8\n\tds_read_b64_tr_b16 %1, %8 offset:1088\n\tds_read_b64_tr_b16 %2, %8 offset:8704\n\tds_read_b64_tr_b16 %3, %8 offset:9792\n\t" \
                           "ds_read_b64_tr_b16 %4, %8 offset:17408\n\tds_read_b64_tr_b16 %5, %8 offset:18496\n\tds_read_b64_tr_b16 %6, %8 offset:26112\n\tds_read_b64_tr_b16 %7, %8 offset:27200\n\ts_waitcnt lgkmcnt(0)" \
                           : "=&v"(t0_), "=&v"(t1_), "=&v"(t2_), "=&v"(t3_), "=&v"(t4_), "=&v"(t5_), "=&v"(t6_), "=&v"(t7_) : "v"(ta_) : "memory"); \
              kf_[0] = __builtin_bit_cast(bf16x8, (v4u){t0_.x, t0_.y, t1_.x, t1_.y}); kf_[1] = __builtin_bit_cast(bf16x8, (v4u){t2_.x, t2_.y, t3_.x, t3_.y}); \
              kf_[2] = __builtin_bit_cast(bf16x8, (v4u){t4_.x, t4_.y, t5_.x, t5_.y}); kf_[3] = __builtin_bit_cast(bf16x8, (v4u){t6_.x, t6_.y, t7_.x, t7_.y}); } \
            _Pragma("unroll") for (int et = 0; et < 2; ++et) { f32x4 kv = {0.f, 0.f, 0.f, 0.f}; \
                _Pragma("unroll") for (int ks = 0; ks < 4; ++ks) { const bf16x8 vf_ = *(const LAS bf16x8*)(buf_ + (128 + 16 * et + fr) * RS_PITCH + 32 * ks + 8 * fq); kv = __builtin_amdgcn_mfma_f32_16x16x32_bf16(kf_[ks], vf_, kv, 0, 0, 0); } \
                st[et] = st[et] * gC + kv; } } while (0)
        v4u RA[5], RB[5], RC[5];
        RS_ISSUE(0, RA); RS_ISSUE(1, RB);
        for (int k = 0; k < 34; k += 3) {
            RS_ISSUE(k + 2, RC);
            RS_STEP(k, RA); __syncthreads(); RS_COMP(k);
            RS_ISSUE(k + 3, RA);
            if (k + 1 < 34) { RS_STEP(k + 1, RB); __syncthreads(); RS_COMP(k + 1); }
            RS_ISSUE(k + 4, RB);
            if (k + 2 < 34) { RS_STEP(k + 2, RC); __syncthreads(); RS_COMP(k + 2); }
        }
        __syncthreads();
#undef RS_ISSUE
#undef RS_STEP
#undef RS_COMP
    }
}

constexpr int RO_PITCH = 136;
constexpr int RO_SLOT = 256 * RO_PITCH * 2;
__device__ __forceinline__ void phase_rout(Frame& F, const int cid) {
    const bf16* Q = (const bf16*)(F.ws + WS_Q);
    const bf16* KN = (const bf16*)(F.ws + WS_K); const bf16* VT = (const bf16*)(F.ws + WS_VT);
    const bf16* SIN = (const bf16*)(F.ws + WS_OBUF);
    bf16* SG = (bf16*)(F.ws + WS_HBUF);
    const float* lg2 = (const float*)(F.ws + WS_TAB + TAB_LG2);
    LAS bf16* SA = (LAS bf16*)F.lds; LAS bf16* SB = (LAS bf16*)(F.lds + RO_SLOT);
    const int lane0 = lane_id();
    const int w = F.wave;
    const bool split13 = (F.G == 256);
    const int ufirst = split13 ? (cid < 128 ? cid : 128 + (cid - 128) * 3) : F.vcu, ucount = split13 ? (cid < 128 ? 1 : 3) : (NB * NH * NCH - 1 - F.vcu) / F.G + 1, ustep = split13 ? 1 : F.G;
    for (int ui = 0; ui < ucount; ++ui) {
        const int unit = ufirst + ui * ustep;
        int lane = lane0; asm volatile("" : "+v"(lane));
        const int tid = w * 64 + lane, fr = lane & 15, fq = lane >> 4;
        const int n = unit & 31, h = (unit >> 5) & 7, b = unit >> 8, bh = b * NH + h;
        const float lgf = lg2[h], lgb = lg2[8 + h];
        const int tok0 = b * SEQ + n * CH;
        const int i = 16 * w + fr;
        const size_t qoff = (size_t)(tok0 + i) * 1024 + h * DK;
        {
            v4u kr[4], vr[8];
#pragma unroll
            for (int it = 0; it < 4; ++it) { const int q = tid + 512 * it, j = q >> 4, pc = q & 15; kr[it] = *(const v4u*)(KN + (size_t)(tok0 + j) * 1024 + h * DK + pc * 8); }
#pragma unroll
            for (int it = 0; it < 8; ++it) { const int q = tid + 512 * it, e = q >> 4, pc = q & 15; vr[it] = *(const v4u*)(VT + ((size_t)(bh * DV + e)) * SEQ + n * CH + pc * 8); }
#pragma unroll
            for (int it = 0; it < 4; ++it) { const int q = tid + 512 * it, j = q >> 4, pc = q & 15; *(LAS v4u*)(SB + j * RO_PITCH + pc * 8) = kr[it]; }
#pragma unroll
            for (int it = 0; it < 8; ++it) { const int q = tid + 512 * it, e = q >> 4, pc = q & 15; *(LAS v4u*)(SA + e * RO_PITCH + pc * 8) = vr[it]; }
        }
        bf16x8 qf[4];
#pragma unroll
        for (int ks = 0; ks < 4; ++ks) qf[ks] = *(const bf16x8*)(Q + qoff + 32 * ks + 8 * fq);
        __syncthreads();
        f32x4 sc[8];
#pragma unroll
        for (int jt = 0; jt < 8; ++jt) {
            f32x4 a = {0.f, 0.f, 0.f, 0.f};
#pragma unroll
            for (int ks = 0; ks < 4; ++ks) { const bf16x8 kf = *(const LAS bf16x8*)(SB + (16 * jt + fr) * RO_PITCH + 32 * ks + 8 * fq); a = __builtin_amdgcn_mfma_f32_16x16x32_bf16(kf, qf[ks], a, 0, 0, 0); }
#pragma unroll
            for (int r = 0; r < 4; ++r) { const int j = 16 * jt + 4 * fq + r, df = i - j; a[r] *= df >= 0 ? __builtin_amdgcn_exp2f((float)df * lgf) : __builtin_amdgcn_exp2f((float)(-df) * lgb); }
            sc[jt] = a;
        }
        f32x4 o[16];
#pragma unroll
        for (int et = 0; et < 16; ++et) o[et] = (f32x4){0.f, 0.f, 0.f, 0.f};
#pragma unroll
        for (int ks = 0; ks < 4; ++ks) {
            v4u pw; pw.x = cvt_pk_bf16(sc[2 * ks][0], sc[2 * ks][1]); pw.y = cvt_pk_bf16(sc[2 * ks][2], sc[2 * ks][3]); pw.z = cvt_pk_bf16(sc[2 * ks + 1][0], sc[2 * ks + 1][1]); pw.w = cvt_pk_bf16(sc[2 * ks + 1][2], sc[2 * ks + 1][3]);
            const bf16x8 pf = __builtin_bit_cast(bf16x8, pw);
#pragma unroll
            for (int et = 0; et < 16; ++et) {
                const LAS bf16* vp = SA + (16 * et + fr) * RO_PITCH + 32 * ks + 4 * fq;
                const v2u lo = *(const LAS v2u*)vp, hi2 = *(const LAS v2u*)(vp + 16);
                v4u vw; vw.x = lo.x; vw.y = lo.y; vw.z = hi2.x; vw.w = hi2.y;
                o[et] = __builtin_amdgcn_mfma_f32_16x16x32_bf16(__builtin_bit_cast(bf16x8, vw), pf, o[et], 0, 0, 0);
            }
        }
        __syncthreads();
        {
            const bf16* sf = SIN + (((size_t)(bh * 2 + 0) * NCH + n) * DV) * DK; const bf16* sb = SIN + (((size_t)(bh * 2 + 1) * NCH + n) * DV) * DK;
            v4u fr_[8], br_[8];
#pragma unroll
            for (int it = 0; it < 8; ++it) { const int q = tid + 512 * it; fr_[it] = *(const v4u*)(sf + (size_t)q * 8); br_[it] = *(const v4u*)(sb + (size_t)q * 8); }
#pragma unroll
            for (int it = 0; it < 8; ++it) { const int q = tid + 512 * it, e = q >> 4, pc = q & 15; *(LAS v4u*)(SA + e * RO_PITCH + pc * 8) = fr_[it]; *(LAS v4u*)(SB + e * RO_PITCH + pc * 8) = br_[it]; }
        }
        bf16x8 qff[4], qbf[4];
        { const float wfq = __builtin_amdgcn_exp2f((float)(i + 1) * lgf), wbq = __builtin_amdgcn_exp2f((float)(CH - i) * lgb);
#pragma unroll
          for (int ks = 0; ks < 4; ++ks) { const v4u qw = __builtin_bit_cast(v4u, qf[ks]); v4u a, b2;
            a.x = cvt_pk_bf16(bflo(qw.x) * wfq, bfhi(qw.x) * wfq); a.y = cvt_pk_bf16(bflo(qw.y) * wfq, bfhi(qw.y) * wfq); a.z = cvt_pk_bf16(bflo(qw.z) * wfq, bfhi(qw.z) * wfq); a.w = cvt_pk_bf16(bflo(qw.w) * wfq, bfhi(qw.w) * wfq);
            b2.x = cvt_pk_bf16(bflo(qw.x) * wbq, bfhi(qw.x) * wbq); b2.y = cvt_pk_bf16(bflo(qw.y) * wbq, bfhi(qw.y) * wbq); b2.z = cvt_pk_bf16(bflo(qw.z) * wbq, bfhi(qw.z) * wbq); b2.w = cvt_pk_bf16(bflo(qw.w) * wbq, bfhi(qw.w) * wbq);
            qff[ks] = __builtin_bit_cast(bf16x8, a); qbf[ks] = __builtin_bit_cast(bf16x8, b2); } }
        __syncthreads();
#pragma unroll
        for (int ks = 0; ks < 4; ++ks)
#pragma unroll
            for (int et = 0; et < 16; ++et) {
                const bf16x8 s1 = *(const LAS bf16x8*)(SA + (16 * et + fr) * RO_PITCH + 32 * ks + 8 * fq), s2 = *(const LAS bf16x8*)(SB + (16 * et + fr) * RO_PITCH + 32 * ks + 8 * fq);
                o[et] = __builtin_amdgcn_mfma_f32_16x16x32_bf16(s1, qff[ks], o[et], 0, 0, 0);
                o[et] = __builtin_amdgcn_mfma_f32_16x16x32_bf16(s2, qbf[ks], o[et], 0, 0, 0);
            }
        float ss = 0.f;
#pragma unroll
        for (int et = 0; et < 16; ++et) ss += (o[et][0] * o[et][0] + o[et][1] * o[et][1]) + (o[et][2] * o[et][2] + o[et][3] * o[et][3]);
        ss += shfl_xor_l(ss, 16, lane); ss += shfl_xor_l(ss, 32, lane);
        const float rinv = 1.0f / sqrtf(ss * (1.0f / DV) + EPS);
        bf16* gp = SG + (size_t)(tok0 + i) * D + h * DV + 4 * fq;
#pragma unroll
        for (int et = 0; et < 16; ++et) { const v2u gg = *(const v2u*)(gp + 16 * et);
            v2u ow; ow.x = cvt_pk_bf16(o[et][0] * rinv * bflo(gg.x), o[et][1] * rinv * bfhi(gg.x)); ow.y = cvt_pk_bf16(o[et][2] * rinv * bflo(gg.y), o[et][3] * rinv * bfhi(gg.y));
            *(v2u*)(gp + 16 * et) = ow; }
        __syncthreads();
    }
}

__global__ void __launch_bounds__(NWAVES * 64, 2) fwd_megakernel(Args args) {
    extern __shared__ __attribute__((aligned(16))) unsigned char lds[];
    Frame F;
    F.lds = (LAS unsigned char*)lds;
    F.MISC = (volatile LAS unsigned*)(F.lds + MISC_OFF);
    F.wave = __builtin_amdgcn_readfirstlane((int)threadIdx.x >> 6);
    F.G = gridDim.x; { const int bx = blockIdx.x; F.vcu = (F.G % 8 == 0) ? (bx % 8) * (F.G / 8) + bx / 8 : bx; }
    F.out = kargs()->out; F.ws = kargs()->ws; F.ctl = (unsigned*)(F.ws + WS_CTL);
    for (int u = (int)threadIdx.x; u < (LDS_BYTES - LDSCTL_OFF) / 4; u += NWAVES * 64) ((LAS unsigned*)(F.lds + LDSCTL_OFF))[u] = 0u;
    __syncthreads();
    XcdBarrier bar = xcd_barrier_post(F.ctl + CW_BAR, F.MISC + 8);
    unsigned char* ws = F.ws;
    const int G = F.G, cid = (int)blockIdx.x;
#define GRID_BAR() xcd_barrier(bar)

#ifndef PHM
#define PHM 0xFFFFF
#endif
#define PH(k) ((PHM >> (k)) & 1)
#ifndef REPM
#define REPM 0
#endif
#define NREP(k) (1 + ((REPM >> (k)) & 1))
#if PH(0)
    phase_prologue(F, args, true);
#if NREP(0) > 1
    phase_prologue(F, args, false);
#endif
#endif
    GRID_BAR();
#if PH(1)
    phase_rows<0>(F, args);
    s5_tables1(F, args);
#endif
    GRID_BAR();
#if PH(2)
    {
        pg8::GridOrder S; S.init(ws + WS_ABUF, ws + WS_W1T, D, MT / 256, NFF / 256, G, cid);
        EpiSwiGLU E{(bf16*)(ws + WS_HBUF)};
        pg8::gemm_phase(F.lds, D, S, E, F.wave);
    }
    if (G == 256 && cid >= 256 - CV_G1_CUS) conv_range(F, 1, 0, CV_L1_G1, (cid - (256 - CV_G1_CUS)) * NWAVES + F.wave, CV_G1_CUS * NWAVES);
#if NREP(2) > 1
    {
        pg8::GridOrder S; S.init(ws + WS_ABUF, ws + WS_W1T, D, MT / 256, NFF / 256, G, cid);
        EpiSwiGLU E{(bf16*)(ws + WS_HBUF)};
        pg8::gemm_phase(F.lds, D, S, E, F.wave);
    }
#endif
#endif
    GRID_BAR();
#if PH(3)
    {
        Ffn1DownOrder S{(const char*)(ws + WS_HBUF), (const char*)(ws + WS_W2T), G, cid};
        EpiFfn1Down E{(bf16*)(ws + WS_OBUF), (float*)(ws + WS_SLAB)};
        pg8::gemm_phase(F.lds, DFF, S, E, F.wave);
    }
    if (G == 256 && cid >= 256 - CV_G2_CUS) conv_range(F, 1, CV_L1_G1, CV_L1_G1 + CV_L1_G2, (cid - (256 - CV_G2_CUS)) * NWAVES + F.wave, CV_G2_CUS * NWAVES);
#if NREP(3) > 1
    {
        pg8::GridOrder S; S.init(ws + WS_HBUF, ws + WS_W2T, DFF, MT / 256, D / 256, G, cid);
        EpiO16 E{(bf16*)(ws + WS_OBUF), D};
        pg8::gemm_phase(F.lds, DFF, S, E, F.wave);
    }
#endif
#endif
    GRID_BAR();
#if PH(4)
    phase_rows<1>(F, args);
    s5_tables2(F, args);
#endif
    GRID_BAR();
#if PH(5)
    {
        MixOrder S{(const char*)(ws + WS_ABUF), (const char*)(ws + WS_WMT), G, cid};
        EpiMix E{ws};
        pg8::gemm_phase(F.lds, D, S, E, F.wave);
    }
    if (G == 256 && cid >= 256 - CV_G3_CUS) conv_range(F, 2, 0, CV_L2_G3, (cid - (256 - CV_G3_CUS)) * NWAVES + F.wave, CV_G3_CUS * NWAVES);
#if NREP(5) > 1
    {
        MixOrder S{(const char*)(ws + WS_ABUF), (const char*)(ws + WS_WMT), G, cid};
        EpiMix E{ws};
        pg8::gemm_phase(F.lds, D, S, E, F.wave);
    }
#endif
#endif
    GRID_BAR();
#if PH(6)
    phase_rstate(F);
#if NREP(6) > 1
    phase_rstate(F);
#endif
#endif
#if PH(7)
    {
        S5EOrder S{(const char*)(ws + WS_US), (const char*)(ws + WS_S5WE), G, cid};
        EpiS5E E{(bf16*)(ws + WS_S5E)};
        pg8::gemm_phase(F.lds, 256, S, E, F.wave);
    }
#endif
    GRID_BAR();
#if PH(8)
    {
        int tid_ = F.wave * 64 + lane_id(); asm volatile("" : "+v"(tid_));
        for (int bg = cid; bg < NB * 64; bg += G) s5_scan_bg(F, bg, tid_);
        asm volatile("s_waitcnt vmcnt(0)" ::: "memory"); __syncthreads();
        S5YOrder S{(const char*)(ws + WS_US), (const char*)(ws + WS_S5ZH), (const char*)(ws + WS_S5WY1), (const char*)(ws + WS_S5WY2), G, cid};
        EpiS5Y E{(bf16*)(ws + WS_AGLU)};
        pg8::gemm_phase(F.lds, 256, S, E, F.wave);
    }
    phase_rout(F, cid);
#endif
    GRID_BAR();
#if PH(9)
    {
        pg8::GridOrder S; S.init(ws + WS_AGLU, ws + WS_WGT, SW, MX / 256, 2 * D / 256, G, cid);
        EpiGLU E{(const bf16*)(ws + WS_HBUF + 32 * MiB), (bf16*)(ws + WS_Q)};
        pg8::gemm_phase(F.lds, SW, S, E, F.wave);
    }
#if NREP(9) > 1
    {
        pg8::GridOrder S; S.init(ws + WS_AGLU, ws + WS_WGT, SW, MX / 256, 2 * D / 256, G, cid);
        EpiGLU E{(const bf16*)(ws + WS_HBUF + 32 * MiB), (bf16*)(ws + WS_Q)};
        pg8::gemm_phase(F.lds, SW, S, E, F.wave);
    }
#endif
#endif
    GRID_BAR();
#if PH(10)
    {
        pg8::GridOrder S; S.init(ws + WS_HBUF, ws + WS_WPT, D, MX / 256, D / 256, G, cid);
        EpiMerge E{(const bf16*)(ws + WS_HBUF + 64 * MiB), (bf16*)(ws + WS_Q)};
        pg8::gemm_phase(F.lds, D, S, E, F.wave);
    }
#if NREP(10) > 1
    {
        pg8::GridOrder S; S.init(ws + WS_HBUF, ws + WS_WPT, D, MX / 256, D / 256, G, cid);
        EpiMerge E{(const bf16*)(ws + WS_HBUF + 64 * MiB), (bf16*)(ws + WS_Q)};
        pg8::gemm_phase(F.lds, D, S, E, F.wave);
    }
#endif
#endif
    GRID_BAR();
#if PH(11)
    {
        pg8::GridOrder S; S.init(ws + WS_Q, ws + WS_WOT, D, MX / 256, D / 256, G, cid);
        EpiO16 E{(bf16*)(ws + WS_OBUF), D};
        pg8::gemm_phase(F.lds, D, S, E, F.wave);
    }
#if NREP(11) > 1
    {
        pg8::GridOrder S; S.init(ws + WS_Q, ws + WS_WOT, D, MX / 256, D / 256, G, cid);
        EpiO16 E{(bf16*)(ws + WS_OBUF), D};
        pg8::gemm_phase(F.lds, D, S, E, F.wave);
    }
#endif
#endif
    GRID_BAR();
#if PH(12)
    phase_rows<2>(F, args);
#if NREP(12) > 1
    phase_rows<2>(F, args);
#endif
#endif
    GRID_BAR();
#if PH(13)
    {
        pg8::GridOrder S; S.init(ws + WS_ABUF, ws + WS_W3T, D, MX / 256, NFF / 256, G, cid);
        EpiSwiGLU E{(bf16*)(ws + WS_HBUF)};
        pg8::gemm_phase(F.lds, D, S, E, F.wave);
    }
#if NREP(13) > 1
    {
        pg8::GridOrder S; S.init(ws + WS_ABUF, ws + WS_W3T, D, MX / 256, NFF / 256, G, cid);
        EpiSwiGLU E{(bf16*)(ws + WS_HBUF)};
        pg8::gemm_phase(F.lds, D, S, E, F.wave);
    }
#endif
#endif
    GRID_BAR();
#if PH(14)
    {
        pg8::GridOrder S; S.init(ws + WS_HBUF, ws + WS_W4T, DFF, MX / 256, D / 256, G, cid);
        EpiO16 E{(bf16*)(ws + WS_OBUF), D};
        pg8::gemm_phase(F.lds, DFF, S, E, F.wave);
    }
#if NREP(14) > 1
    {
        pg8::GridOrder S; S.init(ws + WS_HBUF, ws + WS_W4T, DFF, MX / 256, D / 256, G, cid);
        EpiO16 E{(bf16*)(ws + WS_OBUF), D};
        pg8::gemm_phase(F.lds, DFF, S, E, F.wave);
    }
#endif
#endif
    GRID_BAR();
#if PH(15)
    phase_rows<3>(F, args);
#if NREP(15) > 1
    phase_rows<3>(F, args);
#endif
#endif
}

extern "C" void kernel_launch(void* const* d_in, const int* in_sizes, int n_in, void* d_out, int out_size, void* d_ws, size_t ws_size, hipStream_t stream) {
    static int grid = 0;
    if (grid == 0) {
        if (n_in != 22 || in_sizes[0] != MX * D || out_size != MX * D || ws_size < WS_END) { fprintf(stderr, "kernel_launch: unexpected problem (n_in %d, in0 %d, out %d, ws %zu, need %zu)\n", n_in, n_in > 0 ? in_sizes[0] : -1, out_size, ws_size, (size_t)WS_END); grid = -1; return; }
        int dev = 0, cus = 0, per_cu = 0;
        if (hipGetDevice(&dev) != hipSuccess || hipDeviceGetAttribute(&cus, hipDeviceAttributeMultiprocessorCount, dev) != hipSuccess) { grid = -1; return; }
        if (hipFuncSetAttribute((const void*)fwd_megakernel, hipFuncAttributeMaxDynamicSharedMemorySize, LDS_BYTES) != hipSuccess) { fprintf(stderr, "kernel_launch: hipFuncSetAttribute failed\n"); grid = -1; return; }
        if (hipOccupancyMaxActiveBlocksPerMultiprocessor(&per_cu, (const void*)fwd_megakernel, NWAVES * 64, LDS_BYTES) != hipSuccess || per_cu < 1) { fprintf(stderr, "kernel_launch: occupancy query says %d blocks per CU\n", per_cu); grid = -1; (void)hipGetLastError(); return; }
        grid = cus;
    }
    if (grid < 0) return;
    if (hipMemsetAsync((char*)d_ws + WS_CTL, 0, CTL_ZERO_BYTES, stream) != hipSuccess) return;
    Args a{};
    for (int i = 0; i < 22; ++i) a.in[i] = (const float*)d_in[i];
    a.out = (float*)d_out; a.ws = (unsigned char*)d_ws;
    void* kargs[] = {&a};
    hipError_t e = hipLaunchCooperativeKernel((const void*)fwd_megakernel, dim3(grid), dim3(NWAVES * 64), kargs, LDS_BYTES, stream);
    if (e != hipSuccess) fprintf(stderr, "kernel_launch: cooperative launch failed: %s (grid %d)\n", hipGetErrorString(e), grid);
}
```

```cpp
#include <hip/hip_runtime.h>
#include <cstdio>
#include <cstdint>

#define GAS __attribute__((address_space(1)))
#define LAS __attribute__((address_space(3)))
typedef unsigned short bf16;
typedef unsigned v4u __attribute__((ext_vector_type(4)));
typedef unsigned v2u __attribute__((ext_vector_type(2)));
typedef float f32x4 __attribute__((ext_vector_type(4)));
typedef float f32x2 __attribute__((ext_vector_type(2)));
typedef short bf16x8 __attribute__((ext_vector_type(8)));
typedef short bf16x4 __attribute__((ext_vector_type(4)));

constexpr int D = 2048, NB = 2, SEQ = 4096, MX = NB * SEQ, LC = 256, MC = NB * LC, MT = MX + MC;
constexpr int DFF = 5632, NFF = 2 * DFF, SW = 1024, NMIX = 11264, NH = 8, DK = 128, DV = 256, CH = 128, NCH = SEQ / CH;
constexpr int NADA = 9 * D;
constexpr float EPS = 1e-6f;
constexpr int NWAVES = 8;

constexpr size_t MiB = 1u << 20;
constexpr size_t WS_CTL = 0, CTL_ZERO_BYTES = 1 * MiB;
constexpr size_t WS_W1T = 1 * MiB, WS_W2T = 45 * MiB, WS_WMT = 67 * MiB, WS_WGT = 115 * MiB, WS_WPT = 123 * MiB, WS_WOT = 131 * MiB, WS_W3T = 139 * MiB, WS_W4T = 183 * MiB;
constexpr size_t WS_ABUF = 205 * MiB;
constexpr size_t WS_HBUF = 239 * MiB;
constexpr size_t WS_OBUF = 335 * MiB;
constexpr size_t WS_US = 403 * MiB;
constexpr size_t WS_Q = 420 * MiB, WS_QF = 436 * MiB, WS_QB = 452 * MiB;
constexpr size_t WS_K = 468 * MiB;
constexpr size_t WS_KFT = 484 * MiB, WS_KBT = 500 * MiB, WS_KFTC = 516 * MiB, WS_KBTC = 517 * MiB;
constexpr size_t WS_STREAM = WS_KFT;
constexpr size_t WS_VT = 518 * MiB, WS_VTC = 550 * MiB;
constexpr size_t WS_YF = 552 * MiB;
constexpr size_t WS_S5WE = WS_YF, WS_S5WY1 = WS_YF + 8 * MiB, WS_S5WY2 = WS_YF + 16 * MiB, WS_S5KT = WS_YF + 24 * MiB, WS_S5BRF = WS_YF + 26 * MiB, WS_S5APOW = WS_YF + 28 * MiB;
constexpr size_t WS_S5E = WS_ABUF, WS_S5ZH = WS_ABUF + 17 * MiB;
constexpr int S5_ROWS = 272;
constexpr size_t WS_AGLU = 584 * MiB;
constexpr size_t WS_TAB = 600 * MiB;
constexpr size_t WS_END = 602 * MiB;
constexpr size_t TAB_ROPE = 0, TAB_LG2 = 16384, TAB_AR = 32768, TAB_AI = 65536, TAB_END = 131072;
constexpr int CW_BAR = 4096;
constexpr size_t CTL_ADA = 65536;

#define RLX_AGENT __ATOMIC_RELAXED, __HIP_MEMORY_SCOPE_AGENT
#define LDS_WAIT() asm volatile("s_waitcnt lgkmcnt(0)" ::: "memory")
#define VM_WAIT() asm volatile("s_waitcnt vmcnt(0)" ::: "memory")

__device__ __forceinline__ unsigned f2bf(float f) { unsigned u = __builtin_bit_cast(unsigned, f); return (u + 0x7fffu + ((u >> 16) & 1u)) >> 16; }
__device__ __forceinline__ unsigned pk2(float lo, float hi) { return f2bf(lo) | (f2bf(hi) << 16); }
__device__ __forceinline__ unsigned cvt_pk_bf16(float lo, float hi) { unsigned r; asm volatile("v_cvt_pk_bf16_f32 %0, %1, %2" : "=v"(r) : "v"(lo), "v"(hi)); return r; }
__device__ __forceinline__ float bflo(unsigned w) { return __builtin_bit_cast(float, w << 16); }
__device__ __forceinline__ float bfhi(unsigned w) { return __builtin_bit_cast(float, w & 0xffff0000u); }
__device__ __forceinline__ float fast_sigmoid(float x) { return __builtin_amdgcn_rcpf(1.0f + __builtin_amdgcn_exp2f(-1.4426950408889634f * x)); }
__device__ __forceinline__ float fast_silu(float x) { return x * fast_sigmoid(x); }
__device__ __forceinline__ float gelu_tanh(float x) { const float u = 0.7978845608028654f * (x + 0.044715f * x * x * x); return x * fast_sigmoid(2.0f * u); }
__device__ __forceinline__ int lane_id() { return (int)__builtin_amdgcn_mbcnt_hi(~0u, __builtin_amdgcn_mbcnt_lo(~0u, 0u)); }
__device__ __forceinline__ float shfl_xor_l(float v, int mask, int lane) { return __builtin_bit_cast(float, __builtin_amdgcn_ds_bpermute((lane ^ mask) << 2, __builtin_bit_cast(int, v))); }
__device__ __forceinline__ float wave_sum(float v, int lane) {
#pragma unroll
    for (int o = 1; o < 64; o <<= 1) v += shfl_xor_l(v, o, lane);
    return v;
}

#define XB_TMO      128
#define XB_XCNT(j)  (256  + 64 * (j))
#define XB_XSUB(j)  (1280 + 64 * (j))
#define XB_XGEN(j)  (2304 + 64 * (j))
#define XB_TOP      3328
#define XB_TOPGEN   3392
#define XCD_BAR_WORDS 3456
#define XB_SPIN_CAP (1u << 18)
__device__ __forceinline__ unsigned xb_ld(unsigned* p)              { return __hip_atomic_load(p, __ATOMIC_RELAXED, __HIP_MEMORY_SCOPE_AGENT); }
__device__ __forceinline__ unsigned xb_add(unsigned* p, unsigned v) { return __hip_atomic_fetch_add(p, v, __ATOMIC_RELAXED, __HIP_MEMORY_SCOPE_AGENT); }
__device__ __forceinline__ unsigned xb_xcc_id() { return (unsigned)__builtin_amdgcn_s_getreg((3 << 11) | 20) & 0xFu; }
#define XB_SPIN(cond, bar) do { unsigned _sp = 0; while (cond) { __builtin_amdgcn_s_sleep(1); \
    if ((++_sp & 255u) == 0u) { if (xb_ld(&(bar)[XB_TMO])) break; if (_sp > XB_SPIN_CAP) { atomicAdd(&(bar)[XB_TMO], 1u); break; } } } } while (0)
struct XcdBarrier { unsigned* bar; unsigned x; volatile LAS unsigned* st; };
__device__ __forceinline__ XcdBarrier xcd_barrier_post(unsigned* bar, volatile LAS unsigned* st) {
    XcdBarrier b; b.bar = bar; b.x = xb_xcc_id(); b.st = st;
    if (threadIdx.x == 0) (void)xb_add(&bar[XB_XCNT(b.x)], 1u);
    return b;
}
__device__ __forceinline__ void xcd_barrier_complete(unsigned* bar, unsigned x, unsigned& nloc, unsigned& nx) {
    const unsigned G = gridDim.x * gridDim.y * gridDim.z;
    unsigned sum, cnt, mine, sp = 0u;
    for (;;) {
        sum = 0u; cnt = 0u; mine = 0u;
#pragma unroll
        for (unsigned j = 0; j < 16; ++j) { const unsigned c = xb_ld(&bar[XB_XCNT(j)]); sum += c; cnt += (c > 0u) ? 1u : 0u; mine = (j == x) ? c : mine; }
        if (sum == G) break;
        __builtin_amdgcn_s_sleep(1);
        if ((++sp & 255u) == 0u) { if (xb_ld(&bar[XB_TMO])) break; if (sp > XB_SPIN_CAP) { atomicAdd(&bar[XB_TMO], 1u); break; } }
    }
    nloc = mine > 0u ? mine : 1u; nx = cnt > 0u ? cnt : 1u;
}
__device__ __forceinline__ void xcd_barrier(const XcdBarrier& b) {
    asm volatile("s_waitcnt vmcnt(0)" ::: "memory");
    __syncthreads();
    if (threadIdx.x == 0) {
        unsigned* bar = b.bar;
        __builtin_amdgcn_s_waitcnt(0);
        unsigned nloc = b.st[0], nx = b.st[1];
        if (nloc == 0u) { xcd_barrier_complete(bar, b.x, nloc, nx); b.st[0] = nloc; b.st[1] = nx; }
        const unsigned old = xb_add(&bar[XB_XSUB(b.x)], 1u);
        const unsigned gen = old / nloc;
        if (old + 1u == (gen + 1u) * nloc) {
            __builtin_amdgcn_fence(__ATOMIC_RELEASE, "agent");
            asm volatile("s_waitcnt vmcnt(0)" ::: "memory");
            const unsigned og = xb_add(&bar[XB_TOP], 1u);
            const unsigned tg = og / nx;
            if (og + 1u == (tg + 1u) * nx) xb_add(&bar[XB_TOPGEN], 1u);
            else XB_SPIN(xb_ld(&bar[XB_TOPGEN]) == tg, bar);
            __builtin_amdgcn_fence(__ATOMIC_ACQUIRE, "agent");
            xb_add(&bar[XB_XGEN(b.x)], 1u);
            asm volatile("s_waitcnt vmcnt(0)" ::: "memory");
        } else {
            XB_SPIN(xb_ld(&bar[XB_XGEN(b.x)]) == gen, bar);
            __builtin_amdgcn_fence(__ATOMIC_ACQUIRE, "agent");
            asm volatile("s_waitcnt vmcnt(0)" ::: "memory");
        }
    }
    __syncthreads();
}

namespace pg8 {
constexpr int BM = 256, BK = 64, HALF = 128, HTB = HALF * BK * 2, STAGE_BYTES = 8 * HTB, NXCD = 8;
__device__ __forceinline__ int lds_byte(int r, int c) { const int st = (r >> 4) * 2 + (c >> 5), rr = r & 15, cc = c & 31, ob = rr * 64 + cc * 2; return st * 1024 + (ob ^ (((ob >> 9) & 1) << 5)); }
__device__ __forceinline__ void stage_rc(int b, int& R, int& C) { const int st = b / 1024, sb = b % 1024, swz = sb ^ (((sb >> 9) & 1) << 5); R = (st >> 1) * 16 + swz / 64; C = (st & 1) * 32 + (swz % 64) / 2; }
__device__ __forceinline__ int perm32(int rho) { const int n = rho >> 4, i = rho & 15; return 8 * (i >> 2) + 4 * n + (i & 3); }

struct Unit {
    const char* A; const char* B; unsigned info;
    __device__ __forceinline__ int pm() const { return (int)(info & 255u); }
    __device__ __forceinline__ int pn() const { return (int)((info >> 8) & 255u); }
    __device__ __forceinline__ int kind() const { return (int)((info >> 16) & 15u); }
    __device__ __forceinline__ int nt() const { return (int)((info >> 20) & 255u); }
    __device__ __forceinline__ int cont() const { return (int)((info >> 28) & 1u); }
};
__device__ __forceinline__ Unit make_unit(const char* A, const char* B, int pm, int pn, int kind, int nt, int cont) { return Unit{A, B, (unsigned)pm | ((unsigned)pn << 8) | ((unsigned)kind << 16) | ((unsigned)nt << 20) | ((unsigned)cont << 28)}; }
__device__ __forceinline__ int xcd_remap(int L, int nwg) { const int q = nwg / NXCD, r = nwg % NXCD, xcd = L % NXCD, off = L / NXCD; return (xcd < r ? xcd * (q + 1) : r * (q + 1) + (xcd - r) * q) + off; }

template <class Epi, class Sched>
__device__ __forceinline__ void gemm_phase(LAS unsigned char* lds, const int K, const Sched& S, const Epi& E, const int wave_) {
    int tid = wave_ * 64 + lane_id(); asm volatile("" : "+v"(tid));
    const int wid = wave_, lane = tid & 63, wr = wid >> 2, wc = wid & 3, fr = lane & 15, fq = lane >> 4;
    unsigned voffA[2], voffB[2];
#pragma unroll
    for (int i = 0; i < 2; ++i) { int R, C; stage_rc(tid * 16 + i * 8192, R, C); const int Rb = (R & ~31) + perm32(R & 31);
        voffA[i] = (unsigned)(R * K + C) * 2u; voffB[i] = (unsigned)(Rb * K + C) * 2u; }
    const size_t kstep = (size_t)(BK * 2);
    const size_t hstep = (size_t)HALF * K * 2;
    const unsigned ldsw = (unsigned)wid * 1024u;
    const int aoff = lds_byte(wr * 64 + fr, fq * 8), boff = lds_byte(wc * 32 + fr, fq * 8);
#define PG8_SA(b, h) (((b) * 2 + (h)) * HTB)
#define PG8_SB(b, h) ((4 + (b) * 2 + (h)) * HTB)
#define PG8_STAGE(bufoff, gbase, voff) do { _Pragma("unroll") for (int _i = 0; _i < 2; ++_i) \
        __builtin_amdgcn_global_load_lds((const unsigned*)((const char*)(gbase) + (voff)[_i]), (LAS unsigned*)(lds + (bufoff) + ldsw + _i * 8192), 16, 0, 0); } while (0)
#define PG8_LDA(dst, b, h) do { _Pragma("unroll") for (int m = 0; m < 4; ++m) _Pragma("unroll") for (int k = 0; k < 2; ++k) dst[m][k] = *(const LAS bf16x8*)(lds + PG8_SA(b, h) + aoff + m * 2048 + k * 1024); } while (0)
#define PG8_LDB(dst, b, h) do { _Pragma("unroll") for (int n = 0; n < 2; ++n) _Pragma("unroll") for (int k = 0; k < 2; ++k) dst[n][k] = *(const LAS bf16x8*)(lds + PG8_SB(b, h) + boff + n * 2048 + k * 1024); } while (0)
#define PG8_MMA(ai, bj, At, Bt) do { __builtin_amdgcn_s_setprio(1); _Pragma("unroll") for (int m = 0; m < 4; ++m) _Pragma("unroll") for (int n = 0; n < 2; ++n) _Pragma("unroll") for (int k = 0; k < 2; ++k) \
        acc[ai][bj][m][n] = __builtin_amdgcn_mfma_f32_16x16x32_bf16(Bt[n][k], At[m][k], acc[ai][bj][m][n], 0, 0, 0); __builtin_amdgcn_s_setprio(0); } while (0)
#define PG8_WAIT_V(n) asm volatile("s_waitcnt vmcnt(" #n ")" ::: "memory")
#define PG8_WAIT_L(n) asm volatile("s_waitcnt lgkmcnt(" #n ")" ::: "memory")
#define PG8_BAR __builtin_amdgcn_s_barrier()
#define PG8_SCHED __builtin_amdgcn_sched_barrier(0)
    Unit cur, nxt; int ui = 0;
    if (!S.next(0, cur)) return;
    f32x4 acc[2][2][4][2];
#pragma unroll
    for (int a = 0; a < 2; ++a)
#pragma unroll
        for (int b = 0; b < 2; ++b)
#pragma unroll
            for (int m = 0; m < 4; ++m)
#pragma unroll
                for (int n = 0; n < 2; ++n) acc[a][b][m][n] = (f32x4){0.f, 0.f, 0.f, 0.f};
    bf16x8 At[4][2], B0[2][2], B1[2][2];
    const char* cA = cur.A; const char* cB = cur.B;
    PG8_STAGE(PG8_SB(0, 0), cB, voffB); PG8_STAGE(PG8_SB(0, 1), cB + hstep, voffB); PG8_STAGE(PG8_SA(0, 0), cA, voffA); PG8_STAGE(PG8_SA(0, 1), cA + hstep, voffA);
    if (wr == 1) PG8_BAR;
    PG8_WAIT_V(2); PG8_BAR;
    PG8_STAGE(PG8_SB(1, 0), cB + kstep, voffB); PG8_STAGE(PG8_SA(1, 0), cA + kstep, voffA); PG8_STAGE(PG8_SB(1, 1), cB + hstep + kstep, voffB);
    PG8_WAIT_V(6); PG8_BAR;
    for (;;) {
        const bool has_next = S.next(ui + 1, nxt);
        const char* nA = has_next ? nxt.A : cA; const char* nB = has_next ? nxt.B : cB;
        const int nt = cur.nt();
        for (int t = 0; t < nt; t += 2) {
            const bool last = (t == nt - 2);
            const char* a1 = cA + (size_t)(t + 1) * kstep;
            const char* a2 = last ? nA : cA + (size_t)(t + 2) * kstep; const char* b2 = last ? nB : cB + (size_t)(t + 2) * kstep;
            const char* a3 = a2 + kstep; const char* b3 = b2 + kstep;
            PG8_LDB(B0, 0, 0); PG8_LDB(B1, 0, 1); PG8_SCHED; PG8_LDA(At, 0, 0); PG8_STAGE(PG8_SA(1, 1), a1 + hstep, voffA);
            PG8_WAIT_V(8); PG8_WAIT_L(0); PG8_BAR; PG8_MMA(0, 0, At, B0); PG8_MMA(0, 1, At, B1); PG8_BAR; PG8_SCHED;
            PG8_LDA(At, 0, 1); PG8_STAGE(PG8_SB(0, 0), b2, voffB); PG8_STAGE(PG8_SB(0, 1), b2 + hstep, voffB); PG8_STAGE(PG8_SA(0, 0), a2, voffA);
            PG8_WAIT_V(8); PG8_WAIT_L(0); PG8_BAR; PG8_MMA(1, 0, At, B0); PG8_MMA(1, 1, At, B1); PG8_BAR; PG8_SCHED;
            PG8_LDB(B0, 1, 0); PG8_LDB(B1, 1, 1); PG8_SCHED; PG8_LDA(At, 1, 0); PG8_STAGE(PG8_SA(0, 1), a2 + hstep, voffA);
            PG8_WAIT_V(8); PG8_WAIT_L(0); PG8_BAR; PG8_MMA(0, 0, At, B0); PG8_MMA(0, 1, At, B1); PG8_BAR; PG8_SCHED;
            PG8_LDA(At, 1, 1); PG8_STAGE(PG8_SB(1, 0), b3, voffB); PG8_STAGE(PG8_SB(1, 1), b3 + hstep, voffB); PG8_STAGE(PG8_SA(1, 0), a3, voffA);
            PG8_WAIT_V(8); PG8_WAIT_L(0); PG8_BAR; PG8_MMA(1, 0, At, B0); PG8_MMA(1, 1, At, B1); PG8_BAR; PG8_SCHED;
        }
        if (wr == 0) PG8_BAR;
        if (!cur.cont()) E(acc, cur, wr, wc, fr, fq);
        if (!has_next) break;
        if (!cur.cont()) {
#pragma unroll
        for (int a = 0; a < 2; ++a)
#pragma unroll
            for (int b = 0; b < 2; ++b)
#pragma unroll
                for (int m = 0; m < 4; ++m)
#pragma unroll
                    for (int n = 0; n < 2; ++n) acc[a][b][m][n] = (f32x4){0.f, 0.f, 0.f, 0.f};
        }
        cur = nxt; cA = nA; cB = nB; ++ui;
        if (wr == 1) PG8_BAR;
    }
    PG8_WAIT_V(0);
    PG8_BAR;
#undef PG8_SA
#undef PG8_SB
#undef PG8_STAGE
#undef PG8_LDA
#undef PG8_LDB
#undef PG8_MMA
#undef PG8_WAIT_V
#undef PG8_WAIT_L
#undef PG8_BAR
#undef PG8_SCHED
}

struct GridOrder {
    const char* A; const char* B; size_t tstep; int nM, nN, nwg, G, c, nt;
    __device__ __forceinline__ void init(const void* A_, const void* B_, int K, int nM_, int nN_, int G_, int c_) { A = (const char*)A_; B = (const char*)B_; tstep = (size_t)BM * K * 2; nM = nM_; nN = nN_; nwg = nM * nN; G = G_; c = c_; nt = K / BK; }
    __device__ __forceinline__ bool next(int i, Unit& u) const {
        const long L = (long)i * G + c; if (L >= nwg) return false;
        int wgid;
        if ((nwg & 63) == 0 && (nM & 7) == 0) {
            const int q = nwg >> 3, xcd = (int)L & 7, off = (int)L >> 3, blk = off >> 6;
            int o2 = off;
            if (blk < (q >> 6)) { const int rem = off & 63, half = rem >> 5, j = rem & 31; o2 = (blk << 6) + ((j >> 2) << 3) + half * 4 + (j & 3); }
            wgid = xcd * q + o2;
        } else wgid = xcd_remap((int)L, nwg);
        const int nig = 8 * nN, gid = wgid / nig, fm = gid * 8, gsz = (nM - fm) < 8 ? (nM - fm) : 8;
        const int pm = fm + ((wgid % nig) % gsz), pn = (wgid % nig) / gsz;
        u = make_unit(A + (size_t)pm * tstep, B + (size_t)pn * tstep, pm, pn, 0, nt, 0); return true;
    }
};
}

typedef f32x4 Acc[2][2][4][2];
struct EpiSwiGLU {
    bf16* Hid;
    __device__ __forceinline__ void operator()(const Acc& acc, const pg8::Unit& u, int wr, int wc, int fr0, int fq0) const {
        int fr = fr0, fq = fq0; asm volatile("" : "+v"(fr), "+v"(fq));
        const int row0 = u.pm() * 256 + wr * 64 + fr, col0 = u.pn() * 128 + wc * 32 + 8 * fq;
#pragma unroll
        for (int ai = 0; ai < 2; ++ai)
#pragma unroll
            for (int m = 0; m < 4; ++m) {
                float v[8];
#pragma unroll
                for (int n = 0; n < 2; ++n)
#pragma unroll
                    for (int j = 0; j < 4; ++j) v[4 * n + j] = fast_silu(acc[ai][0][m][n][j]) * acc[ai][1][m][n][j];
                v4u w; w.x = cvt_pk_bf16(v[0], v[1]); w.y = cvt_pk_bf16(v[2], v[3]); w.z = cvt_pk_bf16(v[4], v[5]); w.w = cvt_pk_bf16(v[6], v[7]);
                *(v4u*)(Hid + (size_t)(row0 + ai * 128 + m * 16) * DFF + col0) = w;
            }
    }
};
struct EpiO16 {
    bf16* C; int ldc;
    __device__ __forceinline__ void operator()(const Acc& acc, const pg8::Unit& u, int wr, int wc, int fr0, int fq0) const {
        int fr = fr0, fq = fq0; asm volatile("" : "+v"(fr), "+v"(fq));
        const int row0 = u.pm() * 256 + wr * 64 + fr, col0 = u.pn() * 256 + wc * 32 + 8 * fq;
#pragma unroll
        for (int ai = 0; ai < 2; ++ai)
#pragma unroll
            for (int m = 0; m < 4; ++m) { bf16* rowp = C + (size_t)(row0 + ai * 128 + m * 16) * ldc + col0;
#pragma unroll
                for (int bj = 0; bj < 2; ++bj) { const f32x4 a = acc[ai][bj][m][0], b = acc[ai][bj][m][1];
                    v4u w; w.x = cvt_pk_bf16(a[0], a[1]); w.y = cvt_pk_bf16(a[2], a[3]); w.z = cvt_pk_bf16(b[0], b[1]); w.w = cvt_pk_bf16(b[2], b[3]);
                    *(v4u*)(rowp + bj * 128) = w; } }
    }
};
struct EpiGLU {
    const bf16* SGS; bf16* out;
    __device__ __forceinline__ void operator()(const Acc& acc, const pg8::Unit& u, int wr, int wc, int fr0, int fq0) const {
        int fr = fr0, fq = fq0; asm volatile("" : "+v"(fr), "+v"(fq));
        const int row0 = u.pm() * 256 + wr * 64 + fr, col0 = u.pn() * 128 + wc * 32 + 8 * fq;
#pragma unroll
        for (int ai = 0; ai < 2; ++ai)
#pragma unroll
            for (int m = 0; m < 4; ++m) {
                const size_t off = (size_t)(row0 + ai * 128 + m * 16) * D + col0;
                const v4u s = *(const v4u*)(SGS + off);
                const float sg[8] = {bflo(s.x), bfhi(s.x), bflo(s.y), bfhi(s.y), bflo(s.z), bfhi(s.z), bflo(s.w), bfhi(s.w)};
                float v[8];
#pragma unroll
                for (int n = 0; n < 2; ++n)
#pragma unroll
                    for (int j = 0; j < 4; ++j) v[4 * n + j] = acc[ai][0][m][n][j] * fast_sigmoid(acc[ai][1][m][n][j]) * sg[4 * n + j];
                v4u w; w.x = cvt_pk_bf16(v[0], v[1]); w.y = cvt_pk_bf16(v[2], v[3]); w.z = cvt_pk_bf16(v[4], v[5]); w.w = cvt_pk_bf16(v[6], v[7]);
                *(v4u*)(out + off) = w;
            }
    }
};
struct EpiMerge {
    const bf16* SGR; bf16* mg;
    __device__ __forceinline__ void operator()(const Acc& acc, const pg8::Unit& u, int wr, int wc, int fr0, int fq0) const {
        int fr = fr0, fq = fq0; asm volatile("" : "+v"(fr), "+v"(fq));
        const int row0 = u.pm() * 256 + wr * 64 + fr, col0 = u.pn() * 256 + wc * 32 + 8 * fq;
#pragma unroll
        for (int ai = 0; ai < 2; ++ai)
#pragma unroll
            for (int m = 0; m < 4; ++m)
#pragma unroll
                for (int bj = 0; bj < 2; ++bj) {
                    const size_t off = (size_t)(row0 + ai * 128 + m * 16) * D + col0 + bj * 128;
                    const v4u s = *(const v4u*)(SGR + off), p = *(const v4u*)(mg + off);
                    const float sg[8] = {bflo(s.x), bfhi(s.x), bflo(s.y), bfhi(s.y), bflo(s.z), bfhi(s.z), bflo(s.w), bfhi(s.w)};
                    const float pp[8] = {bflo(p.x), bfhi(p.x), bflo(p.y), bfhi(p.y), bflo(p.z), bfhi(p.z), bflo(p.w), bfhi(p.w)};
                    float v[8];
#pragma unroll
                    for (int n = 0; n < 2; ++n)
#pragma unroll
                        for (int j = 0; j < 4; ++j) v[4 * n + j] = pp[4 * n + j] + sg[4 * n + j] * acc[ai][bj][m][n][j];
                    v4u w; w.x = cvt_pk_bf16(v[0], v[1]); w.y = cvt_pk_bf16(v[2], v[3]); w.z = cvt_pk_bf16(v[4], v[5]); w.w = cvt_pk_bf16(v[6], v[7]);
                    *(v4u*)(mg + off) = w;
                }
    }
};

constexpr int CTX_SPLIT = 4;
constexpr size_t WS_SLAB = WS_Q;
struct Ffn1DownOrder {
    const char* A; const char* B; int G, c;
    static constexpr int NBIG = (MX / 256) * (D / 256), NSMALL = (MC / 256) * (D / 256) * CTX_SPLIT;
    __device__ __forceinline__ bool next(int i, pg8::Unit& u) const {
        const long L = (long)i * G + c; if (L >= NBIG + NSMALL) return false;
        const size_t tstep = (size_t)256 * DFF * 2;
        int pm, pn, kind, nt; size_t koff;
        if (L < NBIG) { const int w = pg8::xcd_remap((int)L, NBIG); const int nig = 8 * 8, gid = w / nig, r = w % nig; pm = gid * 8 + (r & 7); pn = r >> 3; kind = 0; nt = DFF / 64; koff = 0; }
        else { const int w = (int)L - NBIG, sp = w & 3, t = w >> 2; pm = 32 + (t & 1); pn = t >> 1; kind = 1 + sp; nt = DFF / 64 / CTX_SPLIT; koff = (size_t)sp * (DFF / CTX_SPLIT) * 2; }
        u = pg8::make_unit(A + (size_t)pm * tstep + koff, B + (size_t)pn * tstep + koff, pm, pn, kind, nt, 0); return true;
    }
};
struct EpiFfn1Down {
    bf16* O; float* slab;
    __device__ __forceinline__ void operator()(const Acc& acc, const pg8::Unit& u, int wr, int wc, int fr0, int fq0) const {
        int fr = fr0, fq = fq0; asm volatile("" : "+v"(fr), "+v"(fq));
        const int row0 = u.pm() * 256 + wr * 64 + fr, col0 = u.pn() * 256 + wc * 32 + 8 * fq;
        if (u.kind() == 0) {
#pragma unroll
            for (int ai = 0; ai < 2; ++ai)
#pragma unroll
                for (int m = 0; m < 4; ++m) { bf16* rowp = O + (size_t)(row0 + ai * 128 + m * 16) * D + col0;
#pragma unroll
                    for (int bj = 0; bj < 2; ++bj) { const f32x4 a = acc[ai][bj][m][0], b = acc[ai][bj][m][1];
                        v4u w; w.x = cvt_pk_bf16(a[0], a[1]); w.y = cvt_pk_bf16(a[2], a[3]); w.z = cvt_pk_bf16(b[0], b[1]); w.w = cvt_pk_bf16(b[2], b[3]);
                        *(v4u*)(rowp + bj * 128) = w; } }
        } else {
            float* C = slab + (size_t)(u.kind() - 1) * MC * D - (size_t)MX * D;
#pragma unroll
            for (int ai = 0; ai < 2; ++ai)
#pragma unroll
                for (int m = 0; m < 4; ++m) { float* rowp = C + (size_t)(row0 + ai * 128 + m * 16) * D + col0;
#pragma unroll
                    for (int bj = 0; bj < 2; ++bj) { *(f32x4*)(rowp + bj * 128) = acc[ai][bj][m][0]; *(f32x4*)(rowp + bj * 128 + 4) = acc[ai][bj][m][1]; } }
        }
    }
};

enum { MK_S = 0, MK_Q = 1, MK_K = 2, MK_G = 3, MK_GS = 4, MK_GR = 5, MK_KT = 6, MK_VT = 7 };
struct EpiMix {
    unsigned char* ws;
    __device__ __forceinline__ void operator()(const Acc& acc, const pg8::Unit& u, int wr, int wc, int fr0, int fq0) const {
        int fr = fr0, fq = fq0; asm volatile("" : "+v"(fr), "+v"(fq));
        bf16* const US = (bf16*)(ws + WS_US); bf16* const Q = (bf16*)(ws + WS_Q); bf16* const KN = (bf16*)(ws + WS_K);
        bf16* const SG = (bf16*)(ws + WS_HBUF); bf16* const SGS = (bf16*)(ws + WS_HBUF + 32 * MiB); bf16* const SGR = (bf16*)(ws + WS_HBUF + 64 * MiB);
        bf16* const KFTC = (bf16*)(ws + WS_KFTC);
        bf16* const VT = (bf16*)(ws + WS_VT); bf16* const VTC = (bf16*)(ws + WS_VTC);
        const f32x2* const rope = (const f32x2*)(ws + WS_TAB + TAB_ROPE);
        const float* const lg2 = (const float*)(ws + WS_TAB + TAB_LG2);
        const int kind = u.kind();
        if (kind == MK_S) {
#pragma unroll
            for (int ai = 0; ai < 2; ++ai)
#pragma unroll
                for (int m = 0; m < 4; ++m) {
                    const int row = u.pm() * 256 + ai * 128 + wr * 64 + m * 16 + fr;
                    int b_, crow;
                    if (row < MX) { b_ = row >> 12; crow = (row & (SEQ - 1)) >> 4; } else { b_ = (row - MX) >> 8; crow = 256 + (((row - MX) & (LC - 1)) >> 4); }
                    const int s = row & 15;
#pragma unroll
                    for (int bj = 0; bj < 2; ++bj) {
                        const int ch = u.pn() * 256 + bj * 128 + wc * 32 + 8 * fq, g = ch >> 4, c0 = ch & 15;
                        const f32x4 a = acc[ai][bj][m][0], b = acc[ai][bj][m][1];
                        v4u w; w.x = cvt_pk_bf16(a[0], a[1]); w.y = cvt_pk_bf16(a[2], a[3]); w.z = cvt_pk_bf16(b[0], b[1]); w.w = cvt_pk_bf16(b[2], b[3]);
                        *(v4u*)(US + ((size_t)((b_ * 64 + g) * S5_ROWS + crow)) * 256 + s * 16 + c0) = w;
                    }
                }
        } else if (kind == MK_G || kind == MK_GS || kind == MK_GR) {
            bf16* dst = kind == MK_G ? SG : (kind == MK_GS ? SGS : SGR);
            const int row0 = u.pm() * 256 + wr * 64 + fr, col0 = u.pn() * 256 + wc * 32 + 8 * fq;
#pragma unroll
            for (int ai = 0; ai < 2; ++ai)
#pragma unroll
                for (int m = 0; m < 4; ++m)
#pragma unroll
                    for (int bj = 0; bj < 2; ++bj) {
                        float v[8];
#pragma unroll
                        for (int n = 0; n < 2; ++n)
#pragma unroll
                            for (int j = 0; j < 4; ++j) { const float x = acc[ai][bj][m][n][j]; const float s = fast_sigmoid(x); v[4 * n + j] = kind == MK_G ? x * s : s; }
                        v4u w; w.x = cvt_pk_bf16(v[0], v[1]); w.y = cvt_pk_bf16(v[2], v[3]); w.z = cvt_pk_bf16(v[4], v[5]); w.w = cvt_pk_bf16(v[6], v[7]);
                        *(v4u*)(dst + (size_t)(row0 + ai * 128 + m * 16) * D + col0 + bj * 128) = w;
                    }
        } else if (kind == MK_Q || kind == MK_K) {
            const int p = wc >> 1, i0 = 16 * (wc & 1) + 4 * fq;
            const int d0 = 64 * p + i0;
            const bool isctx = u.pm() >= 32;
            f32x4 cs0[8], cs1[8];
#pragma unroll
            for (int am = 0; am < 8; ++am) {
                const int row = u.pm() * 256 + (am >> 2) * 128 + wr * 64 + (am & 3) * 16 + fr;
                const int l = row & (SEQ - 1), pos = p ? (l & 63) : (l >> 6);
                if (!isctx) { cs0[am] = *(const f32x4*)(rope + pos * 32 + i0); cs1[am] = *(const f32x4*)(rope + pos * 32 + i0 + 2); }
                else { cs0[am] = (f32x4){1.f, 0.f, 1.f, 0.f}; cs1[am] = cs0[am]; }
            }
#pragma unroll
            for (int ai = 0; ai < 2; ++ai)
#pragma unroll
                for (int m = 0; m < 4; ++m) {
                    const int am = ai * 4 + m;
                    const int row = u.pm() * 256 + ai * 128 + wr * 64 + m * 16 + fr;
                    const float cc[4] = {cs0[am][0], cs0[am][2], cs1[am][0], cs1[am][2]}, ss[4] = {cs0[am][1], cs0[am][3], cs1[am][1], cs1[am][3]};
#pragma unroll
                    for (int bj = 0; bj < 2; ++bj) {
                        const int head = 2 * u.pn() + bj;
                        float y1[4], y2[4];
#pragma unroll
                        for (int j = 0; j < 4; ++j) { const float x1 = acc[ai][bj][m][0][j], x2 = acc[ai][bj][m][1][j]; y1[j] = x1 * cc[j] - x2 * ss[j]; y2[j] = x1 * ss[j] + x2 * cc[j]; }
                        const int cpos = 32 * wc + 8 * fq;
                        v4u w;
                        if (kind == MK_K) {
                            w.x = cvt_pk_bf16(y1[0], y1[1]); w.y = cvt_pk_bf16(y1[2], y1[3]); w.z = cvt_pk_bf16(y2[0], y2[1]); w.w = cvt_pk_bf16(y2[2], y2[3]);
                            if (!isctx) *(v4u*)(KN + (size_t)row * 1024 + head * 128 + cpos) = w;
                            else *(v4u*)(KFTC + (size_t)(row - MX) * 1024 + head * 128 + cpos) = w;
                        } else {
                            const float qs = 0.08838834764831845f;
                            w.x = cvt_pk_bf16(y1[0] * qs, y1[1] * qs); w.y = cvt_pk_bf16(y1[2] * qs, y1[3] * qs); w.z = cvt_pk_bf16(y2[0] * qs, y2[1] * qs); w.w = cvt_pk_bf16(y2[2] * qs, y2[3] * qs);
                            *(v4u*)(Q + (size_t)row * 1024 + head * 128 + cpos) = w;
                        }
                    }
                }
        } else if (kind == MK_VT) {
            const bool isctx = u.pn() >= 32;
#pragma unroll
            for (int ai = 0; ai < 2; ++ai)
#pragma unroll
                for (int m = 0; m < 4; ++m) {
                    const int f = u.pm() * 256 + ai * 128 + wr * 64 + m * 16 + fr;
#pragma unroll
                    for (int bj = 0; bj < 2; ++bj) {
                        const f32x4 a = acc[ai][bj][m][0], b = acc[ai][bj][m][1];
                        v4u w; w.x = cvt_pk_bf16(a[0], a[1]); w.y = cvt_pk_bf16(a[2], a[3]); w.z = cvt_pk_bf16(b[0], b[1]); w.w = cvt_pk_bf16(b[2], b[3]);
                        const int tc = bj * 128 + wc * 32 + 8 * fq;
                        if (!isctx) { const int tok = u.pn() * 256 + tc, b_ = tok >> 12, l = tok & (SEQ - 1); *(v4u*)(VT + ((size_t)(b_ * 2048 + f) * SEQ + l)) = w; }
                        else { const int b_ = u.pn() - 32; *(v4u*)(VTC + ((size_t)(b_ * 2048 + f) * LC + tc)) = w; }
                    }
                }
        }
    }
};
struct MixOrder {
    const char* U; const char* WM; int G, c;
    static constexpr int N_NORM = 32 * 36, N_CTXS = 16, N_SWAP = 8 * 34, NWG = N_NORM + N_CTXS + N_SWAP;
    __device__ __forceinline__ bool next(int i, pg8::Unit& u) const {
        const long L = (long)i * G + c; if (L >= NWG) return false;
        int w = pg8::xcd_remap((int)L, NWG);
        const size_t tstep = (size_t)256 * D * 2;
        int at, bt, pm, pn, kind;
        bool swapped = false;
        if (w < N_NORM) {
            const int nig = 8 * 36, gid = w / nig, r = w % nig, ct = r >> 3;
            pm = gid * 8 + (r & 7); at = pm;
            if (ct < 4) { bt = ct; kind = MK_S; pn = ct; } else if (ct < 8) { bt = ct; kind = MK_Q; pn = ct - 4; } else if (ct < 12) { bt = ct; kind = MK_K; pn = ct - 8; }
            else if (ct < 20) { bt = ct + 8; kind = MK_G; pn = ct - 12; } else if (ct < 28) { bt = ct + 8; kind = MK_GS; pn = ct - 20; } else { bt = ct + 8; kind = MK_GR; pn = ct - 28; }
        } else if (w < N_NORM + N_CTXS) {
            w -= N_NORM; pm = 32 + (w & 1); at = pm; const int ct = w >> 1;
            if (ct < 4) { bt = ct; pn = ct; kind = MK_S; } else { bt = ct + 4; pn = ct - 4; kind = MK_K; }
        } else {
            w -= N_NORM + N_CTXS; swapped = true;
            const int tt = w >> 3, ft = w & 7;
            bt = tt; pn = tt; at = 12 + ft; pm = ft; kind = MK_VT;
        }
        const char* abase = swapped ? WM : U; const char* bbase = swapped ? U : WM;
        u = pg8::make_unit(abase + (size_t)at * tstep, bbase + (size_t)bt * tstep, pm, pn, kind, D / 64, 0);
        return true;
    }
};

constexpr int RING_BYTES = 131072, LDSCTL_OFF = 143360, MISC_OFF = LDSCTL_OFF + 320, LDS_BYTES = 147456;
struct Args { const float* in[22]; float* out; unsigned char* ws; };
struct Frame {
    LAS unsigned char* lds; volatile LAS unsigned* MISC; unsigned* ctl;
    int wave, vcu, G;
    float* out; unsigned char* ws;
};
typedef const Args __attribute__((address_space(4)))* KArgsPtr;
__device__ __forceinline__ KArgsPtr kargs() { KArgsPtr p = (KArgsPtr)__builtin_amdgcn_kernarg_segment_ptr(); asm volatile("" : "+s"(p)); return p; }
#define FIN(k) ((const float*)kargs()->in[k])

__device__ __forceinline__ int map_pair(int n, int half) { const int h = n < half ? n : n - half, up = n >= half; return 256 * (h >> 7) + 128 * up + (h & 127); }
__device__ __forceinline__ int map_mix(int n) {
    if (n < 1024 || n >= 3072) return n;
    const int base = n & ~127, d = n & 127, p = d >> 6, e = d & 63, s = e >> 5, i = e & 31, t = 32 * p + i;
    return base + 32 * (t >> 4) + 8 * ((t >> 2) & 3) + 4 * s + (t & 3);
}
template <int MAPID>
__device__ __forceinline__ void transpose_item(const float* W, int ldw, int K, int nblk, bf16* WT, int row_off, int half, LAS float* scr, int item, int lane) {
    const int kb = item / nblk, nb = item % nblk, k0 = 64 * kb, n0 = 32 * nb;
    float wv[32];
#pragma unroll
    for (int i = 0; i < 32; ++i) wv[i] = __builtin_nontemporal_load(W + (size_t)(k0 + 2 * i + (lane >> 5)) * ldw + n0 + (lane & 31));
#pragma unroll
    for (int i = 0; i < 32; ++i) scr[(2 * i + (lane >> 5)) * 33 + (lane & 31)] = wv[i];
    LDS_WAIT(); asm volatile("" ::: "memory");
    const int c = lane & 7;
#pragma unroll
    for (int j = 0; j < 4; ++j) { const int n = (lane >> 3) + 8 * j; const LAS float* s = scr + (8 * c) * 33 + n;
        v4u o; o.x = pk2(s[0 * 33], s[1 * 33]); o.y = pk2(s[2 * 33], s[3 * 33]); o.z = pk2(s[4 * 33], s[5 * 33]); o.w = pk2(s[6 * 33], s[7 * 33]);
        const int nn = n0 + n; const int dr = MAPID == 0 ? nn : (MAPID == 1 ? map_pair(nn, half) : map_mix(nn));
        *(v4u*)(WT + (size_t)(row_off + dr) * K + k0 + 8 * c) = o; }
    LDS_WAIT(); asm volatile("" ::: "memory");
}
__device__ __forceinline__ void sincos_d(double x, double& s, double& c) {
    const double TWO_PI = 6.283185307179586476925286766559;
    x -= TWO_PI * __builtin_rint(x / TWO_PI);
    const double h = 0.125 * x, h2 = h * h;
    double sn = h * (1.0 + h2 * (-1.0 / 6 + h2 * (1.0 / 120 + h2 * (-1.0 / 5040 + h2 * (1.0 / 362880 + h2 * (-1.0 / 39916800 + h2 * (1.0 / 6227020800.0)))))));
    double cs = 1.0 + h2 * (-0.5 + h2 * (1.0 / 24 + h2 * (-1.0 / 720 + h2 * (1.0 / 40320 + h2 * (-1.0 / 3628800 + h2 * (1.0 / 479001600.0 + h2 * (-1.0 / 87178291200.0)))))));
#pragma unroll
    for (int k = 0; k < 3; ++k) { const double s2 = 2.0 * sn * cs, c2 = 1.0 - 2.0 * sn * sn; sn = s2; cs = c2; }
    s = sn; c = cs;
}
__device__ __forceinline__ double exp_d(double x) {
    const double y = x * (1.0 / 4096.0);
    double e = 1.0 + y * (1.0 + y * (0.5 + y * (1.0 / 6 + y * (1.0 / 24 + y * (1.0 / 120 + y * (1.0 / 720))))));
#pragma unroll
    for (int k = 0; k < 12; ++k) e = e * e;
    return e;
}
__device__ __forceinline__ double log1p_small_d(double z) {
    const double t = z / (2.0 + z), t2 = t * t;
    return 2.0 * t * (1.0 + t2 * (1.0 / 3 + t2 * (1.0 / 5 + t2 * (1.0 / 7 + t2 * (1.0 / 9 + t2 * (1.0 / 11))))));
}

constexpr int CV_I1 = (D / 64) * (NFF / 32), CV_I2 = (DFF / 64) * (D / 32), CV_IM = (D / 64) * (NMIX / 32), CV_IG = (SW / 64) * (2 * D / 32), CV_IP = (D / 64) * (D / 32);
constexpr int CV_N0 = CV_I1 + CV_I2, CV_N1 = CV_IM + CV_IG + 2 * CV_IP, CV_N2 = CV_I1 + CV_I2;
constexpr int CV_G1_CUS = 40, CV_G2_CUS = 192, CV_G3_CUS = 96;
constexpr int CV_L1_G1 = CV_G1_CUS * NWAVES * 12, CV_L1_G2 = CV_G2_CUS * NWAVES * 7, CV_L2_G3 = CV_G3_CUS * NWAVES * 14;
static_assert(CV_L1_G1 + CV_L1_G2 <= CV_N1 && CV_L2_G3 <= CV_N2, "conversion split");
__device__ __forceinline__ void conv_item(unsigned char* ws, int list, int r, LAS float* scr, int lane_) {
    if (list == 0) {
        if (r < CV_I1) { transpose_item<1>(FIN(7), NFF, D, NFF / 32, (bf16*)(ws + WS_W1T), 0, DFF, scr, r, lane_); return; } r -= CV_I1;
        transpose_item<0>(FIN(8), D, DFF, D / 32, (bf16*)(ws + WS_W2T), 0, 0, scr, r, lane_);
    } else if (list == 1) {
        if (r < CV_IM) { transpose_item<2>(FIN(9), NMIX, D, NMIX / 32, (bf16*)(ws + WS_WMT), 0, 0, scr, r, lane_); return; } r -= CV_IM;
        if (r < CV_IG) { transpose_item<1>(FIN(18), 2 * D, SW, 2 * D / 32, (bf16*)(ws + WS_WGT), 0, D, scr, r, lane_); return; } r -= CV_IG;
        if (r < CV_IP) { transpose_item<0>(FIN(20), D, D, D / 32, (bf16*)(ws + WS_WPT), 0, 0, scr, r, lane_); return; } r -= CV_IP;
        transpose_item<0>(FIN(21), D, D, D / 32, (bf16*)(ws + WS_WOT), 0, 0, scr, r, lane_);
    } else {
        if (r < CV_I1) { transpose_item<1>(FIN(7) + (size_t)D * NFF, NFF, D, NFF / 32, (bf16*)(ws + WS_W3T), 0, DFF, scr, r, lane_); return; } r -= CV_I1;
        transpose_item<0>(FIN(8) + (size_t)DFF * D, D, DFF, D / 32, (bf16*)(ws + WS_W4T), 0, 0, scr, r, lane_);
    }
}
__device__ __forceinline__ void conv_range(Frame& F, int list, int begin, int end, int wi, int nw) {
    int lane_ = lane_id(); asm volatile("" : "+v"(lane_));
    LAS float* scr = (LAS float*)(F.lds + F.wave * 16384);
    for (int it = begin + wi; it < end; it += nw) conv_item(F.ws, list, it, scr, lane_);
}

__device__ __forceinline__ void phase_prologue(Frame& F0, const Args& args, const bool do_ada) {
    Frame& F = F0; int lane_ = lane_id(); asm volatile("" : "+v"(lane_));
    LAS float* scr = (LAS float*)(F.lds + F.wave * 16384);
    const int gw = F.vcu * NWAVES + F.wave, NGW = F.G * NWAVES;
    unsigned char* ws = F.ws;
    {
        const int gt = gw * 64 + lane_, NT = NGW * 64;
        unsigned char* tab = ws + WS_TAB;
        for (int idx = gt; idx < 2048; idx += NT) {
            const int pos = idx >> 5, i = idx & 31;
            const double inv = exp_d(-(double)i * (9.210340371976182736 / 32.0));
            double s, c; sincos_d((double)pos * inv, s, c);
            ((f32x2*)(tab + TAB_ROPE))[idx] = (f32x2){(float)c, (float)s};
        }
        for (int idx = gt; idx < 16; idx += NT) {
            const double x = (double)FIN(19)[idx];
            ((float*)(tab + TAB_LG2))[idx] = (float)(-log1p_small_d(exp_d(-x)) * 1.4426950408889634074);
        }
        for (int idx = gt; idx < 2 * 64 * 64; idx += NT) {
            const int dg = idx >> 6, p = idx & 63;
            const double lr = (double)FIN(10)[idx], li = (double)FIN(11)[idx], step = exp_d((double)FIN(12)[dg]);
            const double mag = exp_d(lr * step); double sn, cs; sincos_d(li * step, sn, cs);
            const double ar = mag * cs, ai = mag * sn, den = lr * lr + li * li, nr = ar - 1.0, ni = ai;
            const double kr = (nr * lr + ni * li) / den, ki = (ni * lr - nr * li) / den;
            ((float*)(tab + TAB_AR))[idx] = (float)ar; ((float*)(tab + TAB_AI))[idx] = (float)ai;
            { f32x2* apw = (f32x2*)(ws + WS_S5APOW) + (size_t)dg * 17 * 64 + p; double pr = 1.0, pi = 0.0;
              for (int k = 0; k < 17; ++k) { apw[k * 64] = (f32x2){(float)pr, (float)pi}; const double t = pr * ar - pi * ai; pi = pr * ai + pi * ar; pr = t; } }
            float* brf = (float*)(ws + WS_S5BRF) + (size_t)idx * 32;
            const float* bre = FIN(13) + (size_t)idx * 16; const float* bim = FIN(14) + (size_t)idx * 16;
            for (int c = 0; c < 16; ++c) { const double br = (double)bre[c], bi = (double)bim[c];
                brf[2 * c] = (float)(kr * br - ki * bi); brf[2 * c + 1] = (float)(kr * bi + ki * br); }
        }
    }
    if (do_ada) {
        float* ADA = (float*)(ws + WS_CTL + CTL_ADA);
        const float* aw = FIN(4);
        for (int it = gw; it < 16 * 72; it += NGW) {
            const int kc = it / 72, cb = it % 72, k0 = kc * 128, col = cb * 256 + 4 * lane_;
            for (int i = lane_; i < 384; i += 64) { const int v = i >> 7, k = i & 127; const float x = v == 0 ? FIN(1)[k0 + k] : (v == 1 ? FIN(1)[D + k0 + k] : FIN(3)[k0 + k]); scr[i] = x / (1.0f + __expf(-x)); }
            LDS_WAIT(); asm volatile("" ::: "memory");
            f32x4 a0 = {0.f, 0.f, 0.f, 0.f}, a1 = a0, a2 = a0;
#pragma unroll 8
            for (int k = 0; k < 128; ++k) { const f32x4 w = __builtin_nontemporal_load((const f32x4*)(aw + (size_t)(k0 + k) * NADA + col)); a0 += w * scr[k]; a1 += w * scr[128 + k]; a2 += w * scr[256 + k]; }
#pragma unroll
            for (int j = 0; j < 4; ++j) { __hip_atomic_fetch_add(ADA + col + j, a0[j], RLX_AGENT); __hip_atomic_fetch_add(ADA + NADA + col + j, a1[j], RLX_AGENT); __hip_atomic_fetch_add(ADA + 2 * NADA + col + j, a2[j], RLX_AGENT); }
            LDS_WAIT(); asm volatile("" ::: "memory");
        }
    }
    {
        const bool tails = (F.G == 256);
        const int b1 = tails ? CV_L1_G1 + CV_L1_G2 : 0, b2 = tails ? CV_L2_G3 : 0;
        const int n0 = CV_N0, n1 = CV_N1 - b1, n2 = CV_N2 - b2;
        for (int it = gw; it < n0 + n1 + n2; it += NGW) {
            if (it < n2) conv_item(ws, 2, b2 + it, scr, lane_);
            else if (it < n2 + n1) conv_item(ws, 1, b1 + it - n2, scr, lane_);
            else conv_item(ws, 0, it - n2 - n1, scr, lane_);
        }
    }
}

template <int MODE>
__device__ __forceinline__ void phase_rows(Frame& F0, const Args& args) {
    Frame& F = F0; int lane_ = lane_id(); asm volatile("" : "+v"(lane_));
    const int gw = F.vcu * NWAVES + F.wave, NGW = F.G * NWAVES;
    const float* ADA = (const float*)(F.ws + WS_CTL + CTL_ADA);
    const float* adab = FIN(5); const float* ng = FIN(6);
    const bf16* O = (const bf16*)(F.ws + WS_OBUF);
    bf16* A = (bf16*)(F.ws + WS_ABUF);
    const int nrows = (MODE <= 1) ? MT : MX;
    for (int r = gw; r < nrows; r += NGW) {
        const int av = r < MX ? (r >> 12) : 2;
        const float* ada = ADA + (size_t)av * NADA;
        f32x4 h[8];
        if (MODE <= 1) { const float* hsrc = r < MX ? FIN(0) + (size_t)r * D : FIN(2) + (size_t)(r - MX) * D;
#pragma unroll
            for (int j = 0; j < 8; ++j) h[j] = __builtin_nontemporal_load((const f32x4*)(hsrc + 256 * j + 4 * lane_)); }
        else { const bf16* hsrc = (const bf16*)(F.ws + WS_STREAM) + (size_t)r * D;
#pragma unroll
            for (int j = 0; j < 8; ++j) { const v2u t = __builtin_nontemporal_load((const v2u*)(hsrc + 256 * j + 4 * lane_)); h[j] = (f32x4){bflo(t.x), bfhi(t.x), bflo(t.y), bfhi(t.y)}; } }
        if (MODE >= 1) {
            constexpr int ipost = MODE - 1;
            const float resw = (MODE == 2) ? 1.0f : 0.5f;
            f32x4 o[8]; float ss = 0.f;
#pragma unroll
            for (int j = 0; j < 8; ++j) {
                if (MODE == 1 && r >= MX) { const float* sl = (const float*)(F.ws + WS_SLAB) + (size_t)(r - MX) * D + 256 * j + 4 * lane_; f32x4 a = *(const f32x4*)sl;
#pragma unroll
                    for (int s = 1; s < CTX_SPLIT; ++s) a += *(const f32x4*)(sl + (size_t)s * MC * D);
                    o[j] = a; }
                else { const v2u t = __builtin_nontemporal_load((const v2u*)(O + (size_t)r * D + 256 * j + 4 * lane_)); o[j] = (f32x4){bflo(t.x), bfhi(t.x), bflo(t.y), bfhi(t.y)}; }
                ss += (o[j][0] * o[j][0] + o[j][1] * o[j][1]) + (o[j][2] * o[j][2] + o[j][3] * o[j][3]); }
            const float rstd = 1.0f / sqrtf(wave_sum(ss, lane_) * (1.0f / D) + EPS);
#pragma unroll
            for (int j = 0; j < 8; ++j) { const int c = 256 * j + 4 * lane_;
                const f32x4 gate = *(const f32x4*)(ada + (3 * ipost + 2) * D + c) + *(const f32x4*)(adab + (3 * ipost + 2) * D + c);
                const f32x4 g = *(const f32x4*)(ng + (2 * ipost + 1) * D + c);
                h[j] = h[j] + (resw * rstd) * (gate * (o[j] * g)); }
            if (r < MX) {
                if (MODE == 3) {
#pragma unroll
                    for (int j = 0; j < 8; ++j) __builtin_nontemporal_store(h[j], (f32x4*)(F.out + (size_t)r * D + 256 * j + 4 * lane_));
                } else {
                    bf16* so = (bf16*)(F.ws + WS_STREAM) + (size_t)r * D;
#pragma unroll
                    for (int j = 0; j < 8; ++j) { v2u w; w.x = cvt_pk_bf16(h[j][0], h[j][1]); w.y = cvt_pk_bf16(h[j][2], h[j][3]); __builtin_nontemporal_store(w, (v2u*)(so + 256 * j + 4 * lane_));
                        h[j] = (f32x4){bflo(w.x), bfhi(w.x), bflo(w.y), bfhi(w.y)}; }
                }
            }
        }
        if (MODE <= 2) {
            constexpr int ipre = MODE;
            float ss = 0.f;
#pragma unroll
            for (int j = 0; j < 8; ++j) ss += (h[j][0] * h[j][0] + h[j][1] * h[j][1]) + (h[j][2] * h[j][2] + h[j][3] * h[j][3]);
            const float rstd = 1.0f / sqrtf(wave_sum(ss, lane_) * (1.0f / D) + EPS);
#pragma unroll
            for (int j = 0; j < 8; ++j) { const int c = 256 * j + 4 * lane_;
                const f32x4 shift = *(const f32x4*)(ada + (3 * ipre) * D + c) + *(const f32x4*)(adab + (3 * ipre) * D + c);
                const f32x4 scale = *(const f32x4*)(ada + (3 * ipre + 1) * D + c) + *(const f32x4*)(adab + (3 * ipre + 1) * D + c);
                const f32x4 g = *(const f32x4*)(ng + (2 * ipre) * D + c);
                const f32x4 v = (h[j] * rstd) * g * (scale + 1.0f) + shift;
                v2u w; w.x = cvt_pk_bf16(v[0], v[1]); w.y = cvt_pk_bf16(v[2], v[3]);
                *(v2u*)(A + (size_t)r * D + c) = w; }
        }
    }
}

__device__ __forceinline__ void s5_tables1(Frame& F, const Args& args) {
    int lane_ = lane_id(); asm volatile("" : "+v"(lane_));
    const int gt = (F.vcu * NWAVES + F.wave) * 64 + lane_, NT = F.G * NWAVES * 64;
    const f32x2* APW = (const f32x2*)(F.ws + WS_S5APOW);
    const float* BRF = (const float*)(F.ws + WS_S5BRF);
    const float* cre = FIN(15); const float* cim = FIN(16);
    float* KT = (float*)(F.ws + WS_S5KT); bf16* WE = (bf16*)(F.ws + WS_S5WE); bf16* WY2 = (bf16*)(F.ws + WS_S5WY2);
    for (int idx = gt; idx < 64 * 2 * 16 * 16 * 4; idx += NT) {
        const int c4 = idx & 3, c = (idx >> 2) & 15, k = (idx >> 6) & 15, dir = (idx >> 10) & 1, g = idx >> 11, dg = dir * 64 + g;
        const f32x2* ap = APW + (size_t)(dg * 17 + k) * 64; const float* cr = cre + (dg * 16 + c) * 64; const float* ci = cim + (dg * 16 + c) * 64;
        const float* br = BRF + (size_t)dg * 64 * 32 + c4 * 8;
        f32x4 acc = {0.f, 0.f, 0.f, 0.f};
#pragma unroll 8
        for (int p = 0; p < 64; ++p) {
            const f32x2 a = ap[p]; const float Cr = cr[p], Ci = ci[p], Gr = Cr * a[0] - Ci * a[1], Gi = Cr * a[1] + Ci * a[0];
            const f32x4 b0 = *(const f32x4*)(br + p * 32), b1 = *(const f32x4*)(br + p * 32 + 4);
            acc[0] += Gr * b0[0] - Gi * b0[1]; acc[1] += Gr * b0[2] - Gi * b0[3]; acc[2] += Gr * b1[0] - Gi * b1[1]; acc[3] += Gr * b1[2] - Gi * b1[3];
        }
        *(f32x4*)(KT + ((size_t)((g * 2 + dir) * 16 + k) * 16 + c) * 16 + c4 * 4) = acc;
    }
    for (int idx = gt; idx < 64 * 256 * 16; idx += NT) {
        const int s = idx & 15, r = (idx >> 4) & 255, g = idx >> 12, dir = r >> 7, part = (r >> 6) & 1, p = r & 63, dg = dir * 64 + g;
        const f32x2 a = APW[(size_t)(dg * 17 + (dir ? s : 15 - s)) * 64 + p]; const float pr = a[0], pi = a[1];
        const f32x4* b4 = (const f32x4*)(BRF + (size_t)(dg * 64 + p) * 32);
        float v[16];
#pragma unroll
        for (int j = 0; j < 8; ++j) { const f32x4 q = b4[j]; v[2 * j] = part ? (pr * q[1] + pi * q[0]) : (pr * q[0] - pi * q[1]); v[2 * j + 1] = part ? (pr * q[3] + pi * q[2]) : (pr * q[2] - pi * q[3]); }
        bf16* o = WE + ((size_t)(g * 256 + r)) * 256 + s * 16;
        v4u w0, w1; w0.x = pk2(v[0], v[1]); w0.y = pk2(v[2], v[3]); w0.z = pk2(v[4], v[5]); w0.w = pk2(v[6], v[7]); w1.x = pk2(v[8], v[9]); w1.y = pk2(v[10], v[11]); w1.z = pk2(v[12], v[13]); w1.w = pk2(v[14], v[15]);
        *(v4u*)o = w0; *(v4u*)(o + 8) = w1;
    }
    for (int idx = gt; idx < 64 * 256 * 32; idx += NT) {
        const int cb = idx & 31, row = (idx >> 5) & 255, g = idx >> 13, t = row >> 4, c = row & 15, col0 = 8 * cb, dir = col0 >> 7, part = (col0 >> 6) & 1, p0 = col0 & 63, dg = dir * 64 + g;
        const f32x2* ap = APW + (size_t)(dg * 17 + (dir ? 16 - t : t + 1)) * 64 + p0; const float* cr = cre + (dg * 16 + c) * 64 + p0; const float* ci = cim + (dg * 16 + c) * 64 + p0;
        float v[8];
#pragma unroll
        for (int j = 0; j < 8; ++j) { const f32x2 a = ap[j]; const float Cr = cr[j], Ci = ci[j]; v[j] = part ? -(Cr * a[1] + Ci * a[0]) : (Cr * a[0] - Ci * a[1]); }
        v4u w; w.x = pk2(v[0], v[1]); w.y = pk2(v[2], v[3]); w.z = pk2(v[4], v[5]); w.w = pk2(v[6], v[7]);
        *(v4u*)(WY2 + ((size_t)(g * 256 + row)) * 256 + col0) = w;
    }
}
__device__ __forceinline__ void s5_tables2(Frame& F, const Args& args) {
    int lane_ = lane_id(); asm volatile("" : "+v"(lane_));
    const int gt = (F.vcu * NWAVES + F.wave) * 64 + lane_, NT = F.G * NWAVES * 64;
    const float* KT = (const float*)(F.ws + WS_S5KT); bf16* WY1 = (bf16*)(F.ws + WS_S5WY1); const float* dskip = FIN(17);
    for (int idx = gt; idx < 64 * 256 * 16; idx += NT) {
        const int s = idx & 15, row = (idx >> 4) & 255, g = idx >> 12, t = row >> 4, c = row & 15;
        float v[16];
#pragma unroll
        for (int j = 0; j < 16; ++j) v[j] = 0.f;
        if (s <= t) { const f32x4* k4 = (const f32x4*)(KT + ((size_t)((g * 2 + 0) * 16 + (t - s)) * 16 + c) * 16);
#pragma unroll
            for (int j = 0; j < 4; ++j) { const f32x4 q = k4[j]; v[4 * j] += q[0]; v[4 * j + 1] += q[1]; v[4 * j + 2] += q[2]; v[4 * j + 3] += q[3]; } }
        if (s >= t) { const f32x4* k4 = (const f32x4*)(KT + ((size_t)((g * 2 + 1) * 16 + (s - t)) * 16 + c) * 16);
#pragma unroll
            for (int j = 0; j < 4; ++j) { const f32x4 q = k4[j]; v[4 * j] += q[0]; v[4 * j + 1] += q[1]; v[4 * j + 2] += q[2]; v[4 * j + 3] += q[3]; } }
        if (s == t) { const float dk = dskip[16 * g + c];
#pragma unroll
            for (int j = 0; j < 16; ++j) v[j] += (j == c) ? dk : 0.f; }
        bf16* o = WY1 + ((size_t)(g * 256 + row)) * 256 + s * 16;
        v4u w0, w1; w0.x = pk2(v[0], v[1]); w0.y = pk2(v[2], v[3]); w0.z = pk2(v[4], v[5]); w0.w = pk2(v[6], v[7]); w1.x = pk2(v[8], v[9]); w1.y = pk2(v[10], v[11]); w1.z = pk2(v[12], v[13]); w1.w = pk2(v[14], v[15]);
        *(v4u*)o = w0; *(v4u*)(o + 8) = w1;
    }
}
struct S5EOrder {
    const char* ZU; const char* WE; int G, c;
    __device__ __forceinline__ bool next(int i, pg8::Unit& u) const {
        const long L = (long)i * G + c; if (L >= 256) return false;
        const int bg = (int)L >> 1, rt = (int)L & 1, g = bg & 63;
        u = pg8::make_unit(ZU + ((size_t)(bg * S5_ROWS + 256 * rt)) * 512, WE + (size_t)g * 256 * 512, bg, rt, 0, 4, 0); return true;
    }
};
struct EpiS5E {
    bf16* E;
    __device__ __forceinline__ void operator()(const Acc& acc, const pg8::Unit& u, int wr, int wc, int fr0, int fq0) const {
        int fr = fr0, fq = fq0; asm volatile("" : "+v"(fr), "+v"(fq));
#pragma unroll
        for (int ai = 0; ai < 2; ++ai)
#pragma unroll
            for (int m = 0; m < 4; ++m) {
                const int crow = 256 * u.pn() + ai * 128 + wr * 64 + m * 16 + fr;
                if (crow < S5_ROWS) {
#pragma unroll
                    for (int bj = 0; bj < 2; ++bj) {
                        const f32x4 a = acc[ai][bj][m][0], b = acc[ai][bj][m][1];
                        v4u w; w.x = cvt_pk_bf16(a[0], a[1]); w.y = cvt_pk_bf16(a[2], a[3]); w.z = cvt_pk_bf16(b[0], b[1]); w.w = cvt_pk_bf16(b[2], b[3]);
                        *(v4u*)(E + ((size_t)(u.pm() * S5_ROWS + crow)) * 256 + bj * 128 + wc * 32 + 8 * fq) = w;
                    }
                }
            }
    }
};
struct S5YOrder {
    const char* ZU; const char* ZH; const char* WY1; const char* WY2; int G, c;
    __device__ __forceinline__ bool next(int i, pg8::Unit& u) const {
        const int bg = (i >> 1) * G + c, seg = i & 1; if (bg >= NB * 64) return false;
        const int g = bg & 63;
        const char* a = seg == 0 ? ZU + ((size_t)(bg * S5_ROWS)) * 512 : ZH + ((size_t)(bg * 256)) * 512;
        const char* b = (seg == 0 ? WY1 : WY2) + (size_t)g * 256 * 512;
        u = pg8::make_unit(a, b, bg, 0, 0, 4, seg == 0 ? 1 : 0); return true;
    }
};
struct EpiS5Y {
    bf16* AGLU;
    __device__ __forceinline__ void operator()(const Acc& acc, const pg8::Unit& u, int wr, int wc, int fr0, int fq0) const {
        int fr = fr0, fq = fq0; asm volatile("" : "+v"(fr), "+v"(fq));
        const int b_ = u.pm() >> 6, g = u.pm() & 63;
#pragma unroll
        for (int ai = 0; ai < 2; ++ai)
#pragma unroll
            for (int m = 0; m < 4; ++m) {
                const int chunk = ai * 128 + wr * 64 + m * 16 + fr;
#pragma unroll
                for (int bj = 0; bj < 2; ++bj) {
                    const int cc = bj * 128 + wc * 32 + 8 * fq, t = cc >> 4, c0 = cc & 15;
                    const f32x4 a = acc[ai][bj][m][0], b = acc[ai][bj][m][1];
                    v4u w; w.x = cvt_pk_bf16(gelu_tanh(a[0]), gelu_tanh(a[1])); w.y = cvt_pk_bf16(gelu_tanh(a[2]), gelu_tanh(a[3])); w.z = cvt_pk_bf16(gelu_tanh(b[0]), gelu_tanh(b[1])); w.w = cvt_pk_bf16(gelu_tanh(b[2]), gelu_tanh(b[3]));
                    *(v4u*)(AGLU + ((size_t)(b_ * SEQ + chunk * 16 + t)) * SW + 16 * g + c0) = w;
                }
            }
    }
};
__device__ __forceinline__ void s5_scan_bg(Frame& F, int bg, int tid) {
    const bf16* E = (const bf16*)(F.ws + WS_S5E); bf16* ZH = (bf16*)(F.ws + WS_S5ZH);
    LAS bf16* EL = (LAS bf16*)F.lds;
    { v4u ev[17];
      static_assert(S5_ROWS * 32 == 17 * NWAVES * 64, "E block pieces");
#pragma unroll
      for (int k = 0; k < 17; ++k) ev[k] = *(const v4u*)(E + (size_t)bg * S5_ROWS * 256 + (size_t)(tid + k * NWAVES * 64) * 8);
#pragma unroll
      for (int k = 0; k < 17; ++k) *(LAS v4u*)(EL + (tid + k * NWAVES * 64) * 8) = ev[k]; }
    __syncthreads();
    if (tid < 128) {
        const int dir = tid >> 6, p = tid & 63, g = bg & 63;
        float ar = ((const float*)(F.ws + WS_TAB + TAB_AR))[(dir * 64 + g) * 64 + p], ai = ((const float*)(F.ws + WS_TAB + TAB_AI))[(dir * 64 + g) * 64 + p];
#pragma unroll
        for (int k = 0; k < 4; ++k) { const float nr = ar * ar - ai * ai, ni = 2.f * ar * ai; ar = nr; ai = ni; }
        LAS bf16* col = EL + dir * 128 + p;
        float hr = 0.f, hi = 0.f;
        for (int k0 = 0; k0 < S5_ROWS; k0 += 16) {
            float er[16], ei[16], orr[16], oi[16];
#pragma unroll
            for (int j = 0; j < 16; ++j) { const int k = k0 + j, row = dir ? (S5_ROWS - 1 - k) : (k < 16 ? 256 + k : k - 16); er[j] = bflo((unsigned)col[row * 256]); ei[j] = bflo((unsigned)col[row * 256 + 64]); }
#pragma unroll
            for (int j = 0; j < 16; ++j) { orr[j] = hr; oi[j] = hi; const float nr = ar * hr - ai * hi + er[j], ni = ar * hi + ai * hr + ei[j]; hr = nr; hi = ni; }
#pragma unroll
            for (int j = 0; j < 16; ++j) { const int k = k0 + j, row = dir ? (S5_ROWS - 1 - k) : (k < 16 ? 256 + k : k - 16); col[row * 256] = (bf16)f2bf(orr[j]); col[row * 256 + 64] = (bf16)f2bf(oi[j]); }
        }
    }
    __syncthreads();
#pragma unroll
    for (int k = 0; k < 16; ++k) { const int i = tid + k * NWAVES * 64; *(v4u*)(ZH + (size_t)bg * 256 * 256 + (size_t)i * 8) = *(const LAS v4u*)(EL + i * 8); }
    __syncthreads();
}

constexpr int RS_PITCH = 136;
constexpr int RS_BUF = (128 + 32) * RS_PITCH * 2;
__device__ __forceinline__ void phase_rstate(Frame& F) {
    const bf16* KNL = (const bf16*)(F.ws + WS_K); const bf16* KNC = (const bf16*)(F.ws + WS_KFTC);
    const bf16* VT = (const bf16*)(F.ws + WS_VT); const bf16* VTC = (const bf16*)(F.ws + WS_VTC);
    bf16* SIN = (bf16*)(F.ws + WS_OBUF);
    const float* lg2 = (const float*)(F.ws + WS_TAB + TAB_LG2);
    const int lane0 = lane_id();
    const int w = F.wave;
    for (int unit = F.vcu; unit < NB * NH * 2 * 8; unit += F.G) {
        int lane = lane0; asm volatile("" : "+v"(lane));
        const int tid = w * 64 + lane, fr = lane & 15, fq = lane >> 4;
        const int sl = unit & 7, dir = (unit >> 3) & 1, h = (unit >> 4) & 7, b = unit >> 7;
        const float gC = __builtin_amdgcn_exp2f((float)CH * lg2[dir * 8 + h]);
        const int bh = b * NH + h;
        const bf16* kT = KNL; const bf16* kTc = KNC;
        const int prow = tid >> 4, pc = tid & 15;
        float kw[4];
#pragma unroll
        for (int i_ = 0; i_ < 4; ++i_) { const int j = prow + 32 * i_; kw[i_] = __builtin_amdgcn_exp2f((float)(dir ? j : CH - 1 - j) * lg2[dir * 8 + h]); }
        f32x4 st[2] = {{0.f, 0.f, 0.f, 0.f}, {0.f, 0.f, 0.f, 0.f}};
#define RS_ISSUE(k, R) do { if ((k) < 34) { const bf16* kb_; const bf16* vb_; int ls_; \
            if ((k) < 2) { const int cc_ = dir ? (1 - (k)) : (k); ls_ = LC; kb_ = kTc + (size_t)(b * LC + cc_ * CH) * 1024 + h * DK; vb_ = VTC + (size_t)(bh * DV + 32 * sl) * LC + cc_ * CH; } \
            else { const int n_ = dir ? (33 - (k)) : ((k) - 2); ls_ = SEQ; kb_ = kT + (size_t)(b * SEQ + n_ * CH) * 1024 + h * DK; vb_ = VT + (size_t)(bh * DV + 32 * sl) * SEQ + n_ * CH; } \
            _Pragma("unroll") for (int i_ = 0; i_ < 4; ++i_) R[i_] = *(const v4u*)(kb_ + (size_t)(prow + 32 * i_) * 1024 + pc * 8);     \
            R[4] = *(const v4u*)(vb_ + (size_t)prow * ls_ + pc * 8); } } while (0)
#define RS_STEP(k, R) do { LAS bf16* buf_ = (LAS bf16*)(F.lds + ((k) & 1) * RS_BUF); \
            _Pragma("unroll") for (int i_ = 0; i_ < 4; ++i_) { const v4u r_ = R[i_]; const float w_ = kw[i_]; v4u s_; \
                s_.x = cvt_pk_bf16(bflo(r_.x) * w_, bfhi(r_.x) * w_); s_.y = cvt_pk_bf16(bflo(r_.y) * w_, bfhi(r_.y) * w_); s_.z = cvt_pk_bf16(bflo(r_.z) * w_, bfhi(r_.z) * w_); s_.w = cvt_pk_bf16(bflo(r_.w) * w_, bfhi(r_.w) * w_); \
                *(LAS v4u*)(buf_ + (prow + 32 * i_) * RS_PITCH + pc * 8) = s_; } \
            *(LAS v4u*)(buf_ + (128 + prow) * RS_PITCH + pc * 8) = R[4]; } while (0)
#define RS_COMP(k) do { const LAS bf16* buf_ = (const LAS bf16*)(F.lds + ((k) & 1) * RS_BUF); \
            const int n_ = (k) < 2 ? -1 : (dir ? (33 - (k)) : ((k) - 2)); \
            if (n_ >= 0) { _Pragma("unroll") for (int et = 0; et < 2; ++et) { v2u o; o.x = cvt_pk_bf16(st[et][0], st[et][1]); o.y = cvt_pk_bf16(st[et][2], st[et][3]); \
                *(v2u*)(SIN + ((((size_t)(bh * 2 + dir) * NCH + n_) * DV + 32 * sl + 16 * et + fr) * DK + 16 * w + 4 * fq)) = o; } } \
            bf16x8 kf_[4];                         \
            { const unsigned ta_ = (unsigned)(size_t)buf_ + (unsigned)((8 * fq + (fr >> 2)) * (RS_PITCH * 2) + (16 * w + 4 * (fr & 3)) * 2); v2u t0_, t1_, t2_, t3_, t4_, t5_, t6_, t7_; \
              asm volatile("ds_read_b64_tr_b16 %0, %8\n\tds_read_b64_tr_b16 %1, %8 offset:1088\n\tds_read_b64_tr_b16 %2, %8 offset:8704\n\tds_read_b64_tr_b16 %3, %8 offset:9792\n\t" \
                           "ds_read_b64_tr_b16 %4, %8 offset:17408\n\tds_read_b64_tr_b16 %5, %8 offset:18496\n\tds_read_b64_tr_b16 %6, %8 offset:26112\n\tds_read_b64_tr_b16 %7, %8 offset:27200\n\ts_waitcnt lgkmcnt(0)" \
                           : "=&v"(t0_), "=&v"(t1_), "=&v"(t2_), "=&v"(t3_), "=&v"(t4_), "=&v"(t5_), "=&v"(t6_), "=&v"(t7_) : "v"(ta_) : "memory"); \
              kf_[0] = __builtin_bit_cast(bf16x8, (v4u){t0_.x, t0_.y, t1_.x, t1_.y}); kf_[1] = __builtin_bit_cast(bf16x8, (v4u){t2_.x, t2_.y, t3_.x, t3_.y}); \
              kf_[2] = __builtin_bit_cast(bf16x8, (v4u){t4_.x, t4_.y, t5_.x, t5_.y}); kf_[3] = __builtin_bit_cast(bf16x8, (v4u){t6_.x, t6_.y, t7_.x, t7_.y}); } \
            _Pragma("unroll") for (int et = 0; et < 2; ++et) { f32x4 kv = {0.f, 0.f, 0.f, 0.f}; \
                _Pragma("unroll") for (int ks = 0; ks < 4; ++ks) { const bf16x8 vf_ = *(const LAS bf16x8*)(buf_ + (128 + 16 * et + fr) * RS_PITCH + 32 * ks + 8 * fq); kv = __builtin_amdgcn_mfma_f32_16x16x32_bf16(kf_[ks], vf_, kv, 0, 0, 0); } \
                st[et] = st[et] * gC + kv; } } while (0)
        v4u RA[5], RB[5], RC[5];
        RS_ISSUE(0, RA); RS_ISSUE(1, RB);
        for (int k = 0; k < 34; k += 3) {
            RS_ISSUE(k + 2, RC);
            RS_STEP(k, RA); __syncthreads(); RS_COMP(k);
            RS_ISSUE(k + 3, RA);
            if (k + 1 < 34) { RS_STEP(k + 1, RB); __syncthreads(); RS_COMP(k + 1); }
            RS_ISSUE(k + 4, RB);
            if (k + 2 < 34) { RS_STEP(k + 2, RC); __syncthreads(); RS_COMP(k + 2); }
        }
        __syncthreads();
#undef RS_ISSUE
#undef RS_STEP
#undef RS_COMP
    }
}

constexpr int RO_PITCH = 136;
constexpr int RO_SLOT = 256 * RO_PITCH * 2;
__device__ __forceinline__ void phase_rout(Frame& F, const int cid) {
    const bf16* Q = (const bf16*)(F.ws + WS_Q);
    const bf16* KN = (const bf16*)(F.ws + WS_K); const bf16* VT = (const bf16*)(F.ws + WS_VT);
    const bf16* SIN = (const bf16*)(F.ws + WS_OBUF);
    bf16* SG = (bf16*)(F.ws + WS_HBUF);
    const float* lg2 = (const float*)(F.ws + WS_TAB + TAB_LG2);
    LAS bf16* SA = (LAS bf16*)F.lds; LAS bf16* SB = (LAS bf16*)(F.lds + RO_SLOT);
    const int lane0 = lane_id();
    const int w = F.wave;
    const bool split13 = (F.G == 256);
    const int ufirst = split13 ? (cid < 128 ? cid : 128 + (cid - 128) * 3) : F.vcu, ucount = split13 ? (cid < 128 ? 1 : 3) : (NB * NH * NCH - 1 - F.vcu) / F.G + 1, ustep = split13 ? 1 : F.G;
    for (int ui = 0; ui < ucount; ++ui) {
        const int unit = ufirst + ui * ustep;
        int lane = lane0; asm volatile("" : "+v"(lane));
        const int tid = w * 64 + lane, fr = lane & 15, fq = lane >> 4;
        const int n = unit & 31, h = (unit >> 5) & 7, b = unit >> 8, bh = b * NH + h;
        const float lgf = lg2[h], lgb = lg2[8 + h];
        const int tok0 = b * SEQ + n * CH;
        const int i = 16 * w + fr;
        const size_t qoff = (size_t)(tok0 + i) * 1024 + h * DK;
        {
            v4u kr[4], vr[8];
#pragma unroll
            for (int it = 0; it < 4; ++it) { const int q = tid + 512 * it, j = q >> 4, pc = q & 15; kr[it] = __builtin_nontemporal_load((const v4u*)(KN + (size_t)(tok0 + j) * 1024 + h * DK + pc * 8)); }
#pragma unroll
            for (int it = 0; it < 8; ++it) { const int q = tid + 512 * it, e = q >> 4, pc = q & 15; vr[it] = __builtin_nontemporal_load((const v4u*)(VT + ((size_t)(bh * DV + e)) * SEQ + n * CH + pc * 8)); }
#pragma unroll
            for (int it = 0; it < 4; ++it) { const int q = tid + 512 * it, j = q >> 4, pc = q & 15; *(LAS v4u*)(SB + j * RO_PITCH + pc * 8) = kr[it]; }
#pragma unroll
            for (int it = 0; it < 8; ++it) { const int q = tid + 512 * it, e = q >> 4, pc = q & 15; *(LAS v4u*)(SA + e * RO_PITCH + pc * 8) = vr[it]; }
        }
        bf16x8 qf[4];
#pragma unroll
        for (int ks = 0; ks < 4; ++ks) qf[ks] = *(const bf16x8*)(Q + qoff + 32 * ks + 8 * fq);
        __syncthreads();
        f32x4 sc[8];
#pragma unroll
        for (int jt = 0; jt < 8; ++jt) {
            f32x4 a = {0.f, 0.f, 0.f, 0.f};
#pragma unroll
            for (int ks = 0; ks < 4; ++ks) { const bf16x8 kf = *(const LAS bf16x8*)(SB + (16 * jt + fr) * RO_PITCH + 32 * ks + 8 * fq); a = __builtin_amdgcn_mfma_f32_16x16x32_bf16(kf, qf[ks], a, 0, 0, 0); }
#pragma unroll
            for (int r = 0; r < 4; ++r) { const int j = 16 * jt + 4 * fq + r, df = i - j; a[r] *= df >= 0 ? __builtin_amdgcn_exp2f((float)df * lgf) : __builtin_amdgcn_exp2f((float)(-df) * lgb); }
            sc[jt] = a;
        }
        f32x4 o[16];
#pragma unroll
        for (int et = 0; et < 16; ++et) o[et] = (f32x4){0.f, 0.f, 0.f, 0.f};
#pragma unroll
        for (int ks = 0; ks < 4; ++ks) {
            v4u pw; pw.x = cvt_pk_bf16(sc[2 * ks][0], sc[2 * ks][1]); pw.y = cvt_pk_bf16(sc[2 * ks][2], sc[2 * ks][3]); pw.z = cvt_pk_bf16(sc[2 * ks + 1][0], sc[2 * ks + 1][1]); pw.w = cvt_pk_bf16(sc[2 * ks + 1][2], sc[2 * ks + 1][3]);
            const bf16x8 pf = __builtin_bit_cast(bf16x8, pw);
#pragma unroll
            for (int et = 0; et < 16; ++et) {
                const LAS bf16* vp = SA + (16 * et + fr) * RO_PITCH + 32 * ks + 4 * fq;
                const v2u lo = *(const LAS v2u*)vp, hi2 = *(const LAS v2u*)(vp + 16);
                v4u vw; vw.x = lo.x; vw.y = lo.y; vw.z = hi2.x; vw.w = hi2.y;
                o[et] = __builtin_amdgcn_mfma_f32_16x16x32_bf16(__builtin_bit_cast(bf16x8, vw), pf, o[et], 0, 0, 0);
            }
        }
        __syncthreads();
        {
            const bf16* sf = SIN + (((size_t)(bh * 2 + 0) * NCH + n) * DV) * DK; const bf16* sb = SIN + (((size_t)(bh * 2 + 1) * NCH + n) * DV) * DK;
            v4u fr_[8], br_[8];
#pragma unroll
            for (int it = 0; it < 8; ++it) { const int q = tid + 512 * it; fr_[it] = __builtin_nontemporal_load((const v4u*)(sf + (size_t)q * 8)); br_[it] = __builtin_nontemporal_load((const v4u*)(sb + (size_t)q * 8)); }
#pragma unroll
            for (int it = 0; it < 8; ++it) { const int q = tid + 512 * it, e = q >> 4, pc = q & 15; *(LAS v4u*)(SA + e * RO_PITCH + pc * 8) = fr_[it]; *(LAS v4u*)(SB + e * RO_PITCH + pc * 8) = br_[it]; }
        }
        bf16x8 qff[4], qbf[4];
        { const float wfq = __builtin_amdgcn_exp2f((float)(i + 1) * lgf), wbq = __builtin_amdgcn_exp2f((float)(CH - i) * lgb);
#pragma unroll
          for (int ks = 0; ks < 4; ++ks) { const v4u qw = __builtin_bit_cast(v4u, qf[ks]); v4u a, b2;
            a.x = cvt_pk_bf16(bflo(qw.x) * wfq, bfhi(qw.x) * wfq); a.y = cvt_pk_bf16(bflo(qw.y) * wfq, bfhi(qw.y) * wfq); a.z = cvt_pk_bf16(bflo(qw.z) * wfq, bfhi(qw.z) * wfq); a.w = cvt_pk_bf16(bflo(qw.w) * wfq, bfhi(qw.w) * wfq);
            b2.x = cvt_pk_bf16(bflo(qw.x) * wbq, bfhi(qw.x) * wbq); b2.y = cvt_pk_bf16(bflo(qw.y) * wbq, bfhi(qw.y) * wbq); b2.z = cvt_pk_bf16(bflo(qw.z) * wbq, bfhi(qw.z) * wbq); b2.w = cvt_pk_bf16(bflo(qw.w) * wbq, bfhi(qw.w) * wbq);
            qff[ks] = __builtin_bit_cast(bf16x8, a); qbf[ks] = __builtin_bit_cast(bf16x8, b2); } }
        __syncthreads();
#pragma unroll
        for (int ks = 0; ks < 4; ++ks)
#pragma unroll
            for (int et = 0; et < 16; ++et) {
                const bf16x8 s1 = *(const LAS bf16x8*)(SA + (16 * et + fr) * RO_PITCH + 32 * ks + 8 * fq), s2 = *(const LAS bf16x8*)(SB + (16 * et + fr) * RO_PITCH + 32 * ks + 8 * fq);
                o[et] = __builtin_amdgcn_mfma_f32_16x16x32_bf16(s1, qff[ks], o[et], 0, 0, 0);
                o[et] = __builtin_amdgcn_mfma_f32_16x16x32_bf16(s2, qbf[ks], o[et], 0, 0, 0);
            }
        float ss = 0.f;
#pragma unroll
        for (int et = 0; et < 16; ++et) ss += (o[et][0] * o[et][0] + o[et][1] * o[et][1]) + (o[et][2] * o[et][2] + o[et][3] * o[et][3]);
        ss += shfl_xor_l(ss, 16, lane); ss += shfl_xor_l(ss, 32, lane);
        const float rinv = 1.0f / sqrtf(ss * (1.0f / DV) + EPS);
        bf16* gp = SG + (size_t)(tok0 + i) * D + h * DV + 4 * fq;
#pragma unroll
        for (int et = 0; et < 16; ++et) { const v2u gg = __builtin_nontemporal_load((const v2u*)(gp + 16 * et));
            v2u ow; ow.x = cvt_pk_bf16(o[et][0] * rinv * bflo(gg.x), o[et][1] * rinv * bfhi(gg.x)); ow.y = cvt_pk_bf16(o[et][2] * rinv * bflo(gg.y), o[et][3] * rinv * bfhi(gg.y));
            *(v2u*)(gp + 16 * et) = ow; }
        __syncthreads();
    }
}

__global__ void __launch_bounds__(NWAVES * 64, 2) fwd_megakernel(Args args) {
    extern __shared__ __attribute__((aligned(16))) unsigned char lds[];
    Frame F;
    F.lds = (LAS unsigned char*)lds;
    F.MISC = (volatile LAS unsigned*)(F.lds + MISC_OFF);
    F.wave = __builtin_amdgcn_readfirstlane((int)threadIdx.x >> 6);
    F.G = gridDim.x; { const int bx = blockIdx.x; F.vcu = (F.G % 8 == 0) ? (bx % 8) * (F.G / 8) + bx / 8 : bx; }
    F.out = kargs()->out; F.ws = kargs()->ws; F.ctl = (unsigned*)(F.ws + WS_CTL);
    for (int u = (int)threadIdx.x; u < (LDS_BYTES - LDSCTL_OFF) / 4; u += NWAVES * 64) ((LAS unsigned*)(F.lds + LDSCTL_OFF))[u] = 0u;
    __syncthreads();
    XcdBarrier bar = xcd_barrier_post(F.ctl + CW_BAR, F.MISC + 8);
    unsigned char* ws = F.ws;
    const int G = F.G, cid = (int)blockIdx.x;
#define GRID_BAR() xcd_barrier(bar)

#ifndef PHM
#define PHM 0xFFFFF
#endif
#define PH(k) ((PHM >> (k)) & 1)
#ifndef REPM
#define REPM 0
#endif
#define NREP(k) (1 + ((REPM >> (k)) & 1))
#if PH(0)
    phase_prologue(F, args, true);
#if NREP(0) > 1
    phase_prologue(F, args, false);
#endif
#endif
    GRID_BAR();
#if PH(1)
    phase_rows<0>(F, args);
    s5_tables1(F, args);
#endif
    GRID_BAR();
#if PH(2)
    {
        pg8::GridOrder S; S.init(ws + WS_ABUF, ws + WS_W1T, D, MT / 256, NFF / 256, G, cid);
        EpiSwiGLU E{(bf16*)(ws + WS_HBUF)};
        pg8::gemm_phase(F.lds, D, S, E, F.wave);
    }
    if (G == 256 && cid >= 256 - CV_G1_CUS) conv_range(F, 1, 0, CV_L1_G1, (cid - (256 - CV_G1_CUS)) * NWAVES + F.wave, CV_G1_CUS * NWAVES);
#if NREP(2) > 1
    {
        pg8::GridOrder S; S.init(ws + WS_ABUF, ws + WS_W1T, D, MT / 256, NFF / 256, G, cid);
        EpiSwiGLU E{(bf16*)(ws + WS_HBUF)};
        pg8::gemm_phase(F.lds, D, S, E, F.wave);
    }
#endif
#endif
    GRID_BAR();
#if PH(3)
    {
        Ffn1DownOrder S{(const char*)(ws + WS_HBUF), (const char*)(ws + WS_W2T), G, cid};
        EpiFfn1Down E{(bf16*)(ws + WS_OBUF), (float*)(ws + WS_SLAB)};
        pg8::gemm_phase(F.lds, DFF, S, E, F.wave);
    }
    if (G == 256 && cid >= 256 - CV_G2_CUS) conv_range(F, 1, CV_L1_G1, CV_L1_G1 + CV_L1_G2, (cid - (256 - CV_G2_CUS)) * NWAVES + F.wave, CV_G2_CUS * NWAVES);
#if NREP(3) > 1
    {
        pg8::GridOrder S; S.init(ws + WS_HBUF, ws + WS_W2T, DFF, MT / 256, D / 256, G, cid);
        EpiO16 E{(bf16*)(ws + WS_OBUF), D};
        pg8::gemm_phase(F.lds, DFF, S, E, F.wave);
    }
#endif
#endif
    GRID_BAR();
#if PH(4)
    phase_rows<1>(F, args);
    s5_tables2(F, args);
#endif
    GRID_BAR();
#if PH(5)
    {
        MixOrder S{(const char*)(ws + WS_ABUF), (const char*)(ws + WS_WMT), G, cid};
        EpiMix E{ws};
        pg8::gemm_phase(F.lds, D, S, E, F.wave);
    }
    if (G == 256 && cid >= 256 - CV_G3_CUS) conv_range(F, 2, 0, CV_L2_G3, (cid - (256 - CV_G3_CUS)) * NWAVES + F.wave, CV_G3_CUS * NWAVES);
#if NREP(5) > 1
    {
        MixOrder S{(const char*)(ws + WS_ABUF), (const char*)(ws + WS_WMT), G, cid};
        EpiMix E{ws};
        pg8::gemm_phase(F.lds, D, S, E, F.wave);
    }
#endif
#endif
    GRID_BAR();
#if PH(6)
    phase_rstate(F);
#if NREP(6) > 1
    phase_rstate(F);
#endif
#endif
#if PH(7)
    {
        S5EOrder S{(const char*)(ws + WS_US), (const char*)(ws + WS_S5WE), G, cid};
        EpiS5E E{(bf16*)(ws + WS_S5E)};
        pg8::gemm_phase(F.lds, 256, S, E, F.wave);
    }
#endif
    GRID_BAR();
#if PH(8)
    {
        int tid_ = F.wave * 64 + lane_id(); asm volatile("" : "+v"(tid_));
        for (int bg = cid; bg < NB * 64; bg += G) s5_scan_bg(F, bg, tid_);
        asm volatile("s_waitcnt vmcnt(0)" ::: "memory"); __syncthreads();
        S5YOrder S{(const char*)(ws + WS_US), (const char*)(ws + WS_S5ZH), (const char*)(ws + WS_S5WY1), (const char*)(ws + WS_S5WY2), G, cid};
        EpiS5Y E{(bf16*)(ws + WS_AGLU)};
        pg8::gemm_phase(F.lds, 256, S, E, F.wave);
    }
    phase_rout(F, cid);
#endif
    GRID_BAR();
#if PH(9)
    {
        pg8::GridOrder S; S.init(ws + WS_AGLU, ws + WS_WGT, SW, MX / 256, 2 * D / 256, G, cid);
        EpiGLU E{(const bf16*)(ws + WS_HBUF + 32 * MiB), (bf16*)(ws + WS_Q)};
        pg8::gemm_phase(F.lds, SW, S, E, F.wave);
    }
#if NREP(9) > 1
    {
        pg8::GridOrder S; S.init(ws + WS_AGLU, ws + WS_WGT, SW, MX / 256, 2 * D / 256, G, cid);
        EpiGLU E{(const bf16*)(ws + WS_HBUF + 32 * MiB), (bf16*)(ws + WS_Q)};
        pg8::gemm_phase(F.lds, SW, S, E, F.wave);
    }
#endif
#endif
    GRID_BAR();
#if PH(10)
    {
        pg8::GridOrder S; S.init(ws + WS_HBUF, ws + WS_WPT, D, MX / 256, D / 256, G, cid);
        EpiMerge E{(const bf16*)(ws + WS_HBUF + 64 * MiB), (bf16*)(ws + WS_Q)};
        pg8::gemm_phase(F.lds, D, S, E, F.wave);
    }
#if NREP(10) > 1
    {
        pg8::GridOrder S; S.init(ws + WS_HBUF, ws + WS_WPT, D, MX / 256, D / 256, G, cid);
        EpiMerge E{(const bf16*)(ws + WS_HBUF + 64 * MiB), (bf16*)(ws + WS_Q)};
        pg8::gemm_phase(F.lds, D, S, E, F.wave);
    }
#endif
#endif
    GRID_BAR();
#if PH(11)
    {
        pg8::GridOrder S; S.init(ws + WS_Q, ws + WS_WOT, D, MX / 256, D / 256, G, cid);
        EpiO16 E{(bf16*)(ws + WS_OBUF), D};
        pg8::gemm_phase(F.lds, D, S, E, F.wave);
    }
#if NREP(11) > 1
    {
        pg8::GridOrder S; S.init(ws + WS_Q, ws + WS_WOT, D, MX / 256, D / 256, G, cid);
        EpiO16 E{(bf16*)(ws + WS_OBUF), D};
        pg8::gemm_phase(F.lds, D, S, E, F.wave);
    }
#endif
#endif
    GRID_BAR();
#if PH(12)
    phase_rows<2>(F, args);
#if NREP(12) > 1
    phase_rows<2>(F, args);
#endif
#endif
    GRID_BAR();
#if PH(13)
    {
        pg8::GridOrder S; S.init(ws + WS_ABUF, ws + WS_W3T, D, MX / 256, NFF / 256, G, cid);
        EpiSwiGLU E{(bf16*)(ws + WS_HBUF)};
        pg8::gemm_phase(F.lds, D, S, E, F.wave);
    }
#if NREP(13) > 1
    {
        pg8::GridOrder S; S.init(ws + WS_ABUF, ws + WS_W3T, D, MX / 256, NFF / 256, G, cid);
        EpiSwiGLU E{(bf16*)(ws + WS_HBUF)};
        pg8::gemm_phase(F.lds, D, S, E, F.wave);
    }
#endif
#endif
    GRID_BAR();
#if PH(14)
    {
        pg8::GridOrder S; S.init(ws + WS_HBUF, ws + WS_W4T, DFF, MX / 256, D / 256, G, cid);
        EpiO16 E{(bf16*)(ws + WS_OBUF), D};
        pg8::gemm_phase(F.lds, DFF, S, E, F.wave);
    }
#if NREP(14) > 1
    {
        pg8::GridOrder S; S.init(ws + WS_HBUF, ws + WS_W4T, DFF, MX / 256, D / 256, G, cid);
        EpiO16 E{(bf16*)(ws + WS_OBUF), D};
        pg8::gemm_phase(F.lds, DFF, S, E, F.wave);
    }
#endif
#endif
    GRID_BAR();
#if PH(15)
    phase_rows<3>(F, args);
#if NREP(15) > 1
    phase_rows<3>(F, args);
#endif
#endif
}

extern "C" void kernel_launch(void* const* d_in, const int* in_sizes, int n_in, void* d_out, int out_size, void* d_ws, size_t ws_size, hipStream_t stream) {
    static int grid = 0;
    if (grid == 0) {
        if (n_in != 22 || in_sizes[0] != MX * D || out_size != MX * D || ws_size < WS_END) { fprintf(stderr, "kernel_launch: unexpected problem (n_in %d, in0 %d, out %d, ws %zu, need %zu)\n", n_in, n_in > 0 ? in_sizes[0] : -1, out_size, ws_size, (size_t)WS_END); grid = -1; return; }
        int dev = 0, cus = 0, per_cu = 0;
        if (hipGetDevice(&dev) != hipSuccess || hipDeviceGetAttribute(&cus, hipDeviceAttributeMultiprocessorCount, dev) != hipSuccess) { grid = -1; return; }
        if (hipFuncSetAttribute((const void*)fwd_megakernel, hipFuncAttributeMaxDynamicSharedMemorySize, LDS_BYTES) != hipSuccess) { fprintf(stderr, "kernel_launch: hipFuncSetAttribute failed\n"); grid = -1; return; }
        if (hipOccupancyMaxActiveBlocksPerMultiprocessor(&per_cu, (const void*)fwd_megakernel, NWAVES * 64, LDS_BYTES) != hipSuccess || per_cu < 1) { fprintf(stderr, "kernel_launch: occupancy query says %d blocks per CU\n", per_cu); grid = -1; (void)hipGetLastError(); return; }
        grid = cus;
    }
    if (grid < 0) return;
    if (hipMemsetAsync((char*)d_ws + WS_CTL, 0, CTL_ZERO_BYTES, stream) != hipSuccess) return;
    Args a{};
    for (int i = 0; i < 22; ++i) a.in[i] = (const float*)d_in[i];
    a.out = (float*)d_out; a.ws = (unsigned char*)d_ws;
    void* kargs[] = {&a};
    hipError_t e = hipLaunchCooperativeKernel((const void*)fwd_megakernel, dim3(grid), dim3(NWAVES * 64), kargs, LDS_BYTES, stream);
    if (e != hipSuccess) fprintf(stderr, "kernel_launch: cooperative launch failed: %s (grid %d)\n", hipGetErrorString(e), grid);
}
```

```cpp
#include <hip/hip_runtime.h>
#include <cstdio>
#include <cstdint>

#define GAS __attribute__((address_space(1)))
#define LAS __attribute__((address_space(3)))
typedef unsigned short bf16;
typedef unsigned v4u __attribute__((ext_vector_type(4)));
typedef unsigned v2u __attribute__((ext_vector_type(2)));
typedef float f32x4 __attribute__((ext_vector_type(4)));
typedef float f32x2 __attribute__((ext_vector_type(2)));
typedef short bf16x8 __attribute__((ext_vector_type(8)));
typedef short bf16x4 __attribute__((ext_vector_type(4)));

constexpr int D = 2048, NB = 2, SEQ = 4096, MX = NB * SEQ, LC = 256, MC = NB * LC, MT = MX + MC;
constexpr int DFF = 5632, NFF = 2 * DFF, SW = 1024, NMIX = 11264, NH = 8, DK = 128, DV = 256, CH = 128, NCH = SEQ / CH;
constexpr int NADA = 9 * D;
constexpr float EPS = 1e-6f;
constexpr int NWAVES = 8;

constexpr size_t MiB = 1u << 20;
constexpr size_t WS_CTL = 0, CTL_ZERO_BYTES = 1 * MiB;
constexpr size_t WS_W1T = 1 * MiB, WS_W2T = 45 * MiB, WS_WMT = 67 * MiB, WS_WGT = 115 * MiB, WS_WPT = 123 * MiB, WS_WOT = 131 * MiB, WS_W3T = 139 * MiB, WS_W4T = 183 * MiB;
constexpr size_t WS_ABUF = 205 * MiB;
constexpr size_t WS_HBUF = 239 * MiB;
constexpr size_t WS_OBUF = 335 * MiB;
constexpr size_t WS_US = 403 * MiB;
constexpr size_t WS_Q = 420 * MiB, WS_QF = 436 * MiB, WS_QB = 452 * MiB;
constexpr size_t WS_K = 468 * MiB;
constexpr size_t WS_KFT = 484 * MiB, WS_KBT = 500 * MiB, WS_KFTC = 516 * MiB, WS_KBTC = 517 * MiB;
constexpr size_t WS_STREAM = WS_KFT;
constexpr size_t WS_VT = 518 * MiB, WS_VTC = 550 * MiB;
constexpr size_t WS_YF = 552 * MiB;
constexpr size_t WS_S5WE = WS_YF, WS_S5WY1 = WS_YF + 8 * MiB, WS_S5WY2 = WS_YF + 16 * MiB, WS_S5KT = WS_YF + 24 * MiB, WS_S5BRF = WS_YF + 26 * MiB, WS_S5APOW = WS_YF + 28 * MiB;
constexpr size_t WS_S5E = WS_ABUF, WS_S5ZH = WS_ABUF + 17 * MiB;
constexpr int S5_ROWS = 272;
constexpr size_t WS_AGLU = 584 * MiB;
constexpr size_t WS_TAB = 600 * MiB;
constexpr size_t WS_END = 602 * MiB;
constexpr size_t TAB_ROPE = 0, TAB_LG2 = 16384, TAB_AR = 32768, TAB_AI = 65536, TAB_END = 131072;
constexpr size_t TAB_MODV = 262144;
constexpr int CW_BAR = 4096;
constexpr size_t CTL_ADA = 65536;

#define RLX_AGENT __ATOMIC_RELAXED, __HIP_MEMORY_SCOPE_AGENT
#define LDS_WAIT() asm volatile("s_waitcnt lgkmcnt(0)" ::: "memory")
#define VM_WAIT() asm volatile("s_waitcnt vmcnt(0)" ::: "memory")

__device__ __forceinline__ unsigned f2bf(float f) { unsigned u = __builtin_bit_cast(unsigned, f); return (u + 0x7fffu + ((u >> 16) & 1u)) >> 16; }
__device__ __forceinline__ unsigned pk2(float lo, float hi) { return f2bf(lo) | (f2bf(hi) << 16); }
__device__ __forceinline__ unsigned cvt_pk_bf16(float lo, float hi) { unsigned r; asm volatile("v_cvt_pk_bf16_f32 %0, %1, %2" : "=v"(r) : "v"(lo), "v"(hi)); return r; }
__device__ __forceinline__ float bflo(unsigned w) { return __builtin_bit_cast(float, w << 16); }
__device__ __forceinline__ float bfhi(unsigned w) { return __builtin_bit_cast(float, w & 0xffff0000u); }
__device__ __forceinline__ float fast_sigmoid(float x) { return __builtin_amdgcn_rcpf(1.0f + __builtin_amdgcn_exp2f(-1.4426950408889634f * x)); }
__device__ __forceinline__ float fast_silu(float x) { return x * fast_sigmoid(x); }
__device__ __forceinline__ float gelu_tanh(float x) { const float u = 0.7978845608028654f * (x + 0.044715f * x * x * x); return x * fast_sigmoid(2.0f * u); }
__device__ __forceinline__ int lane_id() { return (int)__builtin_amdgcn_mbcnt_hi(~0u, __builtin_amdgcn_mbcnt_lo(~0u, 0u)); }
__device__ __forceinline__ float shfl_xor_l(float v, int mask, int lane) { return __builtin_bit_cast(float, __builtin_amdgcn_ds_bpermute((lane ^ mask) << 2, __builtin_bit_cast(int, v))); }
__device__ __forceinline__ float wave_sum(float v, int lane) {
#pragma unroll
    for (int o = 1; o < 64; o <<= 1) v += shfl_xor_l(v, o, lane);
    return v;
}

#define XB_TMO      128
#define XB_XCNT(j)  (256  + 64 * (j))
#define XB_XSUB(j)  (1280 + 64 * (j))
#define XB_XGEN(j)  (2304 + 64 * (j))
#define XB_TOP      3328
#define XB_TOPGEN   3392
#define XCD_BAR_WORDS 3456
#define XB_SPIN_CAP (1u << 18)
__device__ __forceinline__ unsigned xb_ld(unsigned* p)              { return __hip_atomic_load(p, __ATOMIC_RELAXED, __HIP_MEMORY_SCOPE_AGENT); }
__device__ __forceinline__ unsigned xb_add(unsigned* p, unsigned v) { return __hip_atomic_fetch_add(p, v, __ATOMIC_RELAXED, __HIP_MEMORY_SCOPE_AGENT); }
__device__ __forceinline__ unsigned xb_xcc_id() { return (unsigned)__builtin_amdgcn_s_getreg((3 << 11) | 20) & 0xFu; }
#define XB_SPIN(cond, bar) do { unsigned _sp = 0; while (cond) { __builtin_amdgcn_s_sleep(1); \
    if ((++_sp & 255u) == 0u) { if (xb_ld(&(bar)[XB_TMO])) break; if (_sp > XB_SPIN_CAP) { atomicAdd(&(bar)[XB_TMO], 1u); break; } } } } while (0)
struct XcdBarrier { unsigned* bar; unsigned x; volatile LAS unsigned* st; };
__device__ __forceinline__ XcdBarrier xcd_barrier_post(unsigned* bar, volatile LAS unsigned* st) {
    XcdBarrier b; b.bar = bar; b.x = xb_xcc_id(); b.st = st;
    if (threadIdx.x == 0) (void)xb_add(&bar[XB_XCNT(b.x)], 1u);
    return b;
}
__device__ __forceinline__ void xcd_barrier_complete(unsigned* bar, unsigned x, unsigned& nloc, unsigned& nx) {
    const unsigned G = gridDim.x * gridDim.y * gridDim.z;
    unsigned sum, cnt, mine, sp = 0u;
    for (;;) {
        sum = 0u; cnt = 0u; mine = 0u;
#pragma unroll
        for (unsigned j = 0; j < 16; ++j) { const unsigned c = xb_ld(&bar[XB_XCNT(j)]); sum += c; cnt += (c > 0u) ? 1u : 0u; mine = (j == x) ? c : mine; }
        if (sum == G) break;
        __builtin_amdgcn_s_sleep(1);
        if ((++sp & 255u) == 0u) { if (xb_ld(&bar[XB_TMO])) break; if (sp > XB_SPIN_CAP) { atomicAdd(&bar[XB_TMO], 1u); break; } }
    }
    nloc = mine > 0u ? mine : 1u; nx = cnt > 0u ? cnt : 1u;
}
__device__ __forceinline__ void xcd_barrier(const XcdBarrier& b) {
    asm volatile("s_waitcnt vmcnt(0)" ::: "memory");
    __syncthreads();
    if (threadIdx.x == 0) {
        unsigned* bar = b.bar;
        __builtin_amdgcn_s_waitcnt(0);
        unsigned nloc = b.st[0], nx = b.st[1];
        if (nloc == 0u) { xcd_barrier_complete(bar, b.x, nloc, nx); b.st[0] = nloc; b.st[1] = nx; }
        const unsigned old = xb_add(&bar[XB_XSUB(b.x)], 1u);
        const unsigned gen = old / nloc;
        if (old + 1u == (gen + 1u) * nloc) {
            __builtin_amdgcn_fence(__ATOMIC_RELEASE, "agent");
            asm volatile("s_waitcnt vmcnt(0)" ::: "memory");
            const unsigned og = xb_add(&bar[XB_TOP], 1u);
            const unsigned tg = og / nx;
            if (og + 1u == (tg + 1u) * nx) xb_add(&bar[XB_TOPGEN], 1u);
            else XB_SPIN(xb_ld(&bar[XB_TOPGEN]) == tg, bar);
            __builtin_amdgcn_fence(__ATOMIC_ACQUIRE, "agent");
            xb_add(&bar[XB_XGEN(b.x)], 1u);
            asm volatile("s_waitcnt vmcnt(0)" ::: "memory");
        } else {
            XB_SPIN(xb_ld(&bar[XB_XGEN(b.x)]) == gen, bar);
            __builtin_amdgcn_fence(__ATOMIC_ACQUIRE, "agent");
            asm volatile("s_waitcnt vmcnt(0)" ::: "memory");
        }
    }
    __syncthreads();
}

namespace pg8 {
constexpr int BM = 256, BK = 64, HALF = 128, HTB = HALF * BK * 2, STAGE_BYTES = 8 * HTB, NXCD = 8;
__device__ __forceinline__ int lds_byte(int r, int c) { const int st = (r >> 4) * 2 + (c >> 5), rr = r & 15, cc = c & 31, ob = rr * 64 + cc * 2; return st * 1024 + (ob ^ (((ob >> 9) & 1) << 5)); }
__device__ __forceinline__ void stage_rc(int b, int& R, int& C) { const int st = b / 1024, sb = b % 1024, swz = sb ^ (((sb >> 9) & 1) << 5); R = (st >> 1) * 16 + swz / 64; C = (st & 1) * 32 + (swz % 64) / 2; }
__device__ __forceinline__ int perm32(int rho) { const int n = rho >> 4, i = rho & 15; return 8 * (i >> 2) + 4 * n + (i & 3); }

struct Unit {
    const char* A; const char* B; unsigned info;
    __device__ __forceinline__ int pm() const { return (int)(info & 255u); }
    __device__ __forceinline__ int pn() const { return (int)((info >> 8) & 255u); }
    __device__ __forceinline__ int kind() const { return (int)((info >> 16) & 15u); }
    __device__ __forceinline__ int nt() const { return (int)((info >> 20) & 255u); }
    __device__ __forceinline__ int cont() const { return (int)((info >> 28) & 1u); }
};
__device__ __forceinline__ Unit make_unit(const char* A, const char* B, int pm, int pn, int kind, int nt, int cont) { return Unit{A, B, (unsigned)pm | ((unsigned)pn << 8) | ((unsigned)kind << 16) | ((unsigned)nt << 20) | ((unsigned)cont << 28)}; }
__device__ __forceinline__ int xcd_remap(int L, int nwg) { const int q = nwg / NXCD, r = nwg % NXCD, xcd = L % NXCD, off = L / NXCD; return (xcd < r ? xcd * (q + 1) : r * (q + 1) + (xcd - r) * q) + off; }

template <class Epi, class Sched>
__device__ __forceinline__ void gemm_phase(LAS unsigned char* lds, const int K, const Sched& S, const Epi& E, const int wave_) {
    int tid = wave_ * 64 + lane_id(); asm volatile("" : "+v"(tid));
    const int wid = wave_, lane = tid & 63, wr = wid >> 2, wc = wid & 3, fr = lane & 15, fq = lane >> 4;
    unsigned voffA[2], voffB[2];
#pragma unroll
    for (int i = 0; i < 2; ++i) { int R, C; stage_rc(tid * 16 + i * 8192, R, C); const int Rb = (R & ~31) + perm32(R & 31);
        voffA[i] = (unsigned)(R * K + C) * 2u; voffB[i] = (unsigned)(Rb * K + C) * 2u; }
    const size_t kstep = (size_t)(BK * 2);
    const size_t hstep = (size_t)HALF * K * 2;
    const unsigned ldsw = (unsigned)wid * 1024u;
    const int aoff = lds_byte(wr * 64 + fr, fq * 8), boff = lds_byte(wc * 32 + fr, fq * 8);
#define PG8_SA(b, h) (((b) * 2 + (h)) * HTB)
#define PG8_SB(b, h) ((4 + (b) * 2 + (h)) * HTB)
#define PG8_STAGE(bufoff, gbase, voff) do { _Pragma("unroll") for (int _i = 0; _i < 2; ++_i) \
        __builtin_amdgcn_global_load_lds((const unsigned*)((const char*)(gbase) + (voff)[_i]), (LAS unsigned*)(lds + (bufoff) + ldsw + _i * 8192), 16, 0, 0); } while (0)
#define PG8_LDA(dst, b, h) do { _Pragma("unroll") for (int m = 0; m < 4; ++m) _Pragma("unroll") for (int k = 0; k < 2; ++k) dst[m][k] = *(const LAS bf16x8*)(lds + PG8_SA(b, h) + aoff + m * 2048 + k * 1024); } while (0)
#define PG8_LDB(dst, b, h) do { _Pragma("unroll") for (int n = 0; n < 2; ++n) _Pragma("unroll") for (int k = 0; k < 2; ++k) dst[n][k] = *(const LAS bf16x8*)(lds + PG8_SB(b, h) + boff + n * 2048 + k * 1024); } while (0)
#define PG8_MMA(ai, bj, At, Bt) do { __builtin_amdgcn_s_setprio(1); _Pragma("unroll") for (int m = 0; m < 4; ++m) _Pragma("unroll") for (int n = 0; n < 2; ++n) _Pragma("unroll") for (int k = 0; k < 2; ++k) \
        acc[ai][bj][m][n] = __builtin_amdgcn_mfma_f32_16x16x32_bf16(Bt[n][k], At[m][k], acc[ai][bj][m][n], 0, 0, 0); __builtin_amdgcn_s_setprio(0); } while (0)
#define PG8_WAIT_V(n) asm volatile("s_waitcnt vmcnt(" #n ")" ::: "memory")
#define PG8_WAIT_L(n) asm volatile("s_waitcnt lgkmcnt(" #n ")" ::: "memory")
#define PG8_BAR __builtin_amdgcn_s_barrier()
#define PG8_SCHED __builtin_amdgcn_sched_barrier(0)
    Unit cur, nxt; int ui = 0;
    if (!S.next(0, cur)) return;
    f32x4 acc[2][2][4][2];
#pragma unroll
    for (int a = 0; a < 2; ++a)
#pragma unroll
        for (int b = 0; b < 2; ++b)
#pragma unroll
            for (int m = 0; m < 4; ++m)
#pragma unroll
                for (int n = 0; n < 2; ++n) acc[a][b][m][n] = (f32x4){0.f, 0.f, 0.f, 0.f};
    bf16x8 At[4][2], B0[2][2], B1[2][2];
    const char* cA = cur.A; const char* cB = cur.B;
    PG8_STAGE(PG8_SB(0, 0), cB, voffB); PG8_STAGE(PG8_SB(0, 1), cB + hstep, voffB); PG8_STAGE(PG8_SA(0, 0), cA, voffA); PG8_STAGE(PG8_SA(0, 1), cA + hstep, voffA);
    if (wr == 1) PG8_BAR;
    PG8_WAIT_V(2); PG8_BAR;
    PG8_STAGE(PG8_SB(1, 0), cB + kstep, voffB); PG8_STAGE(PG8_SA(1, 0), cA + kstep, voffA); PG8_STAGE(PG8_SB(1, 1), cB + hstep + kstep, voffB);
    PG8_WAIT_V(6); PG8_BAR;
    for (;;) {
        const bool has_next = S.next(ui + 1, nxt);
        const char* nA = has_next ? nxt.A : cA; const char* nB = has_next ? nxt.B : cB;
        const int nt = cur.nt();
        for (int t = 0; t < nt; t += 2) {
            const bool last = (t == nt - 2);
            const char* a1 = cA + (size_t)(t + 1) * kstep;
            const char* a2 = last ? nA : cA + (size_t)(t + 2) * kstep; const char* b2 = last ? nB : cB + (size_t)(t + 2) * kstep;
            const char* a3 = a2 + kstep; const char* b3 = b2 + kstep;
            PG8_LDB(B0, 0, 0); PG8_LDB(B1, 0, 1); PG8_SCHED; PG8_LDA(At, 0, 0); PG8_STAGE(PG8_SA(1, 1), a1 + hstep, voffA);
            PG8_WAIT_V(8); PG8_WAIT_L(0); PG8_BAR; PG8_MMA(0, 0, At, B0); PG8_MMA(0, 1, At, B1); PG8_BAR; PG8_SCHED;
            PG8_LDA(At, 0, 1); PG8_STAGE(PG8_SB(0, 0), b2, voffB); PG8_STAGE(PG8_SB(0, 1), b2 + hstep, voffB); PG8_STAGE(PG8_SA(0, 0), a2, voffA);
            PG8_WAIT_V(8); PG8_WAIT_L(0); PG8_BAR; PG8_MMA(1, 0, At, B0); PG8_MMA(1, 1, At, B1); PG8_BAR; PG8_SCHED;
            PG8_LDB(B0, 1, 0); PG8_LDB(B1, 1, 1); PG8_SCHED; PG8_LDA(At, 1, 0); PG8_STAGE(PG8_SA(0, 1), a2 + hstep, voffA);
            PG8_WAIT_V(8); PG8_WAIT_L(0); PG8_BAR; PG8_MMA(0, 0, At, B0); PG8_MMA(0, 1, At, B1); PG8_BAR; PG8_SCHED;
            PG8_LDA(At, 1, 1); PG8_STAGE(PG8_SB(1, 0), b3, voffB); PG8_STAGE(PG8_SB(1, 1), b3 + hstep, voffB); PG8_STAGE(PG8_SA(1, 0), a3, voffA);
            PG8_WAIT_V(8); PG8_WAIT_L(0); PG8_BAR; PG8_MMA(1, 0, At, B0); PG8_MMA(1, 1, At, B1); PG8_BAR; PG8_SCHED;
        }
        if (wr == 0) PG8_BAR;
        if (!cur.cont()) E(acc, cur, wr, wc, fr, fq);
        if (!has_next) break;
        if (!cur.cont()) {
#pragma unroll
        for (int a = 0; a < 2; ++a)
#pragma unroll
            for (int b = 0; b < 2; ++b)
#pragma unroll
                for (int m = 0; m < 4; ++m)
#pragma unroll
                    for (int n = 0; n < 2; ++n) acc[a][b][m][n] = (f32x4){0.f, 0.f, 0.f, 0.f};
        }
        cur = nxt; cA = nA; cB = nB; ++ui;
        if (wr == 1) PG8_BAR;
    }
    PG8_WAIT_V(0);
    PG8_BAR;
#undef PG8_SA
#undef PG8_SB
#undef PG8_STAGE
#undef PG8_LDA
#undef PG8_LDB
#undef PG8_MMA
#undef PG8_WAIT_V
#undef PG8_WAIT_L
#undef PG8_BAR
#undef PG8_SCHED
}

struct GridOrder {
    const char* A; const char* B; size_t tstep; int nM, nN, nwg, G, c, nt;
    __device__ __forceinline__ void init(const void* A_, const void* B_, int K, int nM_, int nN_, int G_, int c_) { A = (const char*)A_; B = (const char*)B_; tstep = (size_t)BM * K * 2; nM = nM_; nN = nN_; nwg = nM * nN; G = G_; c = c_; nt = K / BK; }
    __device__ __forceinline__ bool next(int i, Unit& u) const {
        const long L = (long)i * G + c; if (L >= nwg) return false;
        int wgid;
        if ((nwg & 63) == 0 && (nM & 7) == 0) {
            const int q = nwg >> 3, xcd = (int)L & 7, off = (int)L >> 3, blk = off >> 6;
            int o2 = off;
            if (blk < (q >> 6)) { const int rem = off & 63, half = rem >> 5, j = rem & 31; o2 = (blk << 6) + ((j >> 2) << 3) + half * 4 + (j & 3); }
            wgid = xcd * q + o2;
        } else wgid = xcd_remap((int)L, nwg);
        const int nig = 8 * nN, gid = wgid / nig, fm = gid * 8, gsz = (nM - fm) < 8 ? (nM - fm) : 8;
        const int pm = fm + ((wgid % nig) % gsz), pn = (wgid % nig) / gsz;
        u = make_unit(A + (size_t)pm * tstep, B + (size_t)pn * tstep, pm, pn, 0, nt, 0); return true;
    }
};
}

typedef f32x4 Acc[2][2][4][2];
struct EpiSwiGLU {
    bf16* Hid;
    __device__ __forceinline__ void operator()(const Acc& acc, const pg8::Unit& u, int wr, int wc, int fr0, int fq0) const {
        int fr = fr0, fq = fq0; asm volatile("" : "+v"(fr), "+v"(fq));
        const int row0 = u.pm() * 256 + wr * 64 + fr, col0 = u.pn() * 128 + wc * 32 + 8 * fq;
#pragma unroll
        for (int ai = 0; ai < 2; ++ai)
#pragma unroll
            for (int m = 0; m < 4; ++m) {
                float v[8];
#pragma unroll
                for (int n = 0; n < 2; ++n)
#pragma unroll
                    for (int j = 0; j < 4; ++j) v[4 * n + j] = fast_silu(acc[ai][0][m][n][j]) * acc[ai][1][m][n][j];
                v4u w; w.x = cvt_pk_bf16(v[0], v[1]); w.y = cvt_pk_bf16(v[2], v[3]); w.z = cvt_pk_bf16(v[4], v[5]); w.w = cvt_pk_bf16(v[6], v[7]);
                *(v4u*)(Hid + (size_t)(row0 + ai * 128 + m * 16) * DFF + col0) = w;
            }
    }
};
struct EpiO16 {
    bf16* C; int ldc;
    __device__ __forceinline__ void operator()(const Acc& acc, const pg8::Unit& u, int wr, int wc, int fr0, int fq0) const {
        int fr = fr0, fq = fq0; asm volatile("" : "+v"(fr), "+v"(fq));
        const int row0 = u.pm() * 256 + wr * 64 + fr, col0 = u.pn() * 256 + wc * 32 + 8 * fq;
#pragma unroll
        for (int ai = 0; ai < 2; ++ai)
#pragma unroll
            for (int m = 0; m < 4; ++m) { bf16* rowp = C + (size_t)(row0 + ai * 128 + m * 16) * ldc + col0;
#pragma unroll
                for (int bj = 0; bj < 2; ++bj) { const f32x4 a = acc[ai][bj][m][0], b = acc[ai][bj][m][1];
                    v4u w; w.x = cvt_pk_bf16(a[0], a[1]); w.y = cvt_pk_bf16(a[2], a[3]); w.z = cvt_pk_bf16(b[0], b[1]); w.w = cvt_pk_bf16(b[2], b[3]);
                    *(v4u*)(rowp + bj * 128) = w; } }
    }
};
struct EpiGLU {
    const bf16* SGS; bf16* out;
    __device__ __forceinline__ void operator()(const Acc& acc, const pg8::Unit& u, int wr, int wc, int fr0, int fq0) const {
        int fr = fr0, fq = fq0; asm volatile("" : "+v"(fr), "+v"(fq));
        const int row0 = u.pm() * 256 + wr * 64 + fr, col0 = u.pn() * 128 + wc * 32 + 8 * fq;
#pragma unroll
        for (int ai = 0; ai < 2; ++ai)
#pragma unroll
            for (int m = 0; m < 4; ++m) {
                const size_t off = (size_t)(row0 + ai * 128 + m * 16) * D + col0;
                const v4u s = *(const v4u*)(SGS + off);
                const float sg[8] = {bflo(s.x), bfhi(s.x), bflo(s.y), bfhi(s.y), bflo(s.z), bfhi(s.z), bflo(s.w), bfhi(s.w)};
                float v[8];
#pragma unroll
                for (int n = 0; n < 2; ++n)
#pragma unroll
                    for (int j = 0; j < 4; ++j) v[4 * n + j] = acc[ai][0][m][n][j] * fast_sigmoid(acc[ai][1][m][n][j]) * sg[4 * n + j];
                v4u w; w.x = cvt_pk_bf16(v[0], v[1]); w.y = cvt_pk_bf16(v[2], v[3]); w.z = cvt_pk_bf16(v[4], v[5]); w.w = cvt_pk_bf16(v[6], v[7]);
                *(v4u*)(out + off) = w;
            }
    }
};
struct EpiMerge {
    const bf16* SGR; bf16* mg;
    __device__ __forceinline__ void operator()(const Acc& acc, const pg8::Unit& u, int wr, int wc, int fr0, int fq0) const {
        int fr = fr0, fq = fq0; asm volatile("" : "+v"(fr), "+v"(fq));
        const int row0 = u.pm() * 256 + wr * 64 + fr, col0 = u.pn() * 256 + wc * 32 + 8 * fq;
#pragma unroll
        for (int ai = 0; ai < 2; ++ai)
#pragma unroll
            for (int m = 0; m < 4; ++m)
#pragma unroll
                for (int bj = 0; bj < 2; ++bj) {
                    const size_t off = (size_t)(row0 + ai * 128 + m * 16) * D + col0 + bj * 128;
                    const v4u s = *(const v4u*)(SGR + off), p = *(const v4u*)(mg + off);
                    const float sg[8] = {bflo(s.x), bfhi(s.x), bflo(s.y), bfhi(s.y), bflo(s.z), bfhi(s.z), bflo(s.w), bfhi(s.w)};
                    const float pp[8] = {bflo(p.x), bfhi(p.x), bflo(p.y), bfhi(p.y), bflo(p.z), bfhi(p.z), bflo(p.w), bfhi(p.w)};
                    float v[8];
#pragma unroll
                    for (int n = 0; n < 2; ++n)
#pragma unroll
                        for (int j = 0; j < 4; ++j) v[4 * n + j] = pp[4 * n + j] + sg[4 * n + j] * acc[ai][bj][m][n][j];
                    v4u w; w.x = cvt_pk_bf16(v[0], v[1]); w.y = cvt_pk_bf16(v[2], v[3]); w.z = cvt_pk_bf16(v[4], v[5]); w.w = cvt_pk_bf16(v[6], v[7]);
                    *(v4u*)(mg + off) = w;
                }
    }
};

constexpr int CTX_SPLIT = 4;
constexpr size_t WS_SLAB = WS_Q;
struct Ffn1DownOrder {
    const char* A; const char* B; int G, c;
    static constexpr int NBIG = (MX / 256) * (D / 256), NSMALL = (MC / 256) * (D / 256) * CTX_SPLIT;
    __device__ __forceinline__ bool next(int i, pg8::Unit& u) const {
        const long L = (long)i * G + c; if (L >= NBIG + NSMALL) return false;
        const size_t tstep = (size_t)256 * DFF * 2;
        int pm, pn, kind, nt; size_t koff;
        if (L < NBIG) { const int w = pg8::xcd_remap((int)L, NBIG); const int nig = 8 * 8, gid = w / nig, r = w % nig; pm = gid * 8 + (r & 7); pn = r >> 3; kind = 0; nt = DFF / 64; koff = 0; }
        else { const int w = (int)L - NBIG, sp = w & 3, t = w >> 2; pm = 32 + (t & 1); pn = t >> 1; kind = 1 + sp; nt = DFF / 64 / CTX_SPLIT; koff = (size_t)sp * (DFF / CTX_SPLIT) * 2; }
        u = pg8::make_unit(A + (size_t)pm * tstep + koff, B + (size_t)pn * tstep + koff, pm, pn, kind, nt, 0); return true;
    }
};
struct EpiFfn1Down {
    bf16* O; float* slab;
    __device__ __forceinline__ void operator()(const Acc& acc, const pg8::Unit& u, int wr, int wc, int fr0, int fq0) const {
        int fr = fr0, fq = fq0; asm volatile("" : "+v"(fr), "+v"(fq));
        const int row0 = u.pm() * 256 + wr * 64 + fr, col0 = u.pn() * 256 + wc * 32 + 8 * fq;
        if (u.kind() == 0) {
#pragma unroll
            for (int ai = 0; ai < 2; ++ai)
#pragma unroll
                for (int m = 0; m < 4; ++m) { bf16* rowp = O + (size_t)(row0 + ai * 128 + m * 16) * D + col0;
#pragma unroll
                    for (int bj = 0; bj < 2; ++bj) { const f32x4 a = acc[ai][bj][m][0], b = acc[ai][bj][m][1];
                        v4u w; w.x = cvt_pk_bf16(a[0], a[1]); w.y = cvt_pk_bf16(a[2], a[3]); w.z = cvt_pk_bf16(b[0], b[1]); w.w = cvt_pk_bf16(b[2], b[3]);
                        *(v4u*)(rowp + bj * 128) = w; } }
        } else {
            float* C = slab + (size_t)(u.kind() - 1) * MC * D - (size_t)MX * D;
#pragma unroll
            for (int ai = 0; ai < 2; ++ai)
#pragma unroll
                for (int m = 0; m < 4; ++m) { float* rowp = C + (size_t)(row0 + ai * 128 + m * 16) * D + col0;
#pragma unroll
                    for (int bj = 0; bj < 2; ++bj) { *(f32x4*)(rowp + bj * 128) = acc[ai][bj][m][0]; *(f32x4*)(rowp + bj * 128 + 4) = acc[ai][bj][m][1]; } }
        }
    }
};

enum { MK_S = 0, MK_Q = 1, MK_K = 2, MK_G = 3, MK_GS = 4, MK_GR = 5, MK_KT = 6, MK_VT = 7 };
struct EpiMix {
    unsigned char* ws;
    __device__ __forceinline__ void operator()(const Acc& acc, const pg8::Unit& u, int wr, int wc, int fr0, int fq0) const {
        int fr = fr0, fq = fq0; asm volatile("" : "+v"(fr), "+v"(fq));
        bf16* const US = (bf16*)(ws + WS_US); bf16* const Q = (bf16*)(ws + WS_Q); bf16* const KN = (bf16*)(ws + WS_K);
        bf16* const SG = (bf16*)(ws + WS_HBUF); bf16* const SGS = (bf16*)(ws + WS_HBUF + 32 * MiB); bf16* const SGR = (bf16*)(ws + WS_HBUF + 64 * MiB);
        bf16* const KFTC = (bf16*)(ws + WS_KFTC);
        bf16* const VT = (bf16*)(ws + WS_VT); bf16* const VTC = (bf16*)(ws + WS_VTC);
        const f32x2* const rope = (const f32x2*)(ws + WS_TAB + TAB_ROPE);
        const float* const lg2 = (const float*)(ws + WS_TAB + TAB_LG2);
        const int kind = u.kind();
        if (kind == MK_S) {
#pragma unroll
            for (int ai = 0; ai < 2; ++ai)
#pragma unroll
                for (int m = 0; m < 4; ++m) {
                    const int row = u.pm() * 256 + ai * 128 + wr * 64 + m * 16 + fr;
                    int b_, crow;
                    if (row < MX) { b_ = row >> 12; crow = (row & (SEQ - 1)) >> 4; } else { b_ = (row - MX) >> 8; crow = 256 + (((row - MX) & (LC - 1)) >> 4); }
                    const int s = row & 15;
#pragma unroll
                    for (int bj = 0; bj < 2; ++bj) {
                        const int ch = u.pn() * 256 + bj * 128 + wc * 32 + 8 * fq, g = ch >> 4, c0 = ch & 15;
                        const f32x4 a = acc[ai][bj][m][0], b = acc[ai][bj][m][1];
                        v4u w; w.x = cvt_pk_bf16(a[0], a[1]); w.y = cvt_pk_bf16(a[2], a[3]); w.z = cvt_pk_bf16(b[0], b[1]); w.w = cvt_pk_bf16(b[2], b[3]);
                        *(v4u*)(US + ((size_t)((b_ * 64 + g) * S5_ROWS + crow)) * 256 + s * 16 + c0) = w;
                    }
                }
        } else if (kind == MK_G || kind == MK_GS || kind == MK_GR) {
            bf16* dst = kind == MK_G ? SG : (kind == MK_GS ? SGS : SGR);
            const int row0 = u.pm() * 256 + wr * 64 + fr, col0 = u.pn() * 256 + wc * 32 + 8 * fq;
#pragma unroll
            for (int ai = 0; ai < 2; ++ai)
#pragma unroll
                for (int m = 0; m < 4; ++m)
#pragma unroll
                    for (int bj = 0; bj < 2; ++bj) {
                        float v[8];
#pragma unroll
                        for (int n = 0; n < 2; ++n)
#pragma unroll
                            for (int j = 0; j < 4; ++j) { const float x = acc[ai][bj][m][n][j]; const float s = fast_sigmoid(x); v[4 * n + j] = kind == MK_G ? x * s : s; }
                        v4u w; w.x = cvt_pk_bf16(v[0], v[1]); w.y = cvt_pk_bf16(v[2], v[3]); w.z = cvt_pk_bf16(v[4], v[5]); w.w = cvt_pk_bf16(v[6], v[7]);
                        *(v4u*)(dst + (size_t)(row0 + ai * 128 + m * 16) * D + col0 + bj * 128) = w;
                    }
        } else if (kind == MK_Q || kind == MK_K) {
            const int p = wc >> 1, i0 = 16 * (wc & 1) + 4 * fq;
            const int d0 = 64 * p + i0;
            const bool isctx = u.pm() >= 32;
            f32x4 cs0[8], cs1[8];
#pragma unroll
            for (int am = 0; am < 8; ++am) {
                const int row = u.pm() * 256 + (am >> 2) * 128 + wr * 64 + (am & 3) * 16 + fr;
                const int l = row & (SEQ - 1), pos = p ? (l & 63) : (l >> 6);
                if (!isctx) { cs0[am] = *(const f32x4*)(rope + pos * 32 + i0); cs1[am] = *(const f32x4*)(rope + pos * 32 + i0 + 2); }
                else { cs0[am] = (f32x4){1.f, 0.f, 1.f, 0.f}; cs1[am] = cs0[am]; }
            }
#pragma unroll
            for (int ai = 0; ai < 2; ++ai)
#pragma unroll
                for (int m = 0; m < 4; ++m) {
                    const int am = ai * 4 + m;
                    const int row = u.pm() * 256 + ai * 128 + wr * 64 + m * 16 + fr;
                    const float cc[4] = {cs0[am][0], cs0[am][2], cs1[am][0], cs1[am][2]}, ss[4] = {cs0[am][1], cs0[am][3], cs1[am][1], cs1[am][3]};
#pragma unroll
                    for (int bj = 0; bj < 2; ++bj) {
                        const int head = 2 * u.pn() + bj;
                        float y1[4], y2[4];
#pragma unroll
                        for (int j = 0; j < 4; ++j) { const float x1 = acc[ai][bj][m][0][j], x2 = acc[ai][bj][m][1][j]; y1[j] = x1 * cc[j] - x2 * ss[j]; y2[j] = x1 * ss[j] + x2 * cc[j]; }
                        const int cpos = 32 * wc + 8 * fq;
                        v4u w;
                        if (kind == MK_K) {
                            w.x = cvt_pk_bf16(y1[0], y1[1]); w.y = cvt_pk_bf16(y1[2], y1[3]); w.z = cvt_pk_bf16(y2[0], y2[1]); w.w = cvt_pk_bf16(y2[2], y2[3]);
                            if (!isctx) *(v4u*)(KN + (size_t)row * 1024 + head * 128 + cpos) = w;
                            else *(v4u*)(KFTC + (size_t)(row - MX) * 1024 + head * 128 + cpos) = w;
                        } else {
                            const float qs = 0.08838834764831845f;
                            w.x = cvt_pk_bf16(y1[0] * qs, y1[1] * qs); w.y = cvt_pk_bf16(y1[2] * qs, y1[3] * qs); w.z = cvt_pk_bf16(y2[0] * qs, y2[1] * qs); w.w = cvt_pk_bf16(y2[2] * qs, y2[3] * qs);
                            *(v4u*)(Q + (size_t)row * 1024 + head * 128 + cpos) = w;
                        }
                    }
                }
        } else if (kind == MK_VT) {
            const bool isctx = u.pn() >= 32;
#pragma unroll
            for (int ai = 0; ai < 2; ++ai)
#pragma unroll
                for (int m = 0; m < 4; ++m) {
                    const int f = u.pm() * 256 + ai * 128 + wr * 64 + m * 16 + fr;
#pragma unroll
                    for (int bj = 0; bj < 2; ++bj) {
                        const f32x4 a = acc[ai][bj][m][0], b = acc[ai][bj][m][1];
                        v4u w; w.x = cvt_pk_bf16(a[0], a[1]); w.y = cvt_pk_bf16(a[2], a[3]); w.z = cvt_pk_bf16(b[0], b[1]); w.w = cvt_pk_bf16(b[2], b[3]);
                        const int tc = bj * 128 + wc * 32 + 8 * fq;
                        if (!isctx) { const int tok = u.pn() * 256 + tc, b_ = tok >> 12, l = tok & (SEQ - 1); *(v4u*)(VT + ((size_t)(b_ * 2048 + f) * SEQ + l)) = w; }
                        else { const int b_ = u.pn() - 32; *(v4u*)(VTC + ((size_t)(b_ * 2048 + f) * LC + tc)) = w; }
                    }
                }
        }
    }
};
struct MixOrder {
    const char* U; const char* WM; int G, c;
    static constexpr int N_NORM = 32 * 36, N_CTXS = 16, N_SWAP = 8 * 34, NWG = N_NORM + N_CTXS + N_SWAP;
    __device__ __forceinline__ bool next(int i, pg8::Unit& u) const {
        const long L = (long)i * G + c; if (L >= NWG) return false;
        int w = pg8::xcd_remap((int)L, NWG);
        const size_t tstep = (size_t)256 * D * 2;
        int at, bt, pm, pn, kind;
        bool swapped = false;
        if (w < N_NORM) {
            const int nig = 8 * 36, gid = w / nig, r = w % nig, ct = r >> 3;
            pm = gid * 8 + (r & 7); at = pm;
            if (ct < 4) { bt = ct; kind = MK_S; pn = ct; } else if (ct < 8) { bt = ct; kind = MK_Q; pn = ct - 4; } else if (ct < 12) { bt = ct; kind = MK_K; pn = ct - 8; }
            else if (ct < 20) { bt = ct + 8; kind = MK_G; pn = ct - 12; } else if (ct < 28) { bt = ct + 8; kind = MK_GS; pn = ct - 20; } else { bt = ct + 8; kind = MK_GR; pn = ct - 28; }
        } else if (w < N_NORM + N_CTXS) {
            w -= N_NORM; pm = 32 + (w & 1); at = pm; const int ct = w >> 1;
            if (ct < 4) { bt = ct; pn = ct; kind = MK_S; } else { bt = ct + 4; pn = ct - 4; kind = MK_K; }
        } else {
            w -= N_NORM + N_CTXS; swapped = true;
            const int tt = w >> 3, ft = w & 7;
            bt = tt; pn = tt; at = 12 + ft; pm = ft; kind = MK_VT;
        }
        const char* abase = swapped ? WM : U; const char* bbase = swapped ? U : WM;
        u = pg8::make_unit(abase + (size_t)at * tstep, bbase + (size_t)bt * tstep, pm, pn, kind, D / 64, 0);
        return true;
    }
};

constexpr int RING_BYTES = 131072, LDSCTL_OFF = 143360, MISC_OFF = LDSCTL_OFF + 320, LDS_BYTES = 147456;
struct Args { const float* in[22]; float* out; unsigned char* ws; };
struct Frame {
    LAS unsigned char* lds; volatile LAS unsigned* MISC; unsigned* ctl;
    int wave, vcu, G;
    float* out; unsigned char* ws;
};
typedef const Args __attribute__((address_space(4)))* KArgsPtr;
__device__ __forceinline__ KArgsPtr kargs() { KArgsPtr p = (KArgsPtr)__builtin_amdgcn_kernarg_segment_ptr(); asm volatile("" : "+s"(p)); return p; }
#define FIN(k) ((const float*)kargs()->in[k])

__device__ __forceinline__ int map_pair(int n, int half) { const int h = n < half ? n : n - half, up = n >= half; return 256 * (h >> 7) + 128 * up + (h & 127); }
__device__ __forceinline__ int map_mix(int n) {
    if (n < 1024 || n >= 3072) return n;
    const int base = n & ~127, d = n & 127, p = d >> 6, e = d & 63, s = e >> 5, i = e & 31, t = 32 * p + i;
    return base + 32 * (t >> 4) + 8 * ((t >> 2) & 3) + 4 * s + (t & 3);
}
template <int MAPID>
__device__ __forceinline__ void transpose_item(const float* W, int ldw, int K, int nblk, bf16* WT, int row_off, int half, LAS float* scr, int item, int lane) {
    const int kb = item / nblk, nb = item % nblk, k0 = 64 * kb, n0 = 32 * nb;
    float wv[32];
#pragma unroll
    for (int i = 0; i < 32; ++i) wv[i] = __builtin_nontemporal_load(W + (size_t)(k0 + 2 * i + (lane >> 5)) * ldw + n0 + (lane & 31));
#pragma unroll
    for (int i = 0; i < 32; ++i) scr[(2 * i + (lane >> 5)) * 33 + (lane & 31)] = wv[i];
    LDS_WAIT(); asm volatile("" ::: "memory");
    const int c = lane & 7;
#pragma unroll
    for (int j = 0; j < 4; ++j) { const int n = (lane >> 3) + 8 * j; const LAS float* s = scr + (8 * c) * 33 + n;
        v4u o; o.x = pk2(s[0 * 33], s[1 * 33]); o.y = pk2(s[2 * 33], s[3 * 33]); o.z = pk2(s[4 * 33], s[5 * 33]); o.w = pk2(s[6 * 33], s[7 * 33]);
        const int nn = n0 + n; const int dr = MAPID == 0 ? nn : (MAPID == 1 ? map_pair(nn, half) : map_mix(nn));
        *(v4u*)(WT + (size_t)(row_off + dr) * K + k0 + 8 * c) = o; }
    LDS_WAIT(); asm volatile("" ::: "memory");
}
__device__ __forceinline__ void sincos_d(double x, double& s, double& c) {
    const double TWO_PI = 6.283185307179586476925286766559;
    x -= TWO_PI * __builtin_rint(x / TWO_PI);
    const double h = 0.125 * x, h2 = h * h;
    double sn = h * (1.0 + h2 * (-1.0 / 6 + h2 * (1.0 / 120 + h2 * (-1.0 / 5040 + h2 * (1.0 / 362880 + h2 * (-1.0 / 39916800 + h2 * (1.0 / 6227020800.0)))))));
    double cs = 1.0 + h2 * (-0.5 + h2 * (1.0 / 24 + h2 * (-1.0 / 720 + h2 * (1.0 / 40320 + h2 * (-1.0 / 3628800 + h2 * (1.0 / 479001600.0 + h2 * (-1.0 / 87178291200.0)))))));
#pragma unroll
    for (int k = 0; k < 3; ++k) { const double s2 = 2.0 * sn * cs, c2 = 1.0 - 2.0 * sn * sn; sn = s2; cs = c2; }
    s = sn; c = cs;
}
__device__ __forceinline__ double exp_d(double x) {
    const double y = x * (1.0 / 4096.0);
    double e = 1.0 + y * (1.0 + y * (0.5 + y * (1.0 / 6 + y * (1.0 / 24 + y * (1.0 / 120 + y * (1.0 / 720))))));
#pragma unroll
    for (int k = 0; k < 12; ++k) e = e * e;
    return e;
}
__device__ __forceinline__ double log1p_small_d(double z) {
    const double t = z / (2.0 + z), t2 = t * t;
    return 2.0 * t * (1.0 + t2 * (1.0 / 3 + t2 * (1.0 / 5 + t2 * (1.0 / 7 + t2 * (1.0 / 9 + t2 * (1.0 / 11))))));
}

constexpr int CV_I1 = (D / 64) * (NFF / 32), CV_I2 = (DFF / 64) * (D / 32), CV_IM = (D / 64) * (NMIX / 32), CV_IG = (SW / 64) * (2 * D / 32), CV_IP = (D / 64) * (D / 32);
constexpr int CV_N0 = CV_I1 + CV_I2, CV_N1 = CV_IM + CV_IG + 2 * CV_IP, CV_N2 = CV_I1 + CV_I2;
constexpr int CV_G1_CUS = 40, CV_G2_CUS = 192, CV_G3_CUS = 96;
constexpr int CV_L1_G1 = CV_G1_CUS * NWAVES * 12, CV_L1_G2 = CV_G2_CUS * NWAVES * 7, CV_L2_G3 = CV_G3_CUS * NWAVES * 14;
static_assert(CV_L1_G1 + CV_L1_G2 <= CV_N1 && CV_L2_G3 <= CV_N2, "conversion split");
__device__ __forceinline__ void conv_item(unsigned char* ws, int list, int r, LAS float* scr, int lane_) {
    if (list == 0) {
        if (r < CV_I1) { transpose_item<1>(FIN(7), NFF, D, NFF / 32, (bf16*)(ws + WS_W1T), 0, DFF, scr, r, lane_); return; } r -= CV_I1;
        transpose_item<0>(FIN(8), D, DFF, D / 32, (bf16*)(ws + WS_W2T), 0, 0, scr, r, lane_);
    } else if (list == 1) {
        if (r < CV_IM) { transpose_item<2>(FIN(9), NMIX, D, NMIX / 32, (bf16*)(ws + WS_WMT), 0, 0, scr, r, lane_); return; } r -= CV_IM;
        if (r < CV_IG) { transpose_item<1>(FIN(18), 2 * D, SW, 2 * D / 32, (bf16*)(ws + WS_WGT), 0, D, scr, r, lane_); return; } r -= CV_IG;
        if (r < CV_IP) { transpose_item<0>(FIN(20), D, D, D / 32, (bf16*)(ws + WS_WPT), 0, 0, scr, r, lane_); return; } r -= CV_IP;
        transpose_item<0>(FIN(21), D, D, D / 32, (bf16*)(ws + WS_WOT), 0, 0, scr, r, lane_);
    } else {
        if (r < CV_I1) { transpose_item<1>(FIN(7) + (size_t)D * NFF, NFF, D, NFF / 32, (bf16*)(ws + WS_W3T), 0, DFF, scr, r, lane_); return; } r -= CV_I1;
        transpose_item<0>(FIN(8) + (size_t)DFF * D, D, DFF, D / 32, (bf16*)(ws + WS_W4T), 0, 0, scr, r, lane_);
    }
}
__device__ __forceinline__ void conv_range(Frame& F, int list, int begin, int end, int wi, int nw) {
    int lane_ = lane_id(); asm volatile("" : "+v"(lane_));
    LAS float* scr = (LAS float*)(F.lds + F.wave * 16384);
    for (int it = begin + wi; it < end; it += nw) conv_item(F.ws, list, it, scr, lane_);
}

__device__ __forceinline__ void phase_prologue(Frame& F0, const Args& args, const bool do_ada) {
    Frame& F = F0; int lane_ = lane_id(); asm volatile("" : "+v"(lane_));
    LAS float* scr = (LAS float*)(F.lds + F.wave * 16384);
    const int gw = F.vcu * NWAVES + F.wave, NGW = F.G * NWAVES;
    unsigned char* ws = F.ws;
    {
        const int gt = gw * 64 + lane_, NT = NGW * 64;
        unsigned char* tab = ws + WS_TAB;
        for (int idx = gt; idx < 2048; idx += NT) {
            const int pos = idx >> 5, i = idx & 31;
            const double inv = exp_d(-(double)i * (9.210340371976182736 / 32.0));
            double s, c; sincos_d((double)pos * inv, s, c);
            ((f32x2*)(tab + TAB_ROPE))[idx] = (f32x2){(float)c, (float)s};
        }
        for (int idx = gt; idx < 16; idx += NT) {
            const double x = (double)FIN(19)[idx];
            ((float*)(tab + TAB_LG2))[idx] = (float)(-log1p_small_d(exp_d(-x)) * 1.4426950408889634074);
        }
        for (int idx = gt; idx < 2 * 64 * 64; idx += NT) {
            const int dg = idx >> 6, p = idx & 63;
            const double lr = (double)FIN(10)[idx], li = (double)FIN(11)[idx], step = exp_d((double)FIN(12)[dg]);
            const double mag = exp_d(lr * step); double sn, cs; sincos_d(li * step, sn, cs);
            const double ar = mag * cs, ai = mag * sn, den = lr * lr + li * li, nr = ar - 1.0, ni = ai;
            const double kr = (nr * lr + ni * li) / den, ki = (ni * lr - nr * li) / den;
            ((float*)(tab + TAB_AR))[idx] = (float)ar; ((float*)(tab + TAB_AI))[idx] = (float)ai;
            { f32x2* apw = (f32x2*)(ws + WS_S5APOW) + (size_t)dg * 17 * 64 + p; double pr = 1.0, pi = 0.0;
              for (int k = 0; k < 17; ++k) { apw[k * 64] = (f32x2){(float)pr, (float)pi}; const double t = pr * ar - pi * ai; pi = pr * ai + pi * ar; pr = t; } }
            float* brf = (float*)(ws + WS_S5BRF) + (size_t)idx * 32;
            const float* bre = FIN(13) + (size_t)idx * 16; const float* bim = FIN(14) + (size_t)idx * 16;
            for (int c = 0; c < 16; ++c) { const double br = (double)bre[c], bi = (double)bim[c];
                brf[2 * c] = (float)(kr * br - ki * bi); brf[2 * c + 1] = (float)(kr * bi + ki * br); }
        }
    }
    if (do_ada) {
        float* ADA = (float*)(ws + WS_CTL + CTL_ADA);
        const float* aw = FIN(4);
        for (int it = gw; it < 16 * 72; it += NGW) {
            const int kc = it / 72, cb = it % 72, k0 = kc * 128, col = cb * 256 + 4 * lane_;
            for (int i = lane_; i < 384; i += 64) { const int v = i >> 7, k = i & 127; const float x = v == 0 ? FIN(1)[k0 + k] : (v == 1 ? FIN(1)[D + k0 + k] : FIN(3)[k0 + k]); scr[i] = x / (1.0f + __expf(-x)); }
            LDS_WAIT(); asm volatile("" ::: "memory");
            f32x4 a0 = {0.f, 0.f, 0.f, 0.f}, a1 = a0, a2 = a0;
#pragma unroll 8
            for (int k = 0; k < 128; ++k) { const f32x4 w = __builtin_nontemporal_load((const f32x4*)(aw + (size_t)(k0 + k) * NADA + col)); a0 += w * scr[k]; a1 += w * scr[128 + k]; a2 += w * scr[256 + k]; }
#pragma unroll
            for (int j = 0; j < 4; ++j) { __hip_atomic_fetch_add(ADA + col + j, a0[j], RLX_AGENT); __hip_atomic_fetch_add(ADA + NADA + col + j, a1[j], RLX_AGENT); __hip_atomic_fetch_add(ADA + 2 * NADA + col + j, a2[j], RLX_AGENT); }
            LDS_WAIT(); asm volatile("" ::: "memory");
        }
    }
    {
        const bool tails = (F.G == 256);
        const int b1 = tails ? CV_L1_G1 + CV_L1_G2 : 0, b2 = tails ? CV_L2_G3 : 0;
        const int n0 = CV_N0, n1 = CV_N1 - b1, n2 = CV_N2 - b2;
        for (int it = gw; it < n0 + n1 + n2; it += NGW) {
            if (it < n2) conv_item(ws, 2, b2 + it, scr, lane_);
            else if (it < n2 + n1) conv_item(ws, 1, b1 + it - n2, scr, lane_);
            else conv_item(ws, 0, it - n2 - n1, scr, lane_);
        }
    }
}

__device__ __forceinline__ void build_modv(Frame& F, const Args& args) {
    int lane_ = lane_id(); asm volatile("" : "+v"(lane_));
    const int gt = (F.vcu * NWAVES + F.wave) * 64 + lane_, NT = F.G * NWAVES * 64;
    const float* ADA = (const float*)(F.ws + WS_CTL + CTL_ADA); const float* adab = FIN(5); const float* ng = FIN(6);
    float* MV = (float*)(F.ws + WS_TAB + TAB_MODV);
    for (int idx = gt; idx < 27 * (D / 4); idx += NT) {
        const int c = (idx % (D / 4)) * 4, v = idx / (D / 4), av = v % 3, i = (v / 3) % 3, kind = v / 9;
        const float* ada = ADA + (size_t)av * NADA;
        f32x4 o;
        if (kind == 0) o = ((i == 1) ? 1.0f : 0.5f) * (*(const f32x4*)(ada + (3 * i + 2) * D + c) + *(const f32x4*)(adab + (3 * i + 2) * D + c)) * *(const f32x4*)(ng + (2 * i + 1) * D + c);
        else if (kind == 1) o = *(const f32x4*)(ng + (2 * i) * D + c) * (*(const f32x4*)(ada + (3 * i + 1) * D + c) + *(const f32x4*)(adab + (3 * i + 1) * D + c) + 1.0f);
        else o = *(const f32x4*)(ada + (3 * i) * D + c) + *(const f32x4*)(adab + (3 * i) * D + c);
        *(f32x4*)(MV + (size_t)v * D + c) = o;
    }
}
template <int MODE>
__device__ __forceinline__ void phase_rows(Frame& F0, const Args& args) {
    Frame& F = F0; int lane_ = lane_id(); asm volatile("" : "+v"(lane_));
    const int gw = F.vcu * NWAVES + F.wave, NGW = F.G * NWAVES;
    const float* ADA = (const float*)(F.ws + WS_CTL + CTL_ADA);
    const float* adab = FIN(5); const float* ng = FIN(6);
    const float* MV = (const float*)(F.ws + WS_TAB + TAB_MODV);
    const bf16* O = (const bf16*)(F.ws + WS_OBUF);
    bf16* A = (bf16*)(F.ws + WS_ABUF);
    const int nrows = (MODE <= 1) ? MT : MX;
    constexpr int ipost = MODE >= 1 ? MODE - 1 : 0, ipre = MODE <= 2 ? MODE : 0;
    int cur_av = -1;
    f32x4 cf[8], gsv[8], shv[8];
    for (int r = gw; r < nrows; r += NGW) {
        const int av = r < MX ? (r >> 12) : 2;
        if (av != cur_av) {
            cur_av = av;
#pragma unroll
            for (int j = 0; j < 8; ++j) { const int c = 256 * j + 4 * lane_;
                if (MODE == 0) { const float* ada = ADA + (size_t)av * NADA;
                    shv[j] = *(const f32x4*)(ada + c) + *(const f32x4*)(adab + c);
                    gsv[j] = *(const f32x4*)(ng + c) * (*(const f32x4*)(ada + D + c) + *(const f32x4*)(adab + D + c) + 1.0f); }
                else {
                    cf[j] = *(const f32x4*)(MV + (size_t)((0 * 3 + ipost) * 3 + av) * D + c);
                    if (MODE <= 2) { gsv[j] = *(const f32x4*)(MV + (size_t)((1 * 3 + ipre) * 3 + av) * D + c); shv[j] = *(const f32x4*)(MV + (size_t)((2 * 3 + ipre) * 3 + av) * D + c); } } }
        }
        f32x4 h[8];
        if (MODE <= 1) { const float* hsrc = r < MX ? FIN(0) + (size_t)r * D : FIN(2) + (size_t)(r - MX) * D;
#pragma unroll
            for (int j = 0; j < 8; ++j) h[j] = __builtin_nontemporal_load((const f32x4*)(hsrc + 256 * j + 4 * lane_)); }
        else { const bf16* hsrc = (const bf16*)(F.ws + WS_STREAM) + (size_t)r * D;
#pragma unroll
            for (int j = 0; j < 8; ++j) { const v2u t = __builtin_nontemporal_load((const v2u*)(hsrc + 256 * j + 4 * lane_)); h[j] = (f32x4){bflo(t.x), bfhi(t.x), bflo(t.y), bfhi(t.y)}; } }
        if (MODE >= 1) {
            f32x4 o[8]; float ss = 0.f;
#pragma unroll
            for (int j = 0; j < 8; ++j) {
                if (MODE == 1 && r >= MX) { const float* sl = (const float*)(F.ws + WS_SLAB) + (size_t)(r - MX) * D + 256 * j + 4 * lane_; f32x4 a = *(const f32x4*)sl;
#pragma unroll
                    for (int s = 1; s < CTX_SPLIT; ++s) a += *(const f32x4*)(sl + (size_t)s * MC * D);
                    o[j] = a; }
                else { const v2u t = __builtin_nontemporal_load((const v2u*)(O + (size_t)r * D + 256 * j + 4 * lane_)); o[j] = (f32x4){bflo(t.x), bfhi(t.x), bflo(t.y), bfhi(t.y)}; }
                ss += (o[j][0] * o[j][0] + o[j][1] * o[j][1]) + (o[j][2] * o[j][2] + o[j][3] * o[j][3]); }
            const float rstd = 1.0f / sqrtf(wave_sum(ss, lane_) * (1.0f / D) + EPS);
#pragma unroll
            for (int j = 0; j < 8; ++j) h[j] = h[j] + rstd * (cf[j] * o[j]);
            if (r < MX) {
                if (MODE == 3) {
#pragma unroll
                    for (int j = 0; j < 8; ++j) __builtin_nontemporal_store(h[j], (f32x4*)(F.out + (size_t)r * D + 256 * j + 4 * lane_));
                } else {
                    bf16* so = (bf16*)(F.ws + WS_STREAM) + (size_t)r * D;
#pragma unroll
                    for (int j = 0; j < 8; ++j) { v2u w; w.x = cvt_pk_bf16(h[j][0], h[j][1]); w.y = cvt_pk_bf16(h[j][2], h[j][3]); __builtin_nontemporal_store(w, (v2u*)(so + 256 * j + 4 * lane_));
                        h[j] = (f32x4){bflo(w.x), bfhi(w.x), bflo(w.y), bfhi(w.y)}; }
                }
            }
        }
        if (MODE <= 2) {
            float ss = 0.f;
#pragma unroll
            for (int j = 0; j < 8; ++j) ss += (h[j][0] * h[j][0] + h[j][1] * h[j][1]) + (h[j][2] * h[j][2] + h[j][3] * h[j][3]);
            const float rstd = 1.0f / sqrtf(wave_sum(ss, lane_) * (1.0f / D) + EPS);
#pragma unroll
            for (int j = 0; j < 8; ++j) { const f32x4 v = (h[j] * rstd) * gsv[j] + shv[j];
                v2u w; w.x = cvt_pk_bf16(v[0], v[1]); w.y = cvt_pk_bf16(v[2], v[3]);
                *(v2u*)(A + (size_t)r * D + 256 * j + 4 * lane_) = w; }
        }
    }
}

__device__ __forceinline__ void s5_tables1(Frame& F, const Args& args) {
    int lane_ = lane_id(); asm volatile("" : "+v"(lane_));
    const int gt = (F.vcu * NWAVES + F.wave) * 64 + lane_, NT = F.G * NWAVES * 64;
    const f32x2* APW = (const f32x2*)(F.ws + WS_S5APOW);
    const float* BRF = (const float*)(F.ws + WS_S5BRF);
    const float* cre = FIN(15); const float* cim = FIN(16);
    float* KT = (float*)(F.ws + WS_S5KT); bf16* WE = (bf16*)(F.ws + WS_S5WE); bf16* WY2 = (bf16*)(F.ws + WS_S5WY2);
    for (int idx = gt; idx < 64 * 2 * 16 * 16 * 4; idx += NT) {
        const int c4 = idx & 3, c = (idx >> 2) & 15, k = (idx >> 6) & 15, dir = (idx >> 10) & 1, g = idx >> 11, dg = dir * 64 + g;
        const f32x2* ap = APW + (size_t)(dg * 17 + k) * 64; const float* cr = cre + (dg * 16 + c) * 64; const float* ci = cim + (dg * 16 + c) * 64;
        const float* br = BRF + (size_t)dg * 64 * 32 + c4 * 8;
        f32x4 acc = {0.f, 0.f, 0.f, 0.f};
#pragma unroll 8
        for (int p = 0; p < 64; ++p) {
            const f32x2 a = ap[p]; const float Cr = cr[p], Ci = ci[p], Gr = Cr * a[0] - Ci * a[1], Gi = Cr * a[1] + Ci * a[0];
            const f32x4 b0 = *(const f32x4*)(br + p * 32), b1 = *(const f32x4*)(br + p * 32 + 4);
            acc[0] += Gr * b0[0] - Gi * b0[1]; acc[1] += Gr * b0[2] - Gi * b0[3]; acc[2] += Gr * b1[0] - Gi * b1[1]; acc[3] += Gr * b1[2] - Gi * b1[3];
        }
        *(f32x4*)(KT + ((size_t)((g * 2 + dir) * 16 + k) * 16 + c) * 16 + c4 * 4) = acc;
    }
    for (int idx = gt; idx < 64 * 256 * 16; idx += NT) {
        const int s = idx & 15, r = (idx >> 4) & 255, g = idx >> 12, dir = r >> 7, part = (r >> 6) & 1, p = r & 63, dg = dir * 64 + g;
        const f32x2 a = APW[(size_t)(dg * 17 + (dir ? s : 15 - s)) * 64 + p]; const float pr = a[0], pi = a[1];
        const f32x4* b4 = (const f32x4*)(BRF + (size_t)(dg * 64 + p) * 32);
        float v[16];
#pragma unroll
        for (int j = 0; j < 8; ++j) { const f32x4 q = b4[j]; v[2 * j] = part ? (pr * q[1] + pi * q[0]) : (pr * q[0] - pi * q[1]); v[2 * j + 1] = part ? (pr * q[3] + pi * q[2]) : (pr * q[2] - pi * q[3]); }
        bf16* o = WE + ((size_t)(g * 256 + r)) * 256 + s * 16;
        v4u w0, w1; w0.x = pk2(v[0], v[1]); w0.y = pk2(v[2], v[3]); w0.z = pk2(v[4], v[5]); w0.w = pk2(v[6], v[7]); w1.x = pk2(v[8], v[9]); w1.y = pk2(v[10], v[11]); w1.z = pk2(v[12], v[13]); w1.w = pk2(v[14], v[15]);
        *(v4u*)o = w0; *(v4u*)(o + 8) = w1;
    }
    for (int idx = gt; idx < 64 * 256 * 32; idx += NT) {
        const int cb = idx & 31, row = (idx >> 5) & 255, g = idx >> 13, t = row >> 4, c = row & 15, col0 = 8 * cb, dir = col0 >> 7, part = (col0 >> 6) & 1, p0 = col0 & 63, dg = dir * 64 + g;
        const f32x2* ap = APW + (size_t)(dg * 17 + (dir ? 16 - t : t + 1)) * 64 + p0; const float* cr = cre + (dg * 16 + c) * 64 + p0; const float* ci = cim + (dg * 16 + c) * 64 + p0;
        float v[8];
#pragma unroll
        for (int j = 0; j < 8; ++j) { const f32x2 a = ap[j]; const float Cr = cr[j], Ci = ci[j]; v[j] = part ? -(Cr * a[1] + Ci * a[0]) : (Cr * a[0] - Ci * a[1]); }
        v4u w; w.x = pk2(v[0], v[1]); w.y = pk2(v[2], v[3]); w.z = pk2(v[4], v[5]); w.w = pk2(v[6], v[7]);
        *(v4u*)(WY2 + ((size_t)(g * 256 + row)) * 256 + col0) = w;
    }
}
__device__ __forceinline__ void s5_tables2(Frame& F, const Args& args) {
    int lane_ = lane_id(); asm volatile("" : "+v"(lane_));
    const int gt = (F.vcu * NWAVES + F.wave) * 64 + lane_, NT = F.G * NWAVES * 64;
    const float* KT = (const float*)(F.ws + WS_S5KT); bf16* WY1 = (bf16*)(F.ws + WS_S5WY1); const float* dskip = FIN(17);
    for (int idx = gt; idx < 64 * 256 * 16; idx += NT) {
        const int s = idx & 15, row = (idx >> 4) & 255, g = idx >> 12, t = row >> 4, c = row & 15;
        float v[16];
#pragma unroll
        for (int j = 0; j < 16; ++j) v[j] = 0.f;
        if (s <= t) { const f32x4* k4 = (const f32x4*)(KT + ((size_t)((g * 2 + 0) * 16 + (t - s)) * 16 + c) * 16);
#pragma unroll
            for (int j = 0; j < 4; ++j) { const f32x4 q = k4[j]; v[4 * j] += q[0]; v[4 * j + 1] += q[1]; v[4 * j + 2] += q[2]; v[4 * j + 3] += q[3]; } }
        if (s >= t) { const f32x4* k4 = (const f32x4*)(KT + ((size_t)((g * 2 + 1) * 16 + (s - t)) * 16 + c) * 16);
#pragma unroll
            for (int j = 0; j < 4; ++j) { const f32x4 q = k4[j]; v[4 * j] += q[0]; v[4 * j + 1] += q[1]; v[4 * j + 2] += q[2]; v[4 * j + 3] += q[3]; } }
        if (s == t) { const float dk = dskip[16 * g + c];
#pragma unroll
            for (int j = 0; j < 16; ++j) v[j] += (j == c) ? dk : 0.f; }
        bf16* o = WY1 + ((size_t)(g * 256 + row)) * 256 + s * 16;
        v4u w0, w1; w0.x = pk2(v[0], v[1]); w0.y = pk2(v[2], v[3]); w0.z = pk2(v[4], v[5]); w0.w = pk2(v[6], v[7]); w1.x = pk2(v[8], v[9]); w1.y = pk2(v[10], v[11]); w1.z = pk2(v[12], v[13]); w1.w = pk2(v[14], v[15]);
        *(v4u*)o = w0; *(v4u*)(o + 8) = w1;
    }
}
struct S5EOrder {
    const char* ZU; const char* WE; int G, c;
    __device__ __forceinline__ bool next(int i, pg8::Unit& u) const {
        const long L = (long)i * G + c; if (L >= 256) return false;
        const int bg = (int)L >> 1, rt = (int)L & 1, g = bg & 63;
        u = pg8::make_unit(ZU + ((size_t)(bg * S5_ROWS + 256 * rt)) * 512, WE + (size_t)g * 256 * 512, bg, rt, 0, 4, 0); return true;
    }
};
struct EpiS5E {
    bf16* E;
    __device__ __forceinline__ void operator()(const Acc& acc, const pg8::Unit& u, int wr, int wc, int fr0, int fq0) const {
        int fr = fr0, fq = fq0; asm volatile("" : "+v"(fr), "+v"(fq));
#pragma unroll
        for (int ai = 0; ai < 2; ++ai)
#pragma unroll
            for (int m = 0; m < 4; ++m) {
                const int crow = 256 * u.pn() + ai * 128 + wr * 64 + m * 16 + fr;
                if (crow < S5_ROWS) {
#pragma unroll
                    for (int bj = 0; bj < 2; ++bj) {
                        const f32x4 a = acc[ai][bj][m][0], b = acc[ai][bj][m][1];
                        v4u w; w.x = cvt_pk_bf16(a[0], a[1]); w.y = cvt_pk_bf16(a[2], a[3]); w.z = cvt_pk_bf16(b[0], b[1]); w.w = cvt_pk_bf16(b[2], b[3]);
                        *(v4u*)(E + ((size_t)(u.pm() * S5_ROWS + crow)) * 256 + bj * 128 + wc * 32 + 8 * fq) = w;
                    }
                }
            }
    }
};
struct S5YOrder {
    const char* ZU; const char* ZH; const char* WY1; const char* WY2; int G, c;
    __device__ __forceinline__ bool next(int i, pg8::Unit& u) const {
        const int bg = (i >> 1) * G + c, seg = i & 1; if (bg >= NB * 64) return false;
        const int g = bg & 63;
        const char* a = seg == 0 ? ZU + ((size_t)(bg * S5_ROWS)) * 512 : ZH + ((size_t)(bg * 256)) * 512;
        const char* b = (seg == 0 ? WY1 : WY2) + (size_t)g * 256 * 512;
        u = pg8::make_unit(a, b, bg, 0, 0, 4, seg == 0 ? 1 : 0); return true;
    }
};
struct EpiS5Y {
    bf16* AGLU;
    __device__ __forceinline__ void operator()(const Acc& acc, const pg8::Unit& u, int wr, int wc, int fr0, int fq0) const {
        int fr = fr0, fq = fq0; asm volatile("" : "+v"(fr), "+v"(fq));
        const int b_ = u.pm() >> 6, g = u.pm() & 63;
#pragma unroll
        for (int ai = 0; ai < 2; ++ai)
#pragma unroll
            for (int m = 0; m < 4; ++m) {
                const int chunk = ai * 128 + wr * 64 + m * 16 + fr;
#pragma unroll
                for (int bj = 0; bj < 2; ++bj) {
                    const int cc = bj * 128 + wc * 32 + 8 * fq, t = cc >> 4, c0 = cc & 15;
                    const f32x4 a = acc[ai][bj][m][0], b = acc[ai][bj][m][1];
                    v4u w; w.x = cvt_pk_bf16(gelu_tanh(a[0]), gelu_tanh(a[1])); w.y = cvt_pk_bf16(gelu_tanh(a[2]), gelu_tanh(a[3])); w.z = cvt_pk_bf16(gelu_tanh(b[0]), gelu_tanh(b[1])); w.w = cvt_pk_bf16(gelu_tanh(b[2]), gelu_tanh(b[3]));
                    *(v4u*)(AGLU + ((size_t)(b_ * SEQ + chunk * 16 + t)) * SW + 16 * g + c0) = w;
                }
            }
    }
};
__device__ __forceinline__ void s5_scan_bg(Frame& F, int bg, int tid) {
    const bf16* E = (const bf16*)(F.ws + WS_S5E); bf16* ZH = (bf16*)(F.ws + WS_S5ZH);
    LAS bf16* EL = (LAS bf16*)F.lds;
    { v4u ev[17];
      static_assert(S5_ROWS * 32 == 17 * NWAVES * 64, "E block pieces");
#pragma unroll
      for (int k = 0; k < 17; ++k) ev[k] = *(const v4u*)(E + (size_t)bg * S5_ROWS * 256 + (size_t)(tid + k * NWAVES * 64) * 8);
#pragma unroll
      for (int k = 0; k < 17; ++k) *(LAS v4u*)(EL + (tid + k * NWAVES * 64) * 8) = ev[k]; }
    __syncthreads();
    if (tid < 128) {
        const int dir = tid >> 6, p = tid & 63, g = bg & 63;
        float ar = ((const float*)(F.ws + WS_TAB + TAB_AR))[(dir * 64 + g) * 64 + p], ai = ((const float*)(F.ws + WS_TAB + TAB_AI))[(dir * 64 + g) * 64 + p];
#pragma unroll
        for (int k = 0; k < 4; ++k) { const float nr = ar * ar - ai * ai, ni = 2.f * ar * ai; ar = nr; ai = ni; }
        LAS bf16* col = EL + dir * 128 + p;
        float hr = 0.f, hi = 0.f;
        for (int k0 = 0; k0 < S5_ROWS; k0 += 16) {
            float er[16], ei[16], orr[16], oi[16];
#pragma unroll
            for (int j = 0; j < 16; ++j) { const int k = k0 + j, row = dir ? (S5_ROWS - 1 - k) : (k < 16 ? 256 + k : k - 16); er[j] = bflo((unsigned)col[row * 256]); ei[j] = bflo((unsigned)col[row * 256 + 64]); }
#pragma unroll
            for (int j = 0; j < 16; ++j) { orr[j] = hr; oi[j] = hi; const float nr = ar * hr - ai * hi + er[j], ni = ar * hi + ai * hr + ei[j]; hr = nr; hi = ni; }
#pragma unroll
            for (int j = 0; j < 16; ++j) { const int k = k0 + j, row = dir ? (S5_ROWS - 1 - k) : (k < 16 ? 256 + k : k - 16); col[row * 256] = (bf16)f2bf(orr[j]); col[row * 256 + 64] = (bf16)f2bf(oi[j]); }
        }
    }
    __syncthreads();
#pragma unroll
    for (int k = 0; k < 16; ++k) { const int i = tid + k * NWAVES * 64; *(v4u*)(ZH + (size_t)bg * 256 * 256 + (size_t)i * 8) = *(const LAS v4u*)(EL + i * 8); }
    __syncthreads();
}

constexpr int RS_PITCH = 136;
constexpr int RS_BUF = (128 + 32) * RS_PITCH * 2;
__device__ __forceinline__ void phase_rstate(Frame& F) {
    const bf16* KNL = (const bf16*)(F.ws + WS_K); const bf16* KNC = (const bf16*)(F.ws + WS_KFTC);
    const bf16* VT = (const bf16*)(F.ws + WS_VT); const bf16* VTC = (const bf16*)(F.ws + WS_VTC);
    bf16* SIN = (bf16*)(F.ws + WS_OBUF);
    const float* lg2 = (const float*)(F.ws + WS_TAB + TAB_LG2);
    const int lane0 = lane_id();
    const int w = F.wave;
    for (int unit = F.vcu; unit < NB * NH * 2 * 8; unit += F.G) {
        int lane = lane0; asm volatile("" : "+v"(lane));
        const int tid = w * 64 + lane, fr = lane & 15, fq = lane >> 4;
        const int sl = unit & 7, dir = (unit >> 3) & 1, h = (unit >> 4) & 7, b = unit >> 7;
        const float gC = __builtin_amdgcn_exp2f((float)CH * lg2[dir * 8 + h]);
        const int bh = b * NH + h;
        const bf16* kT = KNL; const bf16* kTc = KNC;
        const int prow = tid >> 4, pc = tid & 15;
        float kw[4];
#pragma unroll
        for (int i_ = 0; i_ < 4; ++i_) { const int j = prow + 32 * i_; kw[i_] = __builtin_amdgcn_exp2f((float)(dir ? j : CH - 1 - j) * lg2[dir * 8 + h]); }
        f32x4 st[2] = {{0.f, 0.f, 0.f, 0.f}, {0.f, 0.f, 0.f, 0.f}};
#define RS_ISSUE(k, R) do { if ((k) < 34) { const bf16* kb_; const bf16* vb_; int ls_; \
            if ((k) < 2) { const int cc_ = dir ? (1 - (k)) : (k); ls_ = LC; kb_ = kTc + (size_t)(b * LC + cc_ * CH) * 1024 + h * DK; vb_ = VTC + (size_t)(bh * DV + 32 * sl) * LC + cc_ * CH; } \
            else { const int n_ = dir ? (33 - (k)) : ((k) - 2); ls_ = SEQ; kb_ = kT + (size_t)(b * SEQ + n_ * CH) * 1024 + h * DK; vb_ = VT + (size_t)(bh * DV + 32 * sl) * SEQ + n_ * CH; } \
            _Pragma("unroll") for (int i_ = 0; i_ < 4; ++i_) R[i_] = *(const v4u*)(kb_ + (size_t)(prow + 32 * i_) * 1024 + pc * 8);     \
            R[4] = *(const v4u*)(vb_ + (size_t)prow * ls_ + pc * 8); } } while (0)
#define RS_STEP(k, R) do { LAS bf16* buf_ = (LAS bf16*)(F.lds + ((k) & 1) * RS_BUF); \
            _Pragma("unroll") for (int i_ = 0; i_ < 4; ++i_) { const v4u r_ = R[i_]; const float w_ = kw[i_]; v4u s_; \
                s_.x = cvt_pk_bf16(bflo(r_.x) * w_, bfhi(r_.x) * w_); s_.y = cvt_pk_bf16(bflo(r_.y) * w_, bfhi(r_.y) * w_); s_.z = cvt_pk_bf16(bflo(r_.z) * w_, bfhi(r_.z) * w_); s_.w = cvt_pk_bf16(bflo(r_.w) * w_, bfhi(r_.w) * w_); \
                *(LAS v4u*)(buf_ + (prow + 32 * i_) * RS_PITCH + pc * 8) = s_; } \
            *(LAS v4u*)(buf_ + (128 + prow) * RS_PITCH + pc * 8) = R[4]; } while (0)
#define RS_COMP(k) do { const LAS bf16* buf_ = (const LAS bf16*)(F.lds + ((k) & 1) * RS_BUF); \
            const int n_ = (k) < 2 ? -1 : (dir ? (33 - (k)) : ((k) - 2)); \
            if (n_ >= 0) { _Pragma("unroll") for (int et = 0; et < 2; ++et) { v2u o; o.x = cvt_pk_bf16(st[et][0], st[et][1]); o.y = cvt_pk_bf16(st[et][2], st[et][3]); \
                *(v2u*)(SIN + ((((size_t)(bh * 2 + dir) * NCH + n_) * DV + 32 * sl + 16 * et + fr) * DK + 16 * w + 4 * fq)) = o; } } \
            bf16x8 kf_[4];                         \
            { const unsigned ta_ = (unsigned)(size_t)buf_ + (unsigned)((8 * fq + (fr >> 2)) * (RS_PITCH * 2) + (16 * w + 4 * (fr & 3)) * 2); v2u t0_, t1_, t2_, t3_, t4_, t5_, t6_, t7_; \
              asm volatile("ds_read_b64_tr_b16 %0, %8\n\tds_read_b64_tr_b16 %1, %8 offset:1088\n\tds_read_b64_tr_b16 %2, %8 offset:8704\n\tds_read_b64_tr_b16 %3, %8 offset:9792\n\t" \
                           "ds_read_b64_tr_b16 %4, %8 offset:17408\n\tds_read_b64_tr_b16 %5, %8 offset:18496\n\tds_read_b64_tr_b16 %6, %8 offset:26112\n\tds_read_b64_tr_b16 %7, %8 offset:27200\n\ts_waitcnt lgkmcnt(0)" \
                           : "=&v"(t0_), "=&v"(t1_), "=&v"(t2_), "=&v"(t3_), "=&v"(t4_), "=&v"(t5_), "=&v"(t6_), "=&v"(t7_) : "v"(ta_) : "memory"); \
              kf_[0] = __builtin_bit_cast(bf16x8, (v4u){t0_.x, t0_.y, t1_.x, t1_.y}); kf_[1] = __builtin_bit_cast(bf16x8, (v4u){t2_.x, t2_.y, t3_.x, t3_.y}); \
              kf_[2] = __builtin_bit_cast(bf16x8, (v4u){t4_.x, t4_.y, t5_.x, t5_.y}); kf_[3] = __builtin_bit_cast(bf16x8, (v4u){t6_.x, t6_.y, t7_.x, t7_.y}); } \
            _Pragma("unroll") for (int et = 0; et < 2; ++et) { f32x4 kv = {0.f, 0.f, 0.f, 0.f}; \
                _Pragma("unroll") for (int ks = 0; ks < 4; ++ks) { const bf16x8 vf_ = *(const LAS bf16x8*)(buf_ + (128 + 16 * et + fr) * RS_PITCH + 32 * ks + 8 * fq); kv = __builtin_amdgcn_mfma_f32_16x16x32_bf16(kf_[ks], vf_, kv, 0, 0, 0); } \
                st[et] = st[et] * gC + kv; } } while (0)
        v4u RA[5], RB[5], RC[5];
        RS_ISSUE(0, RA); RS_ISSUE(1, RB);
        for (int k = 0; k < 34; k += 3) {
            RS_ISSUE(k + 2, RC);
            RS_STEP(k, RA); __syncthreads(); RS_COMP(k);
            RS_ISSUE(k + 3, RA);
            if (k + 1 < 34) { RS_STEP(k + 1, RB); __syncthreads(); RS_COMP(k + 1); }
            RS_ISSUE(k + 4, RB);
            if (k + 2 < 34) { RS_STEP(k + 2, RC); __syncthreads(); RS_COMP(k + 2); }
        }
        __syncthreads();
#undef RS_ISSUE
#undef RS_STEP
#undef RS_COMP
    }
}

constexpr int RO_PITCH = 136;
constexpr int RO_SLOT = 256 * RO_PITCH * 2;
__device__ __forceinline__ void phase_rout(Frame& F, const int cid) {
    const bf16* Q = (const bf16*)(F.ws + WS_Q);
    const bf16* KN = (const bf16*)(F.ws + WS_K); const bf16* VT = (const bf16*)(F.ws + WS_VT);
    const bf16* SIN = (const bf16*)(F.ws + WS_OBUF);
    bf16* SG = (bf16*)(F.ws + WS_HBUF);
    const float* lg2 = (const float*)(F.ws + WS_TAB + TAB_LG2);
    LAS bf16* SA = (LAS bf16*)F.lds; LAS bf16* SB = (LAS bf16*)(F.lds + RO_SLOT);
    const int lane0 = lane_id();
    const int w = F.wave;
    const bool split13 = (F.G == 256);
    const int ufirst = split13 ? (cid < 128 ? cid : 128 + (cid - 128) * 3) : F.vcu, ucount = split13 ? (cid < 128 ? 1 : 3) : (NB * NH * NCH - 1 - F.vcu) / F.G + 1, ustep = split13 ? 1 : F.G;
    for (int ui = 0; ui < ucount; ++ui) {
        const int unit = ufirst + ui * ustep;
        int lane = lane0; asm volatile("" : "+v"(lane));
        const int tid = w * 64 + lane, fr = lane & 15, fq = lane >> 4;
        const int n = unit & 31, h = (unit >> 5) & 7, b = unit >> 8, bh = b * NH + h;
        const float lgf = lg2[h], lgb = lg2[8 + h];
        const int tok0 = b * SEQ + n * CH;
        const int i = 16 * w + fr;
        const size_t qoff = (size_t)(tok0 + i) * 1024 + h * DK;
        {
            v4u kr[4], vr[8];
#pragma unroll
            for (int it = 0; it < 4; ++it) { const int q = tid + 512 * it, j = q >> 4, pc = q & 15; kr[it] = __builtin_nontemporal_load((const v4u*)(KN + (size_t)(tok0 + j) * 1024 + h * DK + pc * 8)); }
#pragma unroll
            for (int it = 0; it < 8; ++it) { const int q = tid + 512 * it, e = q >> 4, pc = q & 15; vr[it] = __builtin_nontemporal_load((const v4u*)(VT + ((size_t)(bh * DV + e)) * SEQ + n * CH + pc * 8)); }
#pragma unroll
            for (int it = 0; it < 4; ++it) { const int q = tid + 512 * it, j = q >> 4, pc = q & 15; *(LAS v4u*)(SB + j * RO_PITCH + pc * 8) = kr[it]; }
#pragma unroll
            for (int it = 0; it < 8; ++it) { const int q = tid + 512 * it, e = q >> 4, pc = q & 15; *(LAS v4u*)(SA + e * RO_PITCH + pc * 8) = vr[it]; }
        }
        bf16x8 qf[4];
#pragma unroll
        for (int ks = 0; ks < 4; ++ks) qf[ks] = *(const bf16x8*)(Q + qoff + 32 * ks + 8 * fq);
        __syncthreads();
        f32x4 sc[8];
#pragma unroll
        for (int jt = 0; jt < 8; ++jt) {
            f32x4 a = {0.f, 0.f, 0.f, 0.f};
#pragma unroll
            for (int ks = 0; ks < 4; ++ks) { const bf16x8 kf = *(const LAS bf16x8*)(SB + (16 * jt + fr) * RO_PITCH + 32 * ks + 8 * fq); a = __builtin_amdgcn_mfma_f32_16x16x32_bf16(kf, qf[ks], a, 0, 0, 0); }
#pragma unroll
            for (int r = 0; r < 4; ++r) { const int j = 16 * jt + 4 * fq + r, df = i - j; a[r] *= df >= 0 ? __builtin_amdgcn_exp2f((float)df * lgf) : __builtin_amdgcn_exp2f((float)(-df) * lgb); }
            sc[jt] = a;
        }
        f32x4 o[16];
#pragma unroll
        for (int et = 0; et < 16; ++et) o[et] = (f32x4){0.f, 0.f, 0.f, 0.f};
#pragma unroll
        for (int ks = 0; ks < 4; ++ks) {
            v4u pw; pw.x = cvt_pk_bf16(sc[2 * ks][0], sc[2 * ks][1]); pw.y = cvt_pk_bf16(sc[2 * ks][2], sc[2 * ks][3]); pw.z = cvt_pk_bf16(sc[2 * ks + 1][0], sc[2 * ks + 1][1]); pw.w = cvt_pk_bf16(sc[2 * ks + 1][2], sc[2 * ks + 1][3]);
            const bf16x8 pf = __builtin_bit_cast(bf16x8, pw);
#pragma unroll
            for (int et = 0; et < 16; ++et) {
                const LAS bf16* vp = SA + (16 * et + fr) * RO_PITCH + 32 * ks + 4 * fq;
                const v2u lo = *(const LAS v2u*)vp, hi2 = *(const LAS v2u*)(vp + 16);
                v4u vw; vw.x = lo.x; vw.y = lo.y; vw.z = hi2.x; vw.w = hi2.y;
                o[et] = __builtin_amdgcn_mfma_f32_16x16x32_bf16(__builtin_bit_cast(bf16x8, vw), pf, o[et], 0, 0, 0);
            }
        }
        __syncthreads();
        {
            const bf16* sf = SIN + (((size_t)(bh * 2 + 0) * NCH + n) * DV) * DK; const bf16* sb = SIN + (((size_t)(bh * 2 + 1) * NCH + n) * DV) * DK;
            v4u fr_[8], br_[8];
#pragma unroll
            for (int it = 0; it < 8; ++it) { const int q = tid + 512 * it; fr_[it] = __builtin_nontemporal_load((const v4u*)(sf + (size_t)q * 8)); br_[it] = __builtin_nontemporal_load((const v4u*)(sb + (size_t)q * 8)); }
#pragma unroll
            for (int it = 0; it < 8; ++it) { const int q = tid + 512 * it, e = q >> 4, pc = q & 15; *(LAS v4u*)(SA + e * RO_PITCH + pc * 8) = fr_[it]; *(LAS v4u*)(SB + e * RO_PITCH + pc * 8) = br_[it]; }
        }
        bf16x8 qff[4], qbf[4];
        { const float wfq = __builtin_amdgcn_exp2f((float)(i + 1) * lgf), wbq = __builtin_amdgcn_exp2f((float)(CH - i) * lgb);
#pragma unroll
          for (int ks = 0; ks < 4; ++ks) { const v4u qw = __builtin_bit_cast(v4u, qf[ks]); v4u a, b2;
            a.x = cvt_pk_bf16(bflo(qw.x) * wfq, bfhi(qw.x) * wfq); a.y = cvt_pk_bf16(bflo(qw.y) * wfq, bfhi(qw.y) * wfq); a.z = cvt_pk_bf16(bflo(qw.z) * wfq, bfhi(qw.z) * wfq); a.w = cvt_pk_bf16(bflo(qw.w) * wfq, bfhi(qw.w) * wfq);
            b2.x = cvt_pk_bf16(bflo(qw.x) * wbq, bfhi(qw.x) * wbq); b2.y = cvt_pk_bf16(bflo(qw.y) * wbq, bfhi(qw.y) * wbq); b2.z = cvt_pk_bf16(bflo(qw.z) * wbq, bfhi(qw.z) * wbq); b2.w = cvt_pk_bf16(bflo(qw.w) * wbq, bfhi(qw.w) * wbq);
            qff[ks] = __builtin_bit_cast(bf16x8, a); qbf[ks] = __builtin_bit_cast(bf16x8, b2); } }
        __syncthreads();
#pragma unroll
        for (int ks = 0; ks < 4; ++ks)
#pragma unroll
            for (int et = 0; et < 16; ++et) {
                const bf16x8 s1 = *(const LAS bf16x8*)(SA + (16 * et + fr) * RO_PITCH + 32 * ks + 8 * fq), s2 = *(const LAS bf16x8*)(SB + (16 * et + fr) * RO_PITCH + 32 * ks + 8 * fq);
                o[et] = __builtin_amdgcn_mfma_f32_16x16x32_bf16(s1, qff[ks], o[et], 0, 0, 0);
                o[et] = __builtin_amdgcn_mfma_f32_16x16x32_bf16(s2, qbf[ks], o[et], 0, 0, 0);
            }
        float ss = 0.f;
#pragma unroll
        for (int et = 0; et < 16; ++et) ss += (o[et][0] * o[et][0] + o[et][1] * o[et][1]) + (o[et][2] * o[et][2] + o[et][3] * o[et][3]);
        ss += shfl_xor_l(ss, 16, lane); ss += shfl_xor_l(ss, 32, lane);
        const float rinv = 1.0f / sqrtf(ss * (1.0f / DV) + EPS);
        bf16* gp = SG + (size_t)(tok0 + i) * D + h * DV + 4 * fq;
#pragma unroll
        for (int et = 0; et < 16; ++et) { const v2u gg = __builtin_nontemporal_load((const v2u*)(gp + 16 * et));
            v2u ow; ow.x = cvt_pk_bf16(o[et][0] * rinv * bflo(gg.x), o[et][1] * rinv * bfhi(gg.x)); ow.y = cvt_pk_bf16(o[et][2] * rinv * bflo(gg.y), o[et][3] * rinv * bfhi(gg.y));
            *(v2u*)(gp + 16 * et) = ow; }
        __syncthreads();
    }
}

__global__ void __launch_bounds__(NWAVES * 64, 2) fwd_megakernel(Args args) {
    extern __shared__ __attribute__((aligned(16))) unsigned char lds[];
    Frame F;
    F.lds = (LAS unsigned char*)lds;
    F.MISC = (volatile LAS unsigned*)(F.lds + MISC_OFF);
    F.wave = __builtin_amdgcn_readfirstlane((int)threadIdx.x >> 6);
    F.G = gridDim.x; { const int bx = blockIdx.x; F.vcu = (F.G % 8 == 0) ? (bx % 8) * (F.G / 8) + bx / 8 : bx; }
    F.out = kargs()->out; F.ws = kargs()->ws; F.ctl = (unsigned*)(F.ws + WS_CTL);
    for (int u = (int)threadIdx.x; u < (LDS_BYTES - LDSCTL_OFF) / 4; u += NWAVES * 64) ((LAS unsigned*)(F.lds + LDSCTL_OFF))[u] = 0u;
    __syncthreads();
    XcdBarrier bar = xcd_barrier_post(F.ctl + CW_BAR, F.MISC + 8);
    unsigned char* ws = F.ws;
    const int G = F.G, cid = (int)blockIdx.x;
#define GRID_BAR() xcd_barrier(bar)

#ifndef PHM
#define PHM 0xFFFFF
#endif
#define PH(k) ((PHM >> (k)) & 1)
#ifndef REPM
#define REPM 0
#endif
#define NREP(k) (1 + ((REPM >> (k)) & 1))
#if PH(0)
    phase_prologue(F, args, true);
#if NREP(0) > 1
    phase_prologue(F, args, false);
#endif
#endif
    GRID_BAR();
#if PH(1)
    phase_rows<0>(F, args);
    build_modv(F, args);
    s5_tables1(F, args);
#endif
    GRID_BAR();
#if PH(2)
    {
        pg8::GridOrder S; S.init(ws + WS_ABUF, ws + WS_W1T, D, MT / 256, NFF / 256, G, cid);
        EpiSwiGLU E{(bf16*)(ws + WS_HBUF)};
        pg8::gemm_phase(F.lds, D, S, E, F.wave);
    }
    if (G == 256 && cid >= 256 - CV_G1_CUS) conv_range(F, 1, 0, CV_L1_G1, (cid - (256 - CV_G1_CUS)) * NWAVES + F.wave, CV_G1_CUS * NWAVES);
#if NREP(2) > 1
    {
        pg8::GridOrder S; S.init(ws + WS_ABUF, ws + WS_W1T, D, MT / 256, NFF / 256, G, cid);
        EpiSwiGLU E{(bf16*)(ws + WS_HBUF)};
        pg8::gemm_phase(F.lds, D, S, E, F.wave);
    }
#endif
#endif
    GRID_BAR();
#if PH(3)
    {
        Ffn1DownOrder S{(const char*)(ws + WS_HBUF), (const char*)(ws + WS_W2T), G, cid};
        EpiFfn1Down E{(bf16*)(ws + WS_OBUF), (float*)(ws + WS_SLAB)};
        pg8::gemm_phase(F.lds, DFF, S, E, F.wave);
    }
    if (G == 256 && cid >= 256 - CV_G2_CUS) conv_range(F, 1, CV_L1_G1, CV_L1_G1 + CV_L1_G2, (cid - (256 - CV_G2_CUS)) * NWAVES + F.wave, CV_G2_CUS * NWAVES);
#if NREP(3) > 1
    {
        pg8::GridOrder S; S.init(ws + WS_HBUF, ws + WS_W2T, DFF, MT / 256, D / 256, G, cid);
        EpiO16 E{(bf16*)(ws + WS_OBUF), D};
        pg8::gemm_phase(F.lds, DFF, S, E, F.wave);
    }
#endif
#endif
    GRID_BAR();
#if PH(4)
    phase_rows<1>(F, args);
    s5_tables2(F, args);
#endif
    GRID_BAR();
#if PH(5)
    {
        MixOrder S{(const char*)(ws + WS_ABUF), (const char*)(ws + WS_WMT), G, cid};
        EpiMix E{ws};
        pg8::gemm_phase(F.lds, D, S, E, F.wave);
    }
    if (G == 256 && cid >= 256 - CV_G3_CUS) conv_range(F, 2, 0, CV_L2_G3, (cid - (256 - CV_G3_CUS)) * NWAVES + F.wave, CV_G3_CUS * NWAVES);
#if NREP(5) > 1
    {
        MixOrder S{(const char*)(ws + WS_ABUF), (const char*)(ws + WS_WMT), G, cid};
        EpiMix E{ws};
        pg8::gemm_phase(F.lds, D, S, E, F.wave);
    }
#endif
#endif
    GRID_BAR();
#if PH(6)
    phase_rstate(F);
#if NREP(6) > 1
    phase_rstate(F);
#endif
#endif
#if PH(7)
    {
        S5EOrder S{(const char*)(ws + WS_US), (const char*)(ws + WS_S5WE), G, cid};
        EpiS5E E{(bf16*)(ws + WS_S5E)};
        pg8::gemm_phase(F.lds, 256, S, E, F.wave);
    }
#endif
    GRID_BAR();
#if PH(8)
    {
        int tid_ = F.wave * 64 + lane_id(); asm volatile("" : "+v"(tid_));
        for (int bg = cid; bg < NB * 64; bg += G) s5_scan_bg(F, bg, tid_);
        asm volatile("s_waitcnt vmcnt(0)" ::: "memory"); __syncthreads();
        S5YOrder S{(const char*)(ws + WS_US), (const char*)(ws + WS_S5ZH), (const char*)(ws + WS_S5WY1), (const char*)(ws + WS_S5WY2), G, cid};
        EpiS5Y E{(bf16*)(ws + WS_AGLU)};
        pg8::gemm_phase(F.lds, 256, S, E, F.wave);
    }
    phase_rout(F, cid);
#endif
    GRID_BAR();
#if PH(9)
    {
        pg8::GridOrder S; S.init(ws + WS_AGLU, ws + WS_WGT, SW, MX / 256, 2 * D / 256, G, cid);
        EpiGLU E{(const bf16*)(ws + WS_HBUF + 32 * MiB), (bf16*)(ws + WS_Q)};
        pg8::gemm_phase(F.lds, SW, S, E, F.wave);
    }
#if NREP(9) > 1
    {
        pg8::GridOrder S; S.init(ws + WS_AGLU, ws + WS_WGT, SW, MX / 256, 2 * D / 256, G, cid);
        EpiGLU E{(const bf16*)(ws + WS_HBUF + 32 * MiB), (bf16*)(ws + WS_Q)};
        pg8::gemm_phase(F.lds, SW, S, E, F.wave);
    }
#endif
#endif
    GRID_BAR();
#if PH(10)
    {
        pg8::GridOrder S; S.init(ws + WS_HBUF, ws + WS_WPT, D, MX / 256, D / 256, G, cid);
        EpiMerge E{(const bf16*)(ws + WS_HBUF + 64 * MiB), (bf16*)(ws + WS_Q)};
        pg8::gemm_phase(F.lds, D, S, E, F.wave);
    }
#if NREP(10) > 1
    {
        pg8::GridOrder S; S.init(ws + WS_HBUF, ws + WS_WPT, D, MX / 256, D / 256, G, cid);
        EpiMerge E{(const bf16*)(ws + WS_HBUF + 64 * MiB), (bf16*)(ws + WS_Q)};
        pg8::gemm_phase(F.lds, D, S, E, F.wave);
    }
#endif
#endif
    GRID_BAR();
#if PH(11)
    {
        pg8::GridOrder S; S.init(ws + WS_Q, ws + WS_WOT, D, MX / 256, D / 256, G, cid);
        EpiO16 E{(bf16*)(ws + WS_OBUF), D};
        pg8::gemm_phase(F.lds, D, S, E, F.wave);
    }
#if NREP(11) > 1
    {
        pg8::GridOrder S; S.init(ws + WS_Q, ws + WS_WOT, D, MX / 256, D / 256, G, cid);
        EpiO16 E{(bf16*)(ws + WS_OBUF), D};
        pg8::gemm_phase(F.lds, D, S, E, F.wave);
    }
#endif
#endif
    GRID_BAR();
#if PH(12)
    phase_rows<2>(F, args);
#if NREP(12) > 1
    phase_rows<2>(F, args);
#endif
#endif
    GRID_BAR();
#if PH(13)
    {
        pg8::GridOrder S; S.init(ws + WS_ABUF, ws + WS_W3T, D, MX / 256, NFF / 256, G, cid);
        EpiSwiGLU E{(bf16*)(ws + WS_HBUF)};
        pg8::gemm_phase(F.lds, D, S, E, F.wave);
    }
#if NREP(13) > 1
    {
        pg8::GridOrder S; S.init(ws + WS_ABUF, ws + WS_W3T, D, MX / 256, NFF / 256, G, cid);
        EpiSwiGLU E{(bf16*)(ws + WS_HBUF)};
        pg8::gemm_phase(F.lds, D, S, E, F.wave);
    }
#endif
#endif
    GRID_BAR();
#if PH(14)
    {
        pg8::GridOrder S; S.init(ws + WS_HBUF, ws + WS_W4T, DFF, MX / 256, D / 256, G, cid);
        EpiO16 E{(bf16*)(ws + WS_OBUF), D};
        pg8::gemm_phase(F.lds, DFF, S, E, F.wave);
    }
#if NREP(14) > 1
    {
        pg8::GridOrder S; S.init(ws + WS_HBUF, ws + WS_W4T, DFF, MX / 256, D / 256, G, cid);
        EpiO16 E{(bf16*)(ws + WS_OBUF), D};
        pg8::gemm_phase(F.lds, DFF, S, E, F.wave);
    }
#endif
#endif
    GRID_BAR();
#if PH(15)
    phase_rows<3>(F, args);
#if NREP(15) > 1
    phase_rows<3>(F, args);
#endif
#endif
}

extern "C" void kernel_launch(void* const* d_in, const int* in_sizes, int n_in, void* d_out, int out_size, void* d_ws, size_t ws_size, hipStream_t stream) {
    static int grid = 0;
    if (grid == 0) {
        if (n_in != 22 || in_sizes[0] != MX * D || out_size != MX * D || ws_size < WS_END) { fprintf(stderr, "kernel_launch: unexpected problem (n_in %d, in0 %d, out %d, ws %zu, need %zu)\n", n_in, n_in > 0 ? in_sizes[0] : -1, out_size, ws_size, (size_t)WS_END); grid = -1; return; }
        int dev = 0, cus = 0, per_cu = 0;
        if (hipGetDevice(&dev) != hipSuccess || hipDeviceGetAttribute(&cus, hipDeviceAttributeMultiprocessorCount, dev) != hipSuccess) { grid = -1; return; }
        if (hipFuncSetAttribute((const void*)fwd_megakernel, hipFuncAttributeMaxDynamicSharedMemorySize, LDS_BYTES) != hipSuccess) { fprintf(stderr, "kernel_launch: hipFuncSetAttribute failed\n"); grid = -1; return; }
        if (hipOccupancyMaxActiveBlocksPerMultiprocessor(&per_cu, (const void*)fwd_megakernel, NWAVES * 64, LDS_BYTES) != hipSuccess || per_cu < 1) { fprintf(stderr, "kernel_launch: occupancy query says %d blocks per CU\n", per_cu); grid = -1; (void)hipGetLastError(); return; }
        grid = cus;
    }
    if (grid < 0) return;
    if (hipMemsetAsync((char*)d_ws + WS_CTL, 0, CTL_ZERO_BYTES, stream) != hipSuccess) return;
    Args a{};
    for (int i = 0; i < 22; ++i) a.in[i] = (const float*)d_in[i];
    a.out = (float*)d_out; a.ws = (unsigned char*)d_ws;
    void* kargs[] = {&a};
    hipError_t e = hipLaunchCooperativeKernel((const void*)fwd_megakernel, dim3(grid), dim3(NWAVES * 64), kargs, LDS_BYTES, stream);
    if (e != hipSuccess) fprintf(stderr, "kernel_launch: cooperative launch failed: %s (grid %d)\n", hipGetErrorString(e), grid);
}
```

```cpp
#include <hip/hip_runtime.h>
#include <cstdio>
#include <cstdint>

#define GAS __attribute__((address_space(1)))
#define LAS __attribute__((address_space(3)))
typedef unsigned short bf16;
typedef unsigned v4u __attribute__((ext_vector_type(4)));
typedef unsigned v2u __attribute__((ext_vector_type(2)));
typedef float f32x4 __attribute__((ext_vector_type(4)));
typedef float f32x2 __attribute__((ext_vector_type(2)));
typedef short bf16x8 __attribute__((ext_vector_type(8)));
typedef short bf16x4 __attribute__((ext_vector_type(4)));

constexpr int D = 2048, NB = 2, SEQ = 4096, MX = NB * SEQ, LC = 256, MC = NB * LC, MT = MX + MC;
constexpr int DFF = 5632, NFF = 2 * DFF, SW = 1024, NMIX = 11264, NH = 8, DK = 128, DV = 256, CH = 128, NCH = SEQ / CH;
constexpr int NADA = 9 * D;
constexpr float EPS = 1e-6f;
constexpr int NWAVES = 8;

constexpr size_t MiB = 1u << 20;
constexpr size_t WS_CTL = 0, CTL_ZERO_BYTES = 1 * MiB;
constexpr size_t WS_W1T = 1 * MiB, WS_W2T = 45 * MiB, WS_WMT = 67 * MiB, WS_WGT = 115 * MiB, WS_WPT = 123 * MiB, WS_WOT = 131 * MiB, WS_W3T = 139 * MiB, WS_W4T = 183 * MiB;
constexpr size_t WS_ABUF = 205 * MiB;
constexpr size_t WS_HBUF = 239 * MiB;
constexpr size_t WS_OBUF = 335 * MiB;
constexpr size_t WS_US = 403 * MiB;
constexpr size_t WS_Q = 420 * MiB, WS_QF = 436 * MiB, WS_QB = 452 * MiB;
constexpr size_t WS_K = 468 * MiB;
constexpr size_t WS_KFT = 484 * MiB, WS_KBT = 500 * MiB, WS_KFTC = 516 * MiB, WS_KBTC = 517 * MiB;
constexpr size_t WS_STREAM = WS_KFT;
constexpr size_t WS_VT = 518 * MiB, WS_VTC = 550 * MiB;
constexpr size_t WS_YF = 552 * MiB;
constexpr size_t WS_S5WE = WS_YF, WS_S5WY1 = WS_YF + 8 * MiB, WS_S5WY2 = WS_YF + 16 * MiB, WS_S5KT = WS_YF + 24 * MiB, WS_S5BRF = WS_YF + 26 * MiB, WS_S5APOW = WS_YF + 28 * MiB;
constexpr size_t WS_S5E = WS_ABUF, WS_S5ZH = WS_ABUF + 17 * MiB;
constexpr int S5_ROWS = 272;
constexpr size_t WS_AGLU = 584 * MiB;
constexpr size_t WS_TAB = 600 * MiB;
constexpr size_t WS_END = 602 * MiB;
constexpr size_t TAB_ROPE = 0, TAB_LG2 = 16384, TAB_AR = 32768, TAB_AI = 65536, TAB_END = 131072;
constexpr size_t TAB_MODV = 262144;
constexpr int CW_BAR = 4096;
constexpr size_t CTL_ADA = 65536;

#define RLX_AGENT __ATOMIC_RELAXED, __HIP_MEMORY_SCOPE_AGENT
#define LDS_WAIT() asm volatile("s_waitcnt lgkmcnt(0)" ::: "memory")
#define VM_WAIT() asm volatile("s_waitcnt vmcnt(0)" ::: "memory")

__device__ __forceinline__ unsigned f2bf(float f) { unsigned u = __builtin_bit_cast(unsigned, f); return (u + 0x7fffu + ((u >> 16) & 1u)) >> 16; }
__device__ __forceinline__ unsigned pk2(float lo, float hi) { return f2bf(lo) | (f2bf(hi) << 16); }
__device__ __forceinline__ unsigned cvt_pk_bf16(float lo, float hi) { unsigned r; asm volatile("v_cvt_pk_bf16_f32 %0, %1, %2" : "=v"(r) : "v"(lo), "v"(hi)); return r; }
__device__ __forceinline__ float bflo(unsigned w) { return __builtin_bit_cast(float, w << 16); }
__device__ __forceinline__ float bfhi(unsigned w) { return __builtin_bit_cast(float, w & 0xffff0000u); }
__device__ __forceinline__ float fast_sigmoid(float x) { return __builtin_amdgcn_rcpf(1.0f + __builtin_amdgcn_exp2f(-1.4426950408889634f * x)); }
__device__ __forceinline__ float fast_silu(float x) { return x * fast_sigmoid(x); }
__device__ __forceinline__ float gelu_tanh(float x) { const float u = 0.7978845608028654f * (x + 0.044715f * x * x * x); return x * fast_sigmoid(2.0f * u); }
__device__ __forceinline__ int lane_id() { return (int)__builtin_amdgcn_mbcnt_hi(~0u, __builtin_amdgcn_mbcnt_lo(~0u, 0u)); }
__device__ __forceinline__ float shfl_xor_l(float v, int mask, int lane) { return __builtin_bit_cast(float, __builtin_amdgcn_ds_bpermute((lane ^ mask) << 2, __builtin_bit_cast(int, v))); }
__device__ __forceinline__ float wave_sum(float v, int lane) {
#pragma unroll
    for (int o = 1; o < 64; o <<= 1) v += shfl_xor_l(v, o, lane);
    return v;
}

#define XB_TMO      128
#define XB_XCNT(j)  (256  + 64 * (j))
#define XB_XSUB(j)  (1280 + 64 * (j))
#define XB_XGEN(j)  (2304 + 64 * (j))
#define XB_TOP      3328
#define XB_TOPGEN   3392
#define XCD_BAR_WORDS 3456
#define XB_SPIN_CAP (1u << 18)
__device__ __forceinline__ unsigned xb_ld(unsigned* p)              { return __hip_atomic_load(p, __ATOMIC_RELAXED, __HIP_MEMORY_SCOPE_AGENT); }
__device__ __forceinline__ unsigned xb_add(unsigned* p, unsigned v) { return __hip_atomic_fetch_add(p, v, __ATOMIC_RELAXED, __HIP_MEMORY_SCOPE_AGENT); }
__device__ __forceinline__ unsigned xb_xcc_id() { return (unsigned)__builtin_amdgcn_s_getreg((3 << 11) | 20) & 0xFu; }
#define XB_SPIN(cond, bar) do { unsigned _sp = 0; while (cond) { __builtin_amdgcn_s_sleep(1); \
    if ((++_sp & 255u) == 0u) { if (xb_ld(&(bar)[XB_TMO])) break; if (_sp > XB_SPIN_CAP) { atomicAdd(&(bar)[XB_TMO], 1u); break; } } } } while (0)
struct XcdBarrier { unsigned* bar; unsigned x; volatile LAS unsigned* st; };
__device__ __forceinline__ XcdBarrier xcd_barrier_post(unsigned* bar, volatile LAS unsigned* st) {
    XcdBarrier b; b.bar = bar; b.x = xb_xcc_id(); b.st = st;
    if (threadIdx.x == 0) (void)xb_add(&bar[XB_XCNT(b.x)], 1u);
    return b;
}
__device__ __forceinline__ void xcd_barrier_complete(unsigned* bar, unsigned x, unsigned& nloc, unsigned& nx) {
    const unsigned G = gridDim.x * gridDim.y * gridDim.z;
    unsigned sum, cnt, mine, sp = 0u;
    for (;;) {
        sum = 0u; cnt = 0u; mine = 0u;
#pragma unroll
        for (unsigned j = 0; j < 16; ++j) { const unsigned c = xb_ld(&bar[XB_XCNT(j)]); sum += c; cnt += (c > 0u) ? 1u : 0u; mine = (j == x) ? c : mine; }
        if (sum == G) break;
        __builtin_amdgcn_s_sleep(1);
        if ((++sp & 255u) == 0u) { if (xb_ld(&bar[XB_TMO])) break; if (sp > XB_SPIN_CAP) { atomicAdd(&bar[XB_TMO], 1u); break; } }
    }
    nloc = mine > 0u ? mine : 1u; nx = cnt > 0u ? cnt : 1u;
}
__device__ __forceinline__ void xcd_barrier(const XcdBarrier& b) {
    asm volatile("s_waitcnt vmcnt(0)" ::: "memory");
    __syncthreads();
    if (threadIdx.x == 0) {
        unsigned* bar = b.bar;
        __builtin_amdgcn_s_waitcnt(0);
        unsigned nloc = b.st[0], nx = b.st[1];
        if (nloc == 0u) { xcd_barrier_complete(bar, b.x, nloc, nx); b.st[0] = nloc; b.st[1] = nx; }
        const unsigned old = xb_add(&bar[XB_XSUB(b.x)], 1u);
        const unsigned gen = old / nloc;
        if (old + 1u == (gen + 1u) * nloc) {
            __builtin_amdgcn_fence(__ATOMIC_RELEASE, "agent");
            asm volatile("s_waitcnt vmcnt(0)" ::: "memory");
            const unsigned og = xb_add(&bar[XB_TOP], 1u);
            const unsigned tg = og / nx;
            if (og + 1u == (tg + 1u) * nx) xb_add(&bar[XB_TOPGEN], 1u);
            else XB_SPIN(xb_ld(&bar[XB_TOPGEN]) == tg, bar);
            __builtin_amdgcn_fence(__ATOMIC_ACQUIRE, "agent");
            xb_add(&bar[XB_XGEN(b.x)], 1u);
            asm volatile("s_waitcnt vmcnt(0)" ::: "memory");
        } else {
            XB_SPIN(xb_ld(&bar[XB_XGEN(b.x)]) == gen, bar);
            __builtin_amdgcn_fence(__ATOMIC_ACQUIRE, "agent");
            asm volatile("s_waitcnt vmcnt(0)" ::: "memory");
        }
    }
    __syncthreads();
}

namespace pg8 {
constexpr int BM = 256, BK = 64, HALF = 128, HTB = HALF * BK * 2, STAGE_BYTES = 8 * HTB, NXCD = 8;
__device__ __forceinline__ int lds_byte(int r, int c) { const int st = (r >> 4) * 2 + (c >> 5), rr = r & 15, cc = c & 31, ob = rr * 64 + cc * 2; return st * 1024 + (ob ^ (((ob >> 9) & 1) << 5)); }
__device__ __forceinline__ void stage_rc(int b, int& R, int& C) { const int st = b / 1024, sb = b % 1024, swz = sb ^ (((sb >> 9) & 1) << 5); R = (st >> 1) * 16 + swz / 64; C = (st & 1) * 32 + (swz % 64) / 2; }
__device__ __forceinline__ int perm32(int rho) { const int n = rho >> 4, i = rho & 15; return 8 * (i >> 2) + 4 * n + (i & 3); }

struct Unit {
    const char* A; const char* B; unsigned info;
    __device__ __forceinline__ int pm() const { return (int)(info & 255u); }
    __device__ __forceinline__ int pn() const { return (int)((info >> 8) & 255u); }
    __device__ __forceinline__ int kind() const { return (int)((info >> 16) & 15u); }
    __device__ __forceinline__ int nt() const { return (int)((info >> 20) & 255u); }
    __device__ __forceinline__ int cont() const { return (int)((info >> 28) & 1u); }
};
__device__ __forceinline__ Unit make_unit(const char* A, const char* B, int pm, int pn, int kind, int nt, int cont) { return Unit{A, B, (unsigned)pm | ((unsigned)pn << 8) | ((unsigned)kind << 16) | ((unsigned)nt << 20) | ((unsigned)cont << 28)}; }
__device__ __forceinline__ int xcd_remap(int L, int nwg) { const int q = nwg / NXCD, r = nwg % NXCD, xcd = L % NXCD, off = L / NXCD; return (xcd < r ? xcd * (q + 1) : r * (q + 1) + (xcd - r) * q) + off; }

template <class Epi, class Sched>
__device__ __forceinline__ void gemm_phase(LAS unsigned char* lds, const int K, const Sched& S, const Epi& E, const int wave_) {
    int tid = wave_ * 64 + lane_id(); asm volatile("" : "+v"(tid));
    const int wid = wave_, lane = tid & 63, wr = wid >> 2, wc = wid & 3, fr = lane & 15, fq = lane >> 4;
    unsigned voffA[2], voffB[2];
#pragma unroll
    for (int i = 0; i < 2; ++i) { int R, C; stage_rc(tid * 16 + i * 8192, R, C); const int Rb = (R & ~31) + perm32(R & 31);
        voffA[i] = (unsigned)(R * K + C) * 2u; voffB[i] = (unsigned)(Rb * K + C) * 2u; }
    const size_t kstep = (size_t)(BK * 2);
    const size_t hstep = (size_t)HALF * K * 2;
    const unsigned ldsw = (unsigned)wid * 1024u;
    const int aoff = lds_byte(wr * 64 + fr, fq * 8), boff = lds_byte(wc * 32 + fr, fq * 8);
#define PG8_SA(b, h) (((b) * 2 + (h)) * HTB)
#define PG8_SB(b, h) ((4 + (b) * 2 + (h)) * HTB)
#define PG8_STAGE(bufoff, gbase, voff) do { _Pragma("unroll") for (int _i = 0; _i < 2; ++_i) \
        __builtin_amdgcn_global_load_lds((const unsigned*)((const char*)(gbase) + (voff)[_i]), (LAS unsigned*)(lds + (bufoff) + ldsw + _i * 8192), 16, 0, 0); } while (0)
#define PG8_LDA(dst, b, h) do { _Pragma("unroll") for (int m = 0; m < 4; ++m) _Pragma("unroll") for (int k = 0; k < 2; ++k) dst[m][k] = *(const LAS bf16x8*)(lds + PG8_SA(b, h) + aoff + m * 2048 + k * 1024); } while (0)
#define PG8_LDB(dst, b, h) do { _Pragma("unroll") for (int n = 0; n < 2; ++n) _Pragma("unroll") for (int k = 0; k < 2; ++k) dst[n][k] = *(const LAS bf16x8*)(lds + PG8_SB(b, h) + boff + n * 2048 + k * 1024); } while (0)
#define PG8_MMA(ai, bj, At, Bt) do { __builtin_amdgcn_s_setprio(1); _Pragma("unroll") for (int m = 0; m < 4; ++m) _Pragma("unroll") for (int n = 0; n < 2; ++n) _Pragma("unroll") for (int k = 0; k < 2; ++k) \
        acc[ai][bj][m][n] = __builtin_amdgcn_mfma_f32_16x16x32_bf16(Bt[n][k], At[m][k], acc[ai][bj][m][n], 0, 0, 0); __builtin_amdgcn_s_setprio(0); } while (0)
#define PG8_WAIT_V(n) asm volatile("s_waitcnt vmcnt(" #n ")" ::: "memory")
#define PG8_WAIT_L(n) asm volatile("s_waitcnt lgkmcnt(" #n ")" ::: "memory")
#define PG8_BAR __builtin_amdgcn_s_barrier()
#define PG8_SCHED __builtin_amdgcn_sched_barrier(0)
    Unit cur, nxt; int ui = 0;
    if (!S.next(0, cur)) return;
    f32x4 acc[2][2][4][2];
#pragma unroll
    for (int a = 0; a < 2; ++a)
#pragma unroll
        for (int b = 0; b < 2; ++b)
#pragma unroll
            for (int m = 0; m < 4; ++m)
#pragma unroll
                for (int n = 0; n < 2; ++n) acc[a][b][m][n] = (f32x4){0.f, 0.f, 0.f, 0.f};
    bf16x8 At[4][2], B0[2][2], B1[2][2];
    const char* cA = cur.A; const char* cB = cur.B;
    PG8_STAGE(PG8_SB(0, 0), cB, voffB); PG8_STAGE(PG8_SB(0, 1), cB + hstep, voffB); PG8_STAGE(PG8_SA(0, 0), cA, voffA); PG8_STAGE(PG8_SA(0, 1), cA + hstep, voffA);
    if (wr == 1) PG8_BAR;
    PG8_WAIT_V(2); PG8_BAR;
    PG8_STAGE(PG8_SB(1, 0), cB + kstep, voffB); PG8_STAGE(PG8_SA(1, 0), cA + kstep, voffA); PG8_STAGE(PG8_SB(1, 1), cB + hstep + kstep, voffB);
    PG8_WAIT_V(6); PG8_BAR;
    for (;;) {
        const bool has_next = S.next(ui + 1, nxt);
        const char* nA = has_next ? nxt.A : cA; const char* nB = has_next ? nxt.B : cB;
        const int nt = cur.nt();
        for (int t = 0; t < nt; t += 2) {
            const bool last = (t == nt - 2);
            const char* a1 = cA + (size_t)(t + 1) * kstep;
            const char* a2 = last ? nA : cA + (size_t)(t + 2) * kstep; const char* b2 = last ? nB : cB + (size_t)(t + 2) * kstep;
            const char* a3 = a2 + kstep; const char* b3 = b2 + kstep;
            PG8_LDB(B0, 0, 0); PG8_LDB(B1, 0, 1); PG8_SCHED; PG8_LDA(At, 0, 0); PG8_STAGE(PG8_SA(1, 1), a1 + hstep, voffA);
            PG8_WAIT_V(8); PG8_WAIT_L(0); PG8_BAR; PG8_MMA(0, 0, At, B0); PG8_MMA(0, 1, At, B1); PG8_BAR; PG8_SCHED;
            PG8_LDA(At, 0, 1); PG8_STAGE(PG8_SB(0, 0), b2, voffB); PG8_STAGE(PG8_SB(0, 1), b2 + hstep, voffB); PG8_STAGE(PG8_SA(0, 0), a2, voffA);
            PG8_WAIT_V(8); PG8_WAIT_L(0); PG8_BAR; PG8_MMA(1, 0, At, B0); PG8_MMA(1, 1, At, B1); PG8_BAR; PG8_SCHED;
            PG8_LDB(B0, 1, 0); PG8_LDB(B1, 1, 1); PG8_SCHED; PG8_LDA(At, 1, 0); PG8_STAGE(PG8_SA(0, 1), a2 + hstep, voffA);
            PG8_WAIT_V(8); PG8_WAIT_L(0); PG8_BAR; PG8_MMA(0, 0, At, B0); PG8_MMA(0, 1, At, B1); PG8_BAR; PG8_SCHED;
            PG8_LDA(At, 1, 1); PG8_STAGE(PG8_SB(1, 0), b3, voffB); PG8_STAGE(PG8_SB(1, 1), b3 + hstep, voffB); PG8_STAGE(PG8_SA(1, 0), a3, voffA);
            PG8_WAIT_V(8); PG8_WAIT_L(0); PG8_BAR; PG8_MMA(1, 0, At, B0); PG8_MMA(1, 1, At, B1); PG8_BAR; PG8_SCHED;
        }
        if (wr == 0) PG8_BAR;
        if (!cur.cont()) E(acc, cur, wr, wc, fr, fq);
        if (!has_next) break;
        if (!cur.cont()) {
#pragma unroll
        for (int a = 0; a < 2; ++a)
#pragma unroll
            for (int b = 0; b < 2; ++b)
#pragma unroll
                for (int m = 0; m < 4; ++m)
#pragma unroll
                    for (int n = 0; n < 2; ++n) acc[a][b][m][n] = (f32x4){0.f, 0.f, 0.f, 0.f};
        }
        cur = nxt; cA = nA; cB = nB; ++ui;
        if (wr == 1) PG8_BAR;
    }
    PG8_WAIT_V(0);
    PG8_BAR;
#undef PG8_SA
#undef PG8_SB
#undef PG8_STAGE
#undef PG8_LDA
#undef PG8_LDB
#undef PG8_MMA
#undef PG8_WAIT_V
#undef PG8_WAIT_L
#undef PG8_BAR
#undef PG8_SCHED
}

struct GridOrder {
    const char* A; const char* B; size_t tstep; int nM, nN, nwg, G, c, nt;
    __device__ __forceinline__ void init(const void* A_, const void* B_, int K, int nM_, int nN_, int G_, int c_) { A = (const char*)A_; B = (const char*)B_; tstep = (size_t)BM * K * 2; nM = nM_; nN = nN_; nwg = nM * nN; G = G_; c = c_; nt = K / BK; }
    __device__ __forceinline__ bool next(int i, Unit& u) const {
        const long L = (long)i * G + c; if (L >= nwg) return false;
        int wgid;
        if ((nwg & 63) == 0 && (nM & 7) == 0) {
            const int q = nwg >> 3, xcd = (int)L & 7, off = (int)L >> 3, blk = off >> 6;
            int o2 = off;
            if (blk < (q >> 6)) { const int rem = off & 63, half = rem >> 5, j = rem & 31; o2 = (blk << 6) + ((j >> 2) << 3) + half * 4 + (j & 3); }
            wgid = xcd * q + o2;
        } else wgid = xcd_remap((int)L, nwg);
        const int nig = 8 * nN, gid = wgid / nig, fm = gid * 8, gsz = (nM - fm) < 8 ? (nM - fm) : 8;
        const int pm = fm + ((wgid % nig) % gsz), pn = (wgid % nig) / gsz;
        u = make_unit(A + (size_t)pm * tstep, B + (size_t)pn * tstep, pm, pn, 0, nt, 0); return true;
    }
};
}

typedef f32x4 Acc[2][2][4][2];
struct EpiSwiGLU {
    bf16* Hid;
    __device__ __forceinline__ void operator()(const Acc& acc, const pg8::Unit& u, int wr, int wc, int fr0, int fq0) const {
        int fr = fr0, fq = fq0; asm volatile("" : "+v"(fr), "+v"(fq));
        const int row0 = u.pm() * 256 + wr * 64 + fr, col0 = u.pn() * 128 + wc * 32 + 8 * fq;
#pragma unroll
        for (int ai = 0; ai < 2; ++ai)
#pragma unroll
            for (int m = 0; m < 4; ++m) {
                float v[8];
#pragma unroll
                for (int n = 0; n < 2; ++n)
#pragma unroll
                    for (int j = 0; j < 4; ++j) v[4 * n + j] = fast_silu(acc[ai][0][m][n][j]) * acc[ai][1][m][n][j];
                v4u w; w.x = cvt_pk_bf16(v[0], v[1]); w.y = cvt_pk_bf16(v[2], v[3]); w.z = cvt_pk_bf16(v[4], v[5]); w.w = cvt_pk_bf16(v[6], v[7]);
                *(v4u*)(Hid + (size_t)(row0 + ai * 128 + m * 16) * DFF + col0) = w;
            }
    }
};
struct EpiO16 {
    bf16* C; int ldc;
    __device__ __forceinline__ void operator()(const Acc& acc, const pg8::Unit& u, int wr, int wc, int fr0, int fq0) const {
        int fr = fr0, fq = fq0; asm volatile("" : "+v"(fr), "+v"(fq));
        const int row0 = u.pm() * 256 + wr * 64 + fr, col0 = u.pn() * 256 + wc * 32 + 8 * fq;
#pragma unroll
        for (int ai = 0; ai < 2; ++ai)
#pragma unroll
            for (int m = 0; m < 4; ++m) { bf16* rowp = C + (size_t)(row0 + ai * 128 + m * 16) * ldc + col0;
#pragma unroll
                for (int bj = 0; bj < 2; ++bj) { const f32x4 a = acc[ai][bj][m][0], b = acc[ai][bj][m][1];
                    v4u w; w.x = cvt_pk_bf16(a[0], a[1]); w.y = cvt_pk_bf16(a[2], a[3]); w.z = cvt_pk_bf16(b[0], b[1]); w.w = cvt_pk_bf16(b[2], b[3]);
                    *(v4u*)(rowp + bj * 128) = w; } }
    }
};
struct EpiGLU {
    const bf16* SGS; bf16* out;
    __device__ __forceinline__ void operator()(const Acc& acc, const pg8::Unit& u, int wr, int wc, int fr0, int fq0) const {
        int fr = fr0, fq = fq0; asm volatile("" : "+v"(fr), "+v"(fq));
        const int row0 = u.pm() * 256 + wr * 64 + fr, col0 = u.pn() * 128 + wc * 32 + 8 * fq;
#pragma unroll
        for (int ai = 0; ai < 2; ++ai)
#pragma unroll
            for (int m = 0; m < 4; ++m) {
                const size_t off = (size_t)(row0 + ai * 128 + m * 16) * D + col0;
                const v4u s = *(const v4u*)(SGS + off);
                const float sg[8] = {bflo(s.x), bfhi(s.x), bflo(s.y), bfhi(s.y), bflo(s.z), bfhi(s.z), bflo(s.w), bfhi(s.w)};
                float v[8];
#pragma unroll
                for (int n = 0; n < 2; ++n)
#pragma unroll
                    for (int j = 0; j < 4; ++j) v[4 * n + j] = acc[ai][0][m][n][j] * fast_sigmoid(acc[ai][1][m][n][j]) * sg[4 * n + j];
                v4u w; w.x = cvt_pk_bf16(v[0], v[1]); w.y = cvt_pk_bf16(v[2], v[3]); w.z = cvt_pk_bf16(v[4], v[5]); w.w = cvt_pk_bf16(v[6], v[7]);
                *(v4u*)(out + off) = w;
            }
    }
};
struct EpiMerge {
    const bf16* SGR; bf16* mg;
    __device__ __forceinline__ void operator()(const Acc& acc, const pg8::Unit& u, int wr, int wc, int fr0, int fq0) const {
        int fr = fr0, fq = fq0; asm volatile("" : "+v"(fr), "+v"(fq));
        const int row0 = u.pm() * 256 + wr * 64 + fr, col0 = u.pn() * 256 + wc * 32 + 8 * fq;
#pragma unroll
        for (int ai = 0; ai < 2; ++ai)
#pragma unroll
            for (int m = 0; m < 4; ++m)
#pragma unroll
                for (int bj = 0; bj < 2; ++bj) {
                    const size_t off = (size_t)(row0 + ai * 128 + m * 16) * D + col0 + bj * 128;
                    const v4u s = *(const v4u*)(SGR + off), p = *(const v4u*)(mg + off);
                    const float sg[8] = {bflo(s.x), bfhi(s.x), bflo(s.y), bfhi(s.y), bflo(s.z), bfhi(s.z), bflo(s.w), bfhi(s.w)};
                    const float pp[8] = {bflo(p.x), bfhi(p.x), bflo(p.y), bfhi(p.y), bflo(p.z), bfhi(p.z), bflo(p.w), bfhi(p.w)};
                    float v[8];
#pragma unroll
                    for (int n = 0; n < 2; ++n)
#pragma unroll
                        for (int j = 0; j < 4; ++j) v[4 * n + j] = pp[4 * n + j] + sg[4 * n + j] * acc[ai][bj][m][n][j];
                    v4u w; w.x = cvt_pk_bf16(v[0], v[1]); w.y = cvt_pk_bf16(v[2], v[3]); w.z = cvt_pk_bf16(v[4], v[5]); w.w = cvt_pk_bf16(v[6], v[7]);
                    *(v4u*)(mg + off) = w;
                }
    }
};

constexpr int CTX_SPLIT = 4;
constexpr size_t WS_SLAB = WS_Q;
struct Ffn1DownOrder {
    const char* A; const char* B; int G, c;
    static constexpr int NBIG = (MX / 256) * (D / 256), NSMALL = (MC / 256) * (D / 256) * CTX_SPLIT;
    __device__ __forceinline__ bool next(int i, pg8::Unit& u) const {
        const long L = (long)i * G + c; if (L >= NBIG + NSMALL) return false;
        const size_t tstep = (size_t)256 * DFF * 2;
        int pm, pn, kind, nt; size_t koff;
        if (L < NBIG) { const int w = pg8::xcd_remap((int)L, NBIG); const int nig = 8 * 8, gid = w / nig, r = w % nig; pm = gid * 8 + (r & 7); pn = r >> 3; kind = 0; nt = DFF / 64; koff = 0; }
        else { const int w = (int)L - NBIG, sp = w & 3, t = w >> 2; pm = 32 + (t & 1); pn = t >> 1; kind = 1 + sp; nt = DFF / 64 / CTX_SPLIT; koff = (size_t)sp * (DFF / CTX_SPLIT) * 2; }
        u = pg8::make_unit(A + (size_t)pm * tstep + koff, B + (size_t)pn * tstep + koff, pm, pn, kind, nt, 0); return true;
    }
};
struct EpiFfn1Down {
    bf16* O; float* slab;
    __device__ __forceinline__ void operator()(const Acc& acc, const pg8::Unit& u, int wr, int wc, int fr0, int fq0) const {
        int fr = fr0, fq = fq0; asm volatile("" : "+v"(fr), "+v"(fq));
        const int row0 = u.pm() * 256 + wr * 64 + fr, col0 = u.pn() * 256 + wc * 32 + 8 * fq;
        if (u.kind() == 0) {
#pragma unroll
            for (int ai = 0; ai < 2; ++ai)
#pragma unroll
                for (int m = 0; m < 4; ++m) { bf16* rowp = O + (size_t)(row0 + ai * 128 + m * 16) * D + col0;
#pragma unroll
                    for (int bj = 0; bj < 2; ++bj) { const f32x4 a = acc[ai][bj][m][0], b = acc[ai][bj][m][1];
                        v4u w; w.x = cvt_pk_bf16(a[0], a[1]); w.y = cvt_pk_bf16(a[2], a[3]); w.z = cvt_pk_bf16(b[0], b[1]); w.w = cvt_pk_bf16(b[2], b[3]);
                        *(v4u*)(rowp + bj * 128) = w; } }
        } else {
            float* C = slab + (size_t)(u.kind() - 1) * MC * D - (size_t)MX * D;
#pragma unroll
            for (int ai = 0; ai < 2; ++ai)
#pragma unroll
                for (int m = 0; m < 4; ++m) { float* rowp = C + (size_t)(row0 + ai * 128 + m * 16) * D + col0;
#pragma unroll
                    for (int bj = 0; bj < 2; ++bj) { *(f32x4*)(rowp + bj * 128) = acc[ai][bj][m][0]; *(f32x4*)(rowp + bj * 128 + 4) = acc[ai][bj][m][1]; } }
        }
    }
};

enum { MK_S = 0, MK_Q = 1, MK_K = 2, MK_G = 3, MK_GS = 4, MK_GR = 5, MK_KT = 6, MK_VT = 7 };
struct EpiMix {
    unsigned char* ws;
    __device__ __forceinline__ void operator()(const Acc& acc, const pg8::Unit& u, int wr, int wc, int fr0, int fq0) const {
        int fr = fr0, fq = fq0; asm volatile("" : "+v"(fr), "+v"(fq));
        bf16* const US = (bf16*)(ws + WS_US); bf16* const Q = (bf16*)(ws + WS_Q); bf16* const KN = (bf16*)(ws + WS_K);
        bf16* const SG = (bf16*)(ws + WS_HBUF); bf16* const SGS = (bf16*)(ws + WS_HBUF + 32 * MiB); bf16* const SGR = (bf16*)(ws + WS_HBUF + 64 * MiB);
        bf16* const KFTC = (bf16*)(ws + WS_KFTC);
        bf16* const VT = (bf16*)(ws + WS_VT); bf16* const VTC = (bf16*)(ws + WS_VTC);
        const f32x2* const rope = (const f32x2*)(ws + WS_TAB + TAB_ROPE);
        const float* const lg2 = (const float*)(ws + WS_TAB + TAB_LG2);
        const int kind = u.kind();
        if (kind == MK_S) {
#pragma unroll
            for (int ai = 0; ai < 2; ++ai)
#pragma unroll
                for (int m = 0; m < 4; ++m) {
                    const int row = u.pm() * 256 + ai * 128 + wr * 64 + m * 16 + fr;
                    int b_, crow;
                    if (row < MX) { b_ = row >> 12; crow = (row & (SEQ - 1)) >> 4; } else { b_ = (row - MX) >> 8; crow = 256 + (((row - MX) & (LC - 1)) >> 4); }
                    const int s = row & 15;
#pragma unroll
                    for (int bj = 0; bj < 2; ++bj) {
                        const int ch = u.pn() * 256 + bj * 128 + wc * 32 + 8 * fq, g = ch >> 4, c0 = ch & 15;
                        const f32x4 a = acc[ai][bj][m][0], b = acc[ai][bj][m][1];
                        v4u w; w.x = cvt_pk_bf16(a[0], a[1]); w.y = cvt_pk_bf16(a[2], a[3]); w.z = cvt_pk_bf16(b[0], b[1]); w.w = cvt_pk_bf16(b[2], b[3]);
                        *(v4u*)(US + ((size_t)((b_ * 64 + g) * S5_ROWS + crow)) * 256 + s * 16 + c0) = w;
                    }
                }
        } else if (kind == MK_G || kind == MK_GS || kind == MK_GR) {
            bf16* dst = kind == MK_G ? SG : (kind == MK_GS ? SGS : SGR);
            const int row0 = u.pm() * 256 + wr * 64 + fr, col0 = u.pn() * 256 + wc * 32 + 8 * fq;
#pragma unroll
            for (int ai = 0; ai < 2; ++ai)
#pragma unroll
                for (int m = 0; m < 4; ++m)
#pragma unroll
                    for (int bj = 0; bj < 2; ++bj) {
                        float v[8];
#pragma unroll
                        for (int n = 0; n < 2; ++n)
#pragma unroll
                            for (int j = 0; j < 4; ++j) { const float x = acc[ai][bj][m][n][j]; const float s = fast_sigmoid(x); v[4 * n + j] = kind == MK_G ? x * s : s; }
                        v4u w; w.x = cvt_pk_bf16(v[0], v[1]); w.y = cvt_pk_bf16(v[2], v[3]); w.z = cvt_pk_bf16(v[4], v[5]); w.w = cvt_pk_bf16(v[6], v[7]);
                        *(v4u*)(dst + (size_t)(row0 + ai * 128 + m * 16) * D + col0 + bj * 128) = w;
                    }
        } else if (kind == MK_Q || kind == MK_K) {
            const int p = wc >> 1, i0 = 16 * (wc & 1) + 4 * fq;
            const int d0 = 64 * p + i0;
            const bool isctx = u.pm() >= 32;
            f32x4 cs0[8], cs1[8];
#pragma unroll
            for (int am = 0; am < 8; ++am) {
                const int row = u.pm() * 256 + (am >> 2) * 128 + wr * 64 + (am & 3) * 16 + fr;
                const int l = row & (SEQ - 1), pos = p ? (l & 63) : (l >> 6);
                if (!isctx) { cs0[am] = *(const f32x4*)(rope + pos * 32 + i0); cs1[am] = *(const f32x4*)(rope + pos * 32 + i0 + 2); }
                else { cs0[am] = (f32x4){1.f, 0.f, 1.f, 0.f}; cs1[am] = cs0[am]; }
            }
#pragma unroll
            for (int ai = 0; ai < 2; ++ai)
#pragma unroll
                for (int m = 0; m < 4; ++m) {
                    const int am = ai * 4 + m;
                    const int row = u.pm() * 256 + ai * 128 + wr * 64 + m * 16 + fr;
                    const float cc[4] = {cs0[am][0], cs0[am][2], cs1[am][0], cs1[am][2]}, ss[4] = {cs0[am][1], cs0[am][3], cs1[am][1], cs1[am][3]};
#pragma unroll
                    for (int bj = 0; bj < 2; ++bj) {
                        const int head = 2 * u.pn() + bj;
                        float y1[4], y2[4];
#pragma unroll
                        for (int j = 0; j < 4; ++j) { const float x1 = acc[ai][bj][m][0][j], x2 = acc[ai][bj][m][1][j]; y1[j] = x1 * cc[j] - x2 * ss[j]; y2[j] = x1 * ss[j] + x2 * cc[j]; }
                        const int cpos = 32 * wc + 8 * fq;
                        v4u w;
                        if (kind == MK_K) {
                            w.x = cvt_pk_bf16(y1[0], y1[1]); w.y = cvt_pk_bf16(y1[2], y1[3]); w.z = cvt_pk_bf16(y2[0], y2[1]); w.w = cvt_pk_bf16(y2[2], y2[3]);
                            if (!isctx) *(v4u*)(KN + (size_t)row * 1024 + head * 128 + cpos) = w;
                            else *(v4u*)(KFTC + (size_t)(row - MX) * 1024 + head * 128 + cpos) = w;
                        } else {
                            const float qs = 0.08838834764831845f;
                            w.x = cvt_pk_bf16(y1[0] * qs, y1[1] * qs); w.y = cvt_pk_bf16(y1[2] * qs, y1[3] * qs); w.z = cvt_pk_bf16(y2[0] * qs, y2[1] * qs); w.w = cvt_pk_bf16(y2[2] * qs, y2[3] * qs);
                            *(v4u*)(Q + (size_t)row * 1024 + head * 128 + cpos) = w;
                        }
                    }
                }
        } else if (kind == MK_VT) {
            const bool isctx = u.pn() >= 32;
#pragma unroll
            for (int ai = 0; ai < 2; ++ai)
#pragma unroll
                for (int m = 0; m < 4; ++m) {
                    const int f = u.pm() * 256 + ai * 128 + wr * 64 + m * 16 + fr;
#pragma unroll
                    for (int bj = 0; bj < 2; ++bj) {
                        const f32x4 a = acc[ai][bj][m][0], b = acc[ai][bj][m][1];
                        v4u w; w.x = cvt_pk_bf16(a[0], a[1]); w.y = cvt_pk_bf16(a[2], a[3]); w.z = cvt_pk_bf16(b[0], b[1]); w.w = cvt_pk_bf16(b[2], b[3]);
                        const int tc = bj * 128 + wc * 32 + 8 * fq;
                        if (!isctx) { const int tok = u.pn() * 256 + tc, b_ = tok >> 12, l = tok & (SEQ - 1); *(v4u*)(VT + ((size_t)(b_ * 2048 + f) * SEQ + l)) = w; }
                        else { const int b_ = u.pn() - 32; *(v4u*)(VTC + ((size_t)(b_ * 2048 + f) * LC + tc)) = w; }
                    }
                }
        }
    }
};
struct MixOrder {
    const char* U; const char* WM; int G, c;
    static constexpr int N_NORM = 32 * 36, N_CTXS = 16, N_SWAP = 8 * 34, NWG = N_NORM + N_CTXS + N_SWAP;
    __device__ __forceinline__ bool next(int i, pg8::Unit& u) const {
        const long L = (long)i * G + c; if (L >= NWG) return false;
        int w = pg8::xcd_remap((int)L, NWG);
        const size_t tstep = (size_t)256 * D * 2;
        int at, bt, pm, pn, kind;
        bool swapped = false;
        if (w < N_NORM) {
            const int nig = 8 * 36, gid = w / nig, r = w % nig, ct = r >> 3;
            pm = gid * 8 + (r & 7); at = pm;
            if (ct < 4) { bt = ct; kind = MK_S; pn = ct; } else if (ct < 8) { bt = ct; kind = MK_Q; pn = ct - 4; } else if (ct < 12) { bt = ct; kind = MK_K; pn = ct - 8; }
            else if (ct < 20) { bt = ct + 8; kind = MK_G; pn = ct - 12; } else if (ct < 28) { bt = ct + 8; kind = MK_GS; pn = ct - 20; } else { bt = ct + 8; kind = MK_GR; pn = ct - 28; }
        } else if (w < N_NORM + N_CTXS) {
            w -= N_NORM; pm = 32 + (w & 1); at = pm; const int ct = w >> 1;
            if (ct < 4) { bt = ct; pn = ct; kind = MK_S; } else { bt = ct + 4; pn = ct - 4; kind = MK_K; }
        } else {
            w -= N_NORM + N_CTXS; swapped = true;
            const int tt = w >> 3, ft = w & 7;
            bt = tt; pn = tt; at = 12 + ft; pm = ft; kind = MK_VT;
        }
        const char* abase = swapped ? WM : U; const char* bbase = swapped ? U : WM;
        u = pg8::make_unit(abase + (size_t)at * tstep, bbase + (size_t)bt * tstep, pm, pn, kind, D / 64, 0);
        return true;
    }
};

constexpr int RING_BYTES = 131072, LDSCTL_OFF = 143360, MISC_OFF = LDSCTL_OFF + 320, LDS_BYTES = 147456;
struct Args { const float* in[22]; float* out; unsigned char* ws; };
struct Frame {
    LAS unsigned char* lds; volatile LAS unsigned* MISC; unsigned* ctl;
    int wave, vcu, G;
    float* out; unsigned char* ws;
};
typedef const Args __attribute__((address_space(4)))* KArgsPtr;
__device__ __forceinline__ KArgsPtr kargs() { KArgsPtr p = (KArgsPtr)__builtin_amdgcn_kernarg_segment_ptr(); asm volatile("" : "+s"(p)); return p; }
#define FIN(k) ((const float*)kargs()->in[k])

__device__ __forceinline__ int map_pair(int n, int half) { const int h = n < half ? n : n - half, up = n >= half; return 256 * (h >> 7) + 128 * up + (h & 127); }
__device__ __forceinline__ int map_mix(int n) {
    if (n < 1024 || n >= 3072) return n;
    const int base = n & ~127, d = n & 127, p = d >> 6, e = d & 63, s = e >> 5, i = e & 31, t = 32 * p + i;
    return base + 32 * (t >> 4) + 8 * ((t >> 2) & 3) + 4 * s + (t & 3);
}
template <int MAPID>
__device__ __forceinline__ void transpose_item(const float* W, int ldw, int K, int nblk, bf16* WT, int row_off, int half, LAS float* scr, int item, int lane) {
    const int kb = item / nblk, nb = item % nblk, k0 = 64 * kb, n0 = 32 * nb;
    float wv[32];
#pragma unroll
    for (int i = 0; i < 32; ++i) wv[i] = __builtin_nontemporal_load(W + (size_t)(k0 + 2 * i + (lane >> 5)) * ldw + n0 + (lane & 31));
#pragma unroll
    for (int i = 0; i < 32; ++i) scr[(2 * i + (lane >> 5)) * 33 + (lane & 31)] = wv[i];
    LDS_WAIT(); asm volatile("" ::: "memory");
    const int c = lane & 7;
#pragma unroll
    for (int j = 0; j < 4; ++j) { const int n = (lane >> 3) + 8 * j; const LAS float* s = scr + (8 * c) * 33 + n;
        v4u o; o.x = pk2(s[0 * 33], s[1 * 33]); o.y = pk2(s[2 * 33], s[3 * 33]); o.z = pk2(s[4 * 33], s[5 * 33]); o.w = pk2(s[6 * 33], s[7 * 33]);
        const int nn = n0 + n; const int dr = MAPID == 0 ? nn : (MAPID == 1 ? map_pair(nn, half) : map_mix(nn));
        *(v4u*)(WT + (size_t)(row_off + dr) * K + k0 + 8 * c) = o; }
    LDS_WAIT(); asm volatile("" ::: "memory");
}
__device__ __forceinline__ void sincos_d(double x, double& s, double& c) {
    const double TWO_PI = 6.283185307179586476925286766559;
    x -= TWO_PI * __builtin_rint(x / TWO_PI);
    const double h = 0.125 * x, h2 = h * h;
    double sn = h * (1.0 + h2 * (-1.0 / 6 + h2 * (1.0 / 120 + h2 * (-1.0 / 5040 + h2 * (1.0 / 362880 + h2 * (-1.0 / 39916800 + h2 * (1.0 / 6227020800.0)))))));
    double cs = 1.0 + h2 * (-0.5 + h2 * (1.0 / 24 + h2 * (-1.0 / 720 + h2 * (1.0 / 40320 + h2 * (-1.0 / 3628800 + h2 * (1.0 / 479001600.0 + h2 * (-1.0 / 87178291200.0)))))));
#pragma unroll
    for (int k = 0; k < 3; ++k) { const double s2 = 2.0 * sn * cs, c2 = 1.0 - 2.0 * sn * sn; sn = s2; cs = c2; }
    s = sn; c = cs;
}
__device__ __forceinline__ double exp_d(double x) {
    const double y = x * (1.0 / 4096.0);
    double e = 1.0 + y * (1.0 + y * (0.5 + y * (1.0 / 6 + y * (1.0 / 24 + y * (1.0 / 120 + y * (1.0 / 720))))));
#pragma unroll
    for (int k = 0; k < 12; ++k) e = e * e;
    return e;
}
__device__ __forceinline__ double log1p_small_d(double z) {
    const double t = z / (2.0 + z), t2 = t * t;
    return 2.0 * t * (1.0 + t2 * (1.0 / 3 + t2 * (1.0 / 5 + t2 * (1.0 / 7 + t2 * (1.0 / 9 + t2 * (1.0 / 11))))));
}

constexpr int CV_I1 = (D / 64) * (NFF / 32), CV_I2 = (DFF / 64) * (D / 32), CV_IM = (D / 64) * (NMIX / 32), CV_IG = (SW / 64) * (2 * D / 32), CV_IP = (D / 64) * (D / 32);
constexpr int CV_N0 = CV_I1 + CV_I2, CV_N1 = CV_IM + CV_IG + 2 * CV_IP, CV_N2 = CV_I1 + CV_I2;
constexpr int CV_G1_CUS = 40, CV_G2_CUS = 192, CV_G3_CUS = 96;
constexpr int CV_L1_G1 = CV_G1_CUS * NWAVES * 12, CV_L1_G2 = CV_G2_CUS * NWAVES * 7, CV_L2_G3 = CV_G3_CUS * NWAVES * 14;
static_assert(CV_L1_G1 + CV_L1_G2 <= CV_N1 && CV_L2_G3 <= CV_N2, "conversion split");
__device__ __forceinline__ void conv_item(unsigned char* ws, int list, int r, LAS float* scr, int lane_) {
    if (list == 0) {
        if (r < CV_I1) { transpose_item<1>(FIN(7), NFF, D, NFF / 32, (bf16*)(ws + WS_W1T), 0, DFF, scr, r, lane_); return; } r -= CV_I1;
        transpose_item<0>(FIN(8), D, DFF, D / 32, (bf16*)(ws + WS_W2T), 0, 0, scr, r, lane_);
    } else if (list == 1) {
        if (r < CV_IM) { transpose_item<2>(FIN(9), NMIX, D, NMIX / 32, (bf16*)(ws + WS_WMT), 0, 0, scr, r, lane_); return; } r -= CV_IM;
        if (r < CV_IG) { transpose_item<1>(FIN(18), 2 * D, SW, 2 * D / 32, (bf16*)(ws + WS_WGT), 0, D, scr, r, lane_); return; } r -= CV_IG;
        if (r < CV_IP) { transpose_item<0>(FIN(20), D, D, D / 32, (bf16*)(ws + WS_WPT), 0, 0, scr, r, lane_); return; } r -= CV_IP;
        transpose_item<0>(FIN(21), D, D, D / 32, (bf16*)(ws + WS_WOT), 0, 0, scr, r, lane_);
    } else {
        if (r < CV_I1) { transpose_item<1>(FIN(7) + (size_t)D * NFF, NFF, D, NFF / 32, (bf16*)(ws + WS_W3T), 0, DFF, scr, r, lane_); return; } r -= CV_I1;
        transpose_item<0>(FIN(8) + (size_t)DFF * D, D, DFF, D / 32, (bf16*)(ws + WS_W4T), 0, 0, scr, r, lane_);
    }
}
__device__ __forceinline__ void conv_range(Frame& F, int list, int begin, int end, int wi, int nw) {
    int lane_ = lane_id(); asm volatile("" : "+v"(lane_));
    LAS float* scr = (LAS float*)(F.lds + F.wave * 16384);
    for (int it = begin + wi; it < end; it += nw) conv_item(F.ws, list, it, scr, lane_);
}

__device__ __forceinline__ void phase_prologue(Frame& F0, const Args& args, const bool do_ada) {
    Frame& F = F0; int lane_ = lane_id(); asm volatile("" : "+v"(lane_));
    LAS float* scr = (LAS float*)(F.lds + F.wave * 16384);
    const int gw = F.vcu * NWAVES + F.wave, NGW = F.G * NWAVES;
    unsigned char* ws = F.ws;
    {
        const int gt = gw * 64 + lane_, NT = NGW * 64;
        unsigned char* tab = ws + WS_TAB;
        for (int idx = gt; idx < 2048; idx += NT) {
            const int pos = idx >> 5, i = idx & 31;
            const double inv = exp_d(-(double)i * (9.210340371976182736 / 32.0));
            double s, c; sincos_d((double)pos * inv, s, c);
            ((f32x2*)(tab + TAB_ROPE))[idx] = (f32x2){(float)c, (float)s};
        }
        for (int idx = gt; idx < 16; idx += NT) {
            const double x = (double)FIN(19)[idx];
            ((float*)(tab + TAB_LG2))[idx] = (float)(-log1p_small_d(exp_d(-x)) * 1.4426950408889634074);
        }
        for (int idx = gt; idx < 2 * 64 * 64; idx += NT) {
            const int dg = idx >> 6, p = idx & 63;
            const double lr = (double)FIN(10)[idx], li = (double)FIN(11)[idx], step = exp_d((double)FIN(12)[dg]);
            const double mag = exp_d(lr * step); double sn, cs; sincos_d(li * step, sn, cs);
            const double ar = mag * cs, ai = mag * sn, den = lr * lr + li * li, nr = ar - 1.0, ni = ai;
            const double kr = (nr * lr + ni * li) / den, ki = (ni * lr - nr * li) / den;
            ((float*)(tab + TAB_AR))[idx] = (float)ar; ((float*)(tab + TAB_AI))[idx] = (float)ai;
            { f32x2* apw = (f32x2*)(ws + WS_S5APOW) + (size_t)dg * 17 * 64 + p; double pr = 1.0, pi = 0.0;
              for (int k = 0; k < 17; ++k) { apw[k * 64] = (f32x2){(float)pr, (float)pi}; const double t = pr * ar - pi * ai; pi = pr * ai + pi * ar; pr = t; } }
            float* brf = (float*)(ws + WS_S5BRF) + (size_t)idx * 32;
            const float* bre = FIN(13) + (size_t)idx * 16; const float* bim = FIN(14) + (size_t)idx * 16;
            for (int c = 0; c < 16; ++c) { const double br = (double)bre[c], bi = (double)bim[c];
                brf[2 * c] = (float)(kr * br - ki * bi); brf[2 * c + 1] = (float)(kr * bi + ki * br); }
        }
    }
    if (do_ada) {
        float* ADA = (float*)(ws + WS_CTL + CTL_ADA);
        const float* aw = FIN(4);
        for (int it = gw; it < 16 * 72; it += NGW) {
            const int kc = it / 72, cb = it % 72, k0 = kc * 128, col = cb * 256 + 4 * lane_;
            for (int i = lane_; i < 384; i += 64) { const int v = i >> 7, k = i & 127; const float x = v == 0 ? FIN(1)[k0 + k] : (v == 1 ? FIN(1)[D + k0 + k] : FIN(3)[k0 + k]); scr[i] = x / (1.0f + __expf(-x)); }
            LDS_WAIT(); asm volatile("" ::: "memory");
            f32x4 a0 = {0.f, 0.f, 0.f, 0.f}, a1 = a0, a2 = a0;
#pragma unroll 8
            for (int k = 0; k < 128; ++k) { const f32x4 w = __builtin_nontemporal_load((const f32x4*)(aw + (size_t)(k0 + k) * NADA + col)); a0 += w * scr[k]; a1 += w * scr[128 + k]; a2 += w * scr[256 + k]; }
#pragma unroll
            for (int j = 0; j < 4; ++j) { __hip_atomic_fetch_add(ADA + col + j, a0[j], RLX_AGENT); __hip_atomic_fetch_add(ADA + NADA + col + j, a1[j], RLX_AGENT); __hip_atomic_fetch_add(ADA + 2 * NADA + col + j, a2[j], RLX_AGENT); }
            LDS_WAIT(); asm volatile("" ::: "memory");
        }
    }
    {
        const bool tails = (F.G == 256);
        const int b1 = tails ? CV_L1_G1 + CV_L1_G2 : 0, b2 = tails ? CV_L2_G3 : 0;
        const int n0 = CV_N0, n1 = CV_N1 - b1, n2 = CV_N2 - b2;
        for (int it = gw; it < n0 + n1 + n2; it += NGW) {
            if (it < n2) conv_item(ws, 2, b2 + it, scr, lane_);
            else if (it < n2 + n1) conv_item(ws, 1, b1 + it - n2, scr, lane_);
            else conv_item(ws, 0, it - n2 - n1, scr, lane_);
        }
    }
}

__device__ __forceinline__ void build_modv(Frame& F, const Args& args) {
    int lane_ = lane_id(); asm volatile("" : "+v"(lane_));
    const int gt = (F.vcu * NWAVES + F.wave) * 64 + lane_, NT = F.G * NWAVES * 64;
    const float* ADA = (const float*)(F.ws + WS_CTL + CTL_ADA); const float* adab = FIN(5); const float* ng = FIN(6);
    float* MV = (float*)(F.ws + WS_TAB + TAB_MODV);
    for (int idx = gt; idx < 27 * (D / 4); idx += NT) {
        const int c = (idx % (D / 4)) * 4, v = idx / (D / 4), av = v % 3, i = (v / 3) % 3, kind = v / 9;
        const float* ada = ADA + (size_t)av * NADA;
        f32x4 o;
        if (kind == 0) o = ((i == 1) ? 1.0f : 0.5f) * (*(const f32x4*)(ada + (3 * i + 2) * D + c) + *(const f32x4*)(adab + (3 * i + 2) * D + c)) * *(const f32x4*)(ng + (2 * i + 1) * D + c);
        else if (kind == 1) o = *(const f32x4*)(ng + (2 * i) * D + c) * (*(const f32x4*)(ada + (3 * i + 1) * D + c) + *(const f32x4*)(adab + (3 * i + 1) * D + c) + 1.0f);
        else o = *(const f32x4*)(ada + (3 * i) * D + c) + *(const f32x4*)(adab + (3 * i) * D + c);
        *(f32x4*)(MV + (size_t)v * D + c) = o;
    }
}
template <int MODE>
__device__ __forceinline__ void phase_rows(Frame& F0, const Args& args) {
    Frame& F = F0; int lane_ = lane_id(); asm volatile("" : "+v"(lane_));
    const int gw = F.vcu * NWAVES + F.wave, NGW = F.G * NWAVES;
    const float* ADA = (const float*)(F.ws + WS_CTL + CTL_ADA);
    const float* adab = FIN(5); const float* ng = FIN(6);
    const float* MV = (const float*)(F.ws + WS_TAB + TAB_MODV);
    const bf16* O = (const bf16*)(F.ws + WS_OBUF);
    bf16* A = (bf16*)(F.ws + WS_ABUF);
    const int nrows = (MODE <= 1) ? MT : MX;
    constexpr int ipost = MODE >= 1 ? MODE - 1 : 0, ipre = MODE <= 2 ? MODE : 0;
    int cur_av = -1;
    f32x4 cf[8], gsv[8], shv[8];
    for (int r = gw; r < nrows; r += NGW) {
        const int av = r < MX ? (r >> 12) : 2;
        if (av != cur_av) {
            cur_av = av;
#pragma unroll
            for (int j = 0; j < 8; ++j) { const int c = 256 * j + 4 * lane_;
                if (MODE == 0) { const float* ada = ADA + (size_t)av * NADA;
                    shv[j] = *(const f32x4*)(ada + c) + *(const f32x4*)(adab + c);
                    gsv[j] = *(const f32x4*)(ng + c) * (*(const f32x4*)(ada + D + c) + *(const f32x4*)(adab + D + c) + 1.0f); }
                else {
                    cf[j] = *(const f32x4*)(MV + (size_t)((0 * 3 + ipost) * 3 + av) * D + c);
                    if (MODE <= 2) { gsv[j] = *(const f32x4*)(MV + (size_t)((1 * 3 + ipre) * 3 + av) * D + c); shv[j] = *(const f32x4*)(MV + (size_t)((2 * 3 + ipre) * 3 + av) * D + c); } } }
        }
        f32x4 h[8];
        if (MODE <= 1) { const float* hsrc = r < MX ? FIN(0) + (size_t)r * D : FIN(2) + (size_t)(r - MX) * D;
#pragma unroll
            for (int j = 0; j < 8; ++j) h[j] = __builtin_nontemporal_load((const f32x4*)(hsrc + 256 * j + 4 * lane_)); }
        else { const bf16* hsrc = (const bf16*)(F.ws + WS_STREAM) + (size_t)r * D;
#pragma unroll
            for (int j = 0; j < 8; ++j) { const v2u t = __builtin_nontemporal_load((const v2u*)(hsrc + 256 * j + 4 * lane_)); h[j] = (f32x4){bflo(t.x), bfhi(t.x), bflo(t.y), bfhi(t.y)}; } }
        if (MODE >= 1) {
            f32x4 o[8]; float ss = 0.f;
#pragma unroll
            for (int j = 0; j < 8; ++j) {
                if (MODE == 1 && r >= MX) { const float* sl = (const float*)(F.ws + WS_SLAB) + (size_t)(r - MX) * D + 256 * j + 4 * lane_; f32x4 a = *(const f32x4*)sl;
#pragma unroll
                    for (int s = 1; s < CTX_SPLIT; ++s) a += *(const f32x4*)(sl + (size_t)s * MC * D);
                    o[j] = a; }
                else { const v2u t = __builtin_nontemporal_load((const v2u*)(O + (size_t)r * D + 256 * j + 4 * lane_)); o[j] = (f32x4){bflo(t.x), bfhi(t.x), bflo(t.y), bfhi(t.y)}; }
                ss += (o[j][0] * o[j][0] + o[j][1] * o[j][1]) + (o[j][2] * o[j][2] + o[j][3] * o[j][3]); }
            const float rstd = 1.0f / sqrtf(wave_sum(ss, lane_) * (1.0f / D) + EPS);
#pragma unroll
            for (int j = 0; j < 8; ++j) h[j] = h[j] + rstd * (cf[j] * o[j]);
            if (r < MX) {
                if (MODE == 3) {
#pragma unroll
                    for (int j = 0; j < 8; ++j) __builtin_nontemporal_store(h[j], (f32x4*)(F.out + (size_t)r * D + 256 * j + 4 * lane_));
                } else {
                    bf16* so = (bf16*)(F.ws + WS_STREAM) + (size_t)r * D;
#pragma unroll
                    for (int j = 0; j < 8; ++j) { v2u w; w.x = cvt_pk_bf16(h[j][0], h[j][1]); w.y = cvt_pk_bf16(h[j][2], h[j][3]); __builtin_nontemporal_store(w, (v2u*)(so + 256 * j + 4 * lane_));
                        h[j] = (f32x4){bflo(w.x), bfhi(w.x), bflo(w.y), bfhi(w.y)}; }
                }
            }
        }
        if (MODE <= 2) {
            float ss = 0.f;
#pragma unroll
            for (int j = 0; j < 8; ++j) ss += (h[j][0] * h[j][0] + h[j][1] * h[j][1]) + (h[j][2] * h[j][2] + h[j][3] * h[j][3]);
            const float rstd = 1.0f / sqrtf(wave_sum(ss, lane_) * (1.0f / D) + EPS);
#pragma unroll
            for (int j = 0; j < 8; ++j) { const f32x4 v = (h[j] * rstd) * gsv[j] + shv[j];
                v2u w; w.x = cvt_pk_bf16(v[0], v[1]); w.y = cvt_pk_bf16(v[2], v[3]);
                *(v2u*)(A + (size_t)r * D + 256 * j + 4 * lane_) = w; }
        }
    }
}

__device__ __forceinline__ void s5_tables1(Frame& F, const Args& args) {
    int lane_ = lane_id(); asm volatile("" : "+v"(lane_));
    const int gt = (F.vcu * NWAVES + F.wave) * 64 + lane_, NT = F.G * NWAVES * 64;
    const f32x2* APW = (const f32x2*)(F.ws + WS_S5APOW);
    const float* BRF = (const float*)(F.ws + WS_S5BRF);
    const float* cre = FIN(15); const float* cim = FIN(16);
    float* KT = (float*)(F.ws + WS_S5KT); bf16* WE = (bf16*)(F.ws + WS_S5WE); bf16* WY2 = (bf16*)(F.ws + WS_S5WY2);
    for (int idx = gt; idx < 64 * 2 * 16 * 16 * 4; idx += NT) {
        const int c4 = idx & 3, c = (idx >> 2) & 15, k = (idx >> 6) & 15, dir = (idx >> 10) & 1, g = idx >> 11, dg = dir * 64 + g;
        const f32x2* ap = APW + (size_t)(dg * 17 + k) * 64; const float* cr = cre + (dg * 16 + c) * 64; const float* ci = cim + (dg * 16 + c) * 64;
        const float* br = BRF + (size_t)dg * 64 * 32 + c4 * 8;
        f32x4 acc = {0.f, 0.f, 0.f, 0.f};
#pragma unroll 8
        for (int p = 0; p < 64; ++p) {
            const f32x2 a = ap[p]; const float Cr = cr[p], Ci = ci[p], Gr = Cr * a[0] - Ci * a[1], Gi = Cr * a[1] + Ci * a[0];
            const f32x4 b0 = *(const f32x4*)(br + p * 32), b1 = *(const f32x4*)(br + p * 32 + 4);
            acc[0] += Gr * b0[0] - Gi * b0[1]; acc[1] += Gr * b0[2] - Gi * b0[3]; acc[2] += Gr * b1[0] - Gi * b1[1]; acc[3] += Gr * b1[2] - Gi * b1[3];
        }
        *(f32x4*)(KT + ((size_t)((g * 2 + dir) * 16 + k) * 16 + c) * 16 + c4 * 4) = acc;
    }
    for (int idx = gt; idx < 64 * 256 * 16; idx += NT) {
        const int s = idx & 15, r = (idx >> 4) & 255, g = idx >> 12, dir = r >> 7, part = (r >> 6) & 1, p = r & 63, dg = dir * 64 + g;
        const f32x2 a = APW[(size_t)(dg * 17 + (dir ? s : 15 - s)) * 64 + p]; const float pr = a[0], pi = a[1];
        const f32x4* b4 = (const f32x4*)(BRF + (size_t)(dg * 64 + p) * 32);
        float v[16];
#pragma unroll
        for (int j = 0; j < 8; ++j) { const f32x4 q = b4[j]; v[2 * j] = part ? (pr * q[1] + pi * q[0]) : (pr * q[0] - pi * q[1]); v[2 * j + 1] = part ? (pr * q[3] + pi * q[2]) : (pr * q[2] - pi * q[3]); }
        bf16* o = WE + ((size_t)(g * 256 + r)) * 256 + s * 16;
        v4u w0, w1; w0.x = pk2(v[0], v[1]); w0.y = pk2(v[2], v[3]); w0.z = pk2(v[4], v[5]); w0.w = pk2(v[6], v[7]); w1.x = pk2(v[8], v[9]); w1.y = pk2(v[10], v[11]); w1.z = pk2(v[12], v[13]); w1.w = pk2(v[14], v[15]);
        *(v4u*)o = w0; *(v4u*)(o + 8) = w1;
    }
    for (int idx = gt; idx < 64 * 256 * 32; idx += NT) {
        const int cb = idx & 31, row = (idx >> 5) & 255, g = idx >> 13, t = row >> 4, c = row & 15, col0 = 8 * cb, dir = col0 >> 7, part = (col0 >> 6) & 1, p0 = col0 & 63, dg = dir * 64 + g;
        const f32x2* ap = APW + (size_t)(dg * 17 + (dir ? 16 - t : t + 1)) * 64 + p0; const float* cr = cre + (dg * 16 + c) * 64 + p0; const float* ci = cim + (dg * 16 + c) * 64 + p0;
        float v[8];
#pragma unroll
        for (int j = 0; j < 8; ++j) { const f32x2 a = ap[j]; const float Cr = cr[j], Ci = ci[j]; v[j] = part ? -(Cr * a[1] + Ci * a[0]) : (Cr * a[0] - Ci * a[1]); }
        v4u w; w.x = pk2(v[0], v[1]); w.y = pk2(v[2], v[3]); w.z = pk2(v[4], v[5]); w.w = pk2(v[6], v[7]);
        *(v4u*)(WY2 + ((size_t)(g * 256 + row)) * 256 + col0) = w;
    }
}
__device__ __forceinline__ void s5_tables2(Frame& F, const Args& args) {
    int lane_ = lane_id(); asm volatile("" : "+v"(lane_));
    const int gt = (F.vcu * NWAVES + F.wave) * 64 + lane_, NT = F.G * NWAVES * 64;
    const float* KT = (const float*)(F.ws + WS_S5KT); bf16* WY1 = (bf16*)(F.ws + WS_S5WY1); const float* dskip = FIN(17);
    for (int idx = gt; idx < 64 * 256 * 16; idx += NT) {
        const int s = idx & 15, row = (idx >> 4) & 255, g = idx >> 12, t = row >> 4, c = row & 15;
        float v[16];
#pragma unroll
        for (int j = 0; j < 16; ++j) v[j] = 0.f;
        if (s <= t) { const f32x4* k4 = (const f32x4*)(KT + ((size_t)((g * 2 + 0) * 16 + (t - s)) * 16 + c) * 16);
#pragma unroll
            for (int j = 0; j < 4; ++j) { const f32x4 q = k4[j]; v[4 * j] += q[0]; v[4 * j + 1] += q[1]; v[4 * j + 2] += q[2]; v[4 * j + 3] += q[3]; } }
        if (s >= t) { const f32x4* k4 = (const f32x4*)(KT + ((size_t)((g * 2 + 1) * 16 + (s - t)) * 16 + c) * 16);
#pragma unroll
            for (int j = 0; j < 4; ++j) { const f32x4 q = k4[j]; v[4 * j] += q[0]; v[4 * j + 1] += q[1]; v[4 * j + 2] += q[2]; v[4 * j + 3] += q[3]; } }
        if (s == t) { const float dk = dskip[16 * g + c];
#pragma unroll
            for (int j = 0; j < 16; ++j) v[j] += (j == c) ? dk : 0.f; }
        bf16* o = WY1 + ((size_t)(g * 256 + row)) * 256 + s * 16;
        v4u w0, w1; w0.x = pk2(v[0], v[1]); w0.y = pk2(v[2], v[3]); w0.z = pk2(v[4], v[5]); w0.w = pk2(v[6], v[7]); w1.x = pk2(v[8], v[9]); w1.y = pk2(v[10], v[11]); w1.z = pk2(v[12], v[13]); w1.w = pk2(v[14], v[15]);
        *(v4u*)o = w0; *(v4u*)(o + 8) = w1;
    }
}
struct S5EOrder {
    const char* ZU; const char* WE; int G, c;
    __device__ __forceinline__ bool next(int i, pg8::Unit& u) const {
        const long L = (long)i * G + c; if (L >= 256) return false;
        const int bg = (int)L >> 1, rt = (int)L & 1, g = bg & 63;
        u = pg8::make_unit(ZU + ((size_t)(bg * S5_ROWS + 256 * rt)) * 512, WE + (size_t)g * 256 * 512, bg, rt, 0, 4, 0); return true;
    }
};
struct EpiS5E {
    bf16* E;
    __device__ __forceinline__ void operator()(const Acc& acc, const pg8::Unit& u, int wr, int wc, int fr0, int fq0) const {
        int fr = fr0, fq = fq0; asm volatile("" : "+v"(fr), "+v"(fq));
#pragma unroll
        for (int ai = 0; ai < 2; ++ai)
#pragma unroll
            for (int m = 0; m < 4; ++m) {
                const int crow = 256 * u.pn() + ai * 128 + wr * 64 + m * 16 + fr;
                if (crow < S5_ROWS) {
#pragma unroll
                    for (int bj = 0; bj < 2; ++bj) {
                        const f32x4 a = acc[ai][bj][m][0], b = acc[ai][bj][m][1];
                        v4u w; w.x = cvt_pk_bf16(a[0], a[1]); w.y = cvt_pk_bf16(a[2], a[3]); w.z = cvt_pk_bf16(b[0], b[1]); w.w = cvt_pk_bf16(b[2], b[3]);
                        *(v4u*)(E + ((size_t)(u.pm() * S5_ROWS + crow)) * 256 + bj * 128 + wc * 32 + 8 * fq) = w;
                    }
                }
            }
    }
};
struct S5YOrder {
    const char* ZU; const char* ZH; const char* WY1; const char* WY2; int G, c;
    __device__ __forceinline__ bool next(int i, pg8::Unit& u) const {
        const int bg = (i >> 1) * G + c, seg = i & 1; if (bg >= NB * 64) return false;
        const int g = bg & 63;
        const char* a = seg == 0 ? ZU + ((size_t)(bg * S5_ROWS)) * 512 : ZH + ((size_t)(bg * 256)) * 512;
        const char* b = (seg == 0 ? WY1 : WY2) + (size_t)g * 256 * 512;
        u = pg8::make_unit(a, b, bg, 0, 0, 4, seg == 0 ? 1 : 0); return true;
    }
};
struct EpiS5Y {
    bf16* AGLU;
    __device__ __forceinline__ void operator()(const Acc& acc, const pg8::Unit& u, int wr, int wc, int fr0, int fq0) const {
        int fr = fr0, fq = fq0; asm volatile("" : "+v"(fr), "+v"(fq));
        const int b_ = u.pm() >> 6, g = u.pm() & 63;
#pragma unroll
        for (int ai = 0; ai < 2; ++ai)
#pragma unroll
            for (int m = 0; m < 4; ++m) {
                const int chunk = ai * 128 + wr * 64 + m * 16 + fr;
#pragma unroll
                for (int bj = 0; bj < 2; ++bj) {
                    const int cc = bj * 128 + wc * 32 + 8 * fq, t = cc >> 4, c0 = cc & 15;
                    const f32x4 a = acc[ai][bj][m][0], b = acc[ai][bj][m][1];
                    v4u w; w.x = cvt_pk_bf16(gelu_tanh(a[0]), gelu_tanh(a[1])); w.y = cvt_pk_bf16(gelu_tanh(a[2]), gelu_tanh(a[3])); w.z = cvt_pk_bf16(gelu_tanh(b[0]), gelu_tanh(b[1])); w.w = cvt_pk_bf16(gelu_tanh(b[2]), gelu_tanh(b[3]));
                    *(v4u*)(AGLU + ((size_t)(b_ * SEQ + chunk * 16 + t)) * SW + 16 * g + c0) = w;
                }
            }
    }
};
__device__ __forceinline__ void s5_scan_bg(Frame& F, int bg, int tid) {
    const bf16* E = (const bf16*)(F.ws + WS_S5E); bf16* ZH = (bf16*)(F.ws + WS_S5ZH);
    LAS bf16* EL = (LAS bf16*)F.lds;
    { v4u ev[17];
      static_assert(S5_ROWS * 32 == 17 * NWAVES * 64, "E block pieces");
#pragma unroll
      for (int k = 0; k < 17; ++k) ev[k] = *(const v4u*)(E + (size_t)bg * S5_ROWS * 256 + (size_t)(tid + k * NWAVES * 64) * 8);
#pragma unroll
      for (int k = 0; k < 17; ++k) *(LAS v4u*)(EL + (tid + k * NWAVES * 64) * 8) = ev[k]; }
    __syncthreads();
    if (tid < 128) {
        const int dir = tid >> 6, p = tid & 63, g = bg & 63;
        float ar = ((const float*)(F.ws + WS_TAB + TAB_AR))[(dir * 64 + g) * 64 + p], ai = ((const float*)(F.ws + WS_TAB + TAB_AI))[(dir * 64 + g) * 64 + p];
#pragma unroll
        for (int k = 0; k < 4; ++k) { const float nr = ar * ar - ai * ai, ni = 2.f * ar * ai; ar = nr; ai = ni; }
        LAS bf16* col = EL + dir * 128 + p;
        float hr = 0.f, hi = 0.f;
        for (int k0 = 0; k0 < S5_ROWS; k0 += 16) {
            float er[16], ei[16], orr[16], oi[16];
#pragma unroll
            for (int j = 0; j < 16; ++j) { const int k = k0 + j, row = dir ? (S5_ROWS - 1 - k) : (k < 16 ? 256 + k : k - 16); er[j] = bflo((unsigned)col[row * 256]); ei[j] = bflo((unsigned)col[row * 256 + 64]); }
#pragma unroll
            for (int j = 0; j < 16; ++j) { orr[j] = hr; oi[j] = hi; const float nr = ar * hr - ai * hi + er[j], ni = ar * hi + ai * hr + ei[j]; hr = nr; hi = ni; }
#pragma unroll
            for (int j = 0; j < 16; ++j) { const int k = k0 + j, row = dir ? (S5_ROWS - 1 - k) : (k < 16 ? 256 + k : k - 16); col[row * 256] = (bf16)f2bf(orr[j]); col[row * 256 + 64] = (bf16)f2bf(oi[j]); }
        }
    }
    __syncthreads();
#pragma unroll
    for (int k = 0; k < 16; ++k) { const int i = tid + k * NWAVES * 64; *(v4u*)(ZH + (size_t)bg * 256 * 256 + (size_t)i * 8) = *(const LAS v4u*)(EL + i * 8); }
    __syncthreads();
}

constexpr int RS_PITCH = 136;
constexpr int RS_BUF = (128 + 32) * RS_PITCH * 2;
__device__ __forceinline__ void phase_rstate(Frame& F) {
    const bf16* KNL = (const bf16*)(F.ws + WS_K); const bf16* KNC = (const bf16*)(F.ws + WS_KFTC);
    const bf16* VT = (const bf16*)(F.ws + WS_VT); const bf16* VTC = (const bf16*)(F.ws + WS_VTC);
    bf16* SIN = (bf16*)(F.ws + WS_OBUF);
    const float* lg2 = (const float*)(F.ws + WS_TAB + TAB_LG2);
    const int lane0 = lane_id();
    const int w = F.wave;
    for (int unit = F.vcu; unit < NB * NH * 2 * 8; unit += F.G) {
        int lane = lane0; asm volatile("" : "+v"(lane));
        const int tid = w * 64 + lane, fr = lane & 15, fq = lane >> 4;
        const int sl = unit & 7, dir = (unit >> 3) & 1, h = (unit >> 4) & 7, b = unit >> 7;
        const float gC = __builtin_amdgcn_exp2f((float)CH * lg2[dir * 8 + h]);
        const int bh = b * NH + h;
        const bf16* kT = KNL; const bf16* kTc = KNC;
        const int prow = tid >> 4, pc = tid & 15;
        float vw[8];
#pragma unroll
        for (int jj = 0; jj < 8; ++jj) { const int j = 8 * pc + jj; vw[jj] = __builtin_amdgcn_exp2f((float)(dir ? j : CH - 1 - j) * lg2[dir * 8 + h]); }
        f32x4 st[2] = {{0.f, 0.f, 0.f, 0.f}, {0.f, 0.f, 0.f, 0.f}};
#define RS_ISSUE(k, R) do { if ((k) < 34) { const bf16* kb_; const bf16* vb_; int ls_; \
            if ((k) < 2) { const int cc_ = dir ? (1 - (k)) : (k); ls_ = LC; kb_ = kTc + (size_t)(b * LC + cc_ * CH) * 1024 + h * DK; vb_ = VTC + (size_t)(bh * DV + 32 * sl) * LC + cc_ * CH; } \
            else { const int n_ = dir ? (33 - (k)) : ((k) - 2); ls_ = SEQ; kb_ = kT + (size_t)(b * SEQ + n_ * CH) * 1024 + h * DK; vb_ = VT + (size_t)(bh * DV + 32 * sl) * SEQ + n_ * CH; } \
            _Pragma("unroll") for (int i_ = 0; i_ < 4; ++i_) R[i_] = *(const v4u*)(kb_ + (size_t)(prow + 32 * i_) * 1024 + pc * 8);     \
            R[4] = *(const v4u*)(vb_ + (size_t)prow * ls_ + pc * 8); } } while (0)
#define RS_STEP(k, R) do { LAS bf16* buf_ = (LAS bf16*)(F.lds + ((k) & 1) * RS_BUF); \
            _Pragma("unroll") for (int i_ = 0; i_ < 4; ++i_) *(LAS v4u*)(buf_ + (prow + 32 * i_) * RS_PITCH + pc * 8) = R[i_]; \
            { const v4u r_ = R[4]; v4u s_; \
              s_.x = cvt_pk_bf16(bflo(r_.x) * vw[0], bfhi(r_.x) * vw[1]); s_.y = cvt_pk_bf16(bflo(r_.y) * vw[2], bfhi(r_.y) * vw[3]); s_.z = cvt_pk_bf16(bflo(r_.z) * vw[4], bfhi(r_.z) * vw[5]); s_.w = cvt_pk_bf16(bflo(r_.w) * vw[6], bfhi(r_.w) * vw[7]); \
              *(LAS v4u*)(buf_ + (128 + prow) * RS_PITCH + pc * 8) = s_; } } while (0)
#define RS_COMP(k) do { const LAS bf16* buf_ = (const LAS bf16*)(F.lds + ((k) & 1) * RS_BUF); \
            const int n_ = (k) < 2 ? -1 : (dir ? (33 - (k)) : ((k) - 2)); \
            if (n_ >= 0) { _Pragma("unroll") for (int et = 0; et < 2; ++et) { v2u o; o.x = cvt_pk_bf16(st[et][0], st[et][1]); o.y = cvt_pk_bf16(st[et][2], st[et][3]); \
                *(v2u*)(SIN + ((((size_t)(bh * 2 + dir) * NCH + n_) * DV + 32 * sl + 16 * et + fr) * DK + 16 * w + 4 * fq)) = o; } } \
            bf16x8 kf_[4];                         \
            { const unsigned ta_ = (unsigned)(size_t)buf_ + (unsigned)((8 * fq + (fr >> 2)) * (RS_PITCH * 2) + (16 * w + 4 * (fr & 3)) * 2); v2u t0_, t1_, t2_, t3_, t4_, t5_, t6_, t7_; \
              asm volatile("ds_read_b64_tr_b16 %0, %8\n\tds_read_b64_tr_b16 %1, %8 offset:1088\n\tds_read_b64_tr_b16 %2, %8 offset:8704\n\tds_read_b64_tr_b16 %3, %8 offset:9792\n\t" \
                           "ds_read_b64_tr_b16 %4, %8 offset:17408\n\tds_read_b64_tr_b16 %5, %8 offset:18496\n\tds_read_b64_tr_b16 %6, %8 offset:26112\n\tds_read_b64_tr_b16 %7, %8 offset:27200\n\ts_waitcnt lgkmcnt(0)" \
                           : "=&v"(t0_), "=&v"(t1_), "=&v"(t2_), "=&v"(t3_), "=&v"(t4_), "=&v"(t5_), "=&v"(t6_), "=&v"(t7_) : "v"(ta_) : "memory"); \
              kf_[0] = __builtin_bit_cast(bf16x8, (v4u){t0_.x, t0_.y, t1_.x, t1_.y}); kf_[1] = __builtin_bit_cast(bf16x8, (v4u){t2_.x, t2_.y, t3_.x, t3_.y}); \
              kf_[2] = __builtin_bit_cast(bf16x8, (v4u){t4_.x, t4_.y, t5_.x, t5_.y}); kf_[3] = __builtin_bit_cast(bf16x8, (v4u){t6_.x, t6_.y, t7_.x, t7_.y}); } \
            _Pragma("unroll") for (int et = 0; et < 2; ++et) { f32x4 kv = {0.f, 0.f, 0.f, 0.f}; \
                _Pragma("unroll") for (int ks = 0; ks < 4; ++ks) { const bf16x8 vf_ = *(const LAS bf16x8*)(buf_ + (128 + 16 * et + fr) * RS_PITCH + 32 * ks + 8 * fq); kv = __builtin_amdgcn_mfma_f32_16x16x32_bf16(kf_[ks], vf_, kv, 0, 0, 0); } \
                st[et] = st[et] * gC + kv; } } while (0)
        v4u RA[5], RB[5], RC[5];
        RS_ISSUE(0, RA); RS_ISSUE(1, RB);
        for (int k = 0; k < 34; k += 3) {
            RS_ISSUE(k + 2, RC);
            RS_STEP(k, RA); __syncthreads(); RS_COMP(k);
            RS_ISSUE(k + 3, RA);
            if (k + 1 < 34) { RS_STEP(k + 1, RB); __syncthreads(); RS_COMP(k + 1); }
            RS_ISSUE(k + 4, RB);
            if (k + 2 < 34) { RS_STEP(k + 2, RC); __syncthreads(); RS_COMP(k + 2); }
        }
        __syncthreads();
#undef RS_ISSUE
#undef RS_STEP
#undef RS_COMP
    }
}

constexpr int RO_PITCH = 136;
constexpr int RO_SLOT = 256 * RO_PITCH * 2;
__device__ __forceinline__ void phase_rout(Frame& F, const int cid) {
    const bf16* Q = (const bf16*)(F.ws + WS_Q);
    const bf16* KN = (const bf16*)(F.ws + WS_K); const bf16* VT = (const bf16*)(F.ws + WS_VT);
    const bf16* SIN = (const bf16*)(F.ws + WS_OBUF);
    bf16* SG = (bf16*)(F.ws + WS_HBUF);
    const float* lg2 = (const float*)(F.ws + WS_TAB + TAB_LG2);
    LAS bf16* SA = (LAS bf16*)F.lds; LAS bf16* SB = (LAS bf16*)(F.lds + RO_SLOT);
    const int lane0 = lane_id();
    const int w = F.wave;
    const bool split13 = (F.G == 256);
    const int ufirst = split13 ? (cid < 128 ? cid : 128 + (cid - 128) * 3) : F.vcu, ucount = split13 ? (cid < 128 ? 1 : 3) : (NB * NH * NCH - 1 - F.vcu) / F.G + 1, ustep = split13 ? 1 : F.G;
    for (int ui = 0; ui < ucount; ++ui) {
        const int unit = ufirst + ui * ustep;
        int lane = lane0; asm volatile("" : "+v"(lane));
        const int tid = w * 64 + lane, fr = lane & 15, fq = lane >> 4;
        const int n = unit & 31, h = (unit >> 5) & 7, b = unit >> 8, bh = b * NH + h;
        const float lgf = lg2[h], lgb = lg2[8 + h];
        const int tok0 = b * SEQ + n * CH;
        const int i = 16 * w + fr;
        const size_t qoff = (size_t)(tok0 + i) * 1024 + h * DK;
        {
            v4u kr[4], vr[8];
#pragma unroll
            for (int it = 0; it < 4; ++it) { const int q = tid + 512 * it, j = q >> 4, pc = q & 15; kr[it] = __builtin_nontemporal_load((const v4u*)(KN + (size_t)(tok0 + j) * 1024 + h * DK + pc * 8)); }
#pragma unroll
            for (int it = 0; it < 8; ++it) { const int q = tid + 512 * it, e = q >> 4, pc = q & 15; vr[it] = __builtin_nontemporal_load((const v4u*)(VT + ((size_t)(bh * DV + e)) * SEQ + n * CH + pc * 8)); }
#pragma unroll
            for (int it = 0; it < 4; ++it) { const int q = tid + 512 * it, j = q >> 4, pc = q & 15; *(LAS v4u*)(SB + j * RO_PITCH + pc * 8) = kr[it]; }
#pragma unroll
            for (int it = 0; it < 8; ++it) { const int q = tid + 512 * it, e = q >> 4, pc = q & 15; *(LAS v4u*)(SA + e * RO_PITCH + pc * 8) = vr[it]; }
        }
        bf16x8 qf[4];
#pragma unroll
        for (int ks = 0; ks < 4; ++ks) qf[ks] = *(const bf16x8*)(Q + qoff + 32 * ks + 8 * fq);
        __syncthreads();
        f32x4 sc[8];
#pragma unroll
        for (int jt = 0; jt < 8; ++jt) {
            f32x4 a = {0.f, 0.f, 0.f, 0.f};
#pragma unroll
            for (int ks = 0; ks < 4; ++ks) { const bf16x8 kf = *(const LAS bf16x8*)(SB + (16 * jt + fr) * RO_PITCH + 32 * ks + 8 * fq); a = __builtin_amdgcn_mfma_f32_16x16x32_bf16(kf, qf[ks], a, 0, 0, 0); }
#pragma unroll
            for (int r = 0; r < 4; ++r) { const int j = 16 * jt + 4 * fq + r, df = i - j; a[r] *= df >= 0 ? __builtin_amdgcn_exp2f((float)df * lgf) : __builtin_amdgcn_exp2f((float)(-df) * lgb); }
            sc[jt] = a;
        }
        f32x4 o[16];
#pragma unroll
        for (int et = 0; et < 16; ++et) o[et] = (f32x4){0.f, 0.f, 0.f, 0.f};
#pragma unroll
        for (int ks = 0; ks < 4; ++ks) {
            v4u pw; pw.x = cvt_pk_bf16(sc[2 * ks][0], sc[2 * ks][1]); pw.y = cvt_pk_bf16(sc[2 * ks][2], sc[2 * ks][3]); pw.z = cvt_pk_bf16(sc[2 * ks + 1][0], sc[2 * ks + 1][1]); pw.w = cvt_pk_bf16(sc[2 * ks + 1][2], sc[2 * ks + 1][3]);
            const bf16x8 pf = __builtin_bit_cast(bf16x8, pw);
#pragma unroll
            for (int et = 0; et < 16; ++et) {
                const LAS bf16* vp = SA + (16 * et + fr) * RO_PITCH + 32 * ks + 4 * fq;
                const v2u lo = *(const LAS v2u*)vp, hi2 = *(const LAS v2u*)(vp + 16);
                v4u vw; vw.x = lo.x; vw.y = lo.y; vw.z = hi2.x; vw.w = hi2.y;
                o[et] = __builtin_amdgcn_mfma_f32_16x16x32_bf16(__builtin_bit_cast(bf16x8, vw), pf, o[et], 0, 0, 0);
            }
        }
        __syncthreads();
        {
            const bf16* sf = SIN + (((size_t)(bh * 2 + 0) * NCH + n) * DV) * DK; const bf16* sb = SIN + (((size_t)(bh * 2 + 1) * NCH + n) * DV) * DK;
            v4u fr_[8], br_[8];
#pragma unroll
            for (int it = 0; it < 8; ++it) { const int q = tid + 512 * it; fr_[it] = __builtin_nontemporal_load((const v4u*)(sf + (size_t)q * 8)); br_[it] = __builtin_nontemporal_load((const v4u*)(sb + (size_t)q * 8)); }
#pragma unroll
            for (int it = 0; it < 8; ++it) { const int q = tid + 512 * it, e = q >> 4, pc = q & 15; *(LAS v4u*)(SA + e * RO_PITCH + pc * 8) = fr_[it]; *(LAS v4u*)(SB + e * RO_PITCH + pc * 8) = br_[it]; }
        }
        bf16x8 qff[4], qbf[4];
        { const float wfq = __builtin_amdgcn_exp2f((float)(i + 1) * lgf), wbq = __builtin_amdgcn_exp2f((float)(CH - i) * lgb);
#pragma unroll
          for (int ks = 0; ks < 4; ++ks) { const v4u qw = __builtin_bit_cast(v4u, qf[ks]); v4u a, b2;
            a.x = cvt_pk_bf16(bflo(qw.x) * wfq, bfhi(qw.x) * wfq); a.y = cvt_pk_bf16(bflo(qw.y) * wfq, bfhi(qw.y) * wfq); a.z = cvt_pk_bf16(bflo(qw.z) * wfq, bfhi(qw.z) * wfq); a.w = cvt_pk_bf16(bflo(qw.w) * wfq, bfhi(qw.w) * wfq);
            b2.x = cvt_pk_bf16(bflo(qw.x) * wbq, bfhi(qw.x) * wbq); b2.y = cvt_pk_bf16(bflo(qw.y) * wbq, bfhi(qw.y) * wbq); b2.z = cvt_pk_bf16(bflo(qw.z) * wbq, bfhi(qw.z) * wbq); b2.w = cvt_pk_bf16(bflo(qw.w) * wbq, bfhi(qw.w) * wbq);
            qff[ks] = __builtin_bit_cast(bf16x8, a); qbf[ks] = __builtin_bit_cast(bf16x8, b2); } }
        __syncthreads();
#pragma unroll
        for (int ks = 0; ks < 4; ++ks)
#pragma unroll
            for (int et = 0; et < 16; ++et) {
                const bf16x8 s1 = *(const LAS bf16x8*)(SA + (16 * et + fr) * RO_PITCH + 32 * ks + 8 * fq), s2 = *(const LAS bf16x8*)(SB + (16 * et + fr) * RO_PITCH + 32 * ks + 8 * fq);
                o[et] = __builtin_amdgcn_mfma_f32_16x16x32_bf16(s1, qff[ks], o[et], 0, 0, 0);
                o[et] = __builtin_amdgcn_mfma_f32_16x16x32_bf16(s2, qbf[ks], o[et], 0, 0, 0);
            }
        float ss = 0.f;
#pragma unroll
        for (int et = 0; et < 16; ++et) ss += (o[et][0] * o[et][0] + o[et][1] * o[et][1]) + (o[et][2] * o[et][2] + o[et][3] * o[et][3]);
        ss += shfl_xor_l(ss, 16, lane); ss += shfl_xor_l(ss, 32, lane);
        const float rinv = 1.0f / sqrtf(ss * (1.0f / DV) + EPS);
        bf16* gp = SG + (size_t)(tok0 + i) * D + h * DV + 4 * fq;
#pragma unroll
        for (int et = 0; et < 16; ++et) { const v2u gg = __builtin_nontemporal_load((const v2u*)(gp + 16 * et));
            v2u ow; ow.x = cvt_pk_bf16(o[et][0] * rinv * bflo(gg.x), o[et][1] * rinv * bfhi(gg.x)); ow.y = cvt_pk_bf16(o[et][2] * rinv * bflo(gg.y), o[et][3] * rinv * bfhi(gg.y));
            *(v2u*)(gp + 16 * et) = ow; }
        __syncthreads();
    }
}

__global__ void __launch_bounds__(NWAVES * 64, 2) fwd_megakernel(Args args) {
    extern __shared__ __attribute__((aligned(16))) unsigned char lds[];
    Frame F;
    F.lds = (LAS unsigned char*)lds;
    F.MISC = (volatile LAS unsigned*)(F.lds + MISC_OFF);
    F.wave = __builtin_amdgcn_readfirstlane((int)threadIdx.x >> 6);
    F.G = gridDim.x; { const int bx = blockIdx.x; F.vcu = (F.G % 8 == 0) ? (bx % 8) * (F.G / 8) + bx / 8 : bx; }
    F.out = kargs()->out; F.ws = kargs()->ws; F.ctl = (unsigned*)(F.ws + WS_CTL);
    for (int u = (int)threadIdx.x; u < (LDS_BYTES - LDSCTL_OFF) / 4; u += NWAVES * 64) ((LAS unsigned*)(F.lds + LDSCTL_OFF))[u] = 0u;
    __syncthreads();
    XcdBarrier bar = xcd_barrier_post(F.ctl + CW_BAR, F.MISC + 8);
    unsigned char* ws = F.ws;
    const int G = F.G, cid = (int)blockIdx.x;
#define GRID_BAR() xcd_barrier(bar)

#ifndef PHM
#define PHM 0xFFFFF
#endif
#define PH(k) ((PHM >> (k)) & 1)
#ifndef REPM
#define REPM 0
#endif
#define NREP(k) (1 + ((REPM >> (k)) & 1))
#if PH(0)
    phase_prologue(F, args, true);
#if NREP(0) > 1
    phase_prologue(F, args, false);
#endif
#endif
    GRID_BAR();
#if PH(1)
    phase_rows<0>(F, args);
    build_modv(F, args);
    s5_tables1(F, args);
#endif
    GRID_BAR();
#if PH(2)
    {
        pg8::GridOrder S; S.init(ws + WS_ABUF, ws + WS_W1T, D, MT / 256, NFF / 256, G, cid);
        EpiSwiGLU E{(bf16*)(ws + WS_HBUF)};
        pg8::gemm_phase(F.lds, D, S, E, F.wave);
    }
    if (G == 256 && cid >= 256 - CV_G1_CUS) conv_range(F, 1, 0, CV_L1_G1, (cid - (256 - CV_G1_CUS)) * NWAVES + F.wave, CV_G1_CUS * NWAVES);
#if NREP(2) > 1
    {
        pg8::GridOrder S; S.init(ws + WS_ABUF, ws + WS_W1T, D, MT / 256, NFF / 256, G, cid);
        EpiSwiGLU E{(bf16*)(ws + WS_HBUF)};
        pg8::gemm_phase(F.lds, D, S, E, F.wave);
    }
#endif
#endif
    GRID_BAR();
#if PH(3)
    {
        Ffn1DownOrder S{(const char*)(ws + WS_HBUF), (const char*)(ws + WS_W2T), G, cid};
        EpiFfn1Down E{(bf16*)(ws + WS_OBUF), (float*)(ws + WS_SLAB)};
        pg8::gemm_phase(F.lds, DFF, S, E, F.wave);
    }
    if (G == 256 && cid >= 256 - CV_G2_CUS) conv_range(F, 1, CV_L1_G1, CV_L1_G1 + CV_L1_G2, (cid - (256 - CV_G2_CUS)) * NWAVES + F.wave, CV_G2_CUS * NWAVES);
#if NREP(3) > 1
    {
        pg8::GridOrder S; S.init(ws + WS_HBUF, ws + WS_W2T, DFF, MT / 256, D / 256, G, cid);
        EpiO16 E{(bf16*)(ws + WS_OBUF), D};
        pg8::gemm_phase(F.lds, DFF, S, E, F.wave);
    }
#endif
#endif
    GRID_BAR();
#if PH(4)
    phase_rows<1>(F, args);
    s5_tables2(F, args);
#endif
    GRID_BAR();
#if PH(5)
    {
        MixOrder S{(const char*)(ws + WS_ABUF), (const char*)(ws + WS_WMT), G, cid};
        EpiMix E{ws};
        pg8::gemm_phase(F.lds, D, S, E, F.wave);
    }
    if (G == 256 && cid >= 256 - CV_G3_CUS) conv_range(F, 2, 0, CV_L2_G3, (cid - (256 - CV_G3_CUS)) * NWAVES + F.wave, CV_G3_CUS * NWAVES);
#if NREP(5) > 1
    {
        MixOrder S{(const char*)(ws + WS_ABUF), (const char*)(ws + WS_WMT), G, cid};
        EpiMix E{ws};
        pg8::gemm_phase(F.lds, D, S, E, F.wave);
    }
#endif
#endif
    GRID_BAR();
#if PH(6)
    phase_rstate(F);
#if NREP(6) > 1
    phase_rstate(F);
#endif
#endif
#if PH(7)
    {
        S5EOrder S{(const char*)(ws + WS_US), (const char*)(ws + WS_S5WE), G, cid};
        EpiS5E E{(bf16*)(ws + WS_S5E)};
        pg8::gemm_phase(F.lds, 256, S, E, F.wave);
    }
#endif
    GRID_BAR();
#if PH(8)
    {
        int tid_ = F.wave * 64 + lane_id(); asm volatile("" : "+v"(tid_));
        for (int bg = cid; bg < NB * 64; bg += G) s5_scan_bg(F, bg, tid_);
        asm volatile("s_waitcnt vmcnt(0)" ::: "memory"); __syncthreads();
        S5YOrder S{(const char*)(ws + WS_US), (const char*)(ws + WS_S5ZH), (const char*)(ws + WS_S5WY1), (const char*)(ws + WS_S5WY2), G, cid};
        EpiS5Y E{(bf16*)(ws + WS_AGLU)};
        pg8::gemm_phase(F.lds, 256, S, E, F.wave);
    }
    phase_rout(F, cid);
#endif
    GRID_BAR();
#if PH(9)
    {
        pg8::GridOrder S; S.init(ws + WS_AGLU, ws + WS_WGT, SW, MX / 256, 2 * D / 256, G, cid);
        EpiGLU E{(const bf16*)(ws + WS_HBUF + 32 * MiB), (bf16*)(ws + WS_Q)};
        pg8::gemm_phase(F.lds, SW, S, E, F.wave);
    }
#if NREP(9) > 1
    {
        pg8::GridOrder S; S.init(ws + WS_AGLU, ws + WS_WGT, SW, MX / 256, 2 * D / 256, G, cid);
        EpiGLU E{(const bf16*)(ws + WS_HBUF + 32 * MiB), (bf16*)(ws + WS_Q)};
        pg8::gemm_phase(F.lds, SW, S, E, F.wave);
    }
#endif
#endif
    GRID_BAR();
#if PH(10)
    {
        pg8::GridOrder S; S.init(ws + WS_HBUF, ws + WS_WPT, D, MX / 256, D / 256, G, cid);
        EpiMerge E{(const bf16*)(ws + WS_HBUF + 64 * MiB), (bf16*)(ws + WS_Q)};
        pg8::gemm_phase(F.lds, D, S, E, F.wave);
    }
#if NREP(10) > 1
    {
        pg8::GridOrder S; S.init(ws + WS_HBUF, ws + WS_WPT, D, MX / 256, D / 256, G, cid);
        EpiMerge E{(const bf16*)(ws + WS_HBUF + 64 * MiB), (bf16*)(ws + WS_Q)};
        pg8::gemm_phase(F.lds, D, S, E, F.wave);
    }
#endif
#endif
    GRID_BAR();
#if PH(11)
    {
        pg8::GridOrder S; S.init(ws + WS_Q, ws + WS_WOT, D, MX / 256, D / 256, G, cid);
        EpiO16 E{(bf16*)(ws + WS_OBUF), D};
        pg8::gemm_phase(F.lds, D, S, E, F.wave);
    }
#if NREP(11) > 1
    {
        pg8::GridOrder S; S.init(ws + WS_Q, ws + WS_WOT, D, MX / 256, D / 256, G, cid);
        EpiO16 E{(bf16*)(ws + WS_OBUF), D};
        pg8::gemm_phase(F.lds, D, S, E, F.wave);
    }
#endif
#endif
    GRID_BAR();
#if PH(12)
    phase_rows<2>(F, args);
#if NREP(12) > 1
    phase_rows<2>(F, args);
#endif
#endif
    GRID_BAR();
#if PH(13)
    {
        pg8::GridOrder S; S.init(ws + WS_ABUF, ws + WS_W3T, D, MX / 256, NFF / 256, G, cid);
        EpiSwiGLU E{(bf16*)(ws + WS_HBUF)};
        pg8::gemm_phase(F.lds, D, S, E, F.wave);
    }
#if NREP(13) > 1
    {
        pg8::GridOrder S; S.init(ws + WS_ABUF, ws + WS_W3T, D, MX / 256, NFF / 256, G, cid);
        EpiSwiGLU E{(bf16*)(ws + WS_HBUF)};
        pg8::gemm_phase(F.lds, D, S, E, F.wave);
    }
#endif
#endif
    GRID_BAR();
#if PH(14)
    {
        pg8::GridOrder S; S.init(ws + WS_HBUF, ws + WS_W4T, DFF, MX / 256, D / 256, G, cid);
        EpiO16 E{(bf16*)(ws + WS_OBUF), D};
        pg8::gemm_phase(F.lds, DFF, S, E, F.wave);
    }
#if NREP(14) > 1
    {
        pg8::GridOrder S; S.init(ws + WS_HBUF, ws + WS_W4T, DFF, MX / 256, D / 256, G, cid);
        EpiO16 E{(bf16*)(ws + WS_OBUF), D};
        pg8::gemm_phase(F.lds, DFF, S, E, F.wave);
    }
#endif
#endif
    GRID_BAR();
#if PH(15)
    phase_rows<3>(F, args);
#if NREP(15) > 1
    phase_rows<3>(F, args);
#endif
#endif
}

extern "C" void kernel_launch(void* const* d_in, const int* in_sizes, int n_in, void* d_out, int out_size, void* d_ws, size_t ws_size, hipStream_t stream) {
    static int grid = 0;
    if (grid == 0) {
        if (n_in != 22 || in_sizes[0] != MX * D || out_size != MX * D || ws_size < WS_END) { fprintf(stderr, "kernel_launch: unexpected problem (n_in %d, in0 %d, out %d, ws %zu, need %zu)\n", n_in, n_in > 0 ? in_sizes[0] : -1, out_size, ws_size, (size_t)WS_END); grid = -1; return; }
        int dev = 0, cus = 0, per_cu = 0;
        if (hipGetDevice(&dev) != hipSuccess || hipDeviceGetAttribute(&cus, hipDeviceAttributeMultiprocessorCount, dev) != hipSuccess) { grid = -1; return; }
        if (hipFuncSetAttribute((const void*)fwd_megakernel, hipFuncAttributeMaxDynamicSharedMemorySize, LDS_BYTES) != hipSuccess) { fprintf(stderr, "kernel_launch: hipFuncSetAttribute failed\n"); grid = -1; return; }
        if (hipOccupancyMaxActiveBlocksPerMultiprocessor(&per_cu, (const void*)fwd_megakernel, NWAVES * 64, LDS_BYTES) != hipSuccess || per_cu < 1) { fprintf(stderr, "kernel_launch: occupancy query says %d blocks per CU\n", per_cu); grid = -1; (void)hipGetLastError(); return; }
        grid = cus;
    }
    if (grid < 0) return;
    if (hipMemsetAsync((char*)d_ws + WS_CTL, 0, CTL_ZERO_BYTES, stream) != hipSuccess) return;
    Args a{};
    for (int i = 0; i < 22; ++i) a.in[i] = (const float*)d_in[i];
    a.out = (float*)d_out; a.ws = (unsigned char*)d_ws;
    void* kargs[] = {&a};
    hipError_t e = hipLaunchCooperativeKernel((const void*)fwd_megakernel, dim3(grid), dim3(NWAVES * 64), kargs, LDS_BYTES, stream);
    if (e != hipSuccess) fprintf(stderr, "kernel_launch: cooperative launch failed: %s (grid %d)\n", hipGetErrorString(e), grid);
}
```

```cpp
#include <hip/hip_runtime.h>
#include <cstdio>
#include <cstdint>

#define GAS __attribute__((address_space(1)))
#define LAS __attribute__((address_space(3)))
typedef unsigned short bf16;
typedef unsigned v4u __attribute__((ext_vector_type(4)));
typedef unsigned v2u __attribute__((ext_vector_type(2)));
typedef float f32x4 __attribute__((ext_vector_type(4)));
typedef float f32x2 __attribute__((ext_vector_type(2)));
typedef short bf16x8 __attribute__((ext_vector_type(8)));
typedef short bf16x4 __attribute__((ext_vector_type(4)));

constexpr int D = 2048, NB = 2, SEQ = 4096, MX = NB * SEQ, LC = 256, MC = NB * LC, MT = MX + MC;
constexpr int DFF = 5632, NFF = 2 * DFF, SW = 1024, NMIX = 11264, NH = 8, DK = 128, DV = 256, CH = 128, NCH = SEQ / CH;
constexpr int NADA = 9 * D;
constexpr float EPS = 1e-6f;
constexpr int NWAVES = 8;

constexpr size_t MiB = 1u << 20;
constexpr size_t WS_CTL = 0, CTL_ZERO_BYTES = 1 * MiB;
constexpr size_t WS_W1T = 1 * MiB, WS_W2T = 45 * MiB, WS_WMT = 67 * MiB, WS_WGT = 115 * MiB, WS_WPT = 123 * MiB, WS_WOT = 131 * MiB, WS_W3T = 139 * MiB, WS_W4T = 183 * MiB;
constexpr size_t WS_ABUF = 205 * MiB;
constexpr size_t WS_HBUF = 239 * MiB;
constexpr size_t WS_OBUF = 335 * MiB;
constexpr size_t WS_US = 403 * MiB;
constexpr size_t WS_Q = 420 * MiB, WS_QF = 436 * MiB, WS_QB = 452 * MiB;
constexpr size_t WS_K = 468 * MiB;
constexpr size_t WS_KFT = 484 * MiB, WS_KBT = 500 * MiB, WS_KFTC = 516 * MiB, WS_KBTC = 517 * MiB;
constexpr size_t WS_STREAM = WS_KFT;
constexpr size_t WS_VT = 518 * MiB, WS_VTC = 550 * MiB;
constexpr size_t WS_YF = 552 * MiB;
constexpr size_t WS_S5WE = WS_YF, WS_S5WY1 = WS_YF + 8 * MiB, WS_S5WY2 = WS_YF + 16 * MiB, WS_S5KT = WS_YF + 24 * MiB, WS_S5BRF = WS_YF + 26 * MiB, WS_S5APOW = WS_YF + 28 * MiB;
constexpr size_t WS_S5E = WS_ABUF, WS_S5ZH = WS_ABUF + 17 * MiB;
constexpr int S5_ROWS = 272;
constexpr size_t WS_AGLU = 584 * MiB;
constexpr size_t WS_TAB = 600 * MiB;
constexpr size_t WS_END = 602 * MiB;
constexpr size_t TAB_ROPE = 0, TAB_LG2 = 16384, TAB_AR = 32768, TAB_AI = 65536, TAB_END = 131072;
constexpr size_t TAB_MODV = 262144;
constexpr int CW_BAR = 4096;
constexpr size_t CTL_ADA = 65536;

#define RLX_AGENT __ATOMIC_RELAXED, __HIP_MEMORY_SCOPE_AGENT
#define LDS_WAIT() asm volatile("s_waitcnt lgkmcnt(0)" ::: "memory")
#define VM_WAIT() asm volatile("s_waitcnt vmcnt(0)" ::: "memory")

__device__ __forceinline__ unsigned f2bf(float f) { unsigned u = __builtin_bit_cast(unsigned, f); return (u + 0x7fffu + ((u >> 16) & 1u)) >> 16; }
__device__ __forceinline__ unsigned pk2(float lo, float hi) { return f2bf(lo) | (f2bf(hi) << 16); }
__device__ __forceinline__ unsigned cvt_pk_bf16(float lo, float hi) { unsigned r; asm volatile("v_cvt_pk_bf16_f32 %0, %1, %2" : "=v"(r) : "v"(lo), "v"(hi)); return r; }
__device__ __forceinline__ float bflo(unsigned w) { return __builtin_bit_cast(float, w << 16); }
__device__ __forceinline__ float bfhi(unsigned w) { return __builtin_bit_cast(float, w & 0xffff0000u); }
__device__ __forceinline__ float fast_sigmoid(float x) { return __builtin_amdgcn_rcpf(1.0f + __builtin_amdgcn_exp2f(-1.4426950408889634f * x)); }
__device__ __forceinline__ float fast_silu(float x) { return x * fast_sigmoid(x); }
__device__ __forceinline__ float gelu_tanh(float x) { const float u = 0.7978845608028654f * (x + 0.044715f * x * x * x); return x * fast_sigmoid(2.0f * u); }
__device__ __forceinline__ int lane_id() { return (int)__builtin_amdgcn_mbcnt_hi(~0u, __builtin_amdgcn_mbcnt_lo(~0u, 0u)); }
__device__ __forceinline__ float shfl_xor_l(float v, int mask, int lane) { return __builtin_bit_cast(float, __builtin_amdgcn_ds_bpermute((lane ^ mask) << 2, __builtin_bit_cast(int, v))); }
__device__ __forceinline__ float wave_sum(float v, int lane) {
#pragma unroll
    for (int o = 1; o < 64; o <<= 1) v += shfl_xor_l(v, o, lane);
    return v;
}

#define XB_TMO      128
#define XB_XCNT(j)  (256  + 64 * (j))
#define XB_XSUB(j)  (1280 + 64 * (j))
#define XB_XGEN(j)  (2304 + 64 * (j))
#define XB_TOP      3328
#define XB_TOPGEN   3392
#define XCD_BAR_WORDS 3456
#define XB_SPIN_CAP (1u << 18)
__device__ __forceinline__ unsigned xb_ld(unsigned* p)              { return __hip_atomic_load(p, __ATOMIC_RELAXED, __HIP_MEMORY_SCOPE_AGENT); }
__device__ __forceinline__ unsigned xb_add(unsigned* p, unsigned v) { return __hip_atomic_fetch_add(p, v, __ATOMIC_RELAXED, __HIP_MEMORY_SCOPE_AGENT); }
__device__ __forceinline__ unsigned xb_xcc_id() { return (unsigned)__builtin_amdgcn_s_getreg((3 << 11) | 20) & 0xFu; }
#define XB_SPIN(cond, bar) do { unsigned _sp = 0; while (cond) { __builtin_amdgcn_s_sleep(1); \
    if ((++_sp & 255u) == 0u) { if (xb_ld(&(bar)[XB_TMO])) break; if (_sp > XB_SPIN_CAP) { atomicAdd(&(bar)[XB_TMO], 1u); break; } } } } while (0)
struct XcdBarrier { unsigned* bar; unsigned x; volatile LAS unsigned* st; };
__device__ __forceinline__ XcdBarrier xcd_barrier_post(unsigned* bar, volatile LAS unsigned* st) {
    XcdBarrier b; b.bar = bar; b.x = xb_xcc_id(); b.st = st;
    if (threadIdx.x == 0) (void)xb_add(&bar[XB_XCNT(b.x)], 1u);
    return b;
}
__device__ __forceinline__ void xcd_barrier_complete(unsigned* bar, unsigned x, unsigned& nloc, unsigned& nx) {
    const unsigned G = gridDim.x * gridDim.y * gridDim.z;
    unsigned sum, cnt, mine, sp = 0u;
    for (;;) {
        sum = 0u; cnt = 0u; mine = 0u;
#pragma unroll
        for (unsigned j = 0; j < 16; ++j) { const unsigned c = xb_ld(&bar[XB_XCNT(j)]); sum += c; cnt += (c > 0u) ? 1u : 0u; mine = (j == x) ? c : mine; }
        if (sum == G) break;
        __builtin_amdgcn_s_sleep(1);
        if ((++sp & 255u) == 0u) { if (xb_ld(&bar[XB_TMO])) break; if (sp > XB_SPIN_CAP) { atomicAdd(&bar[XB_TMO], 1u); break; } }
    }
    nloc = mine > 0u ? mine : 1u; nx = cnt > 0u ? cnt : 1u;
}
__device__ __forceinline__ void xcd_barrier(const XcdBarrier& b) {
    asm volatile("s_waitcnt vmcnt(0)" ::: "memory");
    __syncthreads();
    if (threadIdx.x == 0) {
        unsigned* bar = b.bar;
        __builtin_amdgcn_s_waitcnt(0);
        unsigned nloc = b.st[0], nx = b.st[1];
        if (nloc == 0u) { xcd_barrier_complete(bar, b.x, nloc, nx); b.st[0] = nloc; b.st[1] = nx; }
        const unsigned old = xb_add(&bar[XB_XSUB(b.x)], 1u);
        const unsigned gen = old / nloc;
        if (old + 1u == (gen + 1u) * nloc) {
            __builtin_amdgcn_fence(__ATOMIC_RELEASE, "agent");
            asm volatile("s_waitcnt vmcnt(0)" ::: "memory");
            const unsigned og = xb_add(&bar[XB_TOP], 1u);
            const unsigned tg = og / nx;
            if (og + 1u == (tg + 1u) * nx) xb_add(&bar[XB_TOPGEN], 1u);
            else XB_SPIN(xb_ld(&bar[XB_TOPGEN]) == tg, bar);
            __builtin_amdgcn_fence(__ATOMIC_ACQUIRE, "agent");
            xb_add(&bar[XB_XGEN(b.x)], 1u);
            asm volatile("s_waitcnt vmcnt(0)" ::: "memory");
        } else {
            __builtin_amdgcn_fence(__ATOMIC_ACQUIRE, "agent");
            XB_SPIN(xb_ld(&bar[XB_XGEN(b.x)]) == gen, bar);
            asm volatile("s_waitcnt vmcnt(0)" ::: "memory");
        }
    }
    __syncthreads();
}

__device__ __forceinline__ void xcd_barrier_arrive(const XcdBarrier& b) {
    asm volatile("s_waitcnt vmcnt(0)" ::: "memory");
    __syncthreads();
    if (threadIdx.x == 0) {
        unsigned* bar = b.bar;
        __builtin_amdgcn_s_waitcnt(0);
        unsigned nloc = b.st[0], nx = b.st[1];
        if (nloc == 0u) { xcd_barrier_complete(bar, b.x, nloc, nx); b.st[0] = nloc; b.st[1] = nx; }
        const unsigned old = xb_add(&bar[XB_XSUB(b.x)], 1u);
        const unsigned gen = old / nloc;
        unsigned role = 0u, tg = 0u;
        if (old + 1u == (gen + 1u) * nloc) {
            __builtin_amdgcn_fence(__ATOMIC_RELEASE, "agent");
            asm volatile("s_waitcnt vmcnt(0)" ::: "memory");
            const unsigned og = xb_add(&bar[XB_TOP], 1u);
            tg = og / nx; role = 1u;
            if (og + 1u == (tg + 1u) * nx) { xb_add(&bar[XB_TOPGEN], 1u); role = 2u; }
        }
        b.st[2] = gen; b.st[3] = role; b.st[4] = tg;
    }
}
__device__ __forceinline__ void xcd_barrier_wait(const XcdBarrier& b) {
    asm volatile("s_waitcnt vmcnt(0)" ::: "memory");
    __syncthreads();
    if (threadIdx.x == 0) {
        unsigned* bar = b.bar;
        const unsigned gen = b.st[2], role = b.st[3], tg = b.st[4];
        if (role != 0u) {
            if (role == 1u) XB_SPIN(xb_ld(&bar[XB_TOPGEN]) == tg, bar);
            __builtin_amdgcn_fence(__ATOMIC_ACQUIRE, "agent");
            xb_add(&bar[XB_XGEN(b.x)], 1u);
            asm volatile("s_waitcnt vmcnt(0)" ::: "memory");
        } else {
            __builtin_amdgcn_fence(__ATOMIC_ACQUIRE, "agent");
            XB_SPIN(xb_ld(&bar[XB_XGEN(b.x)]) == gen, bar);
            asm volatile("s_waitcnt vmcnt(0)" ::: "memory");
        }
    }
    __syncthreads();
}

namespace pg8 {
constexpr int BM = 256, BK = 64, HALF = 128, HTB = HALF * BK * 2, STAGE_BYTES = 8 * HTB, NXCD = 8;
__device__ __forceinline__ int lds_byte(int r, int c) { const int st = (r >> 4) * 2 + (c >> 5), rr = r & 15, cc = c & 31, ob = rr * 64 + cc * 2; return st * 1024 + (ob ^ (((ob >> 9) & 1) << 5)); }
__device__ __forceinline__ void stage_rc(int b, int& R, int& C) { const int st = b / 1024, sb = b % 1024, swz = sb ^ (((sb >> 9) & 1) << 5); R = (st >> 1) * 16 + swz / 64; C = (st & 1) * 32 + (swz % 64) / 2; }
__device__ __forceinline__ int perm32(int rho) { const int n = rho >> 4, i = rho & 15; return 8 * (i >> 2) + 4 * n + (i & 3); }

struct Unit {
    const char* A; const char* B; unsigned info;
    __device__ __forceinline__ int pm() const { return (int)(info & 255u); }
    __device__ __forceinline__ int pn() const { return (int)((info >> 8) & 255u); }
    __device__ __forceinline__ int kind() const { return (int)((info >> 16) & 15u); }
    __device__ __forceinline__ int nt() const { return (int)((info >> 20) & 255u); }
    __device__ __forceinline__ int cont() const { return (int)((info >> 28) & 1u); }
};
__device__ __forceinline__ Unit make_unit(const char* A, const char* B, int pm, int pn, int kind, int nt, int cont) { return Unit{A, B, (unsigned)pm | ((unsigned)pn << 8) | ((unsigned)kind << 16) | ((unsigned)nt << 20) | ((unsigned)cont << 28)}; }
__device__ __forceinline__ int xcd_remap(int L, int nwg) { const int q = nwg / NXCD, r = nwg % NXCD, xcd = L % NXCD, off = L / NXCD; return (xcd < r ? xcd * (q + 1) : r * (q + 1) + (xcd - r) * q) + off; }

template <class Epi, class Sched>
__device__ __forceinline__ void gemm_phase(LAS unsigned char* lds, const int K, const Sched& S, const Epi& E, const int wave_) {
    int tid = wave_ * 64 + lane_id(); asm volatile("" : "+v"(tid));
    const int wid = wave_, lane = tid & 63, wr = wid >> 2, wc = wid & 3, fr = lane & 15, fq = lane >> 4;
    unsigned voffA[2], voffB[2];
#pragma unroll
    for (int i = 0; i < 2; ++i) { int R, C; stage_rc(tid * 16 + i * 8192, R, C); const int Rb = (R & ~31) + perm32(R & 31);
        voffA[i] = (unsigned)(R * K + C) * 2u; voffB[i] = (unsigned)(Rb * K + C) * 2u; }
    const size_t kstep = (size_t)(BK * 2);
    const size_t hstep = (size_t)HALF * K * 2;
    const unsigned ldsw = (unsigned)wid * 1024u;
    const int aoff = lds_byte(wr * 64 + fr, fq * 8), boff = lds_byte(wc * 32 + fr, fq * 8);
#define PG8_SA(b, h) (((b) * 2 + (h)) * HTB)
#define PG8_SB(b, h) ((4 + (b) * 2 + (h)) * HTB)
#define PG8_STAGE(bufoff, gbase, voff) do { _Pragma("unroll") for (int _i = 0; _i < 2; ++_i) \
        __builtin_amdgcn_global_load_lds((const unsigned*)((const char*)(gbase) + (voff)[_i]), (LAS unsigned*)(lds + (bufoff) + ldsw + _i * 8192), 16, 0, 0); } while (0)
#define PG8_LDA(dst, b, h) do { _Pragma("unroll") for (int m = 0; m < 4; ++m) _Pragma("unroll") for (int k = 0; k < 2; ++k) dst[m][k] = *(const LAS bf16x8*)(lds + PG8_SA(b, h) + aoff + m * 2048 + k * 1024); } while (0)
#define PG8_LDB(dst, b, h) do { _Pragma("unroll") for (int n = 0; n < 2; ++n) _Pragma("unroll") for (int k = 0; k < 2; ++k) dst[n][k] = *(const LAS bf16x8*)(lds + PG8_SB(b, h) + boff + n * 2048 + k * 1024); } while (0)
#define PG8_MMA(ai, bj, At, Bt) do { __builtin_amdgcn_s_setprio(1); _Pragma("unroll") for (int m = 0; m < 4; ++m) _Pragma("unroll") for (int n = 0; n < 2; ++n) _Pragma("unroll") for (int k = 0; k < 2; ++k) \
        acc[ai][bj][m][n] = __builtin_amdgcn_mfma_f32_16x16x32_bf16(Bt[n][k], At[m][k], acc[ai][bj][m][n], 0, 0, 0); __builtin_amdgcn_s_setprio(0); } while (0)
#define PG8_WAIT_V(n) asm volatile("s_waitcnt vmcnt(" #n ")" ::: "memory")
#define PG8_WAIT_L(n) asm volatile("s_waitcnt lgkmcnt(" #n ")" ::: "memory")
#define PG8_BAR __builtin_amdgcn_s_barrier()
#define PG8_SCHED __builtin_amdgcn_sched_barrier(0)
    Unit cur, nxt; int ui = 0;
    if (!S.next(0, cur)) return;
    f32x4 acc[2][2][4][2];
#pragma unroll
    for (int a = 0; a < 2; ++a)
#pragma unroll
        for (int b = 0; b < 2; ++b)
#pragma unroll
            for (int m = 0; m < 4; ++m)
#pragma unroll
                for (int n = 0; n < 2; ++n) acc[a][b][m][n] = (f32x4){0.f, 0.f, 0.f, 0.f};
    bf16x8 At[4][2], B0[2][2], B1[2][2];
    const char* cA = cur.A; const char* cB = cur.B;
    PG8_STAGE(PG8_SB(0, 0), cB, voffB); PG8_STAGE(PG8_SB(0, 1), cB + hstep, voffB); PG8_STAGE(PG8_SA(0, 0), cA, voffA); PG8_STAGE(PG8_SA(0, 1), cA + hstep, voffA);
    if (wr == 1) PG8_BAR;
    PG8_WAIT_V(2); PG8_BAR;
    PG8_STAGE(PG8_SB(1, 0), cB + kstep, voffB); PG8_STAGE(PG8_SA(1, 0), cA + kstep, voffA); PG8_STAGE(PG8_SB(1, 1), cB + hstep + kstep, voffB);
    PG8_WAIT_V(6); PG8_BAR;
    for (;;) {
        const bool has_next = S.next(ui + 1, nxt);
        const char* nA = has_next ? nxt.A : cA; const char* nB = has_next ? nxt.B : cB;
        const int nt = cur.nt();
        for (int t = 0; t < nt; t += 2) {
            const bool last = (t == nt - 2);
            const char* a1 = cA + (size_t)(t + 1) * kstep;
            const char* a2 = last ? nA : cA + (size_t)(t + 2) * kstep; const char* b2 = last ? nB : cB + (size_t)(t + 2) * kstep;
            const char* a3 = a2 + kstep; const char* b3 = b2 + kstep;
            PG8_LDB(B0, 0, 0); PG8_LDB(B1, 0, 1); PG8_SCHED; PG8_LDA(At, 0, 0); PG8_STAGE(PG8_SA(1, 1), a1 + hstep, voffA);
            PG8_WAIT_V(8); PG8_WAIT_L(0); PG8_BAR; PG8_MMA(0, 0, At, B0); PG8_MMA(0, 1, At, B1); PG8_BAR; PG8_SCHED;
            PG8_LDA(At, 0, 1); PG8_STAGE(PG8_SB(0, 0), b2, voffB); PG8_STAGE(PG8_SB(0, 1), b2 + hstep, voffB); PG8_STAGE(PG8_SA(0, 0), a2, voffA);
            PG8_WAIT_V(8); PG8_WAIT_L(0); PG8_BAR; PG8_MMA(1, 0, At, B0); PG8_MMA(1, 1, At, B1); PG8_BAR; PG8_SCHED;
            PG8_LDB(B0, 1, 0); PG8_LDB(B1, 1, 1); PG8_SCHED; PG8_LDA(At, 1, 0); PG8_STAGE(PG8_SA(0, 1), a2 + hstep, voffA);
            PG8_WAIT_V(8); PG8_WAIT_L(0); PG8_BAR; PG8_MMA(0, 0, At, B0); PG8_MMA(0, 1, At, B1); PG8_BAR; PG8_SCHED;
            PG8_LDA(At, 1, 1); PG8_STAGE(PG8_SB(1, 0), b3, voffB); PG8_STAGE(PG8_SB(1, 1), b3 + hstep, voffB); PG8_STAGE(PG8_SA(1, 0), a3, voffA);
            PG8_WAIT_V(8); PG8_WAIT_L(0); PG8_BAR; PG8_MMA(1, 0, At, B0); PG8_MMA(1, 1, At, B1); PG8_BAR; PG8_SCHED;
        }
        if (wr == 0) PG8_BAR;
        if (!cur.cont()) E(acc, cur, wr, wc, fr, fq);
        if (!has_next) break;
        if (!cur.cont()) {
#pragma unroll
        for (int a = 0; a < 2; ++a)
#pragma unroll
            for (int b = 0; b < 2; ++b)
#pragma unroll
                for (int m = 0; m < 4; ++m)
#pragma unroll
                    for (int n = 0; n < 2; ++n) acc[a][b][m][n] = (f32x4){0.f, 0.f, 0.f, 0.f};
        }
        cur = nxt; cA = nA; cB = nB; ++ui;
        if (wr == 1) PG8_BAR;
    }
    PG8_WAIT_V(0);
    PG8_BAR;
#undef PG8_SA
#undef PG8_SB
#undef PG8_STAGE
#undef PG8_LDA
#undef PG8_LDB
#undef PG8_MMA
#undef PG8_WAIT_V
#undef PG8_WAIT_L
#undef PG8_BAR
#undef PG8_SCHED
}

struct GridOrder {
    const char* A; const char* B; size_t tstep; int nM, nN, nwg, G, c, nt;
    __device__ __forceinline__ void init(const void* A_, const void* B_, int K, int nM_, int nN_, int G_, int c_) { A = (const char*)A_; B = (const char*)B_; tstep = (size_t)BM * K * 2; nM = nM_; nN = nN_; nwg = nM * nN; G = G_; c = c_; nt = K / BK; }
    __device__ __forceinline__ bool next(int i, Unit& u) const {
        const long L = (long)i * G + c; if (L >= nwg) return false;
        int wgid;
        if ((nwg & 63) == 0 && (nM & 7) == 0) {
            const int q = nwg >> 3, xcd = (int)L & 7, off = (int)L >> 3, blk = off >> 6;
            int o2 = off;
            if (blk < (q >> 6)) { const int rem = off & 63, half = rem >> 5, j = rem & 31; o2 = (blk << 6) + ((j >> 2) << 3) + half * 4 + (j & 3); }
            wgid = xcd * q + o2;
        } else wgid = xcd_remap((int)L, nwg);
        const int nig = 8 * nN, gid = wgid / nig, fm = gid * 8, gsz = (nM - fm) < 8 ? (nM - fm) : 8;
        const int pm = fm + ((wgid % nig) % gsz), pn = (wgid % nig) / gsz;
        u = make_unit(A + (size_t)pm * tstep, B + (size_t)pn * tstep, pm, pn, 0, nt, 0); return true;
    }
};
}

typedef f32x4 Acc[2][2][4][2];
struct EpiSwiGLU {
    bf16* Hid;
    __device__ __forceinline__ void operator()(const Acc& acc, const pg8::Unit& u, int wr, int wc, int fr0, int fq0) const {
        int fr = fr0, fq = fq0; asm volatile("" : "+v"(fr), "+v"(fq));
        const int row0 = u.pm() * 256 + wr * 64 + fr, col0 = u.pn() * 128 + wc * 32 + 8 * fq;
#pragma unroll
        for (int ai = 0; ai < 2; ++ai)
#pragma unroll
            for (int m = 0; m < 4; ++m) {
                float v[8];
#pragma unroll
                for (int n = 0; n < 2; ++n)
#pragma unroll
                    for (int j = 0; j < 4; ++j) v[4 * n + j] = fast_silu(acc[ai][0][m][n][j]) * acc[ai][1][m][n][j];
                v4u w; w.x = cvt_pk_bf16(v[0], v[1]); w.y = cvt_pk_bf16(v[2], v[3]); w.z = cvt_pk_bf16(v[4], v[5]); w.w = cvt_pk_bf16(v[6], v[7]);
                *(v4u*)(Hid + (size_t)(row0 + ai * 128 + m * 16) * DFF + col0) = w;
            }
    }
};
struct GluLocalOrder {
    const char* A; const char* B; pg8::GridOrder T;
    __device__ __forceinline__ bool next(int i, pg8::Unit& u) const {
        if (i > 1) return false;
        pg8::Unit t; if (!T.next(0, t)) return false;
        const size_t tstep = (size_t)256 * SW * 2;
        u = pg8::make_unit(A + (size_t)t.pm() * tstep, B + (size_t)(2 * t.pn() + i) * tstep, t.pm(), 2 * t.pn() + i, 0, SW / 64, 0); return true;
    }
};
constexpr size_t CTL_ROWSQ = 524288;
struct EpiFfn2DownFused {
    const bf16* stream; float* out; float* rowsq; const float* cfv; XcdBarrier bar;
    __device__ __forceinline__ void operator()(const Acc& acc, const pg8::Unit& u, int wr, int wc, int fr0, int fq0) const {
        int fr = fr0, fq = fq0; asm volatile("" : "+v"(fr), "+v"(fq));
        const int lane = fq * 16 + fr;
        const int rowb = u.pm() * 256 + wr * 64 + fr;
#pragma unroll
        for (int ai = 0; ai < 2; ++ai)
#pragma unroll
            for (int m = 0; m < 4; ++m) {
                float ss = 0.f;
#pragma unroll
                for (int bj = 0; bj < 2; ++bj)
#pragma unroll
                    for (int n = 0; n < 2; ++n) { const f32x4 a = acc[ai][bj][m][n]; ss += (a[0] * a[0] + a[1] * a[1]) + (a[2] * a[2] + a[3] * a[3]); }
                ss += shfl_xor_l(ss, 16, lane); ss += shfl_xor_l(ss, 32, lane);
                if (fq == 0) __hip_atomic_fetch_add(rowsq + rowb + ai * 128 + m * 16, ss, RLX_AGENT);
            }
        xcd_barrier(bar);
        const float* cf = cfv + (size_t)(u.pm() >> 4) * D;
        f32x4 c0[2], c1[2];
#pragma unroll
        for (int bj = 0; bj < 2; ++bj) { const int col0 = u.pn() * 256 + bj * 128 + wc * 32 + 8 * fq; c0[bj] = *(const f32x4*)(cf + col0); c1[bj] = *(const f32x4*)(cf + col0 + 4); }
#pragma unroll
        for (int ai = 0; ai < 2; ++ai) {
            v4u hv[4][2]; float rs[4];
#pragma unroll
            for (int m = 0; m < 4; ++m) {
                const int row = rowb + ai * 128 + m * 16;
                rs[m] = rowsq[row];
#pragma unroll
                for (int bj = 0; bj < 2; ++bj) hv[m][bj] = __builtin_nontemporal_load((const v4u*)(stream + (size_t)row * D + u.pn() * 256 + bj * 128 + wc * 32 + 8 * fq));
            }
#pragma unroll
            for (int m = 0; m < 4; ++m) {
                const int row = rowb + ai * 128 + m * 16;
                const float rstd = 1.0f / sqrtf(rs[m] * (1.0f / D) + EPS);
#pragma unroll
                for (int bj = 0; bj < 2; ++bj) {
                    const int col0 = u.pn() * 256 + bj * 128 + wc * 32 + 8 * fq;
                    const v4u h_ = hv[m][bj];
                    const f32x4 h0 = {bflo(h_.x), bfhi(h_.x), bflo(h_.y), bfhi(h_.y)}, h1 = {bflo(h_.z), bfhi(h_.z), bflo(h_.w), bfhi(h_.w)};
                    const f32x4 o0 = h0 + rstd * (c0[bj] * acc[ai][bj][m][0]), o1 = h1 + rstd * (c1[bj] * acc[ai][bj][m][1]);
                    __builtin_nontemporal_store(o0, (f32x4*)(out + (size_t)row * D + col0)); __builtin_nontemporal_store(o1, (f32x4*)(out + (size_t)row * D + col0 + 4));
                }
            }
        }
    }
};
struct EpiO16 {
    bf16* C; int ldc;
    __device__ __forceinline__ void operator()(const Acc& acc, const pg8::Unit& u, int wr, int wc, int fr0, int fq0) const {
        int fr = fr0, fq = fq0; asm volatile("" : "+v"(fr), "+v"(fq));
        const int row0 = u.pm() * 256 + wr * 64 + fr, col0 = u.pn() * 256 + wc * 32 + 8 * fq;
#pragma unroll
        for (int ai = 0; ai < 2; ++ai)
#pragma unroll
            for (int m = 0; m < 4; ++m) { bf16* rowp = C + (size_t)(row0 + ai * 128 + m * 16) * ldc + col0;
#pragma unroll
                for (int bj = 0; bj < 2; ++bj) { const f32x4 a = acc[ai][bj][m][0], b = acc[ai][bj][m][1];
                    v4u w; w.x = cvt_pk_bf16(a[0], a[1]); w.y = cvt_pk_bf16(a[2], a[3]); w.z = cvt_pk_bf16(b[0], b[1]); w.w = cvt_pk_bf16(b[2], b[3]);
                    *(v4u*)(rowp + bj * 128) = w; } }
    }
};
struct EpiGLU {
    const bf16* SGS; bf16* out;
    __device__ __forceinline__ void operator()(const Acc& acc, const pg8::Unit& u, int wr, int wc, int fr0, int fq0) const {
        int fr = fr0, fq = fq0; asm volatile("" : "+v"(fr), "+v"(fq));
        const int row0 = u.pm() * 256 + wr * 64 + fr, col0 = u.pn() * 128 + wc * 32 + 8 * fq;
#pragma unroll
        for (int ai = 0; ai < 2; ++ai)
#pragma unroll
            for (int m = 0; m < 4; ++m) {
                const size_t off = (size_t)(row0 + ai * 128 + m * 16) * D + col0;
                const v4u s = *(const v4u*)(SGS + off);
                const float sg[8] = {bflo(s.x), bfhi(s.x), bflo(s.y), bfhi(s.y), bflo(s.z), bfhi(s.z), bflo(s.w), bfhi(s.w)};
                float v[8];
#pragma unroll
                for (int n = 0; n < 2; ++n)
#pragma unroll
                    for (int j = 0; j < 4; ++j) v[4 * n + j] = acc[ai][0][m][n][j] * fast_sigmoid(acc[ai][1][m][n][j]) * sg[4 * n + j];
                v4u w; w.x = cvt_pk_bf16(v[0], v[1]); w.y = cvt_pk_bf16(v[2], v[3]); w.z = cvt_pk_bf16(v[4], v[5]); w.w = cvt_pk_bf16(v[6], v[7]);
                *(v4u*)(out + off) = w;
            }
    }
};
struct EpiMerge {
    const bf16* SGR; bf16* mg;
    __device__ __forceinline__ void operator()(const Acc& acc, const pg8::Unit& u, int wr, int wc, int fr0, int fq0) const {
        int fr = fr0, fq = fq0; asm volatile("" : "+v"(fr), "+v"(fq));
        const int row0 = u.pm() * 256 + wr * 64 + fr, col0 = u.pn() * 256 + wc * 32 + 8 * fq;
#pragma unroll
        for (int ai = 0; ai < 2; ++ai)
#pragma unroll
            for (int m = 0; m < 4; ++m)
#pragma unroll
                for (int bj = 0; bj < 2; ++bj) {
                    const size_t off = (size_t)(row0 + ai * 128 + m * 16) * D + col0 + bj * 128;
                    const v4u s = *(const v4u*)(SGR + off), p = *(const v4u*)(mg + off);
                    const float sg[8] = {bflo(s.x), bfhi(s.x), bflo(s.y), bfhi(s.y), bflo(s.z), bfhi(s.z), bflo(s.w), bfhi(s.w)};
                    const float pp[8] = {bflo(p.x), bfhi(p.x), bflo(p.y), bfhi(p.y), bflo(p.z), bfhi(p.z), bflo(p.w), bfhi(p.w)};
                    float v[8];
#pragma unroll
                    for (int n = 0; n < 2; ++n)
#pragma unroll
                        for (int j = 0; j < 4; ++j) v[4 * n + j] = pp[4 * n + j] + sg[4 * n + j] * acc[ai][bj][m][n][j];
                    v4u w; w.x = cvt_pk_bf16(v[0], v[1]); w.y = cvt_pk_bf16(v[2], v[3]); w.z = cvt_pk_bf16(v[4], v[5]); w.w = cvt_pk_bf16(v[6], v[7]);
                    *(v4u*)(mg + off) = w;
                }
    }
};

constexpr int CTX_SPLIT = 4;
constexpr size_t WS_SLAB = WS_Q;
struct Ffn1DownOrder {
    const char* A; const char* B; int G, c;
    static constexpr int NBIG = (MX / 256) * (D / 256), NSMALL = (MC / 256) * (D / 256) * CTX_SPLIT;
    __device__ __forceinline__ bool next(int i, pg8::Unit& u) const {
        const long L = (long)i * G + c; if (L >= NBIG + NSMALL) return false;
        const size_t tstep = (size_t)256 * DFF * 2;
        int pm, pn, kind, nt; size_t koff;
        if (L < NBIG) { const int w = pg8::xcd_remap((int)L, NBIG); const int nig = 8 * 8, gid = w / nig, r = w % nig; pm = gid * 8 + (r & 7); pn = r >> 3; kind = 0; nt = DFF / 64; koff = 0; }
        else { const int w = (int)L - NBIG, sp = w & 3, t = w >> 2; pm = 32 + (t & 1); pn = t >> 1; kind = 1 + sp; nt = DFF / 64 / CTX_SPLIT; koff = (size_t)sp * (DFF / CTX_SPLIT) * 2; }
        u = pg8::make_unit(A + (size_t)pm * tstep + koff, B + (size_t)pn * tstep + koff, pm, pn, kind, nt, 0); return true;
    }
};
struct EpiFfn1Down {
    bf16* O; float* slab;
    __device__ __forceinline__ void operator()(const Acc& acc, const pg8::Unit& u, int wr, int wc, int fr0, int fq0) const {
        int fr = fr0, fq = fq0; asm volatile("" : "+v"(fr), "+v"(fq));
        const int row0 = u.pm() * 256 + wr * 64 + fr, col0 = u.pn() * 256 + wc * 32 + 8 * fq;
        if (u.kind() == 0) {
#pragma unroll
            for (int ai = 0; ai < 2; ++ai)
#pragma unroll
                for (int m = 0; m < 4; ++m) { bf16* rowp = O + (size_t)(row0 + ai * 128 + m * 16) * D + col0;
#pragma unroll
                    for (int bj = 0; bj < 2; ++bj) { const f32x4 a = acc[ai][bj][m][0], b = acc[ai][bj][m][1];
                        v4u w; w.x = cvt_pk_bf16(a[0], a[1]); w.y = cvt_pk_bf16(a[2], a[3]); w.z = cvt_pk_bf16(b[0], b[1]); w.w = cvt_pk_bf16(b[2], b[3]);
                        *(v4u*)(rowp + bj * 128) = w; } }
        } else {
            float* C = slab + (size_t)(u.kind() - 1) * MC * D - (size_t)MX * D;
#pragma unroll
            for (int ai = 0; ai < 2; ++ai)
#pragma unroll
                for (int m = 0; m < 4; ++m) { float* rowp = C + (size_t)(row0 + ai * 128 + m * 16) * D + col0;
#pragma unroll
                    for (int bj = 0; bj < 2; ++bj) { *(f32x4*)(rowp + bj * 128) = acc[ai][bj][m][0]; *(f32x4*)(rowp + bj * 128 + 4) = acc[ai][bj][m][1]; } }
        }
    }
};

enum { MK_S = 0, MK_Q = 1, MK_K = 2, MK_G = 3, MK_GS = 4, MK_GR = 5, MK_KT = 6, MK_VT = 7 };
struct EpiMix {
    unsigned char* ws;
    __device__ __forceinline__ void operator()(const Acc& acc, const pg8::Unit& u, int wr, int wc, int fr0, int fq0) const {
        int fr = fr0, fq = fq0; asm volatile("" : "+v"(fr), "+v"(fq));
        bf16* const US = (bf16*)(ws + WS_US); bf16* const Q = (bf16*)(ws + WS_Q); bf16* const KN = (bf16*)(ws + WS_K);
        bf16* const SG = (bf16*)(ws + WS_HBUF); bf16* const SGS = (bf16*)(ws + WS_HBUF + 32 * MiB); bf16* const SGR = (bf16*)(ws + WS_HBUF + 64 * MiB);
        bf16* const KFTC = (bf16*)(ws + WS_KFTC);
        bf16* const VT = (bf16*)(ws + WS_VT); bf16* const VTC = (bf16*)(ws + WS_VTC);
        const f32x2* const rope = (const f32x2*)(ws + WS_TAB + TAB_ROPE);
        const float* const lg2 = (const float*)(ws + WS_TAB + TAB_LG2);
        const int kind = u.kind();
        if (kind == MK_S) {
#pragma unroll
            for (int ai = 0; ai < 2; ++ai)
#pragma unroll
                for (int m = 0; m < 4; ++m) {
                    const int row = u.pm() * 256 + ai * 128 + wr * 64 + m * 16 + fr;
                    int b_, crow;
                    if (row < MX) { b_ = row >> 12; crow = (row & (SEQ - 1)) >> 4; } else { b_ = (row - MX) >> 8; crow = 256 + (((row - MX) & (LC - 1)) >> 4); }
                    const int s = row & 15;
#pragma unroll
                    for (int bj = 0; bj < 2; ++bj) {
                        const int ch = u.pn() * 256 + bj * 128 + wc * 32 + 8 * fq, g = ch >> 4, c0 = ch & 15;
                        const f32x4 a = acc[ai][bj][m][0], b = acc[ai][bj][m][1];
                        v4u w; w.x = cvt_pk_bf16(a[0], a[1]); w.y = cvt_pk_bf16(a[2], a[3]); w.z = cvt_pk_bf16(b[0], b[1]); w.w = cvt_pk_bf16(b[2], b[3]);
                        *(v4u*)(US + ((size_t)((b_ * 64 + g) * S5_ROWS + crow)) * 256 + s * 16 + c0) = w;
                    }
                }
        } else if (kind == MK_G || kind == MK_GS || kind == MK_GR) {
            bf16* dst = kind == MK_G ? SG : (kind == MK_GS ? SGS : SGR);
            const int row0 = u.pm() * 256 + wr * 64 + fr, col0 = u.pn() * 256 + wc * 32 + 8 * fq;
#pragma unroll
            for (int ai = 0; ai < 2; ++ai)
#pragma unroll
                for (int m = 0; m < 4; ++m)
#pragma unroll
                    for (int bj = 0; bj < 2; ++bj) {
                        float v[8];
#pragma unroll
                        for (int n = 0; n < 2; ++n)
#pragma unroll
                            for (int j = 0; j < 4; ++j) { const float x = acc[ai][bj][m][n][j]; const float s = fast_sigmoid(x); v[4 * n + j] = kind == MK_G ? x * s : s; }
                        v4u w; w.x = cvt_pk_bf16(v[0], v[1]); w.y = cvt_pk_bf16(v[2], v[3]); w.z = cvt_pk_bf16(v[4], v[5]); w.w = cvt_pk_bf16(v[6], v[7]);
                        *(v4u*)(dst + (size_t)(row0 + ai * 128 + m * 16) * D + col0 + bj * 128) = w;
                    }
        } else if (kind == MK_Q || kind == MK_K) {
            const int p = wc >> 1, i0 = 16 * (wc & 1) + 4 * fq;
            const int d0 = 64 * p + i0;
            const bool isctx = u.pm() >= 32;
            f32x4 cs0[8], cs1[8];
#pragma unroll
            for (int am = 0; am < 8; ++am) {
                const int row = u.pm() * 256 + (am >> 2) * 128 + wr * 64 + (am & 3) * 16 + fr;
                const int l = row & (SEQ - 1), pos = p ? (l & 63) : (l >> 6);
                if (!isctx) { cs0[am] = *(const f32x4*)(rope + pos * 32 + i0); cs1[am] = *(const f32x4*)(rope + pos * 32 + i0 + 2); }
                else { cs0[am] = (f32x4){1.f, 0.f, 1.f, 0.f}; cs1[am] = cs0[am]; }
            }
#pragma unroll
            for (int ai = 0; ai < 2; ++ai)
#pragma unroll
                for (int m = 0; m < 4; ++m) {
                    const int am = ai * 4 + m;
                    const int row = u.pm() * 256 + ai * 128 + wr * 64 + m * 16 + fr;
                    const float cc[4] = {cs0[am][0], cs0[am][2], cs1[am][0], cs1[am][2]}, ss[4] = {cs0[am][1], cs0[am][3], cs1[am][1], cs1[am][3]};
#pragma unroll
                    for (int bj = 0; bj < 2; ++bj) {
                        const int head = 2 * u.pn() + bj;
                        float y1[4], y2[4];
#pragma unroll
                        for (int j = 0; j < 4; ++j) { const float x1 = acc[ai][bj][m][0][j], x2 = acc[ai][bj][m][1][j]; y1[j] = x1 * cc[j] - x2 * ss[j]; y2[j] = x1 * ss[j] + x2 * cc[j]; }
                        const int cpos = 32 * wc + 8 * fq;
                        v4u w;
                        if (kind == MK_K) {
                            w.x = cvt_pk_bf16(y1[0], y1[1]); w.y = cvt_pk_bf16(y1[2], y1[3]); w.z = cvt_pk_bf16(y2[0], y2[1]); w.w = cvt_pk_bf16(y2[2], y2[3]);
                            if (!isctx) *(v4u*)(KN + (size_t)row * 1024 + head * 128 + cpos) = w;
                            else *(v4u*)(KFTC + (size_t)(row - MX) * 1024 + head * 128 + cpos) = w;
                        } else {
                            const float qs = 0.08838834764831845f;
                            w.x = cvt_pk_bf16(y1[0] * qs, y1[1] * qs); w.y = cvt_pk_bf16(y1[2] * qs, y1[3] * qs); w.z = cvt_pk_bf16(y2[0] * qs, y2[1] * qs); w.w = cvt_pk_bf16(y2[2] * qs, y2[3] * qs);
                            *(v4u*)(Q + (size_t)row * 1024 + head * 128 + cpos) = w;
                        }
                    }
                }
        } else if (kind == MK_VT) {
            const bool isctx = u.pn() >= 32;
#pragma unroll
            for (int ai = 0; ai < 2; ++ai)
#pragma unroll
                for (int m = 0; m < 4; ++m) {
                    const int f = u.pm() * 256 + ai * 128 + wr * 64 + m * 16 + fr;
#pragma unroll
                    for (int bj = 0; bj < 2; ++bj) {
                        const f32x4 a = acc[ai][bj][m][0], b = acc[ai][bj][m][1];
                        v4u w; w.x = cvt_pk_bf16(a[0], a[1]); w.y = cvt_pk_bf16(a[2], a[3]); w.z = cvt_pk_bf16(b[0], b[1]); w.w = cvt_pk_bf16(b[2], b[3]);
                        const int tc = bj * 128 + wc * 32 + 8 * fq;
                        if (!isctx) { const int tok = u.pn() * 256 + tc, b_ = tok >> 12, l = tok & (SEQ - 1); *(v4u*)(VT + ((size_t)(b_ * 2048 + f) * SEQ + l)) = w; }
                        else { const int b_ = u.pn() - 32; *(v4u*)(VTC + ((size_t)(b_ * 2048 + f) * LC + tc)) = w; }
                    }
                }
        }
    }
};
struct MixOrder {
    const char* U; const char* WM; int G, c;
    static constexpr int N_NORM = 32 * 36, N_CTXS = 16, N_SWAP = 8 * 34, NWG = N_NORM + N_CTXS + N_SWAP;
    __device__ __forceinline__ bool next(int i, pg8::Unit& u) const {
        const long L = (long)i * G + c; if (L >= NWG) return false;
        int w = pg8::xcd_remap((int)L, NWG);
        const size_t tstep = (size_t)256 * D * 2;
        int at, bt, pm, pn, kind;
        bool swapped = false;
        if (w < N_NORM) {
            const int nig = 8 * 36, gid = w / nig, r = w % nig, ct = r >> 3;
            pm = gid * 8 + (r & 7); at = pm;
            if (ct < 4) { bt = ct; kind = MK_S; pn = ct; } else if (ct < 8) { bt = ct; kind = MK_Q; pn = ct - 4; } else if (ct < 12) { bt = ct; kind = MK_K; pn = ct - 8; }
            else if (ct < 20) { bt = ct + 8; kind = MK_G; pn = ct - 12; } else if (ct < 28) { bt = ct + 8; kind = MK_GS; pn = ct - 20; } else { bt = ct + 8; kind = MK_GR; pn = ct - 28; }
        } else if (w < N_NORM + N_CTXS) {
            w -= N_NORM; pm = 32 + (w & 1); at = pm; const int ct = w >> 1;
            if (ct < 4) { bt = ct; pn = ct; kind = MK_S; } else { bt = ct + 4; pn = ct - 4; kind = MK_K; }
        } else {
            w -= N_NORM + N_CTXS; swapped = true;
            const int tt = w >> 3, ft = w & 7;
            bt = tt; pn = tt; at = 12 + ft; pm = ft; kind = MK_VT;
        }
        const char* abase = swapped ? WM : U; const char* bbase = swapped ? U : WM;
        u = pg8::make_unit(abase + (size_t)at * tstep, bbase + (size_t)bt * tstep, pm, pn, kind, D / 64, 0);
        return true;
    }
};

constexpr int RING_BYTES = 131072, LDSCTL_OFF = 143360, MISC_OFF = LDSCTL_OFF + 320, LDS_BYTES = 147456;
struct Args { const float* in[22]; float* out; unsigned char* ws; };
struct Frame {
    LAS unsigned char* lds; volatile LAS unsigned* MISC; unsigned* ctl;
    int wave, vcu, G;
    float* out; unsigned char* ws;
};
typedef const Args __attribute__((address_space(4)))* KArgsPtr;
__device__ __forceinline__ KArgsPtr kargs() { KArgsPtr p = (KArgsPtr)__builtin_amdgcn_kernarg_segment_ptr(); asm volatile("" : "+s"(p)); return p; }
#define FIN(k) ((const float*)kargs()->in[k])

__device__ __forceinline__ int map_pair(int n, int half) { const int h = n < half ? n : n - half, up = n >= half; return 256 * (h >> 7) + 128 * up + (h & 127); }
__device__ __forceinline__ int map_mix(int n) {
    if (n < 1024 || n >= 3072) return n;
    const int base = n & ~127, d = n & 127, p = d >> 6, e = d & 63, s = e >> 5, i = e & 31, t = 32 * p + i;
    return base + 32 * (t >> 4) + 8 * ((t >> 2) & 3) + 4 * s + (t & 3);
}
template <int MAPID>
__device__ __forceinline__ void transpose_item(const float* W, int ldw, int K, int nblk, bf16* WT, int row_off, int half, LAS float* scr, int item, int lane) {
    const int kb = item / nblk, nb = item % nblk, k0 = 64 * kb, n0 = 32 * nb;
    float wv[32];
#pragma unroll
    for (int i = 0; i < 32; ++i) wv[i] = __builtin_nontemporal_load(W + (size_t)(k0 + 2 * i + (lane >> 5)) * ldw + n0 + (lane & 31));
#pragma unroll
    for (int i = 0; i < 32; ++i) scr[(2 * i + (lane >> 5)) * 33 + (lane & 31)] = wv[i];
    LDS_WAIT(); asm volatile("" ::: "memory");
    const int c = lane & 7;
#pragma unroll
    for (int j = 0; j < 4; ++j) { const int n = (lane >> 3) + 8 * j; const LAS float* s = scr + (8 * c) * 33 + n;
        v4u o; o.x = pk2(s[0 * 33], s[1 * 33]); o.y = pk2(s[2 * 33], s[3 * 33]); o.z = pk2(s[4 * 33], s[5 * 33]); o.w = pk2(s[6 * 33], s[7 * 33]);
        const int nn = n0 + n; const int dr = MAPID == 0 ? nn : (MAPID == 1 ? map_pair(nn, half) : map_mix(nn));
        *(v4u*)(WT + (size_t)(row_off + dr) * K + k0 + 8 * c) = o; }
    LDS_WAIT(); asm volatile("" ::: "memory");
}
__device__ __forceinline__ void sincos_d(double x, double& s, double& c) {
    const double TWO_PI = 6.283185307179586476925286766559;
    x -= TWO_PI * __builtin_rint(x / TWO_PI);
    const double h = 0.125 * x, h2 = h * h;
    double sn = h * (1.0 + h2 * (-1.0 / 6 + h2 * (1.0 / 120 + h2 * (-1.0 / 5040 + h2 * (1.0 / 362880 + h2 * (-1.0 / 39916800 + h2 * (1.0 / 6227020800.0)))))));
    double cs = 1.0 + h2 * (-0.5 + h2 * (1.0 / 24 + h2 * (-1.0 / 720 + h2 * (1.0 / 40320 + h2 * (-1.0 / 3628800 + h2 * (1.0 / 479001600.0 + h2 * (-1.0 / 87178291200.0)))))));
#pragma unroll
    for (int k = 0; k < 3; ++k) { const double s2 = 2.0 * sn * cs, c2 = 1.0 - 2.0 * sn * sn; sn = s2; cs = c2; }
    s = sn; c = cs;
}
__device__ __forceinline__ double exp_d(double x) {
    const double y = x * (1.0 / 4096.0);
    double e = 1.0 + y * (1.0 + y * (0.5 + y * (1.0 / 6 + y * (1.0 / 24 + y * (1.0 / 120 + y * (1.0 / 720))))));
#pragma unroll
    for (int k = 0; k < 12; ++k) e = e * e;
    return e;
}
__device__ __forceinline__ double log1p_small_d(double z) {
    const double t = z / (2.0 + z), t2 = t * t;
    return 2.0 * t * (1.0 + t2 * (1.0 / 3 + t2 * (1.0 / 5 + t2 * (1.0 / 7 + t2 * (1.0 / 9 + t2 * (1.0 / 11))))));
}

constexpr int CV_I1 = (D / 64) * (NFF / 32), CV_I2 = (DFF / 64) * (D / 32), CV_IM = (D / 64) * (NMIX / 32), CV_IG = (SW / 64) * (2 * D / 32), CV_IP = (D / 64) * (D / 32);
constexpr int CV_N0 = CV_I1 + CV_I2, CV_N1 = CV_IM + CV_IG + 2 * CV_IP, CV_N2 = CV_I1 + CV_I2;
constexpr int CV_G1_CUS = 40, CV_G2_CUS = 192, CV_G3_CUS = 96;
constexpr int CV_L1_G1 = CV_G1_CUS * NWAVES * 12, CV_L1_G2 = CV_G2_CUS * NWAVES * 7, CV_L2_G3 = CV_G3_CUS * NWAVES * 14;
constexpr int CV_G6_CUS = 128;
static_assert(CV_L1_G1 + CV_L1_G2 <= CV_N1 && CV_L2_G3 <= CV_I1, "conversion split");
__device__ __forceinline__ void conv_item(unsigned char* ws, int list, int r, LAS float* scr, int lane_) {
    if (list == 0) {
        if (r < CV_I1) { transpose_item<1>(FIN(7), NFF, D, NFF / 32, (bf16*)(ws + WS_W1T), 0, DFF, scr, r, lane_); return; } r -= CV_I1;
        transpose_item<0>(FIN(8), D, DFF, D / 32, (bf16*)(ws + WS_W2T), 0, 0, scr, r, lane_);
    } else if (list == 1) {
        if (r < CV_IM) { transpose_item<2>(FIN(9), NMIX, D, NMIX / 32, (bf16*)(ws + WS_WMT), 0, 0, scr, r, lane_); return; } r -= CV_IM;
        if (r < CV_IG) { transpose_item<1>(FIN(18), 2 * D, SW, 2 * D / 32, (bf16*)(ws + WS_WGT), 0, D, scr, r, lane_); return; } r -= CV_IG;
        if (r < CV_IP) { transpose_item<0>(FIN(20), D, D, D / 32, (bf16*)(ws + WS_WPT), 0, 0, scr, r, lane_); return; } r -= CV_IP;
        transpose_item<0>(FIN(21), D, D, D / 32, (bf16*)(ws + WS_WOT), 0, 0, scr, r, lane_);
    } else {
        if (r < CV_I1) { transpose_item<1>(FIN(7) + (size_t)D * NFF, NFF, D, NFF / 32, (bf16*)(ws + WS_W3T), 0, DFF, scr, r, lane_); return; } r -= CV_I1;
        transpose_item<0>(FIN(8) + (size_t)DFF * D, D, DFF, D / 32, (bf16*)(ws + WS_W4T), 0, 0, scr, r, lane_);
    }
}
__device__ __forceinline__ void conv_range(Frame& F, int list, int begin, int end, int wi, int nw) {
    int lane_ = lane_id(); asm volatile("" : "+v"(lane_));
    LAS float* scr = (LAS float*)(F.lds + F.wave * 16384);
    for (int it = begin + wi; it < end; it += nw) conv_item(F.ws, list, it, scr, lane_);
}

__device__ __forceinline__ void phase_prologue(Frame& F0, const Args& args, const bool do_ada) {
    Frame& F = F0; int lane_ = lane_id(); asm volatile("" : "+v"(lane_));
    LAS float* scr = (LAS float*)(F.lds + F.wave * 16384);
    const int gw = F.vcu * NWAVES + F.wave, NGW = F.G * NWAVES;
    unsigned char* ws = F.ws;
    {
        const int gt = gw * 64 + lane_, NT = NGW * 64;
        unsigned char* tab = ws + WS_TAB;
        for (int idx = gt; idx < 2048; idx += NT) {
            const int pos = idx >> 5, i = idx & 31;
            const double inv = exp_d(-(double)i * (9.210340371976182736 / 32.0));
            double s, c; sincos_d((double)pos * inv, s, c);
            ((f32x2*)(tab + TAB_ROPE))[idx] = (f32x2){(float)c, (float)s};
        }
        for (int idx = gt; idx < 16; idx += NT) {
            const double x = (double)FIN(19)[idx];
            ((float*)(tab + TAB_LG2))[idx] = (float)(-log1p_small_d(exp_d(-x)) * 1.4426950408889634074);
        }
        for (int idx = gt; idx < 2 * 64 * 64; idx += NT) {
            const int dg = idx >> 6, p = idx & 63;
            const double lr = (double)FIN(10)[idx], li = (double)FIN(11)[idx], step = exp_d((double)FIN(12)[dg]);
            const double mag = exp_d(lr * step); double sn, cs; sincos_d(li * step, sn, cs);
            const double ar = mag * cs, ai = mag * sn, den = lr * lr + li * li, nr = ar - 1.0, ni = ai;
            const double kr = (nr * lr + ni * li) / den, ki = (ni * lr - nr * li) / den;
            ((float*)(tab + TAB_AR))[idx] = (float)ar; ((float*)(tab + TAB_AI))[idx] = (float)ai;
            { f32x2* apw = (f32x2*)(ws + WS_S5APOW) + (size_t)dg * 17 * 64 + p; double pr = 1.0, pi = 0.0;
              for (int k = 0; k < 17; ++k) { apw[k * 64] = (f32x2){(float)pr, (float)pi}; const double t = pr * ar - pi * ai; pi = pr * ai + pi * ar; pr = t; } }
            float* brf = (float*)(ws + WS_S5BRF) + (size_t)idx * 32;
            const float* bre = FIN(13) + (size_t)idx * 16; const float* bim = FIN(14) + (size_t)idx * 16;
            for (int c = 0; c < 16; ++c) { const double br = (double)bre[c], bi = (double)bim[c];
                brf[2 * c] = (float)(kr * br - ki * bi); brf[2 * c + 1] = (float)(kr * bi + ki * br); }
        }
    }
    if (do_ada) {
        float* ADA = (float*)(ws + WS_CTL + CTL_ADA);
        const float* aw = FIN(4);
        for (int it = (gw >= 128 || NGW < 1280) ? (NGW < 1280 ? gw : gw - 128) : 16 * 72; it < 16 * 72; it += NGW) {
            const int kc = it / 72, cb = it % 72, k0 = kc * 128, col = cb * 256 + 4 * lane_;
            for (int i = lane_; i < 384; i += 64) { const int v = i >> 7, k = i & 127; const float x = v == 0 ? FIN(1)[k0 + k] : (v == 1 ? FIN(1)[D + k0 + k] : FIN(3)[k0 + k]); scr[i] = x / (1.0f + __expf(-x)); }
            LDS_WAIT(); asm volatile("" ::: "memory");
            f32x4 a0 = {0.f, 0.f, 0.f, 0.f}, a1 = a0, a2 = a0;
#pragma unroll 16
            for (int k = 0; k < 128; ++k) { const f32x4 w = __builtin_nontemporal_load((const f32x4*)(aw + (size_t)(k0 + k) * NADA + col)); a0 += w * scr[k]; a1 += w * scr[128 + k]; a2 += w * scr[256 + k]; }
#pragma unroll
            for (int j = 0; j < 4; ++j) { __hip_atomic_fetch_add(ADA + col + j, a0[j], RLX_AGENT); __hip_atomic_fetch_add(ADA + NADA + col + j, a1[j], RLX_AGENT); __hip_atomic_fetch_add(ADA + 2 * NADA + col + j, a2[j], RLX_AGENT); }
            LDS_WAIT(); asm volatile("" ::: "memory");
        }
    }
    {
        const bool tails = (F.G == 256);
        const int b1 = tails ? CV_L1_G1 + CV_L1_G2 : 0, b2 = tails ? CV_L2_G3 : 0;
        const int n0 = CV_N0, n1 = CV_N1 - b1, n2 = (tails ? CV_I1 : CV_N2) - b2;
        for (int it = NGW - 1 - gw; it < n0 + n1 + n2; it += NGW) {
            if (it < n2) conv_item(ws, 2, b2 + it, scr, lane_);
            else if (it < n2 + n1) conv_item(ws, 1, b1 + it - n2, scr, lane_);
            else conv_item(ws, 0, it - n2 - n1, scr, lane_);
        }
    }
}

__device__ __forceinline__ void build_modv(Frame& F, const Args& args) {
    int lane_ = lane_id(); asm volatile("" : "+v"(lane_));
    const int gt = (F.vcu * NWAVES + F.wave) * 64 + lane_, NT = F.G * NWAVES * 64;
    const float* ADA = (const float*)(F.ws + WS_CTL + CTL_ADA); const float* adab = FIN(5); const float* ng = FIN(6);
    float* MV = (float*)(F.ws + WS_TAB + TAB_MODV);
    for (int idx = gt; idx < 27 * (D / 4); idx += NT) {
        const int c = (idx % (D / 4)) * 4, v = idx / (D / 4), av = v % 3, i = (v / 3) % 3, kind = v / 9;
        const float* ada = ADA + (size_t)av * NADA;
        f32x4 o;
        if (kind == 0) o = ((i == 1) ? 1.0f : 0.5f) * (*(const f32x4*)(ada + (3 * i + 2) * D + c) + *(const f32x4*)(adab + (3 * i + 2) * D + c)) * *(const f32x4*)(ng + (2 * i + 1) * D + c);
        else if (kind == 1) o = *(const f32x4*)(ng + (2 * i) * D + c) * (*(const f32x4*)(ada + (3 * i + 1) * D + c) + *(const f32x4*)(adab + (3 * i + 1) * D + c) + 1.0f);
        else o = *(const f32x4*)(ada + (3 * i) * D + c) + *(const f32x4*)(adab + (3 * i) * D + c);
        *(f32x4*)(MV + (size_t)v * D + c) = o;
    }
}
template <int MODE>
__device__ __forceinline__ void phase_rows_old(Frame& F0, const Args& args) {
    Frame& F = F0; int lane_ = lane_id(); asm volatile("" : "+v"(lane_));
    const int gw = F.vcu * NWAVES + F.wave, NGW = F.G * NWAVES;
    const float* ADA = (const float*)(F.ws + WS_CTL + CTL_ADA);
    const float* adab = FIN(5); const float* ng = FIN(6);
    const float* MV = (const float*)(F.ws + WS_TAB + TAB_MODV);
    const bf16* O = (const bf16*)(F.ws + WS_OBUF);
    bf16* A = (bf16*)(F.ws + WS_ABUF);
    const int nrows = (MODE <= 1) ? MT : MX;
    constexpr int ipost = MODE >= 1 ? MODE - 1 : 0, ipre = MODE <= 2 ? MODE : 0;
    int cur_av = -1;
    f32x4 cf[8], gsv[8], shv[8];
    const bool remap = (MODE == 1 && NGW == 2048);
    const int nlist = gw < 512 ? 4 : (gw < 1024 ? 5 : 4);
    for (int ri = 0; remap ? (ri < nlist) : (gw + ri * NGW < nrows); ++ri) {
        const int r = !remap ? gw + ri * NGW : (ri < 3 ? gw + 2048 * ri : (gw < 512 ? MX + gw : (ri == 3 ? gw + 6144 : gw - 512 + 6144)));
        const int av = r < MX ? (r >> 12) : 2;
        if (av != cur_av) {
            cur_av = av;
#pragma unroll
            for (int j = 0; j < 8; ++j) { const int c = 256 * j + 4 * lane_;
                if (MODE == 0) { const float* ada = ADA + (size_t)av * NADA;
                    shv[j] = *(const f32x4*)(ada + c) + *(const f32x4*)(adab + c);
                    gsv[j] = *(const f32x4*)(ng + c) * (*(const f32x4*)(ada + D + c) + *(const f32x4*)(adab + D + c) + 1.0f); }
                else {
                    cf[j] = *(const f32x4*)(MV + (size_t)((0 * 3 + ipost) * 3 + av) * D + c);
                    if (MODE <= 2) { gsv[j] = *(const f32x4*)(MV + (size_t)((1 * 3 + ipre) * 3 + av) * D + c); shv[j] = *(const f32x4*)(MV + (size_t)((2 * 3 + ipre) * 3 + av) * D + c); } } }
        }
        f32x4 h[8];
        if (MODE <= 1) { const float* hsrc = r < MX ? FIN(0) + (size_t)r * D : FIN(2) + (size_t)(r - MX) * D;
#pragma unroll
            for (int j = 0; j < 8; ++j) h[j] = __builtin_nontemporal_load((const f32x4*)(hsrc + 256 * j + 4 * lane_)); }
        else { const bf16* hsrc = (const bf16*)(F.ws + WS_STREAM) + (size_t)r * D;
#pragma unroll
            for (int j = 0; j < 8; ++j) { const v2u t = __builtin_nontemporal_load((const v2u*)(hsrc + 256 * j + 4 * lane_)); h[j] = (f32x4){bflo(t.x), bfhi(t.x), bflo(t.y), bfhi(t.y)}; } }
        if (MODE >= 1) {
            f32x4 o[8]; float ss = 0.f;
#pragma unroll
            for (int j = 0; j < 8; ++j) {
                if (MODE == 1 && r >= MX) { const float* sl = (const float*)(F.ws + WS_SLAB) + (size_t)(r - MX) * D + 256 * j + 4 * lane_; f32x4 a = *(const f32x4*)sl;
#pragma unroll
                    for (int s = 1; s < CTX_SPLIT; ++s) a += *(const f32x4*)(sl + (size_t)s * MC * D);
                    o[j] = a; }
                else { const v2u t = __builtin_nontemporal_load((const v2u*)(O + (size_t)r * D + 256 * j + 4 * lane_)); o[j] = (f32x4){bflo(t.x), bfhi(t.x), bflo(t.y), bfhi(t.y)}; }
                ss += (o[j][0] * o[j][0] + o[j][1] * o[j][1]) + (o[j][2] * o[j][2] + o[j][3] * o[j][3]); }
            const float rstd = 1.0f / sqrtf(wave_sum(ss, lane_) * (1.0f / D) + EPS);
#pragma unroll
            for (int j = 0; j < 8; ++j) h[j] = h[j] + rstd * (cf[j] * o[j]);
            if (r < MX) {
                if (MODE == 3) {
#pragma unroll
                    for (int j = 0; j < 8; ++j) __builtin_nontemporal_store(h[j], (f32x4*)(F.out + (size_t)r * D + 256 * j + 4 * lane_));
                } else {
                    bf16* so = (bf16*)(F.ws + WS_STREAM) + (size_t)r * D;
#pragma unroll
                    for (int j = 0; j < 8; ++j) { v2u w; w.x = cvt_pk_bf16(h[j][0], h[j][1]); w.y = cvt_pk_bf16(h[j][2], h[j][3]); *(v2u*)(so + 256 * j + 4 * lane_) = w;
                        h[j] = (f32x4){bflo(w.x), bfhi(w.x), bflo(w.y), bfhi(w.y)}; }
                }
            }
        }
        if (MODE <= 2) {
            float ss = 0.f;
#pragma unroll
            for (int j = 0; j < 8; ++j) ss += (h[j][0] * h[j][0] + h[j][1] * h[j][1]) + (h[j][2] * h[j][2] + h[j][3] * h[j][3]);
            const float rstd = 1.0f / sqrtf(wave_sum(ss, lane_) * (1.0f / D) + EPS);
#pragma unroll
            for (int j = 0; j < 8; ++j) { const f32x4 v = (h[j] * rstd) * gsv[j] + shv[j];
                v2u w; w.x = cvt_pk_bf16(v[0], v[1]); w.y = cvt_pk_bf16(v[2], v[3]);
                *(v2u*)(A + (size_t)r * D + 256 * j + 4 * lane_) = w; }
        }
    }
}

#ifndef ROWS_PF
#define ROWS_PF 13
#endif
#define RW_LD16NT(dst, ptr) asm volatile("global_load_dwordx4 %0, %1, off nt" : "=v"(dst) : "v"(ptr) : "memory")
#define RW_LD8NT(dst, ptr) asm volatile("global_load_dwordx2 %0, %1, off nt" : "=v"(dst) : "v"(ptr) : "memory")
#define RW_WAIT8(n, R) asm volatile("s_waitcnt vmcnt(" #n ")" : "+v"(R[0]), "+v"(R[1]), "+v"(R[2]), "+v"(R[3]), "+v"(R[4]), "+v"(R[5]), "+v"(R[6]), "+v"(R[7]) :: "memory")
template <int MODE>
__device__ __forceinline__ void phase_rows(Frame& F0, const Args& args) {
    Frame& F = F0; int lane_ = lane_id(); asm volatile("" : "+v"(lane_));
    const int gw = F.vcu * NWAVES + F.wave, NGW = F.G * NWAVES;
    const float* ADA = (const float*)(F.ws + WS_CTL + CTL_ADA);
    const float* adab = FIN(5); const float* ng = FIN(6);
    const float* MV = (const float*)(F.ws + WS_TAB + TAB_MODV);
    const bf16* O = (const bf16*)(F.ws + WS_OBUF);
    bf16* A = (bf16*)(F.ws + WS_ABUF);
    const float* xin = FIN(0); const float* cin = FIN(2);
    const int nrows = (MODE == 0) ? MT : MX;
    constexpr int ipost = MODE >= 1 ? MODE - 1 : 0, ipre = MODE <= 2 ? MODE : 0;
    f32x4 cf[8], gsv[8], shv[8];
    f32x4 HA[8], HB[8]; v2u hA[8], hB[8], OA[8], OB[8];
#define RW_ISSUE(r_, HS, hS, OS) do { \
        if (MODE <= 1) { const float* src_ = (r_) < MX ? xin + (size_t)(r_) * D : cin + (size_t)((r_) - MX) * D; \
            _Pragma("unroll") for (int j = 0; j < 8; ++j) RW_LD16NT(HS[j], src_ + 256 * j + 4 * lane_); } \
        else { const bf16* src_ = (const bf16*)(F.ws + WS_STREAM) + (size_t)(r_) * D; \
            _Pragma("unroll") for (int j = 0; j < 8; ++j) RW_LD8NT(hS[j], src_ + 256 * j + 4 * lane_); } \
        if (MODE >= 1) { _Pragma("unroll") for (int j = 0; j < 8; ++j) RW_LD8NT(OS[j], O + (size_t)(r_) * D + 256 * j + 4 * lane_); }     \
    } while (0)
#define RW_WAIT(FIRST, HS, hS, OS) do { if (FIRST) { if (MODE <= 1) RW_WAIT8(0, HS); else RW_WAIT8(0, hS); if (MODE >= 1) RW_WAIT8(0, OS); } \
        else if (MODE == 2) { RW_WAIT8(16, hS); RW_WAIT8(16, OS); } \
        else { if (MODE <= 1) RW_WAIT8(8, HS); else RW_WAIT8(8, hS); if (MODE >= 1) RW_WAIT8(8, OS); } } while (0)
#define RW_VEC(av) do { \
        { \
            _Pragma("unroll") for (int j = 0; j < 8; ++j) { const int c = 256 * j + 4 * lane_; \
                if (MODE == 0) { const float* ada = ADA + (size_t)av * NADA;       \
                    shv[j] = *(const f32x4*)(ada + c) + *(const f32x4*)(adab + c); \
                    gsv[j] = *(const f32x4*)(ng + c) * (*(const f32x4*)(ada + D + c) + *(const f32x4*)(adab + D + c) + 1.0f); } \
                else { \
                    cf[j] = *(const f32x4*)(MV + (size_t)((0 * 3 + ipost) * 3 + av) * D + c); \
                    if (MODE <= 2) { gsv[j] = *(const f32x4*)(MV + (size_t)((1 * 3 + ipre) * 3 + av) * D + c); shv[j] = *(const f32x4*)(MV + (size_t)((2 * 3 + ipre) * 3 + av) * D + c); } } } \
        } } while (0)
#define RW_ROW(FIRST, r, HS, hS, OS, ISSUE_NEXT) do { \
        RW_WAIT(FIRST, HS, hS, OS); \
        ISSUE_NEXT; \
        f32x4 h[8]; \
        if (MODE <= 1) { _Pragma("unroll") for (int j = 0; j < 8; ++j) h[j] = HS[j]; } \
        else { _Pragma("unroll") for (int j = 0; j < 8; ++j) { const v2u t = hS[j]; h[j] = (f32x4){bflo(t.x), bfhi(t.x), bflo(t.y), bfhi(t.y)}; } } \
        if (MODE >= 1) { \
            {                                                    \
            {                                                    \
                float ss = 0.f; \
                _Pragma("unroll") for (int j = 0; j < 8; ++j) { const v2u t = OS[j]; const f32x4 o = {bflo(t.x), bfhi(t.x), bflo(t.y), bfhi(t.y)}; ss += (o[0] * o[0] + o[1] * o[1]) + (o[2] * o[2] + o[3] * o[3]); } \
                const float rstd = 1.0f / sqrtf(wave_sum(ss, lane_) * (1.0f / D) + EPS); \
                _Pragma("unroll") for (int j = 0; j < 8; ++j) { const v2u t = OS[j]; const f32x4 o = {bflo(t.x), bfhi(t.x), bflo(t.y), bfhi(t.y)}; h[j] = h[j] + rstd * (cf[j] * o); } \
            } } \
            {                                                    \
                if (MODE == 3) { \
                    _Pragma("unroll") for (int j = 0; j < 8; ++j) __builtin_nontemporal_store(h[j], (f32x4*)(F.out + (size_t)(r) * D + 256 * j + 4 * lane_)); \
                } else {                                            \
                    bf16* so = (bf16*)(F.ws + WS_STREAM) + (size_t)(r) * D; \
                    _Pragma("unroll") for (int j = 0; j < 8; ++j) { v2u w; w.x = cvt_pk_bf16(h[j][0], h[j][1]); w.y = cvt_pk_bf16(h[j][2], h[j][3]); *(v2u*)(so + 256 * j + 4 * lane_) = w;        \
                        h[j] = (f32x4){bflo(w.x), bfhi(w.x), bflo(w.y), bfhi(w.y)}; } \
                } \
            } \
        } \
        if (MODE <= 2) { \
            float ss = 0.f; \
            _Pragma("unroll") for (int j = 0; j < 8; ++j) ss += (h[j][0] * h[j][0] + h[j][1] * h[j][1]) + (h[j][2] * h[j][2] + h[j][3] * h[j][3]); \
            const float rstd = 1.0f / sqrtf(wave_sum(ss, lane_) * (1.0f / D) + EPS); \
            _Pragma("unroll") for (int j = 0; j < 8; ++j) { const f32x4 v = (h[j] * rstd) * gsv[j] + shv[j]; \
                v2u w; w.x = cvt_pk_bf16(v[0], v[1]); w.y = cvt_pk_bf16(v[2], v[3]); \
                *(v2u*)(A + (size_t)(r) * D + 256 * j + 4 * lane_) = w; } \
        } \
    } while (0)
    if (NGW != 2048) { phase_rows_old<MODE>(F0, args); return; }
    {
        const int r0 = gw, r1 = gw + 2048, r2 = gw + 4096, r3 = gw + 6144;
        RW_ISSUE(r0, HA, hA, OA);
        RW_VEC(0);
        RW_ROW(true, r0, HA, hA, OA, RW_ISSUE(r1, HB, hB, OB));
        RW_ROW(false, r1, HB, hB, OB, RW_ISSUE(r2, HA, hA, OA));
        RW_VEC(1);
        RW_ROW(false, r2, HA, hA, OA, RW_ISSUE(r3, HB, hB, OB));
        if (MODE == 0) {
            const int r4 = gw < MC ? gw + 8192 : r3;
            RW_ROW(false, r3, HB, hB, OB, RW_ISSUE(r4, HA, hA, OA));
            RW_WAIT(true, HA, hA, OA);
            if (gw < MC) { RW_VEC(2); RW_ROW(true, r4, HA, hA, OA, (void)0); }
        } else {
            RW_ROW(false, r3, HB, hB, OB, (void)0);
        }
    }
#undef RW_ISSUE
#undef RW_WAIT
#undef RW_ROW
#undef RW_VEC
    if (MODE == 1) {
        for (int rc = gw + ((MX - gw + NGW - 1) / NGW) * NGW; rc < MT; rc += NGW) {
            f32x4 h[8], o[8]; float ss = 0.f;
#pragma unroll
            for (int j = 0; j < 8; ++j) { const int c = 256 * j + 4 * lane_;
                cf[j] = *(const f32x4*)(MV + (size_t)((0 * 3 + ipost) * 3 + 2) * D + c); gsv[j] = *(const f32x4*)(MV + (size_t)((1 * 3 + ipre) * 3 + 2) * D + c); shv[j] = *(const f32x4*)(MV + (size_t)((2 * 3 + ipre) * 3 + 2) * D + c);
                h[j] = __builtin_nontemporal_load((const f32x4*)(cin + (size_t)(rc - MX) * D + c)); }
#pragma unroll
            for (int j = 0; j < 8; ++j) { const float* sl = (const float*)(F.ws + WS_SLAB) + (size_t)(rc - MX) * D + 256 * j + 4 * lane_; f32x4 a = *(const f32x4*)sl;
#pragma unroll
                for (int s = 1; s < CTX_SPLIT; ++s) a += *(const f32x4*)(sl + (size_t)s * MC * D);
                o[j] = a; ss += (a[0] * a[0] + a[1] * a[1]) + (a[2] * a[2] + a[3] * a[3]); }
            const float rstd = 1.0f / sqrtf(wave_sum(ss, lane_) * (1.0f / D) + EPS);
            float s2 = 0.f;
#pragma unroll
            for (int j = 0; j < 8; ++j) { h[j] = h[j] + rstd * (cf[j] * o[j]); s2 += (h[j][0] * h[j][0] + h[j][1] * h[j][1]) + (h[j][2] * h[j][2] + h[j][3] * h[j][3]); }
            const float rstd2 = 1.0f / sqrtf(wave_sum(s2, lane_) * (1.0f / D) + EPS);
#pragma unroll
            for (int j = 0; j < 8; ++j) { const f32x4 v = (h[j] * rstd2) * gsv[j] + shv[j];
                v2u w; w.x = cvt_pk_bf16(v[0], v[1]); w.y = cvt_pk_bf16(v[2], v[3]);
                *(v2u*)(A + (size_t)rc * D + 256 * j + 4 * lane_) = w; }
        }
    }
}

__device__ __forceinline__ void s5_tables1(Frame& F, const Args& args) {
    int lane_ = lane_id(); asm volatile("" : "+v"(lane_));
    const int gt = (F.vcu * NWAVES + F.wave) * 64 + lane_, NT = F.G * NWAVES * 64;
    const f32x2* APW = (const f32x2*)(F.ws + WS_S5APOW);
    const float* BRF = (const float*)(F.ws + WS_S5BRF);
    const float* cre = FIN(15); const float* cim = FIN(16);
    float* KT = (float*)(F.ws + WS_S5KT); bf16* WE = (bf16*)(F.ws + WS_S5WE); bf16* WY2 = (bf16*)(F.ws + WS_S5WY2);
    {
        const int fr = lane_ & 15, fq = lane_ >> 4, gwv = F.vcu * NWAVES + F.wave;
        for (int tile = gwv; tile < 64 * 2 * 16; tile += F.G * NWAVES) {
            const int k = tile & 15, dir = (tile >> 4) & 1, g = tile >> 5, dg = dir * 64 + g;
            const f32x2* ap = APW + (size_t)(dg * 17 + k) * 64; const float* cr = cre + (dg * 16 + fr) * 64; const float* ci = cim + (dg * 16 + fr) * 64;
            const float* br = BRF + (size_t)dg * 64 * 32 + 2 * fr;
            f32x4 acc = {0.f, 0.f, 0.f, 0.f};
            f32x2 bbv[16], av[16]; float crv[16], civ[16];
#pragma unroll
            for (int s4 = 0; s4 < 16; ++s4) { const int p = 4 * s4 + fq;
                bbv[s4] = *(const f32x2*)(br + p * 32); av[s4] = ap[p]; crv[s4] = cr[p]; civ[s4] = ci[p]; }
#pragma unroll
            for (int s4 = 0; s4 < 16; ++s4) {
                const float Gr = crv[s4] * av[s4][0] - civ[s4] * av[s4][1], Gi = crv[s4] * av[s4][1] + civ[s4] * av[s4][0];
                acc = __builtin_amdgcn_mfma_f32_16x16x4f32(bbv[s4][0], Gr, acc, 0, 0, 0);
                acc = __builtin_amdgcn_mfma_f32_16x16x4f32(-bbv[s4][1], Gi, acc, 0, 0, 0);
            }
            *(f32x4*)(KT + ((size_t)((g * 2 + dir) * 16 + k) * 16 + fr) * 16 + 4 * fq) = acc;
        }
    }
    for (int base = gt; base < 64 * 256 * 16; base += 2 * NT) {
        f32x2 a_[2]; f32x4 q_[2][8]; int idx_[2];
#pragma unroll
        for (int u = 0; u < 2; ++u) { const int idx = (base + u * NT < 64 * 256 * 16) ? base + u * NT : base; idx_[u] = idx;
            const int s = idx & 15, r = (idx >> 4) & 255, g = idx >> 12, dir = r >> 7, p = r & 63, dg = dir * 64 + g;
            a_[u] = APW[(size_t)(dg * 17 + (dir ? s : 15 - s)) * 64 + p];
            const f32x4* b4 = (const f32x4*)(BRF + (size_t)(dg * 64 + p) * 32);
#pragma unroll
            for (int j = 0; j < 8; ++j) q_[u][j] = b4[j]; }
#pragma unroll
        for (int u = 0; u < 2; ++u) { const int idx = idx_[u]; const int s = idx & 15, r = (idx >> 4) & 255, g = idx >> 12, part = (r >> 6) & 1; const float pr = a_[u][0], pi = a_[u][1];
            float v[16];
#pragma unroll
            for (int j = 0; j < 8; ++j) { const f32x4 q = q_[u][j]; v[2 * j] = part ? (pr * q[1] + pi * q[0]) : (pr * q[0] - pi * q[1]); v[2 * j + 1] = part ? (pr * q[3] + pi * q[2]) : (pr * q[2] - pi * q[3]); }
            bf16* o = WE + ((size_t)(g * 256 + r)) * 256 + s * 16;
            v4u w0, w1; w0.x = pk2(v[0], v[1]); w0.y = pk2(v[2], v[3]); w0.z = pk2(v[4], v[5]); w0.w = pk2(v[6], v[7]); w1.x = pk2(v[8], v[9]); w1.y = pk2(v[10], v[11]); w1.z = pk2(v[12], v[13]); w1.w = pk2(v[14], v[15]);
            *(v4u*)o = w0; *(v4u*)(o + 8) = w1; }
    }
    for (int base = gt; base < 64 * 256 * 32; base += 4 * NT) {
        f32x4 a_[4][4], cr_[4][2], ci_[4][2]; int idx_[4];
#pragma unroll
        for (int u = 0; u < 4; ++u) { const int idx = (base + u * NT < 64 * 256 * 32) ? base + u * NT : base; idx_[u] = idx;
            const int cb = idx & 31, row = (idx >> 5) & 255, g = idx >> 13, t = row >> 4, c = row & 15, col0 = 8 * cb, dir = col0 >> 7, p0 = col0 & 63, dg = dir * 64 + g;
            const f32x2* ap = APW + (size_t)(dg * 17 + (dir ? 16 - t : t + 1)) * 64 + p0; const float* cr = cre + (dg * 16 + c) * 64 + p0; const float* ci = cim + (dg * 16 + c) * 64 + p0;
#pragma unroll
            for (int j = 0; j < 4; ++j) a_[u][j] = *(const f32x4*)(ap + 2 * j);
            cr_[u][0] = *(const f32x4*)cr; cr_[u][1] = *(const f32x4*)(cr + 4); ci_[u][0] = *(const f32x4*)ci; ci_[u][1] = *(const f32x4*)(ci + 4); }
#pragma unroll
        for (int u = 0; u < 4; ++u) { const int idx = idx_[u]; const int cb = idx & 31, row = (idx >> 5) & 255, g = idx >> 13, col0 = 8 * cb, part = (col0 >> 6) & 1;
            float v[8];
#pragma unroll
            for (int j = 0; j < 8; ++j) { const float ar = a_[u][j >> 1][2 * (j & 1)], ai = a_[u][j >> 1][2 * (j & 1) + 1], Cr = cr_[u][j >> 2][j & 3], Ci = ci_[u][j >> 2][j & 3]; v[j] = part ? -(Cr * ai + Ci * ar) : (Cr * ar - Ci * ai); }
            v4u w; w.x = pk2(v[0], v[1]); w.y = pk2(v[2], v[3]); w.z = pk2(v[4], v[5]); w.w = pk2(v[6], v[7]);
            *(v4u*)(WY2 + ((size_t)(g * 256 + row)) * 256 + col0) = w; }
    }
}
__device__ __forceinline__ void s5_tables2(Frame& F, const Args& args) {
    int lane_ = lane_id(); asm volatile("" : "+v"(lane_));
    const int gt = (F.vcu * NWAVES + F.wave) * 64 + lane_, NT = F.G * NWAVES * 64;
    const float* KT = (const float*)(F.ws + WS_S5KT); bf16* WY1 = (bf16*)(F.ws + WS_S5WY1); const float* dskip = FIN(17);
    for (int idx = gt; idx < 64 * 256 * 16; idx += NT) {
        const int s = idx & 15, row = (idx >> 4) & 255, g = idx >> 12, t = row >> 4, c = row & 15;
        float v[16];
#pragma unroll
        for (int j = 0; j < 16; ++j) v[j] = 0.f;
        if (s <= t) { const f32x4* k4 = (const f32x4*)(KT + ((size_t)((g * 2 + 0) * 16 + (t - s)) * 16 + c) * 16);
#pragma unroll
            for (int j = 0; j < 4; ++j) { const f32x4 q = k4[j]; v[4 * j] += q[0]; v[4 * j + 1] += q[1]; v[4 * j + 2] += q[2]; v[4 * j + 3] += q[3]; } }
        if (s >= t) { const f32x4* k4 = (const f32x4*)(KT + ((size_t)((g * 2 + 1) * 16 + (s - t)) * 16 + c) * 16);
#pragma unroll
            for (int j = 0; j < 4; ++j) { const f32x4 q = k4[j]; v[4 * j] += q[0]; v[4 * j + 1] += q[1]; v[4 * j + 2] += q[2]; v[4 * j + 3] += q[3]; } }
        if (s == t) { const float dk = dskip[16 * g + c];
#pragma unroll
            for (int j = 0; j < 16; ++j) v[j] += (j == c) ? dk : 0.f; }
        bf16* o = WY1 + ((size_t)(g * 256 + row)) * 256 + s * 16;
        v4u w0, w1; w0.x = pk2(v[0], v[1]); w0.y = pk2(v[2], v[3]); w0.z = pk2(v[4], v[5]); w0.w = pk2(v[6], v[7]); w1.x = pk2(v[8], v[9]); w1.y = pk2(v[10], v[11]); w1.z = pk2(v[12], v[13]); w1.w = pk2(v[14], v[15]);
        *(v4u*)o = w0; *(v4u*)(o + 8) = w1;
    }
}
struct S5EOrder {
    const char* ZU; const char* WE; int G, c;
    __device__ __forceinline__ bool next(int i, pg8::Unit& u) const {
        const long L = (long)i * G + c; if (L >= 256) return false;
        const int bg = (int)L >> 1, rt = (int)L & 1, g = bg & 63;
        u = pg8::make_unit(ZU + ((size_t)(bg * S5_ROWS + 256 * rt)) * 512, WE + (size_t)g * 256 * 512, bg, rt, 0, 4, 0); return true;
    }
};
struct EpiS5E {
    bf16* E;
    __device__ __forceinline__ void operator()(const Acc& acc, const pg8::Unit& u, int wr, int wc, int fr0, int fq0) const {
        int fr = fr0, fq = fq0; asm volatile("" : "+v"(fr), "+v"(fq));
#pragma unroll
        for (int ai = 0; ai < 2; ++ai)
#pragma unroll
            for (int m = 0; m < 4; ++m) {
                const int crow = 256 * u.pn() + ai * 128 + wr * 64 + m * 16 + fr;
                if (crow < S5_ROWS) {
#pragma unroll
                    for (int bj = 0; bj < 2; ++bj) {
                        const f32x4 a = acc[ai][bj][m][0], b = acc[ai][bj][m][1];
                        v4u w; w.x = cvt_pk_bf16(a[0], a[1]); w.y = cvt_pk_bf16(a[2], a[3]); w.z = cvt_pk_bf16(b[0], b[1]); w.w = cvt_pk_bf16(b[2], b[3]);
                        *(v4u*)(E + ((size_t)(u.pm() * S5_ROWS + crow)) * 256 + bj * 128 + wc * 32 + 8 * fq) = w;
                    }
                }
            }
    }
};
struct S5YOrder {
    const char* ZU; const char* ZH; const char* WY1; const char* WY2; int G, c;
    __device__ __forceinline__ bool next(int i, pg8::Unit& u) const {
        const int bg = (i >> 1) * G + c, seg = i & 1; if (bg >= NB * 64) return false;
        const int g = bg & 63;
        const char* a = seg == 0 ? ZU + ((size_t)(bg * S5_ROWS)) * 512 : ZH + ((size_t)(bg * 256)) * 512;
        const char* b = (seg == 0 ? WY1 : WY2) + (size_t)g * 256 * 512;
        u = pg8::make_unit(a, b, bg, 0, 0, 4, seg == 0 ? 1 : 0); return true;
    }
};
struct EpiS5Y {
    bf16* AGLU;
    __device__ __forceinline__ void operator()(const Acc& acc, const pg8::Unit& u, int wr, int wc, int fr0, int fq0) const {
        int fr = fr0, fq = fq0; asm volatile("" : "+v"(fr), "+v"(fq));
        const int b_ = u.pm() >> 6, g = u.pm() & 63;
#pragma unroll
        for (int ai = 0; ai < 2; ++ai)
#pragma unroll
            for (int m = 0; m < 4; ++m) {
                const int chunk = ai * 128 + wr * 64 + m * 16 + fr;
#pragma unroll
                for (int bj = 0; bj < 2; ++bj) {
                    const int cc = bj * 128 + wc * 32 + 8 * fq, t = cc >> 4, c0 = cc & 15;
                    const f32x4 a = acc[ai][bj][m][0], b = acc[ai][bj][m][1];
                    v4u w; w.x = cvt_pk_bf16(gelu_tanh(a[0]), gelu_tanh(a[1])); w.y = cvt_pk_bf16(gelu_tanh(a[2]), gelu_tanh(a[3])); w.z = cvt_pk_bf16(gelu_tanh(b[0]), gelu_tanh(b[1])); w.w = cvt_pk_bf16(gelu_tanh(b[2]), gelu_tanh(b[3]));
                    *(v4u*)(AGLU + ((size_t)(b_ * SEQ + chunk * 16 + t)) * SW + 16 * g + c0) = w;
                }
            }
    }
};
__device__ __forceinline__ void s5_scan_bg(Frame& F, int bg, int tid) {
    const bf16* E = (const bf16*)(F.ws + WS_S5E); bf16* ZH = (bf16*)(F.ws + WS_S5ZH);
    LAS bf16* EL = (LAS bf16*)F.lds;
    { v4u ev[17];
      static_assert(S5_ROWS * 32 == 17 * NWAVES * 64, "E block pieces");
#pragma unroll
      for (int k = 0; k < 17; ++k) ev[k] = *(const v4u*)(E + (size_t)bg * S5_ROWS * 256 + (size_t)(tid + k * NWAVES * 64) * 8);
#pragma unroll
      for (int k = 0; k < 17; ++k) *(LAS v4u*)(EL + (tid + k * NWAVES * 64) * 8) = ev[k]; }
    __syncthreads();
    if (tid < 128) {
        const int dir = tid >> 6, p = tid & 63, g = bg & 63;
        float ar = ((const float*)(F.ws + WS_TAB + TAB_AR))[(dir * 64 + g) * 64 + p], ai = ((const float*)(F.ws + WS_TAB + TAB_AI))[(dir * 64 + g) * 64 + p];
#pragma unroll
        for (int k = 0; k < 4; ++k) { const float nr = ar * ar - ai * ai, ni = 2.f * ar * ai; ar = nr; ai = ni; }
        LAS bf16* col = EL + dir * 128 + p;
        float hr = 0.f, hi = 0.f;
        for (int k0 = 0; k0 < S5_ROWS; k0 += 16) {
            float er[16], ei[16], orr[16], oi[16];
#pragma unroll
            for (int j = 0; j < 16; ++j) { const int k = k0 + j, row = dir ? (S5_ROWS - 1 - k) : (k < 16 ? 256 + k : k - 16); er[j] = bflo((unsigned)col[row * 256]); ei[j] = bflo((unsigned)col[row * 256 + 64]); }
#pragma unroll
            for (int j = 0; j < 16; ++j) { orr[j] = hr; oi[j] = hi; const float nr = ar * hr - ai * hi + er[j], ni = ar * hi + ai * hr + ei[j]; hr = nr; hi = ni; }
#pragma unroll
            for (int j = 0; j < 16; ++j) { const int k = k0 + j, row = dir ? (S5_ROWS - 1 - k) : (k < 16 ? 256 + k : k - 16); col[row * 256] = (bf16)f2bf(orr[j]); col[row * 256 + 64] = (bf16)f2bf(oi[j]); }
        }
    }
    __syncthreads();
#pragma unroll
    for (int k = 0; k < 16; ++k) { const int i = tid + k * NWAVES * 64; *(v4u*)(ZH + (size_t)bg * 256 * 256 + (size_t)i * 8) = *(const LAS v4u*)(EL + i * 8); }
    __syncthreads();
}

constexpr int RS_PITCH = 136;
constexpr int RS_BUF = (128 + 32) * RS_PITCH * 2;
__device__ __forceinline__ void phase_rstate(Frame& F) {
    const bf16* KNL = (const bf16*)(F.ws + WS_K); const bf16* KNC = (const bf16*)(F.ws + WS_KFTC);
    const bf16* VT = (const bf16*)(F.ws + WS_VT); const bf16* VTC = (const bf16*)(F.ws + WS_VTC);
    bf16* SIN = (bf16*)(F.ws + WS_OBUF);
    const float* lg2 = (const float*)(F.ws + WS_TAB + TAB_LG2);
    const int lane0 = lane_id();
    const int w = F.wave;
    for (int unit = F.vcu; unit < NB * NH * 2 * 8; unit += F.G) {
        int lane = lane0; asm volatile("" : "+v"(lane));
        const int tid = w * 64 + lane, fr = lane & 15, fq = lane >> 4;
        const int sl = unit & 7, dir = (unit >> 3) & 1, h = (unit >> 4) & 7, b = unit >> 7;
        const float gC = __builtin_amdgcn_exp2f((float)CH * lg2[dir * 8 + h]);
        const int bh = b * NH + h;
        const bf16* kT = KNL; const bf16* kTc = KNC;
        const int prow = tid >> 4, pc = tid & 15;
        float vw[8];
#pragma unroll
        for (int jj = 0; jj < 8; ++jj) { const int j = 8 * pc + jj; vw[jj] = __builtin_amdgcn_exp2f((float)(dir ? j : CH - 1 - j) * lg2[dir * 8 + h]); }
        f32x4 st[2] = {{0.f, 0.f, 0.f, 0.f}, {0.f, 0.f, 0.f, 0.f}};
#define RS_ISSUE(k, R) do { const int kk_ = (k) < 34 ? (k) : 33; const bool cx_ = kk_ < 2;        \
            const int cc_ = dir ? (1 - kk_) : kk_, n_ = dir ? (33 - kk_) : (kk_ - 2); \
            const bf16* kb_ = cx_ ? kTc + (size_t)(b * LC + cc_ * CH) * 1024 + h * DK : kT + (size_t)(b * SEQ + n_ * CH) * 1024 + h * DK; \
            const bf16* vb_ = cx_ ? VTC + (size_t)(bh * DV + 32 * sl) * LC + cc_ * CH : VT + (size_t)(bh * DV + 32 * sl) * SEQ + n_ * CH; \
            const int ls_ = cx_ ? LC : SEQ; \
            _Pragma("unroll") for (int i_ = 0; i_ < 4; ++i_) R[i_] = *(const v4u*)(kb_ + (size_t)(prow + 32 * i_) * 1024 + pc * 8);     \
            R[4] = *(const v4u*)(vb_ + (size_t)prow * ls_ + pc * 8); } while (0)
#define RS_STEP(k, R) do { LAS bf16* buf_ = (LAS bf16*)(F.lds + ((k) & 1) * RS_BUF); \
            _Pragma("unroll") for (int i_ = 0; i_ < 4; ++i_) *(LAS v4u*)(buf_ + (prow + 32 * i_) * RS_PITCH + pc * 8) = R[i_]; \
            { v4u r_ = R[4]; v4u s_; asm volatile("" : "+v"(r_.x), "+v"(r_.y), "+v"(r_.z), "+v"(r_.w));       \
              s_.x = cvt_pk_bf16(bflo(r_.x) * vw[0], bfhi(r_.x) * vw[1]); s_.y = cvt_pk_bf16(bflo(r_.y) * vw[2], bfhi(r_.y) * vw[3]); s_.z = cvt_pk_bf16(bflo(r_.z) * vw[4], bfhi(r_.z) * vw[5]); s_.w = cvt_pk_bf16(bflo(r_.w) * vw[6], bfhi(r_.w) * vw[7]); \
              *(LAS v4u*)(buf_ + (128 + prow) * RS_PITCH + pc * 8) = s_; } } while (0)
#define RS_COMP(k, ST) do { const LAS bf16* buf_ = (const LAS bf16*)(F.lds + ((k) & 1) * RS_BUF); \
            const int n_ = dir ? (33 - (k)) : ((k) - 2); \
            if (ST) { _Pragma("unroll") for (int et = 0; et < 2; ++et) { v2u o; o.x = cvt_pk_bf16(st[et][0], st[et][1]); o.y = cvt_pk_bf16(st[et][2], st[et][3]); \
                *(v2u*)(SIN + ((((size_t)(bh * 2 + dir) * NCH + n_) * DV + 32 * sl + 16 * et + fr) * DK + 16 * w + 4 * fq)) = o; } } \
            bf16x8 kf_[4];                         \
            { const unsigned ta_ = (unsigned)(size_t)buf_ + (unsigned)((8 * fq + (fr >> 2)) * (RS_PITCH * 2) + (16 * w + 4 * (fr & 3)) * 2); v2u t0_, t1_, t2_, t3_, t4_, t5_, t6_, t7_; \
              asm volatile("ds_read_b64_tr_b16 %0, %8\n\tds_read_b64_tr_b16 %1, %8 offset:1088\n\tds_read_b64_tr_b16 %2, %8 offset:8704\n\tds_read_b64_tr_b16 %3, %8 offset:9792\n\t" \
                           "ds_read_b64_tr_b16 %4, %8 offset:17408\n\tds_read_b64_tr_b16 %5, %8 offset:18496\n\tds_read_b64_tr_b16 %6, %8 offset:26112\n\tds_read_b64_tr_b16 %7, %8 offset:27200\n\ts_waitcnt lgkmcnt(0)" \
                           : "=&v"(t0_), "=&v"(t1_), "=&v"(t2_), "=&v"(t3_), "=&v"(t4_), "=&v"(t5_), "=&v"(t6_), "=&v"(t7_) : "v"(ta_) : "memory"); \
              kf_[0] = __builtin_bit_cast(bf16x8, (v4u){t0_.x, t0_.y, t1_.x, t1_.y}); kf_[1] = __builtin_bit_cast(bf16x8, (v4u){t2_.x, t2_.y, t3_.x, t3_.y}); \
              kf_[2] = __builtin_bit_cast(bf16x8, (v4u){t4_.x, t4_.y, t5_.x, t5_.y}); kf_[3] = __builtin_bit_cast(bf16x8, (v4u){t6_.x, t6_.y, t7_.x, t7_.y}); } \
            _Pragma("unroll") for (int et = 0; et < 2; ++et) { f32x4 kv = {0.f, 0.f, 0.f, 0.f}; \
                _Pragma("unroll") for (int ks = 0; ks < 4; ++ks) { const bf16x8 vf_ = *(const LAS bf16x8*)(buf_ + (128 + 16 * et + fr) * RS_PITCH + 32 * ks + 8 * fq); kv = __builtin_amdgcn_mfma_f32_16x16x32_bf16(kf_[ks], vf_, kv, 0, 0, 0); } \
                st[et] = st[et] * gC + kv; } } while (0)
        v4u RA[5], RB[5], RC[5];
        RS_ISSUE(0, RA); RS_ISSUE(1, RB); RS_ISSUE(2, RC);
        RS_STEP(0, RA); __syncthreads(); RS_ISSUE(3, RA); RS_COMP(0, false);
        RS_STEP(1, RB); __syncthreads(); RS_ISSUE(4, RB); RS_COMP(1, false);
        for (int k = 2; k < 32; k += 3) {
            RS_STEP(k, RC); __syncthreads(); RS_ISSUE(k + 3, RC); RS_COMP(k, true);
            RS_STEP(k + 1, RA); __syncthreads(); RS_ISSUE(k + 4, RA); RS_COMP(k + 1, true);
            RS_STEP(k + 2, RB); __syncthreads(); RS_ISSUE(k + 5, RB); RS_COMP(k + 2, true);
        }
        RS_STEP(32, RC); __syncthreads(); RS_COMP(32, true);
        RS_STEP(33, RA); __syncthreads(); RS_COMP(33, true);
        __syncthreads();
#undef RS_ISSUE
#undef RS_STEP
#undef RS_COMP
    }
}

constexpr int RO_PITCH = 136;
constexpr int RO_SLOT = 256 * RO_PITCH * 2;
__device__ __forceinline__ void phase_rout(Frame& F, const int cid) {
    const bf16* Q = (const bf16*)(F.ws + WS_Q);
    const bf16* KN = (const bf16*)(F.ws + WS_K); const bf16* VT = (const bf16*)(F.ws + WS_VT);
    const bf16* SIN = (const bf16*)(F.ws + WS_OBUF);
    bf16* SG = (bf16*)(F.ws + WS_HBUF);
    const float* lg2 = (const float*)(F.ws + WS_TAB + TAB_LG2);
    LAS bf16* SA = (LAS bf16*)F.lds; LAS bf16* SB = (LAS bf16*)(F.lds + RO_SLOT);
    const int lane0 = lane_id();
    const int w = F.wave;
    const bool split13 = (F.G == 256);
    const int ufirst = split13 ? (cid < 128 ? cid : 128 + (cid - 128) * 3) : F.vcu, ucount = split13 ? (cid < 128 ? 1 : 3) : (NB * NH * NCH - 1 - F.vcu) / F.G + 1, ustep = split13 ? 1 : F.G;
    for (int ui = 0; ui < ucount; ++ui) {
        const int unit = ufirst + ui * ustep;
        int lane = lane0; asm volatile("" : "+v"(lane));
        const int tid = w * 64 + lane, fr = lane & 15, fq = lane >> 4;
        const int n = unit & 31, h = (unit >> 5) & 7, b = unit >> 8, bh = b * NH + h;
        const float lgf = lg2[h], lgb = lg2[8 + h];
        const int tok0 = b * SEQ + n * CH;
        const int i = 16 * w + fr;
        const size_t qoff = (size_t)(tok0 + i) * 1024 + h * DK;
        {
            v4u kr[4], vr[8];
#pragma unroll
            for (int it = 0; it < 4; ++it) { const int q = tid + 512 * it, j = q >> 4, pc = q & 15; kr[it] = __builtin_nontemporal_load((const v4u*)(KN + (size_t)(tok0 + j) * 1024 + h * DK + pc * 8)); }
#pragma unroll
            for (int it = 0; it < 8; ++it) { const int q = tid + 512 * it, e = q >> 4, pc = q & 15; vr[it] = __builtin_nontemporal_load((const v4u*)(VT + ((size_t)(bh * DV + e)) * SEQ + n * CH + pc * 8)); }
#pragma unroll
            for (int it = 0; it < 4; ++it) { const int q = tid + 512 * it, j = q >> 4, pc = q & 15; *(LAS v4u*)(SB + j * RO_PITCH + pc * 8) = kr[it]; }
#pragma unroll
            for (int it = 0; it < 8; ++it) { const int q = tid + 512 * it, e = q >> 4, pc = q & 15; *(LAS v4u*)(SA + e * RO_PITCH + pc * 8) = vr[it]; }
        }
        bf16x8 qf[4];
#pragma unroll
        for (int ks = 0; ks < 4; ++ks) qf[ks] = *(const bf16x8*)(Q + qoff + 32 * ks + 8 * fq);
        __syncthreads();
        f32x4 sc[8];
#pragma unroll
        for (int jt = 0; jt < 8; ++jt) {
            f32x4 a = {0.f, 0.f, 0.f, 0.f};
#pragma unroll
            for (int ks = 0; ks < 4; ++ks) { const bf16x8 kf = *(const LAS bf16x8*)(SB + (16 * jt + fr) * RO_PITCH + 32 * ks + 8 * fq); a = __builtin_amdgcn_mfma_f32_16x16x32_bf16(kf, qf[ks], a, 0, 0, 0); }
#pragma unroll
            for (int r = 0; r < 4; ++r) { const int j = 16 * jt + 4 * fq + r, df = i - j; a[r] *= df >= 0 ? __builtin_amdgcn_exp2f((float)df * lgf) : __builtin_amdgcn_exp2f((float)(-df) * lgb); }
            sc[jt] = a;
        }
        f32x4 o[16];
#pragma unroll
        for (int et = 0; et < 16; ++et) o[et] = (f32x4){0.f, 0.f, 0.f, 0.f};
#pragma unroll
        for (int ks = 0; ks < 4; ++ks) {
            v4u pw; pw.x = cvt_pk_bf16(sc[2 * ks][0], sc[2 * ks][1]); pw.y = cvt_pk_bf16(sc[2 * ks][2], sc[2 * ks][3]); pw.z = cvt_pk_bf16(sc[2 * ks + 1][0], sc[2 * ks + 1][1]); pw.w = cvt_pk_bf16(sc[2 * ks + 1][2], sc[2 * ks + 1][3]);
            const bf16x8 pf = __builtin_bit_cast(bf16x8, pw);
#pragma unroll
            for (int et = 0; et < 16; ++et) {
                const LAS bf16* vp = SA + (16 * et + fr) * RO_PITCH + 32 * ks + 4 * fq;
                const v2u lo = *(const LAS v2u*)vp, hi2 = *(const LAS v2u*)(vp + 16);
                v4u vw; vw.x = lo.x; vw.y = lo.y; vw.z = hi2.x; vw.w = hi2.y;
                o[et] = __builtin_amdgcn_mfma_f32_16x16x32_bf16(__builtin_bit_cast(bf16x8, vw), pf, o[et], 0, 0, 0);
            }
        }
        __syncthreads();
        {
            const bf16* sf = SIN + (((size_t)(bh * 2 + 0) * NCH + n) * DV) * DK; const bf16* sb = SIN + (((size_t)(bh * 2 + 1) * NCH + n) * DV) * DK;
            v4u fr_[8], br_[8];
#pragma unroll
            for (int it = 0; it < 8; ++it) { const int q = tid + 512 * it; fr_[it] = __builtin_nontemporal_load((const v4u*)(sf + (size_t)q * 8)); br_[it] = __builtin_nontemporal_load((const v4u*)(sb + (size_t)q * 8)); }
#pragma unroll
            for (int it = 0; it < 8; ++it) { const int q = tid + 512 * it, e = q >> 4, pc = q & 15; *(LAS v4u*)(SA + e * RO_PITCH + pc * 8) = fr_[it]; *(LAS v4u*)(SB + e * RO_PITCH + pc * 8) = br_[it]; }
        }
        bf16x8 qff[4], qbf[4];
        { const float wfq = __builtin_amdgcn_exp2f((float)(i + 1) * lgf), wbq = __builtin_amdgcn_exp2f((float)(CH - i) * lgb);
#pragma unroll
          for (int ks = 0; ks < 4; ++ks) { const v4u qw = __builtin_bit_cast(v4u, qf[ks]); v4u a, b2;
            a.x = cvt_pk_bf16(bflo(qw.x) * wfq, bfhi(qw.x) * wfq); a.y = cvt_pk_bf16(bflo(qw.y) * wfq, bfhi(qw.y) * wfq); a.z = cvt_pk_bf16(bflo(qw.z) * wfq, bfhi(qw.z) * wfq); a.w = cvt_pk_bf16(bflo(qw.w) * wfq, bfhi(qw.w) * wfq);
            b2.x = cvt_pk_bf16(bflo(qw.x) * wbq, bfhi(qw.x) * wbq); b2.y = cvt_pk_bf16(bflo(qw.y) * wbq, bfhi(qw.y) * wbq); b2.z = cvt_pk_bf16(bflo(qw.z) * wbq, bfhi(qw.z) * wbq); b2.w = cvt_pk_bf16(bflo(qw.w) * wbq, bfhi(qw.w) * wbq);
            qff[ks] = __builtin_bit_cast(bf16x8, a); qbf[ks] = __builtin_bit_cast(bf16x8, b2); } }
        __syncthreads();
#pragma unroll
        for (int ks = 0; ks < 4; ++ks)
#pragma unroll
            for (int et = 0; et < 16; ++et) {
                const bf16x8 s1 = *(const LAS bf16x8*)(SA + (16 * et + fr) * RO_PITCH + 32 * ks + 8 * fq), s2 = *(const LAS bf16x8*)(SB + (16 * et + fr) * RO_PITCH + 32 * ks + 8 * fq);
                o[et] = __builtin_amdgcn_mfma_f32_16x16x32_bf16(s1, qff[ks], o[et], 0, 0, 0);
                o[et] = __builtin_amdgcn_mfma_f32_16x16x32_bf16(s2, qbf[ks], o[et], 0, 0, 0);
            }
        float ss = 0.f;
#pragma unroll
        for (int et = 0; et < 16; ++et) ss += (o[et][0] * o[et][0] + o[et][1] * o[et][1]) + (o[et][2] * o[et][2] + o[et][3] * o[et][3]);
        ss += shfl_xor_l(ss, 16, lane); ss += shfl_xor_l(ss, 32, lane);
        const float rinv = 1.0f / sqrtf(ss * (1.0f / DV) + EPS);
        bf16* gp = SG + (size_t)(tok0 + i) * D + h * DV + 4 * fq;
#pragma unroll
        for (int et = 0; et < 16; ++et) { const v2u gg = __builtin_nontemporal_load((const v2u*)(gp + 16 * et));
            v2u ow; ow.x = cvt_pk_bf16(o[et][0] * rinv * bflo(gg.x), o[et][1] * rinv * bfhi(gg.x)); ow.y = cvt_pk_bf16(o[et][2] * rinv * bflo(gg.y), o[et][3] * rinv * bfhi(gg.y));
            *(v2u*)(gp + 16 * et) = ow; }
        __syncthreads();
    }
}

__global__ void __launch_bounds__(NWAVES * 64, 2) fwd_megakernel(Args args) {
    extern __shared__ __attribute__((aligned(16))) unsigned char lds[];
    Frame F;
    F.lds = (LAS unsigned char*)lds;
    F.MISC = (volatile LAS unsigned*)(F.lds + MISC_OFF);
    F.wave = __builtin_amdgcn_readfirstlane((int)threadIdx.x >> 6);
    F.G = gridDim.x; { const int bx = blockIdx.x; F.vcu = (F.G % 8 == 0) ? (bx % 8) * (F.G / 8) + bx / 8 : bx; }
    F.out = kargs()->out; F.ws = kargs()->ws; F.ctl = (unsigned*)(F.ws + WS_CTL);
    for (int u = (int)threadIdx.x; u < (LDS_BYTES - LDSCTL_OFF) / 4; u += NWAVES * 64) ((LAS unsigned*)(F.lds + LDSCTL_OFF))[u] = 0u;
    __syncthreads();
    XcdBarrier bar = xcd_barrier_post(F.ctl + CW_BAR, F.MISC + 8);
    unsigned char* ws = F.ws;
    const int G = F.G, cid = (int)blockIdx.x;
#define GRID_BAR() xcd_barrier(bar)

#ifndef PHM
#define PHM 0xFFFFF
#endif
#define PH(k) ((PHM >> (k)) & 1)
#ifndef REPM
#define REPM 0
#endif
#define NREP(k) (1 + ((REPM >> (k)) & 1))
#if PH(0)
    phase_prologue(F, args, true);
#if NREP(0) > 1
    phase_prologue(F, args, false);
#endif
#endif
    GRID_BAR();
#if PH(1)
#if (ROWS_PF >> 0) & 1
    phase_rows<0>(F, args);
#else
    phase_rows_old<0>(F, args);
#endif
#endif
    xcd_barrier_arrive(bar);
#if PH(1)
    build_modv(F, args);
    s5_tables1(F, args);
#endif
    xcd_barrier_wait(bar);
#if PH(2)
    {
        pg8::GridOrder S; S.init(ws + WS_ABUF, ws + WS_W1T, D, MT / 256, NFF / 256, G, cid);
        EpiSwiGLU E{(bf16*)(ws + WS_HBUF)};
        pg8::gemm_phase(F.lds, D, S, E, F.wave);
    }
    if (G == 256 && cid >= 256 - CV_G1_CUS) conv_range(F, 1, 0, CV_L1_G1, (cid - (256 - CV_G1_CUS)) * NWAVES + F.wave, CV_G1_CUS * NWAVES);
#if NREP(2) > 1
    {
        pg8::GridOrder S; S.init(ws + WS_ABUF, ws + WS_W1T, D, MT / 256, NFF / 256, G, cid);
        EpiSwiGLU E{(bf16*)(ws + WS_HBUF)};
        pg8::gemm_phase(F.lds, D, S, E, F.wave);
    }
#endif
#endif
    GRID_BAR();
#if PH(3)
    {
        Ffn1DownOrder S{(const char*)(ws + WS_HBUF), (const char*)(ws + WS_W2T), G, cid};
        EpiFfn1Down E{(bf16*)(ws + WS_OBUF), (float*)(ws + WS_SLAB)};
        pg8::gemm_phase(F.lds, DFF, S, E, F.wave);
    }
    if (G == 256 && cid >= 256 - CV_G2_CUS) conv_range(F, 1, CV_L1_G1, CV_L1_G1 + CV_L1_G2, (cid - (256 - CV_G2_CUS)) * NWAVES + F.wave, CV_G2_CUS * NWAVES);
#if NREP(3) > 1
    {
        pg8::GridOrder S; S.init(ws + WS_HBUF, ws + WS_W2T, DFF, MT / 256, D / 256, G, cid);
        EpiO16 E{(bf16*)(ws + WS_OBUF), D};
        pg8::gemm_phase(F.lds, DFF, S, E, F.wave);
    }
#endif
#endif
    GRID_BAR();
#if PH(4)
#if (ROWS_PF >> 1) & 1
    phase_rows<1>(F, args);
#else
    phase_rows_old<1>(F, args);
#endif
#endif
    xcd_barrier_arrive(bar);
#if PH(4)
    s5_tables2(F, args);
#endif
    xcd_barrier_wait(bar);
#if PH(5)
    {
        MixOrder S{(const char*)(ws + WS_ABUF), (const char*)(ws + WS_WMT), G, cid};
        EpiMix E{ws};
        pg8::gemm_phase(F.lds, D, S, E, F.wave);
    }
    if (G == 256 && cid >= 256 - CV_G3_CUS) conv_range(F, 2, 0, CV_L2_G3, (cid - (256 - CV_G3_CUS)) * NWAVES + F.wave, CV_G3_CUS * NWAVES);
#if NREP(5) > 1
    {
        MixOrder S{(const char*)(ws + WS_ABUF), (const char*)(ws + WS_WMT), G, cid};
        EpiMix E{ws};
        pg8::gemm_phase(F.lds, D, S, E, F.wave);
    }
#endif
#endif
    GRID_BAR();
#if PH(6)
    phase_rstate(F);
#if NREP(6) > 1
    phase_rstate(F);
#endif
#endif
#if PH(7)
    {
        S5EOrder S{(const char*)(ws + WS_US), (const char*)(ws + WS_S5WE), G, cid};
        EpiS5E E{(bf16*)(ws + WS_S5E)};
        pg8::gemm_phase(F.lds, 256, S, E, F.wave);
    }
#endif
    GRID_BAR();
#if PH(8)
    {
        int tid_ = F.wave * 64 + lane_id(); asm volatile("" : "+v"(tid_));
        for (int bg = cid; bg < NB * 64; bg += G) s5_scan_bg(F, bg, tid_);
        asm volatile("s_waitcnt vmcnt(0)" ::: "memory"); __syncthreads();
        S5YOrder S{(const char*)(ws + WS_US), (const char*)(ws + WS_S5ZH), (const char*)(ws + WS_S5WY1), (const char*)(ws + WS_S5WY2), G, cid};
        EpiS5Y E{(bf16*)(ws + WS_AGLU)};
        pg8::gemm_phase(F.lds, 256, S, E, F.wave);
    }
    phase_rout(F, cid);
#endif
    GRID_BAR();
#if PH(9)
    if (G == 256) {
        GluLocalOrder S; S.A = (const char*)(ws + WS_AGLU); S.B = (const char*)(ws + WS_WGT); S.T.init(ws + WS_HBUF, ws + WS_WPT, D, MX / 256, D / 256, G, cid);
        EpiGLU E{(const bf16*)(ws + WS_HBUF + 32 * MiB), (bf16*)(ws + WS_Q)};
        pg8::gemm_phase(F.lds, SW, S, E, F.wave);
    } else {
        pg8::GridOrder S; S.init(ws + WS_AGLU, ws + WS_WGT, SW, MX / 256, 2 * D / 256, G, cid);
        EpiGLU E{(const bf16*)(ws + WS_HBUF + 32 * MiB), (bf16*)(ws + WS_Q)};
        pg8::gemm_phase(F.lds, SW, S, E, F.wave);
    }
#if NREP(9) > 1
    {
        pg8::GridOrder S; S.init(ws + WS_AGLU, ws + WS_WGT, SW, MX / 256, 2 * D / 256, G, cid);
        EpiGLU E{(const bf16*)(ws + WS_HBUF + 32 * MiB), (bf16*)(ws + WS_Q)};
        pg8::gemm_phase(F.lds, SW, S, E, F.wave);
    }
#endif
#endif
    if (G != 256) GRID_BAR();
#if PH(10)
    {
        pg8::GridOrder S; S.init(ws + WS_HBUF, ws + WS_WPT, D, MX / 256, D / 256, G, cid);
        EpiMerge E{(const bf16*)(ws + WS_HBUF + 64 * MiB), (bf16*)(ws + WS_Q)};
        pg8::gemm_phase(F.lds, D, S, E, F.wave);
    }
#if NREP(10) > 1
    {
        pg8::GridOrder S; S.init(ws + WS_HBUF, ws + WS_WPT, D, MX / 256, D / 256, G, cid);
        EpiMerge E{(const bf16*)(ws + WS_HBUF + 64 * MiB), (bf16*)(ws + WS_Q)};
        pg8::gemm_phase(F.lds, D, S, E, F.wave);
    }
#endif
#endif
    GRID_BAR();
#if PH(11)
    {
        pg8::GridOrder S; S.init(ws + WS_Q, ws + WS_WOT, D, MX / 256, D / 256, G, cid);
        EpiO16 E{(bf16*)(ws + WS_OBUF), D};
        pg8::gemm_phase(F.lds, D, S, E, F.wave);
    }
#if NREP(11) > 1
    {
        pg8::GridOrder S; S.init(ws + WS_Q, ws + WS_WOT, D, MX / 256, D / 256, G, cid);
        EpiO16 E{(bf16*)(ws + WS_OBUF), D};
        pg8::gemm_phase(F.lds, D, S, E, F.wave);
    }
#endif
#endif
    GRID_BAR();
#if PH(12)
#if (ROWS_PF >> 2) & 1
    phase_rows<2>(F, args);
#else
    phase_rows_old<2>(F, args);
#endif
#if NREP(12) > 1
#if (ROWS_PF >> 2) & 1
    phase_rows<2>(F, args);
#else
    phase_rows_old<2>(F, args);
#endif
#endif
#endif
    GRID_BAR();
#if PH(13)
    {
        pg8::GridOrder S; S.init(ws + WS_ABUF, ws + WS_W3T, D, MX / 256, NFF / 256, G, cid);
        EpiSwiGLU E{(bf16*)(ws + WS_HBUF)};
        pg8::gemm_phase(F.lds, D, S, E, F.wave);
    }
    if (G == 256 && cid >= 256 - CV_G6_CUS) conv_range(F, 2, CV_I1, CV_N2, (cid - (256 - CV_G6_CUS)) * NWAVES + F.wave, CV_G6_CUS * NWAVES);
#if NREP(13) > 1
    {
        pg8::GridOrder S; S.init(ws + WS_ABUF, ws + WS_W3T, D, MX / 256, NFF / 256, G, cid);
        EpiSwiGLU E{(bf16*)(ws + WS_HBUF)};
        pg8::gemm_phase(F.lds, D, S, E, F.wave);
    }
#endif
#endif
    GRID_BAR();
    if (G == 256) {
        pg8::GridOrder S; S.init(ws + WS_HBUF, ws + WS_W4T, DFF, MX / 256, D / 256, G, cid);
        EpiFfn2DownFused E{(const bf16*)(ws + WS_STREAM), F.out, (float*)(ws + WS_CTL + CTL_ROWSQ), (const float*)(ws + WS_TAB + TAB_MODV) + (size_t)((0 * 3 + 2) * 3) * D, bar};
        pg8::gemm_phase(F.lds, DFF, S, E, F.wave);
    } else {
        {
            pg8::GridOrder S; S.init(ws + WS_HBUF, ws + WS_W4T, DFF, MX / 256, D / 256, G, cid);
            EpiO16 E{(bf16*)(ws + WS_OBUF), D};
            pg8::gemm_phase(F.lds, DFF, S, E, F.wave);
        }
        GRID_BAR();
        phase_rows_old<3>(F, args);
    }
}

extern "C" void kernel_launch(void* const* d_in, const int* in_sizes, int n_in, void* d_out, int out_size, void* d_ws, size_t ws_size, hipStream_t stream) {
    static int grid = 0;
    if (grid == 0) {
        if (n_in != 22 || in_sizes[0] != MX * D || out_size != MX * D || ws_size < WS_END) { fprintf(stderr, "kernel_launch: unexpected problem (n_in %d, in0 %d, out %d, ws %zu, need %zu)\n", n_in, n_in > 0 ? in_sizes[0] : -1, out_size, ws_size, (size_t)WS_END); grid = -1; return; }
        int dev = 0, cus = 0, per_cu = 0;
        if (hipGetDevice(&dev) != hipSuccess || hipDeviceGetAttribute(&cus, hipDeviceAttributeMultiprocessorCount, dev) != hipSuccess) { grid = -1; return; }
        if (hipFuncSetAttribute((const void*)fwd_megakernel, hipFuncAttributeMaxDynamicSharedMemorySize, LDS_BYTES) != hipSuccess) { fprintf(stderr, "kernel_launch: hipFuncSetAttribute failed\n"); grid = -1; return; }
        if (hipOccupancyMaxActiveBlocksPerMultiprocessor(&per_cu, (const void*)fwd_megakernel, NWAVES * 64, LDS_BYTES) != hipSuccess || per_cu < 1) { fprintf(stderr, "kernel_launch: occupancy query says %d blocks per CU\n", per_cu); grid = -1; (void)hipGetLastError(); return; }
        grid = cus;
    }
    if (grid < 0) return;
    if (hipMemsetAsync((char*)d_ws + WS_CTL, 0, CTL_ZERO_BYTES, stream) != hipSuccess) return;
    Args a{};
    for (int i = 0; i < 22; ++i) a.in[i] = (const float*)d_in[i];
    a.out = (float*)d_out; a.ws = (unsigned char*)d_ws;
    void* kargs[] = {&a};
    hipError_t e = hipLaunchCooperativeKernel((const void*)fwd_megakernel, dim3(grid), dim3(NWAVES * 64), kargs, LDS_BYTES, stream);
    if (e != hipSuccess) fprintf(stderr, "kernel_launch: cooperative launch failed: %s (grid %d)\n", hipGetErrorString(e), grid);
}
```
